# Optimizing an MI355X kernel written in HIP

```python
import math
import jax, jax.numpy as jnp
from jax import lax
import numpy as np

D_MODEL = 4096
BATCH = 2
SEQ = 4096
DEPTH = 4

ATTN_WIDTH = D_MODEL // 2
SSM_WIDTH = D_MODEL - ATTN_WIDTH
MIX_WIDTH = ATTN_WIDTH + SSM_WIDTH
DIFF_HEAD_DIM = 64
DIFF_V_DIM = 2 * DIFF_HEAD_DIM
N_HEADS = ATTN_WIDTH // DIFF_V_DIM
SSM_GROUP = 16
N_SSM_GROUPS = SSM_WIDTH // SSM_GROUP
SSM_STATE = 64
IN_WIDTH = 3 * ATTN_WIDTH + SSM_WIDTH
D_FF = 4 * D_MODEL
NUM_BUCKETS = 32
MAX_EXACT = 16
MAX_DISTANCE = 128
Q_BLOCK = 128
EPS = 1e-6
DT_MIN = 1e-3
DT_MAX = 1e-1

kernel_name = "hymba_diffattn_s5_hybrid"


def rmsnorm(x, g):
    xf = x.astype(jnp.float32)
    xf = xf * lax.rsqrt(jnp.mean(xf * xf, axis=-1, keepdims=True) + EPS)
    return (xf * g.astype(jnp.float32)).astype(x.dtype)


def t5_bucket(rel):
    n = jnp.maximum(rel, 0)
    is_small = n < MAX_EXACT
    nf = jnp.maximum(n, 1).astype(jnp.float32)
    large = MAX_EXACT + (jnp.log(nf / MAX_EXACT) / math.log(MAX_DISTANCE / MAX_EXACT)
                         * (NUM_BUCKETS - MAX_EXACT)).astype(jnp.int32)
    large = jnp.minimum(large, NUM_BUCKETS - 1)
    return jnp.where(is_small, n, large)


def diff_attention(qkv, rel_bias, lq1, lk1, lq2, lk2, gain, lam_init):
    B, S, _ = qkv.shape
    q = qkv[..., :ATTN_WIDTH].reshape(B, S, N_HEADS, 2, DIFF_HEAD_DIM)
    k = qkv[..., ATTN_WIDTH:2 * ATTN_WIDTH].reshape(B, S, N_HEADS, 2, DIFF_HEAD_DIM)
    v = qkv[..., 2 * ATTN_WIDTH:].reshape(B, S, N_HEADS, DIFF_V_DIM)
    q1, q2 = q[..., 0, :], q[..., 1, :]
    k1, k2 = k[..., 0, :], k[..., 1, :]
    lam = (jnp.exp(jnp.sum(lq1.astype(jnp.float32) * lk1.astype(jnp.float32)))
           - jnp.exp(jnp.sum(lq2.astype(jnp.float32) * lk2.astype(jnp.float32)))
           + lam_init)
    scale = DIFF_HEAD_DIM ** -0.5
    nb = S // Q_BLOCK
    kpos = jnp.arange(S)

    def to_blocks(t):
        return t.reshape(B, nb, Q_BLOCK, N_HEADS, DIFF_HEAD_DIM).transpose(1, 0, 2, 3, 4)

    def block(args):
        q1b, q2b, i = args
        qpos = i * Q_BLOCK + jnp.arange(Q_BLOCK)
        rel = qpos[:, None] - kpos[None, :]
        bias = rel_bias[t5_bucket(rel)].transpose(2, 0, 1).astype(jnp.float32)
        mask = rel >= 0

        def probs(qb, kk):
            s = jnp.einsum('bqhd,bkhd->bhqk', qb, kk).astype(jnp.float32) * scale + bias
            s = jnp.where(mask, s, -jnp.inf)
            return jax.nn.softmax(s, axis=-1)

        a = probs(q1b, k1) - lam * probs(q2b, k2)
        return jnp.einsum('bhqk,bkhe->bqhe', a.astype(v.dtype), v)

    o = lax.map(block, (to_blocks(q1), to_blocks(q2), jnp.arange(nb)))
    o = o.transpose(1, 0, 2, 3, 4).reshape(B, S, N_HEADS, DIFF_V_DIM)
    o = rmsnorm(o, gain) * (1.0 - lam_init)
    return o.reshape(B, S, ATTN_WIDTH)


def _scan_combine(e1, e2):
    a1r, a1i, b1r, b1i = e1
    a2r, a2i, b2r, b2i = e2
    ar = a2r * a1r - a2i * a1i
    ai = a2r * a1i + a2i * a1r
    br = a2r * b1r - a2i * b1i + b2r
    bi = a2r * b1i + a2i * b1r + b2i
    return (ar, ai, br, bi)


def s5_layer(u, lam_re, lam_im, log_dt, b_re, b_im, c_re, c_im, d, w_glu, b_glu):
    B, S, _ = u.shape
    f32 = jnp.float32
    uf = u.astype(f32).reshape(B, S, N_SSM_GROUPS, SSM_GROUP)
    dt = jnp.exp(log_dt.astype(f32))[:, None]
    lr, li = lam_re.astype(f32), lam_im.astype(f32)
    mag = jnp.exp(lr * dt)
    ar, ai = mag * jnp.cos(li * dt), mag * jnp.sin(li * dt)
    den = lr * lr + li * li
    nr, ni = ar - 1.0, ai
    gr = (nr * lr + ni * li) / den
    gi = (ni * lr - nr * li) / den
    br_, bi_ = b_re.astype(f32), b_im.astype(f32)
    bbr = gr[..., None] * br_ - gi[..., None] * bi_
    bbi = gr[..., None] * bi_ + gi[..., None] * br_
    bu_r = jnp.einsum('bsgh,gph->bsgp', uf, bbr)
    bu_i = jnp.einsum('bsgh,gph->bsgp', uf, bbi)
    a_r = jnp.broadcast_to(ar, bu_r.shape)
    a_i = jnp.broadcast_to(ai, bu_i.shape)
    _, _, s_r, s_i = lax.associative_scan(_scan_combine, (a_r, a_i, bu_r, bu_i), axis=1)
    y = (jnp.einsum('ghp,bsgp->bsgh', c_re.astype(f32), s_r)
         - jnp.einsum('ghp,bsgp->bsgh', c_im.astype(f32), s_i)
         + d.astype(f32) * uf)
    y = jax.nn.gelu(y.reshape(B, S, SSM_WIDTH))
    y = y * jax.nn.sigmoid(y @ w_glu.astype(f32) + b_glu.astype(f32))
    return y.astype(u.dtype)


def setup_inputs(seed: int = 0) -> dict:
    key = jax.random.key(seed)
    ks = jax.random.split(key, 24)
    f32 = jnp.float32
    n = jnp.arange(SSM_STATE, dtype=f32)
    lam_re = -0.5 + 0.01 * jax.random.normal(ks[13], (DEPTH, N_SSM_GROUPS, SSM_STATE), f32)
    lam_im = math.pi * n + 0.01 * jax.random.normal(ks[14], (DEPTH, N_SSM_GROUPS, SSM_STATE), f32)
    log_dt = jax.random.uniform(ks[15], (DEPTH, N_SSM_GROUPS), f32,
                                math.log(DT_MIN), math.log(DT_MAX))
    b_scale = (2.0 * SSM_GROUP) ** -0.5
    c_scale = (2.0 * SSM_STATE) ** -0.5
    return {
        "x": jax.random.normal(ks[0], (BATCH, SEQ, D_MODEL), f32),
        "w_in": jax.random.normal(ks[1], (DEPTH, D_MODEL, IN_WIDTH), f32) * D_MODEL ** -0.5,
        "w_out": jax.random.normal(ks[2], (DEPTH, MIX_WIDTH, D_MODEL), f32) * MIX_WIDTH ** -0.5,
        "norm_mix": 1.0 + 0.02 * jax.random.normal(ks[3], (DEPTH, D_MODEL), f32),
        "norm_mlp": 1.0 + 0.02 * jax.random.normal(ks[4], (DEPTH, D_MODEL), f32),
        "w_up": jax.random.normal(ks[5], (DEPTH, D_MODEL, D_FF), f32) * D_MODEL ** -0.5,
        "w_down": jax.random.normal(ks[6], (DEPTH, D_FF, D_MODEL), f32) * D_FF ** -0.5,
        "norm_final": 1.0 + 0.02 * jax.random.normal(ks[7], (D_MODEL,), f32),
        "rel_bias": 0.5 * jax.random.normal(ks[8], (NUM_BUCKETS, N_HEADS), f32),
        "lambda_q1": 0.1 * jax.random.normal(ks[9], (DEPTH, DIFF_HEAD_DIM), f32),
        "lambda_k1": 0.1 * jax.random.normal(ks[10], (DEPTH, DIFF_HEAD_DIM), f32),
        "lambda_q2": 0.1 * jax.random.normal(ks[11], (DEPTH, DIFF_HEAD_DIM), f32),
        "lambda_k2": 0.1 * jax.random.normal(ks[12], (DEPTH, DIFF_HEAD_DIM), f32),
        "subln_gain": 1.0 + 0.02 * jax.random.normal(ks[16], (DEPTH, DIFF_V_DIM), f32),
        "ssm_lambda_re": lam_re,
        "ssm_lambda_im": lam_im,
        "ssm_log_dt": log_dt,
        "ssm_b_re": b_scale * jax.random.normal(ks[17], (DEPTH, N_SSM_GROUPS, SSM_STATE, SSM_GROUP), f32),
        "ssm_b_im": b_scale * jax.random.normal(ks[18], (DEPTH, N_SSM_GROUPS, SSM_STATE, SSM_GROUP), f32),
        "ssm_c_re": c_scale * jax.random.normal(ks[19], (DEPTH, N_SSM_GROUPS, SSM_GROUP, SSM_STATE), f32),
        "ssm_c_im": c_scale * jax.random.normal(ks[20], (DEPTH, N_SSM_GROUPS, SSM_GROUP, SSM_STATE), f32),
        "ssm_d": jax.random.normal(ks[21], (DEPTH, N_SSM_GROUPS, SSM_GROUP), f32),
        "w_glu": jax.random.normal(ks[22], (DEPTH, SSM_WIDTH, SSM_WIDTH), f32) * SSM_WIDTH ** -0.5,
        "b_glu": 0.02 * jax.random.normal(ks[23], (DEPTH, SSM_WIDTH), f32),
    }


def reference(x, w_in, w_out, norm_mix, norm_mlp, w_up, w_down, norm_final, rel_bias,
              lambda_q1, lambda_k1, lambda_q2, lambda_k2, subln_gain,
              ssm_lambda_re, ssm_lambda_im, ssm_log_dt, ssm_b_re, ssm_b_im,
              ssm_c_re, ssm_c_im, ssm_d, w_glu, b_glu):
    h = x
    for i in range(DEPTH):
        lam_init = 0.8 - 0.6 * math.exp(-0.3 * i)
        xn = rmsnorm(h, norm_mix[i])
        proj = xn @ w_in[i]
        attn = diff_attention(proj[..., :3 * ATTN_WIDTH], rel_bias,
                              lambda_q1[i], lambda_k1[i], lambda_q2[i], lambda_k2[i],
                              subln_gain[i], lam_init)
        ssm = s5_layer(proj[..., 3 * ATTN_WIDTH:], ssm_lambda_re[i], ssm_lambda_im[i],
                       ssm_log_dt[i], ssm_b_re[i], ssm_b_im[i], ssm_c_re[i], ssm_c_im[i],
                       ssm_d[i], w_glu[i], b_glu[i])
        h = h + jnp.concatenate([attn, ssm], axis=-1) @ w_out[i]
        xn = rmsnorm(h, norm_mlp[i])
        h = h + jnp.square(jax.nn.relu(xn @ w_up[i])) @ w_down[i]
    return rmsnorm(h, norm_final)
```

```cpp
#define MK_PER_PHASE 1
#include <hip/hip_runtime.h>
#include <cstdio>
#include <cstdint>
namespace pg8 {
#define PG8_LAS __attribute__((address_space(3)))
typedef unsigned short bf16_t;
typedef short bf16x8 __attribute__((ext_vector_type(8)));
typedef float f32x4 __attribute__((ext_vector_type(4)));
typedef unsigned u32x4 __attribute__((ext_vector_type(4)));
constexpr int BM = 256, BK = 64, HALF = 128, HTB = HALF * BK * 2  , STAGE_BYTES = 8 * HTB, NXCD = 8, WGM = 8;

__host__ __device__ __forceinline__ int lds_byte(int r, int c) { const int st = (r >> 4) * 2 + (c >> 5), rr = r & 15, cc = c & 31, ob = rr * 64 + cc * 2; return st * 1024 + (ob ^ (((ob >> 9) & 1) << 5)); }
__host__ __device__ __forceinline__ void stage_rc(int b, int& R, int& C) { const int st = b / 1024, sb = b % 1024, swz = sb ^ (((sb >> 9) & 1) << 5); R = (st >> 1) * 16 + swz / 64; C = (st & 1) * 32 + (swz % 64) / 2; }
__host__ __device__ __forceinline__ int perm32(int rho) { const int n = rho >> 4, i = rho & 15; return 8 * (i >> 2) + 4 * n + (i & 3); }

struct Unit { int pm, pn; };
struct Gemm { const bf16_t* A; const bf16_t* Bt; int M, N, K; };

struct StaticOrder {
    int nM, nN, nwg, G, c;
    __host__ __device__ void init(int M, int N, int G_, int c_) { nM = M / BM; nN = N / BM; nwg = nM * nN; G = G_; c = c_; }
    __host__ __device__ bool next(int i, Unit& u) const {
        const long L = (long)i * G + c; if (L >= nwg) return false;
        int wgid = (int)L; { const int q = nwg / NXCD, r = nwg % NXCD, xcd = wgid % NXCD, off = wgid / NXCD; wgid = (xcd < r ? xcd * (q + 1) : r * (q + 1) + (xcd - r) * q) + off; }
        const int nig = WGM * nN, gid = wgid / nig, fm = gid * WGM, gsz = (nM - fm) < WGM ? (nM - fm) : WGM;
        u.pm = fm + ((wgid % nig) % gsz); u.pn = (wgid % nig) / gsz; return true;
    }
    __device__ __forceinline__ void a_ready(const Unit&) const {}
    __device__ __forceinline__ void done(const Unit&) const {}
};

__device__ __forceinline__ unsigned cvt_pk_bf16(float lo, float hi) { unsigned r; asm volatile("v_cvt_pk_bf16_f32 %0, %1, %2" : "=v"(r) : "v"(lo), "v"(hi)); return r; }
typedef float f32x2 __attribute__((ext_vector_type(2)));
__device__ __forceinline__ f32x2 gelu_pk(f32x2 v) {
    const f32x2 av = __builtin_elementwise_abs(v), d = av * 0.2316418882f + 1.0f;
    f32x2 t; t.x = __builtin_amdgcn_rcpf(d.x); t.y = __builtin_amdgcn_rcpf(d.y);
    f32x2 q = t * 0.5307027145f + (-0.7265760135f); q = q * t + 0.7107068705f; q = q * t + (-0.142248368f); q = q * t + 0.127414796f; q = q * t;
    const f32x2 s = (v * v) * (-0.72134752044f);
    f32x2 e; e.x = __builtin_amdgcn_exp2f(s.x); e.y = __builtin_amdgcn_exp2f(s.y);
    const f32x2 m = v * (q * e), r = v - m;
    f32x2 o; o.x = v.x < 0.f ? m.x : r.x; o.y = v.y < 0.f ? m.y : r.y; return o;
}

template <int ACT  > struct EpiBf16 {
    static constexpr bool PERM = true, AFTER_DRAIN = false; static_assert(ACT == 0 || ACT == 1, "EpiBf16: ACT is 0 (none) or 1 (gelu_pk)");
    bf16_t* O; int ldc; const float* bias; int split_cols; size_t split_stride; float scale0;
    __device__ __forceinline__ void operator()(const f32x4 (&acc)[2][2][4][2], const Unit& u, int wr, int wc, int fr, int fq) const {
        const int row0 = u.pm * BM + wr * 64 + fr; int colt = u.pn * BM; bf16_t* base = O;
        float sc = 1.f; if (split_cols) { const int t = colt / split_cols; base += (size_t)t * split_stride; colt -= t * split_cols; if (t == 0) sc = scale0; }
        const int col0 = colt + wc * 32 + 8 * fq, bcol0 = u.pn * BM + wc * 32 + 8 * fq;
        f32x4 bv[2][2];
#pragma unroll
        for (int bj = 0; bj < 2; ++bj)
#pragma unroll
            for (int n = 0; n < 2; ++n) bv[bj][n] = bias ? *(const f32x4*)(bias + bcol0 + bj * HALF + 4 * n) : (f32x4){0.f, 0.f, 0.f, 0.f};
#pragma unroll
        for (int ai = 0; ai < 2; ++ai)
#pragma unroll
            for (int m = 0; m < 4; ++m) { bf16_t* rowp = base + (size_t)(row0 + ai * HALF + m * 16) * ldc + col0;
#pragma unroll
                for (int bj = 0; bj < 2; ++bj) { f32x4 v0 = acc[ai][bj][m][0] + bv[bj][0], v1 = acc[ai][bj][m][1] + bv[bj][1];
                    if (ACT == 1) { f32x2 a = gelu_pk((f32x2){v0[0], v0[1]}), b = gelu_pk((f32x2){v0[2], v0[3]}), c = gelu_pk((f32x2){v1[0], v1[1]}), d = gelu_pk((f32x2){v1[2], v1[3]});
                        v0 = (f32x4){a.x, a.y, b.x, b.y}; v1 = (f32x4){c.x, c.y, d.x, d.y}; }
                    v0 = v0 * sc; v1 = v1 * sc; u32x4 w; w.x = cvt_pk_bf16(v0[0], v0[1]); w.y = cvt_pk_bf16(v0[2], v0[3]); w.z = cvt_pk_bf16(v1[0], v1[1]); w.w = cvt_pk_bf16(v1[2], v1[3]);
                    *(u32x4*)(rowp + bj * HALF) = w; } }
    }
};

__device__ __forceinline__ u32x4 pack8(f32x4 v0, f32x4 v1) { u32x4 w; w.x = cvt_pk_bf16(v0[0], v0[1]); w.y = cvt_pk_bf16(v0[2], v0[3]); w.z = cvt_pk_bf16(v1[0], v1[1]); w.w = cvt_pk_bf16(v1[2], v1[3]); return w; }
__device__ __forceinline__ float bf_lo(unsigned w) { return __uint_as_float(w << 16); }
__device__ __forceinline__ float bf_hi(unsigned w) { return __uint_as_float(w & 0xffff0000u); }
constexpr float RMS_EPS = 1e-6f;
typedef unsigned long long ssq_t;
constexpr float SSQ_SCALE = 16777216.0f, SSQ_INV = 1.0f / (16777216.0f * 4096.0f);
__device__ __forceinline__ float rstd_of(const ssq_t* ssq, int row) { return 1.0f / sqrtf((float)ssq[row] * SSQ_INV + RMS_EPS); }
struct EpiProj {
    static constexpr bool PERM = true, AFTER_DRAIN = false;
    bf16_t* QKV; bf16_t* UT; const ssq_t* ssq; float c2;
    __device__ __forceinline__ void operator()(const f32x4 (&acc)[2][2][4][2], const Unit& u, int wr, int wc, int fr, int fq) const {
#ifndef STUB_EPIPROJ
        const int row0 = u.pm * BM + wr * 64 + fr, colt = u.pn * BM;
        const float sc = (colt < 2048) ? c2 : 1.f;
#pragma unroll
        for (int ai = 0; ai < 2; ++ai)
#pragma unroll
            for (int m = 0; m < 4; ++m) { const int row = row0 + ai * HALF + m * 16;
                const float rs = sc * rstd_of(ssq, row);
#pragma unroll
                for (int bj = 0; bj < 2; ++bj) { const int col = colt + bj * HALF + wc * 32 + 8 * fq;
                    const u32x4 w = pack8(acc[ai][bj][m][0] * rs, acc[ai][bj][m][1] * rs);
                    if (colt < 6144) *(u32x4*)(QKV + (size_t)row * 6144 + col) = w;
                    else { const int cu = col - 6144; *(u32x4*)(UT + ((size_t)(cu >> 4) * 8192 + row) * 16 + (cu & 15)) = w; } } }
#endif
    }
};
struct EpiUp {
    static constexpr bool PERM = true, AFTER_DRAIN = false;
    bf16_t* O; int ldc; const ssq_t* ssq;
    __device__ __forceinline__ void operator()(const f32x4 (&acc)[2][2][4][2], const Unit& u, int wr, int wc, int fr, int fq) const {
#ifndef STUB_EPIUP
        const int row0 = u.pm * BM + wr * 64 + fr, colt = u.pn * BM;
#pragma unroll
        for (int ai = 0; ai < 2; ++ai)
#pragma unroll
            for (int m = 0; m < 4; ++m) { const int row = row0 + ai * HALF + m * 16;
                const float rs = rstd_of(ssq, row);
#pragma unroll
                for (int bj = 0; bj < 2; ++bj) { const int col = colt + bj * HALF + wc * 32 + 8 * fq;
                    f32x4 v0 = acc[ai][bj][m][0] * rs, v1 = acc[ai][bj][m][1] * rs;
#pragma unroll
                    for (int e = 0; e < 4; ++e) { const float a = fmaxf(v0[e], 0.f), b = fmaxf(v1[e], 0.f); v0[e] = a * a; v1[e] = b * b; }
                    *(u32x4*)(O + (size_t)row * ldc + col) = pack8(v0, v1); } }
#endif
    }
};
struct EpiGlu {
    static constexpr bool PERM = true, AFTER_DRAIN = false;
    const bf16_t* YG; bf16_t* CAT; const float* bias;
    __device__ __forceinline__ void operator()(const f32x4 (&acc)[2][2][4][2], const Unit& u, int wr, int wc, int fr, int fq) const {
#ifndef STUB_EPIGLU
        const int row0 = u.pm * BM + wr * 64 + fr, colt = u.pn * BM;
        f32x4 bv[2][2];
#pragma unroll
        for (int bj = 0; bj < 2; ++bj)
#pragma unroll
            for (int n = 0; n < 2; ++n) bv[bj][n] = *(const f32x4*)(bias + colt + bj * HALF + wc * 32 + 8 * fq + 4 * n);
#pragma unroll
        for (int ai = 0; ai < 2; ++ai)
#pragma unroll
            for (int m = 0; m < 4; ++m) { const int row = row0 + ai * HALF + m * 16;
#pragma unroll
                for (int bj = 0; bj < 2; ++bj) { const int col = colt + bj * HALF + wc * 32 + 8 * fq;
                    const u32x4 yw = *(const u32x4*)(YG + (size_t)row * 2048 + col);
                    f32x4 v0 = acc[ai][bj][m][0] + bv[bj][0], v1 = acc[ai][bj][m][1] + bv[bj][1];
#pragma unroll
                    for (int e = 0; e < 4; ++e) { v0[e] = __builtin_amdgcn_rcpf(1.0f + __builtin_amdgcn_exp2f(-1.4426950408889634f * v0[e])); v1[e] = __builtin_amdgcn_rcpf(1.0f + __builtin_amdgcn_exp2f(-1.4426950408889634f * v1[e])); }
                    v0[0] *= bf_lo(yw.x); v0[1] *= bf_hi(yw.x); v0[2] *= bf_lo(yw.y); v0[3] *= bf_hi(yw.y);
                    v1[0] *= bf_lo(yw.z); v1[1] *= bf_hi(yw.z); v1[2] *= bf_lo(yw.w); v1[3] *= bf_hi(yw.w);
                    *(u32x4*)(CAT + (size_t)row * 4096 + 2048 + col) = pack8(v0, v1); }
                asm volatile("" ::: "memory"); }
#endif
    }
};
struct EpiRes {
    static constexpr bool PERM = true, AFTER_DRAIN = false;
    const float* base; float* H; bf16_t* HB; ssq_t* ssq_out;
    __device__ __forceinline__ void operator()(const f32x4 (&acc)[2][2][4][2], const Unit& u, int wr, int wc, int fr, int fq) const {
#ifndef STUB_EPIRES
        const int row0 = u.pm * BM + wr * 64 + fr, colt = u.pn * BM;
#pragma unroll
        for (int ai = 0; ai < 2; ++ai)
#pragma unroll
            for (int m = 0; m < 4; ++m) { const int row = row0 + ai * HALF + m * 16; float ss = 0.f;
#pragma unroll
                for (int bj = 0; bj < 2; ++bj) { const size_t off = (size_t)row * 4096 + colt + bj * HALF + wc * 32 + 8 * fq;
                    const f32x4 h0 = *(const f32x4*)(base + off) + acc[ai][bj][m][0], h1 = *(const f32x4*)(base + off + 4) + acc[ai][bj][m][1];
                    *(f32x4*)(H + off) = h0; *(f32x4*)(H + off + 4) = h1; *(u32x4*)(HB + off) = pack8(h0, h1);
                    ss += (h0[0] * h0[0] + h0[1] * h0[1]) + (h0[2] * h0[2] + h0[3] * h0[3]) + (h1[0] * h1[0] + h1[1] * h1[1]) + (h1[2] * h1[2] + h1[3] * h1[3]); }
                ss += __shfl_xor(ss, 16); ss += __shfl_xor(ss, 32);
                if (fq == 0) __hip_atomic_fetch_add(ssq_out + row, (ssq_t)(ss * SSQ_SCALE), __ATOMIC_RELAXED, __HIP_MEMORY_SCOPE_AGENT);
                asm volatile("" ::: "memory"); }
#endif
    }
};

template <class Epi, class Sched, bool ALIGN_EPI = false, bool SP2 = false>
__device__ __forceinline__ void gemm_phase(PG8_LAS unsigned char* lds, const Gemm g, const Sched& S, const Epi& E) {
    int tid_ = threadIdx.x; asm volatile("" : "+v"(tid_));
    const int tid = tid_, wid = __builtin_amdgcn_readfirstlane(tid >> 6), lane = tid & 63, wr = wid >> 2, wc = wid & 3, fr = lane & 15, fq = lane >> 4;
    const int K = g.K, nt = K / BK;
    unsigned voffA[2], voffB[2];
#pragma unroll
    for (int i = 0; i < 2; ++i) { int R, C; stage_rc(tid * 16 + i * 8192, R, C); const int Rb = Epi::PERM ? ((R & ~31) + perm32(R & 31)) : R;
        voffA[i] = (unsigned)(R * K + C) * 2u; voffB[i] = (unsigned)(Rb * K + C) * 2u; }
    const size_t kstep = (size_t)(BK * 2);
    const size_t hstep = (size_t)HALF * K * 2;
    const size_t tstep = 2 * hstep;
    const unsigned ldsw = (unsigned)wid * 1024u;
    const int aoff = lds_byte(wr * 64 + fr, fq * 8), boff = lds_byte(wc * 32 + fr, fq * 8);
#define PG8_SA(b, h) (((b) * 2 + (h)) * HTB)
#define PG8_SB(b, h) ((4 + (b) * 2 + (h)) * HTB)
#define PG8_STAGE(bufoff, gbase, voff) do { _Pragma("unroll") for (int _i = 0; _i < 2; ++_i) \
        __builtin_amdgcn_global_load_lds((const unsigned*)((const char*)(gbase) + (voff)[_i]), (PG8_LAS unsigned*)(lds + (bufoff) + ldsw + _i * 8192), 16, 0, 0); } while (0)
#define PG8_LDA(dst, b, h) do { _Pragma("unroll") for (int m = 0; m < 4; ++m) _Pragma("unroll") for (int k = 0; k < 2; ++k) dst[m][k] = *(const PG8_LAS bf16x8*)(lds + PG8_SA(b, h) + aoff + m * 2048 + k * 1024); } while (0)
#define PG8_LDB(dst, b, h) do { _Pragma("unroll") for (int n = 0; n < 2; ++n) _Pragma("unroll") for (int k = 0; k < 2; ++k) dst[n][k] = *(const PG8_LAS bf16x8*)(lds + PG8_SB(b, h) + boff + n * 2048 + k * 1024); } while (0)
#define PG8_MMA(ai, bj, At, Bt) do { __builtin_amdgcn_s_setprio(1); _Pragma("unroll") for (int m = 0; m < 4; ++m) _Pragma("unroll") for (int n = 0; n < 2; ++n) _Pragma("unroll") for (int k = 0; k < 2; ++k) \
        acc[ai][bj][m][n] = __builtin_amdgcn_mfma_f32_16x16x32_bf16(Bt[n][k], At[m][k], acc[ai][bj][m][n], 0, 0, 0); __builtin_amdgcn_s_setprio(0); } while (0)
#define PG8_WAIT_V(n) asm volatile("s_waitcnt vmcnt(" #n ")" ::: "memory")
#define PG8_WAIT_L(n) asm volatile("s_waitcnt lgkmcnt(" #n ")" ::: "memory")
#define PG8_BAR __builtin_amdgcn_s_barrier()
#define PG8_SCHED __builtin_amdgcn_sched_barrier(0)
    Unit cur, nxt; int ui = 0;
    if (!S.next(0, cur)) return;
    f32x4 acc[2][2][4][2];
#pragma unroll
    for (int a = 0; a < 2; ++a)
#pragma unroll
        for (int b = 0; b < 2; ++b)
#pragma unroll
            for (int m = 0; m < 4; ++m)
#pragma unroll
                for (int n = 0; n < 2; ++n) acc[a][b][m][n] = (f32x4){0.f, 0.f, 0.f, 0.f};
    bf16x8 At[4][2], B0[2][2], B1[2][2];
    const char* cA = (const char*)g.A + (size_t)cur.pm * tstep; const char* cB = (const char*)g.Bt + (size_t)cur.pn * tstep;
    S.a_ready(cur);
    if constexpr (SP2) {
        PG8_STAGE(PG8_SB(0, 0), cB, voffB); PG8_STAGE(PG8_SB(0, 1), cB + hstep, voffB); PG8_STAGE(PG8_SA(0, 0), cA, voffA); PG8_STAGE(PG8_SA(0, 1), cA + hstep, voffA);
        if (wr == 1) PG8_BAR;
        PG8_WAIT_V(2); PG8_BAR;
        PG8_STAGE(PG8_SB(1, 0), cB + kstep, voffB); PG8_STAGE(PG8_SA(1, 0), cA + kstep, voffA); PG8_STAGE(PG8_SB(1, 1), cB + hstep + kstep, voffB);
        PG8_WAIT_V(6); PG8_BAR;
    } else {
        PG8_STAGE(PG8_SB(0, 0), cB, voffB); PG8_STAGE(PG8_SA(0, 0), cA, voffA); PG8_STAGE(PG8_SB(0, 1), cB + hstep, voffB); PG8_STAGE(PG8_SA(0, 1), cA + hstep, voffA);
        if (wr == 1) PG8_BAR;
        PG8_WAIT_V(4); PG8_BAR;
        PG8_STAGE(PG8_SB(1, 0), cB + kstep, voffB); PG8_STAGE(PG8_SA(1, 0), cA + kstep, voffA); PG8_STAGE(PG8_SB(1, 1), cB + hstep + kstep, voffB);
        PG8_WAIT_V(6); PG8_BAR;
    }
    for (;;) {
        const bool has_next = S.next(ui + 1, nxt);
        const char* nA = has_next ? (const char*)g.A + (size_t)nxt.pm * tstep : cA; const char* nB = has_next ? (const char*)g.Bt + (size_t)nxt.pn * tstep : cB;
        for (int t = 0; t < nt; t += 2) {
            const bool last = (t == nt - 2);
            const char* a1 = cA + (size_t)(t + 1) * kstep;
            const char* a2 = last ? nA : cA + (size_t)(t + 2) * kstep; const char* b2 = last ? nB : cB + (size_t)(t + 2) * kstep;
            const char* a3 = a2 + kstep; const char* b3 = b2 + kstep;
            if (last && has_next) S.a_ready(nxt);
            if constexpr (SP2) {
            PG8_LDB(B0, 0, 0); PG8_LDB(B1, 0, 1); PG8_SCHED; PG8_LDA(At, 0, 0); PG8_STAGE(PG8_SA(1, 1), a1 + hstep, voffA);
            PG8_WAIT_V(8); PG8_WAIT_L(0); PG8_BAR; PG8_MMA(0, 0, At, B0); PG8_MMA(0, 1, At, B1); PG8_BAR; PG8_SCHED;
            PG8_LDA(At, 0, 1); PG8_STAGE(PG8_SB(0, 0), b2, voffB); PG8_STAGE(PG8_SB(0, 1), b2 + hstep, voffB); PG8_STAGE(PG8_SA(0, 0), a2, voffA);
            PG8_WAIT_V(8); PG8_WAIT_L(0); PG8_BAR; PG8_MMA(1, 0, At, B0); PG8_MMA(1, 1, At, B1); PG8_BAR; PG8_SCHED;
            PG8_LDB(B0, 1, 0); PG8_LDB(B1, 1, 1); PG8_SCHED; PG8_LDA(At, 1, 0); PG8_STAGE(PG8_SA(0, 1), a2 + hstep, voffA);
            PG8_WAIT_V(8); PG8_WAIT_L(0); PG8_BAR; PG8_MMA(0, 0, At, B0); PG8_MMA(0, 1, At, B1); PG8_BAR; PG8_SCHED;
            PG8_LDA(At, 1, 1); PG8_STAGE(PG8_SB(1, 0), b3, voffB); PG8_STAGE(PG8_SB(1, 1), b3 + hstep, voffB); PG8_STAGE(PG8_SA(1, 0), a3, voffA);
            PG8_WAIT_V(8); PG8_WAIT_L(0); PG8_BAR; PG8_MMA(1, 0, At, B0); PG8_MMA(1, 1, At, B1); PG8_BAR; PG8_SCHED;
            } else {
            PG8_LDB(B0, 0, 0); PG8_SCHED; PG8_LDA(At, 0, 0); PG8_STAGE(PG8_SA(1, 1), a1 + hstep, voffA);
            PG8_WAIT_L(8); PG8_BAR; PG8_WAIT_L(0); PG8_MMA(0, 0, At, B0); PG8_BAR; PG8_SCHED;
            PG8_LDB(B1, 0, 1); PG8_STAGE(PG8_SB(0, 0), b2, voffB);
            PG8_BAR; PG8_WAIT_L(0); PG8_MMA(0, 1, At, B1); PG8_BAR;
            PG8_LDA(At, 0, 1); PG8_STAGE(PG8_SA(0, 0), a2, voffA);
            PG8_BAR; PG8_WAIT_L(0); PG8_MMA(1, 0, At, B0); PG8_BAR; PG8_SCHED;
            PG8_STAGE(PG8_SB(0, 1), b2 + hstep, voffB);
            PG8_WAIT_V(6); PG8_BAR; PG8_MMA(1, 1, At, B1); PG8_BAR;
            PG8_LDB(B0, 1, 0); PG8_SCHED; PG8_LDA(At, 1, 0); PG8_STAGE(PG8_SA(0, 1), a2 + hstep, voffA);
            PG8_WAIT_L(8); PG8_BAR; PG8_WAIT_L(0); PG8_MMA(0, 0, At, B0); PG8_BAR; PG8_SCHED;
            PG8_LDB(B1, 1, 1); PG8_STAGE(PG8_SB(1, 0), b3, voffB);
            PG8_BAR; PG8_WAIT_L(0); PG8_MMA(0, 1, At, B1); PG8_BAR;
            PG8_LDA(At, 1, 1); PG8_STAGE(PG8_SA(1, 0), a3, voffA);
            PG8_BAR; PG8_WAIT_L(0); PG8_MMA(1, 0, At, B0); PG8_BAR; PG8_SCHED;
            PG8_STAGE(PG8_SB(1, 1), b3 + hstep, voffB);
            PG8_WAIT_V(6); PG8_BAR; PG8_MMA(1, 1, At, B1); PG8_BAR;
            }
        }
        if constexpr (ALIGN_EPI) { if (wr == 0) PG8_BAR; }
        if constexpr (!Epi::AFTER_DRAIN) { E(acc, cur, wr, wc, fr, fq); S.done(cur); }
        if (!has_next) break;
#pragma unroll
        for (int a = 0; a < 2; ++a)
#pragma unroll
            for (int b = 0; b < 2; ++b)
#pragma unroll
                for (int m = 0; m < 4; ++m)
#pragma unroll
                    for (int n = 0; n < 2; ++n) acc[a][b][m][n] = (f32x4){0.f, 0.f, 0.f, 0.f};
        cur = nxt; cA = nA; cB = nB; ++ui;
        if constexpr (ALIGN_EPI) { if (wr == 1) PG8_BAR; }
    }
    PG8_WAIT_V(0);
    if constexpr (!ALIGN_EPI) { if (wr == 0) PG8_BAR; }
    PG8_BAR;
    if constexpr (Epi::AFTER_DRAIN) { E.fused(acc, cur, wr, wc, fr, fq, lds, wid, lane); S.done(cur); }
#undef PG8_SA
#undef PG8_SB
#undef PG8_STAGE
#undef PG8_LDA
#undef PG8_LDB
#undef PG8_MMA
#undef PG8_WAIT_V
#undef PG8_WAIT_L
#undef PG8_BAR
#undef PG8_SCHED
}
}

#ifndef PG8_SP2
#define PG8_SP2 true
#endif
#ifndef PG8_ALIGN
#define PG8_ALIGN true
#endif
#include <hip/hip_bf16.h>
#include <cmath>
namespace attn_body {
using bf16=__hip_bfloat16;
using bf16x8=__attribute__((ext_vector_type(8)))short;
using s16x4=__attribute__((ext_vector_type(4)))short;
using f32x16=__attribute__((ext_vector_type(16)))float;
using u32x4=__attribute__((ext_vector_type(4)))unsigned;
constexpr int BATCH=2,NHEAD=16,SEQ=4096,D=64,DM=6144;
constexpr int OPITCH=4096;
constexpr int NW=8,QBLK=32,QB=QBLK*NW,KVBLK=64,NQB=SEQ/QB;
constexpr int ATTN_PITCH=DM, ATTN_UNIT_ROWS=QB;
__device__ __forceinline__ int crow(int r,int hi){return (r&3)+8*(r>>2)+4*hi;}
#define SBAR() __builtin_amdgcn_sched_barrier(0)
__device__ __forceinline__ void cmask(f32x16&p0,f32x16&p1,int jb,int qrel,int hi){
  const float NEG=-INFINITY; int kb=64*jb+4*hi;
  #pragma unroll
  for(int r=0;r<16;++r){int kv=kb+(r&3)+8*(r>>2); if(kv>qrel)p0[r]=NEG; if(kv+32>qrel)p1[r]=NEG;}
}

__device__ __forceinline__ int t5_bucket(int n){ if(n<16)return n; const int st[15]={19,21,24,27,31,35,40,46,52,59,67,77,87,99,113}; int b=16;
  #pragma unroll
  for(int i=0;i<15;++i)b+=(n>=st[i])?1:0; return b; }
typedef const __attribute__((address_space(3))) float* lds_cfptr;
__device__ __forceinline__ void bmask(f32x16&p0,f32x16&p1,int jb,int qrel,int hi,lds_cfptr lut){
  const float NEG=-INFINITY; const int base=qrel-64*jb-4*hi;
  #pragma unroll
  for(int r=0;r<16;++r){const int n0=base-((r&3)+8*(r>>2)),n1=n0-32;
    const float b0=lut[n0<0?0:(n0>128?128:n0)],b1=lut[n1<0?0:(n1>128?128:n1)];
    p0[r]=(n0<0)?NEG:p0[r]+b0; p1[r]=(n1<0)?NEG:p1[r]+b1;}
}
constexpr int NSLOT=3, SLOTB=8192;
constexpr int LDS_K=0, LDS_V=NSLOT*SLOTB, LDS_WS=2*NSLOT*SLOTB, LDS_OST=LDS_WS+NW*64*4, LDS_LUT=LDS_OST+NW*4096, LDS_BYTES=LDS_LUT+1024;
constexpr float C2=0.125f*1.4426950408889634f;
__device__ __forceinline__ void glds16(const void*gsrc,unsigned lds_dst){unsigned keep;
  asm volatile("s_mov_b32 %0, m0\n\ts_mov_b32 m0, %2\n\ts_nop 0\n\tglobal_load_lds_dwordx4 %1, off\n\ts_mov_b32 m0, %0":"=&s"(keep):"v"(gsrc),"s"(lds_dst):"memory");}
__device__ __forceinline__ float max3f(float a,float b,float c){float r;asm("v_max3_f32 %0, %1, %2, %3":"=v"(r):"v"(a),"v"(b),"v"(c));return r;}
__device__ __forceinline__ float max2f(float a,float b){float r;asm("v_max_f32_e32 %0, %1, %2":"=v"(r):"v"(a),"v"(b));return r;}
__device__ __forceinline__ float fadd_s(float a,float b){float r;asm("v_add_f32_e32 %0, %1, %2":"=v"(r):"v"(a),"v"(b));return r;}
__device__ __forceinline__ float fsub_s(float a,float b){float r;asm("v_sub_f32_e32 %0, %1, %2":"=v"(r):"v"(a),"v"(b));return r;}
typedef float f32x2_t __attribute__((ext_vector_type(2))); typedef __bf16 bf16x2_t __attribute__((ext_vector_type(2)));
__device__ __forceinline__ unsigned cvtpk_s(float lo,float hi){f32x2_t v={lo,hi};bf16x2_t b=__builtin_convertvector(v,bf16x2_t);return __builtin_bit_cast(unsigned,b);}
#define WAIT_BAR(N) asm volatile("s_waitcnt vmcnt(" #N ") lgkmcnt(0)\n\ts_barrier":::"memory")

__device__ __forceinline__ void qkt(f32x16&p0,f32x16&p1,const char*Kslot,const bf16x8*qr,const f32x16&negm,int r32,int hi){
  const char*kb=Kslot+hi*1024+r32*16;
  #pragma unroll
  for(int d0=0;d0<4;++d0){
    const bf16x8 b0=*reinterpret_cast<const bf16x8*>(kb+d0*2048);
    const bf16x8 b1=*reinterpret_cast<const bf16x8*>(kb+d0*2048+512);
    if(d0==0){p0=__builtin_amdgcn_mfma_f32_32x32x16_bf16(b0,qr[0],negm,0,0,0);p1=__builtin_amdgcn_mfma_f32_32x32x16_bf16(b1,qr[0],negm,0,0,0);}
    else{p0=__builtin_amdgcn_mfma_f32_32x32x16_bf16(b0,qr[d0],p0,0,0,0);p1=__builtin_amdgcn_mfma_f32_32x32x16_bf16(b1,qr[d0],p1,0,0,0);}}
}
typedef __attribute__((address_space(3))) const char* lds_cptr;
typedef short v4i16_t __attribute__((ext_vector_type(4)));
__device__ __forceinline__ void kload8(bf16x8*kf,lds_cptr kp){
  kf[0]=*(const __attribute__((address_space(3))) bf16x8*)(kp);      kf[1]=*(const __attribute__((address_space(3))) bf16x8*)(kp+512);
  kf[2]=*(const __attribute__((address_space(3))) bf16x8*)(kp+2048); kf[3]=*(const __attribute__((address_space(3))) bf16x8*)(kp+2560);
  kf[4]=*(const __attribute__((address_space(3))) bf16x8*)(kp+4096); kf[5]=*(const __attribute__((address_space(3))) bf16x8*)(kp+4608);
  kf[6]=*(const __attribute__((address_space(3))) bf16x8*)(kp+6144); kf[7]=*(const __attribute__((address_space(3))) bf16x8*)(kp+6656);
}
__device__ __forceinline__ void kload2(bf16x8*kf,lds_cptr kp,int j){ kf[2*j]=*(const __attribute__((address_space(3))) bf16x8*)(kp+j*2048); kf[2*j+1]=*(const __attribute__((address_space(3))) bf16x8*)(kp+j*2048+512); }
__device__ __forceinline__ s16x4 vtr(lds_cptr p){ return __builtin_bit_cast(s16x4,__builtin_amdgcn_ds_read_tr16_b64_v4i16((__attribute__((address_space(3))) v4i16_t*)p)); }
__device__ __forceinline__ float rowmax(const f32x16&p0,const f32x16&p1){
  float a=max3f(p0[0],p0[1],p1[0]),b=max3f(p0[2],p0[3],p1[1]);a=max3f(a,p1[2],p1[3]);
  #pragma unroll
  for(int r=4;r<16;r+=4){a=max3f(a,p0[r],p0[r+1]);b=max3f(b,p0[r+2],p0[r+3]);a=max3f(a,p1[r],p1[r+1]);b=max3f(b,p1[r+2],p1[r+3]);}
  const float m=max2f(a,b);
  auto rr=__builtin_amdgcn_permlane32_swap(__float_as_uint(m),__float_as_uint(m),false,false);
  return max2f(__uint_as_float(rr[0]),__uint_as_float(rr[1]));
}
__device__ __forceinline__ void pv(f32x16*o,int vb,bf16x8 pa0,bf16x8 pa1,bf16x8 pa2,bf16x8 pa3){
  #pragma unroll
  for(int d0=0;d0<2;++d0){s16x4 lo[4],hi[4];
    #pragma unroll
    for(int ks=0;ks<4;++ks){
      asm volatile("ds_read_b64_tr_b16 %0,%1 offset:%c2":"=&v"(lo[ks]):"v"(vb),"i"(d0*4096+ks*1024):"memory");
      asm volatile("ds_read_b64_tr_b16 %0,%1 offset:%c2":"=&v"(hi[ks]):"v"(vb),"i"(d0*4096+ks*1024+512):"memory");}
    asm volatile("s_waitcnt lgkmcnt(0)":::"memory");SBAR();
    #define PK(k) (bf16x8){lo[k][0],lo[k][1],lo[k][2],lo[k][3],hi[k][0],hi[k][1],hi[k][2],hi[k][3]}
    o[d0]=__builtin_amdgcn_mfma_f32_32x32x16_bf16(pa0,PK(0),o[d0],0,0,0);
    o[d0]=__builtin_amdgcn_mfma_f32_32x32x16_bf16(pa1,PK(1),o[d0],0,0,0);
    o[d0]=__builtin_amdgcn_mfma_f32_32x32x16_bf16(pa2,PK(2),o[d0],0,0,0);
    o[d0]=__builtin_amdgcn_mfma_f32_32x32x16_bf16(pa3,PK(3),o[d0],0,0,0);
    #undef PK
  }
}

#ifndef ATTN_STORE16
#define ATTN_STORE16(p,v) (*(u32x4*)(p)=(v))
#endif
struct UnitArgs { int kind; int qcol,kcol,vcol,ocol; const float* relb; float* scr; float lam,oscale; const float* gain; };
template<int THRL> __device__ __forceinline__ void attn_unit(int b,int h,int qb,const bf16*Q,const bf16*__restrict__ K,const bf16*__restrict__ V,bf16*O,char*shm,const UnitArgs&ua){
  int tid_=threadIdx.x; asm volatile("":"+v"(tid_)); const int tid=tid_,lane=tid&63,r32=lane&31,hi=lane>>5; const int wid=__builtin_amdgcn_readfirstlane(tid>>6);
  const long rowbase=(long)b*SEQ; const int q0=qb*QB;
  const bf16*Qw=Q+(rowbase+q0+wid*QBLK)*DM+ua.qcol;
  const bf16*Kh=K+rowbase*DM+ua.kcol,*Vh=V+rowbase*DM+ua.vcol;
  const unsigned lds0=(unsigned)(uintptr_t)shm;
  float*wsf=(float*)(shm+LDS_WS)+wid*64;
  const bf16*ksrc=Kh+(long)lane*DM+wid*8;
  const bf16*vsrc=Vh+(long)(16*(wid&3)+(lane>>2))*DM+(wid>>2)*32+(lane&3)*8;
  const unsigned kdst=lds0+LDS_K+wid*1024, vdst=lds0+LDS_V+wid*1024;
  #define DMA_K(t,slot) glds16(ksrc+(long)(t)*KVBLK*DM,(unsigned)__builtin_amdgcn_readfirstlane(kdst+(slot)))
  #define DMA_V(t,slot) glds16(vsrc+(long)(t)*KVBLK*DM,(unsigned)__builtin_amdgcn_readfirstlane(vdst+(slot)))
  const int vb0=(int)(lds0+LDS_V)+((lane>>4)&1)*32+(lane&3)*8+(4*hi+((lane&15)>>2))*64;
  const char*Kbase=shm+LDS_K; bf16x8 kf[8];
  const lds_cptr shm3=(lds_cptr)shm; const lds_cptr kp0=shm3+LDS_K+hi*1024+r32*16; const lds_cptr vp0=shm3+LDS_V+((lane>>4)&1)*32+(lane&3)*8+(4*hi+((lane&15)>>2))*64;
  const int NT=(q0+QB)/KVBLK;
  { __attribute__((address_space(3))) float* lw=(__attribute__((address_space(3))) float*)((__attribute__((address_space(3))) char*)shm+LDS_LUT);
    if(tid<129){ const int bk=t5_bucket(tid); lw[tid]=(ua.relb[bk*NHEAD+h]-ua.relb[31*NHEAD+h])*1.4426950408889634f; } }
  const lds_cfptr lutp=(lds_cfptr)((lds_cptr)shm+LDS_LUT);
  DMA_K(0,0);DMA_V(0,0);DMA_K(1,SLOTB);
  bf16x8 qr[4];
  #pragma unroll
  for(int d0=0;d0<4;++d0)qr[d0]=*reinterpret_cast<const bf16x8*>(&Qw[(long)r32*DM+d0*16+hi*8]);
  float mhat=0.f,l_reg=0.f;f32x16 o[2];o[0]=f32x16{};o[1]=f32x16{};f32x16 negm=f32x16{};asm volatile("":"+v"(negm));
  const int qrel=wid*QBLK+r32;
  #define CMASK(P0,P1,t) do{int jb_=(t)-(NT-4); if(jb_>=-2)bmask(P0,P1,jb_,qrel,hi,lutp);}while(0)
  bool resc=false;
  #define START(P0,P1) do{ const float rm=rowmax(P0,P1); resc=false; \
    { const float dl=rm; mhat=fadd_s(mhat,dl); \
      _Pragma("unroll") for(int r=0;r<16;++r){P0[r]=fsub_s(P0[r],dl);P1[r]=fsub_s(P1[r],dl);} \
      _Pragma("unroll") for(int r=0;r<16;++r)negm[r]=-mhat; asm volatile("":"+v"(negm)); } \
    _Pragma("unroll") for(int r=0;r<16;++r)P0[r]=__builtin_amdgcn_exp2f(P0[r]); }while(0)
  #define RESC() do{ if(resc){ asm volatile("s_waitcnt lgkmcnt(0)":::"memory"); \
      _Pragma("unroll") for(int d_=0;d_<2;++d_) _Pragma("unroll") for(int r=0;r<16;++r)o[d_][r]*=wsf[crow(r,hi)]; } }while(0)
  f32x16 pA0,pA1,pB0,pB1;
  int sl_prev=0,sl_cur=0,sl_next=SLOTB;
  #define ROT() do{sl_prev=sl_cur;sl_cur=sl_next;sl_next=(sl_next==(NSLOT-1)*SLOTB)?0:sl_next+SLOTB;}while(0)
  DMA_K(2,2*SLOTB);
  WAIT_BAR(3);
  qkt(pA0,pA1,Kbase,qr,negm,r32,hi);asm volatile("s_nop 15\n\ts_nop 7":"+v"(pA0),"+v"(pA1));CMASK(pA0,pA1,0);
  START(pA0,pA1);
  _Pragma("unroll") for(int r=0;r<16;++r)pA1[r]=__builtin_amdgcn_exp2f(pA1[r]);
  WAIT_BAR(0);
  DMA_K(3,0);DMA_V(1,SLOTB);
  ROT();
  kload8(kf,kp0+sl_cur);
  WAIT_BAR(2);
  s16x4 vlo[8],vhi[8]; u32x4 pw0,pw1,pw2,pw3;
  #define PKW(P,B) cvtpk_s(P[B],P[B+1])
  #define PAF(k) __builtin_bit_cast(bf16x8,pw##k)
  #define VFR(i) (bf16x8){vlo[i][0],vlo[i][1],vlo[i][2],vlo[i][3],vhi[i][0],vhi[i][1],vhi[i][2],vhi[i][3]}
  #define PIN(x) asm volatile("":"+v"(x))
  #define MX3(a,b,c) __builtin_fmaxf(__builtin_fmaxf((a),(b)),(c))
  #define GAPA(MF,A0,A1,A2,A3,W0,W1,PW) do{ MF; sacc+=A0; sacc+=A1; sacc+=A2; sacc+=A3; PIN(sacc); W0; W1; PIN(PW); SBAR(); }while(0)
  #define EX(v) __builtin_amdgcn_exp2f(v)
  #define GAPB(MF,X,B) do{ MF; X[B]=EX(X[B]); X[B+1]=EX(X[B+1]); X[B+2]=EX(X[B+2]); X[B+3]=EX(X[B+3]); PIN(X); SBAR(); }while(0)
  #define VRD(i) do{ vlo[i]=vtr(vp_+(((i)>>2)*4096+((i)&3)*1024)); vhi[i]=vtr(vp_+(((i)>>2)*4096+((i)&3)*1024+512)); }while(0)
  #define KRD(G,j) do{ if(G){ kload2(kf,kp0+sl_next,j); SBAR(); } }while(0)
  #define STEP(C0,C1,P0,P1,t,GK,GV,GL) do{ SBAR(); \
    const lds_cptr vp_=vp0+sl_prev; \
    VRD(0); SBAR(); float sacc=(P0[0]+P0[1]); \
    GAPA(C0=__builtin_amdgcn_mfma_f32_32x32x16_bf16(kf[0],qr[0],negm,0,0,0), P0[2],P0[3],P0[4],P0[5],     pw0[0]=PKW(P0,0), pw0[1]=PKW(P0,2), pw0); \
    VRD(4); SBAR(); GAPA(C1=__builtin_amdgcn_mfma_f32_32x32x16_bf16(kf[1],qr[0],negm,0,0,0), P0[6],P0[7],P0[8],P0[9],     pw0[2]=PKW(P0,4), pw0[3]=PKW(P0,6), pw0); \
    VRD(1); SBAR(); GAPA(C0=__builtin_amdgcn_mfma_f32_32x32x16_bf16(kf[2],qr[1],C0,0,0,0),   P0[10],P0[11],P0[12],P0[13], pw1[0]=PKW(P0,8), pw1[1]=PKW(P0,10), pw1); \
    VRD(5); SBAR(); GAPA(C1=__builtin_amdgcn_mfma_f32_32x32x16_bf16(kf[3],qr[1],C1,0,0,0),   P0[14],P0[15],P1[0],P1[1],   pw1[2]=PKW(P0,12),pw1[3]=PKW(P0,14), pw1); \
    VRD(2); SBAR(); GAPA(C0=__builtin_amdgcn_mfma_f32_32x32x16_bf16(kf[4],qr[2],C0,0,0,0),   P1[2],P1[3],P1[4],P1[5],     pw2[0]=PKW(P1,0), pw2[1]=PKW(P1,2), pw2); \
    VRD(6); SBAR(); GAPA(C1=__builtin_amdgcn_mfma_f32_32x32x16_bf16(kf[5],qr[2],C1,0,0,0),   P1[6],P1[7],P1[8],P1[9],     pw2[2]=PKW(P1,4), pw2[3]=PKW(P1,6), pw2); \
    VRD(3); SBAR(); GAPA(C0=__builtin_amdgcn_mfma_f32_32x32x16_bf16(kf[6],qr[3],C0,0,0,0),   P1[10],P1[11],P1[12],P1[13], pw3[0]=PKW(P1,8), pw3[1]=PKW(P1,10), pw3); \
    VRD(7); SBAR(); GAPA(C1=__builtin_amdgcn_mfma_f32_32x32x16_bf16(kf[7],qr[3],C1,0,0,0),   P1[14],P1[15],0.f,0.f,       pw3[2]=PKW(P1,12),pw3[3]=PKW(P1,14), pw3); \
    l_reg+=sacc; \
    if(GK){DMA_K((t)+3,sl_cur);} if(GV){DMA_V((t)+1,sl_next);} \
    CMASK(C0,C1,t); \
    { float a=MX3(C0[0],C0[1],C1[0]),b=MX3(C0[2],C0[3],C1[1]); a=MX3(a,C1[2],C1[3]); \
      _Pragma("unroll") for(int r=4;r<16;r+=4){a=MX3(a,C0[r],C0[r+1]);b=MX3(b,C0[r+2],C0[r+3]);a=MX3(a,C1[r],C1[r+1]);b=MX3(b,C1[r+2],C1[r+3]);} \
      float rm=__builtin_fmaxf(a,b); { auto rr=__builtin_amdgcn_permlane32_swap(__float_as_uint(rm),__float_as_uint(rm),false,false); rm=__builtin_fmaxf(__uint_as_float(rr[0]),__uint_as_float(rr[1])); } \
      resc=false; \
      if(__builtin_expect(__any(rm>(float)THRL),0)){ const float dl=__builtin_fmaxf(rm,0.f); mhat+=dl; \
        _Pragma("unroll") for(int r=0;r<16;++r){C0[r]-=dl;C1[r]-=dl;} \
        _Pragma("unroll") for(int r=0;r<16;++r)negm[r]=-mhat; asm volatile("":"+v"(negm)); \
        const float f=__builtin_amdgcn_exp2f(-dl); l_reg*=f; if(hi==0)wsf[r32]=f; resc=true; } } \
    SBAR(); \
    GAPB(o[0]=__builtin_amdgcn_mfma_f32_32x32x16_bf16(PAF(0),VFR(0),o[0],0,0,0), C0,0); \
    GAPB(o[1]=__builtin_amdgcn_mfma_f32_32x32x16_bf16(PAF(0),VFR(4),o[1],0,0,0), C0,4); \
    KRD(GL,0); GAPB(o[0]=__builtin_amdgcn_mfma_f32_32x32x16_bf16(PAF(1),VFR(1),o[0],0,0,0), C0,8); \
    KRD(GL,1); GAPB(o[1]=__builtin_amdgcn_mfma_f32_32x32x16_bf16(PAF(1),VFR(5),o[1],0,0,0), C0,12); \
    KRD(GL,2); GAPB(o[0]=__builtin_amdgcn_mfma_f32_32x32x16_bf16(PAF(2),VFR(2),o[0],0,0,0), C1,0); \
    KRD(GL,3); GAPB(o[1]=__builtin_amdgcn_mfma_f32_32x32x16_bf16(PAF(2),VFR(6),o[1],0,0,0), C1,4); \
    GAPB(o[0]=__builtin_amdgcn_mfma_f32_32x32x16_bf16(PAF(3),VFR(3),o[0],0,0,0), C1,8); \
    GAPB(o[1]=__builtin_amdgcn_mfma_f32_32x32x16_bf16(PAF(3),VFR(7),o[1],0,0,0), C1,12); \
    }while(0)
  int t=1;
  #undef CMASK
  #define CMASK(P0,P1,t) do{}while(0)
  for(;t+7<NT;t+=2){
    STEP(pB0,pB1,pA0,pA1,t,true,true,true);     WAIT_BAR(2); RESC(); ROT();
    STEP(pA0,pA1,pB0,pB1,t+1,true,true,true);   WAIT_BAR(2); RESC(); ROT();
  }
  #undef CMASK
  #define CMASK(P0,P1,t) do{int jb_=(t)-(NT-4); if(jb_>=-2)bmask(P0,P1,jb_,qrel,hi,lutp);}while(0)
  #define ENDW(tt) do{ if((tt)+3<NT){WAIT_BAR(2);} else if((tt)+2<NT){WAIT_BAR(1);} else {WAIT_BAR(0);} }while(0)
  for(;t+1<NT;t+=2){
    STEP(pB0,pB1,pA0,pA1,t,(t+3<NT),(t+1<NT),(t+1<NT));       ENDW(t);   RESC(); ROT();
    STEP(pA0,pA1,pB0,pB1,t+1,(t+4<NT),(t+2<NT),(t+2<NT));     ENDW(t+1); RESC(); ROT();
  }
  STEP(pB0,pB1,pA0,pA1,NT-1,false,false,false); RESC();
  { float sacc=pB0[0]+pB0[1]; _Pragma("unroll") for(int r=2;r<16;++r)sacc+=pB0[r]; _Pragma("unroll") for(int r=0;r<16;++r)sacc+=pB1[r]; l_reg+=sacc;
    pw0=(u32x4){PKW(pB0,0),PKW(pB0,2),PKW(pB0,4),PKW(pB0,6)};pw1=(u32x4){PKW(pB0,8),PKW(pB0,10),PKW(pB0,12),PKW(pB0,14)};pw2=(u32x4){PKW(pB1,0),PKW(pB1,2),PKW(pB1,4),PKW(pB1,6)};pw3=(u32x4){PKW(pB1,8),PKW(pB1,10),PKW(pB1,12),PKW(pB1,14)};
    SBAR(); pv(o,vb0+sl_cur,PAF(0),PAF(1),PAF(2),PAF(3)); }
  #undef PKW
  #undef PAF
  #undef VFR
  #undef PIN
  #undef MX3
  #undef GAPA
  #undef GAPB
  #undef EX
  #undef VRD
  #undef KRD
  #undef STEP
  #undef ENDW
  {auto rr=__builtin_amdgcn_permlane32_swap(__float_as_uint(l_reg),__float_as_uint(l_reg),false,false);l_reg=__uint_as_float(rr[0])+__uint_as_float(rr[1]);}
  if(hi==0)wsf[32+r32]=l_reg;asm volatile("s_waitcnt lgkmcnt(0)":::"memory");
  float rli[16];
  #pragma unroll
  for(int r=0;r<16;++r)rli[r]=__builtin_amdgcn_rcpf(wsf[32+crow(r,hi)]);
  float*sc0=ua.scr,*sc1=ua.scr+QB*64;
  #define SIDX(r,d0) ((wid*QBLK+crow(r,hi))*64+(d0)*32+r32)
  if(ua.kind<2){ float*sd=(ua.kind==0)?sc0:sc1;
    #pragma unroll
    for(int r=0;r<16;++r){
      #pragma unroll
      for(int d0=0;d0<2;++d0)sd[SIDX(r,d0)]=o[d0][r]*rli[r];} }
  else if(ua.kind==2){
    #pragma unroll
    for(int r=0;r<16;++r){
      #pragma unroll
      for(int d0=0;d0<2;++d0){const int ix=SIDX(r,d0); const float a=o[d0][r]*rli[r]-ua.lam*__hip_atomic_load(sc0+ix,__ATOMIC_RELAXED,__HIP_MEMORY_SCOPE_AGENT); sc0[ix]=a;}} }
  else{
    f32x16 a0v[2]; float rs[16];
    #pragma unroll
    for(int r=0;r<16;++r){ float ss=0.f;
      #pragma unroll
      for(int d0=0;d0<2;++d0){const int ix=SIDX(r,d0); const float a1=o[d0][r]*rli[r]-ua.lam*__hip_atomic_load(sc1+ix,__ATOMIC_RELAXED,__HIP_MEMORY_SCOPE_AGENT); const float a0=__hip_atomic_load(sc0+ix,__ATOMIC_RELAXED,__HIP_MEMORY_SCOPE_AGENT); o[d0][r]=a1; a0v[d0][r]=a0; ss+=a0*a0+a1*a1;}
      ss+=__shfl_xor(ss,1); ss+=__shfl_xor(ss,2); ss+=__shfl_xor(ss,4); ss+=__shfl_xor(ss,8); ss+=__shfl_xor(ss,16);
      rs[r]=ua.oscale/sqrtf(ss*(1.0f/128.0f)+1e-6f); }
    bf16*Ow=O+(rowbase+q0+wid*QBLK)*OPITCH+ua.ocol;
    bf16*stg=(bf16*)(shm+LDS_OST)+wid*2048;
    #pragma unroll
    for(int vh=0;vh<2;++vh){
      const float g0=ua.gain[vh*64+r32],g1=ua.gain[vh*64+32+r32];
      #pragma unroll
      for(int r=0;r<16;++r){const int orow=crow(r,hi);
        stg[orow*64+r32]=__float2bfloat16((vh==0?a0v[0][r]:o[0][r])*rs[r]*g0);
        stg[orow*64+32+r32]=__float2bfloat16((vh==0?a0v[1][r]:o[1][r])*rs[r]*g1);}
      asm volatile("s_waitcnt lgkmcnt(0)":::"memory");
      #pragma unroll
      for(int i=0;i<4;++i){const int row=i*8+(lane>>3),ch=lane&7; const u32x4 v=*(const u32x4*)(stg+row*64+ch*8); ATTN_STORE16(Ow+(long)row*OPITCH+vh*64+ch*8,v);}
      asm volatile("s_waitcnt lgkmcnt(0)":::"memory");
    } }
  #undef SIDX
  asm volatile("s_waitcnt lgkmcnt(0)\n\ts_barrier":::"memory");
  #undef DMA_K
  #undef DMA_V
  #undef CMASK
  #undef START
  #undef RESC
  #undef ROT
}
constexpr int ATTN_LDS_BYTES=LDS_BYTES;
#undef SBAR
#undef WAIT_BAR
}

constexpr int NWAVES = 8;
#ifndef MK_PER_PHASE
#define MK_PER_PHASE 0
#endif
constexpr int BATCH = 2, SEQ = 4096, DMODEL = 4096, M = BATCH * SEQ, DEPTH = 4, FF = 16384, NGRP = 128;
constexpr int N_PHASES = 2 + 6 * DEPTH;
constexpr size_t MiB = 1u << 20;
constexpr size_t WS_CTL = 0, CTL_ZERO_BYTES = 1 * MiB;
constexpr int CW_BAR = 4096;
constexpr size_t SSQ_OFF = 128 * 1024;
static_assert(SSQ_OFF + 9 * (size_t)M * 8 <= CTL_ZERO_BYTES, "ssq inside the memset region");
constexpr size_t WS_W = 16 * MiB, W_LAYER = 360 * MiB;
constexpr size_t W_IN = 0, W_OUT = 64 * MiB, W_UP = 96 * MiB, W_DN = 224 * MiB, W_GLU = 352 * MiB;
constexpr size_t WS_SSMP = WS_W + DEPTH * W_LAYER;
constexpr size_t SSMP_STRIDE = 144 * 1024;
constexpr size_t WS_H = 1536 * MiB, WS_HB = 1664 * MiB, WS_QKV = 1728 * MiB, WS_UT = 1824 * MiB, WS_YG = 1856 * MiB, WS_CAT = 1888 * MiB, WS_ATT = 1952 * MiB, WS_HID = 1984 * MiB, WS_END = 2240 * MiB;
static_assert(WS_SSMP + (size_t)DEPTH * NGRP * SSMP_STRIDE <= WS_H, "d_ws map");
constexpr int RING_OFF = 0, RING_BYTES = 131072;
constexpr int LDSCTL_OFF = RING_BYTES, MISC_OFF = LDSCTL_OFF + 320;
constexpr int LDS_BYTES = 147456;
static_assert(MISC_OFF + 128 <= LDS_BYTES, "LDS map");

#define GAS __attribute__((address_space(1)))
#define LAS __attribute__((address_space(3)))
typedef unsigned short bf16;
typedef unsigned v4u __attribute__((ext_vector_type(4)));
typedef float f32x4 __attribute__((ext_vector_type(4)));
typedef short bf16x8 __attribute__((ext_vector_type(8)));
typedef GAS unsigned gu32;
typedef GAS unsigned long long gu64;
#define RLX_AGENT __ATOMIC_RELAXED, __HIP_MEMORY_SCOPE_AGENT
#define LDS_WAIT() asm volatile("s_waitcnt lgkmcnt(0)" ::: "memory")
#define VM_WAIT() asm volatile("s_waitcnt vmcnt(0)" ::: "memory")
__device__ __forceinline__ unsigned long long rt() { return __builtin_amdgcn_s_memrealtime(); }
__device__ __forceinline__ unsigned f2bf(float f) { unsigned u = __builtin_bit_cast(unsigned, f); return (u + 0x7fffu + ((u >> 16) & 1u)) >> 16; }
__device__ __forceinline__ unsigned pk2(float lo, float hi) { return f2bf(lo) | (f2bf(hi) << 16); }

#define XB_TMO      128
#define XB_XCNT(j)  (256  + 64 * (j))
#define XB_XSUB(j)  (1280 + 64 * (j))
#define XB_XGEN(j)  (2304 + 64 * (j))
#define XB_TOP      3328
#define XB_TOPGEN   3392
#define XCD_BAR_WORDS 3456
#define XB_SPIN_CAP (1u << 18)

__device__ __forceinline__ unsigned xb_ld(unsigned* p)              { return __hip_atomic_load(p, __ATOMIC_RELAXED, __HIP_MEMORY_SCOPE_AGENT); }
__device__ __forceinline__ unsigned xb_add(unsigned* p, unsigned v) { return __hip_atomic_fetch_add(p, v, __ATOMIC_RELAXED, __HIP_MEMORY_SCOPE_AGENT); }
__device__ __forceinline__ unsigned xb_xcc_id() { return (unsigned)__builtin_amdgcn_s_getreg((3 << 11) | 20) & 0xFu; }
#define XB_SPIN(cond, bar) do { unsigned _sp = 0; while (cond) { __builtin_amdgcn_s_sleep(1); \
    if ((++_sp & 255u) == 0u) { if (xb_ld(&(bar)[XB_TMO])) break; if (_sp > XB_SPIN_CAP) { atomicAdd(&(bar)[XB_TMO], 1u); break; } } } } while (0)

struct XcdBarrier {
    unsigned* bar; unsigned x;
    volatile LAS unsigned* st;
};

__device__ __forceinline__ XcdBarrier xcd_barrier_post(unsigned* bar, volatile LAS unsigned* st) {
    XcdBarrier b; b.bar = bar; b.x = xb_xcc_id(); b.st = st;
    if (threadIdx.x == 0) (void)xb_add(&bar[XB_XCNT(b.x)], 1u);
    return b;
}
__device__ __forceinline__ void xcd_barrier_complete(unsigned* bar, unsigned x, unsigned& nloc, unsigned& nx) {
    const unsigned G = gridDim.x * gridDim.y * gridDim.z;
    unsigned sum, cnt, mine, sp = 0u;
    for (;;) {
        sum = 0u; cnt = 0u; mine = 0u;
#pragma unroll
        for (unsigned j = 0; j < 16; ++j) { const unsigned c = xb_ld(&bar[XB_XCNT(j)]); sum += c; cnt += (c > 0u) ? 1u : 0u; mine = (j == x) ? c : mine; }
        if (sum == G) break;
        __builtin_amdgcn_s_sleep(1);
        if ((++sp & 255u) == 0u) { if (xb_ld(&bar[XB_TMO])) break; if (sp > XB_SPIN_CAP) { atomicAdd(&bar[XB_TMO], 1u); break; } }
    }
    nloc = mine > 0u ? mine : 1u; nx = cnt > 0u ? cnt : 1u;
}

__device__ __forceinline__ void xcd_barrier(const XcdBarrier& b) {
    asm volatile("s_waitcnt vmcnt(0)" ::: "memory");
    __syncthreads();
    if (threadIdx.x == 0) {
        unsigned* bar = b.bar;
        __builtin_amdgcn_s_waitcnt(0);
        unsigned nloc = b.st[0], nx = b.st[1];
        if (nloc == 0u) { xcd_barrier_complete(bar, b.x, nloc, nx); b.st[0] = nloc; b.st[1] = nx; }
        const unsigned old = xb_add(&bar[XB_XSUB(b.x)], 1u);
        const unsigned gen = old / nloc;
        if (old + 1u == (gen + 1u) * nloc) {
            __builtin_amdgcn_fence(__ATOMIC_RELEASE, "agent");
            asm volatile("s_waitcnt vmcnt(0)" ::: "memory");
            const unsigned og = xb_add(&bar[XB_TOP], 1u);
            const unsigned tg = og / nx;
            if (og + 1u == (tg + 1u) * nx) xb_add(&bar[XB_TOPGEN], 1u);
            else XB_SPIN(xb_ld(&bar[XB_TOPGEN]) == tg, bar);
            __builtin_amdgcn_fence(__ATOMIC_ACQUIRE, "agent");
            xb_add(&bar[XB_XGEN(b.x)], 1u);
            asm volatile("s_waitcnt vmcnt(0)" ::: "memory");
        } else {
            XB_SPIN(xb_ld(&bar[XB_XGEN(b.x)]) == gen, bar);
            __builtin_amdgcn_fence(__ATOMIC_ACQUIRE, "agent");
            asm volatile("s_waitcnt vmcnt(0)" ::: "memory");
        }
    }
    __syncthreads();
}

struct Frame {
    LAS unsigned char* lds;
    volatile LAS unsigned* MISC;
    gu32* ctl;
    int tid, lane, wave;
    int vcu, G;
    const float* const* in;
    float* out; unsigned char* ws;
};
enum In { I_X = 0, I_WIN, I_WOUT, I_NMIX, I_NMLP, I_WUP, I_WDN, I_NFIN, I_RELB, I_LQ1, I_LK1, I_LQ2, I_LK2, I_SUBG, I_SLRE, I_SLIM, I_SLDT, I_SBRE, I_SBIM, I_SCRE, I_SCIM, I_SD, I_WGLU, I_BGLU, N_IN };

__device__ __forceinline__ float wave_sum(float v) {
#pragma unroll
    for (int o = 1; o < 64; o <<= 1) v += __shfl_xor(v, o);
    return v;
}
__device__ __forceinline__ void p0_transpose_item(const float* W, int K, int N, const float* gain, bf16* WT, LAS float* scr, int item, int lane) {
    const int nblk = N / 32, kb = item / nblk, nb = item % nblk, k0 = 64 * kb, n0 = 32 * nb;
#pragma unroll 8
    for (int i = 0; i < 32; ++i) { const int kk = 2 * i + (lane >> 5); const float g = gain ? gain[k0 + kk] : 1.0f; scr[kk * 33 + (lane & 31)] = W[(size_t)(k0 + kk) * N + n0 + (lane & 31)] * g; }
    LDS_WAIT(); asm volatile("" ::: "memory");
    const int c = lane & 7;
#pragma unroll
    for (int j = 0; j < 4; ++j) { const int n = (lane >> 3) + 8 * j; const LAS float* s = scr + (8 * c) * 33 + n;
        v4u o; o.x = pk2(s[0 * 33], s[1 * 33]); o.y = pk2(s[2 * 33], s[3 * 33]); o.z = pk2(s[4 * 33], s[5 * 33]); o.w = pk2(s[6 * 33], s[7 * 33]);
        *(GAS v4u*)(WT + (size_t)(n0 + n) * K + k0 + 8 * c) = o; }
    LDS_WAIT(); asm volatile("" ::: "memory");
}
__device__ __forceinline__ void ssm_setup_unit(Frame& F, int l, int g) {
    LAS float* apr = (LAS float*)(F.lds + RING_OFF); LAS float* api = apr + 17 * 64; LAS float* bbr = api + 17 * 64; LAS float* bbi = bbr + 1024;
    LAS float* cr = bbi + 1024; LAS float* ci = cr + 1024; LAS float* gg = ci + 1024;
    const int lg = l * NGRP + g, tid = F.tid;
    bf16* P = (bf16*)(F.ws + WS_SSMP + (size_t)lg * SSMP_STRIDE); bf16* WmT = P; bf16* VmT = P + 32768; bf16* Kt = P + 65536; float* A16 = (float*)(P + 65536 + 17 * 256);
    if (tid < 64) { const int p = tid;
        const float dt = expf(F.in[I_SLDT][lg]), lr = F.in[I_SLRE][lg * 64 + p], li = F.in[I_SLIM][lg * 64 + p];
        const float mag = expf(lr * dt), th = li * dt, ar = mag * cosf(th), ai = mag * sinf(th);
        float pr = 1.f, pi = 0.f;
        for (int tau = 0; tau <= 16; ++tau) { apr[tau * 64 + p] = pr; api[tau * 64 + p] = pi; const float npr = pr * ar - pi * ai, npi = pr * ai + pi * ar; pr = npr; pi = npi; }
        const float den = lr * lr + li * li, nr = ar - 1.0f, ni = ai;
        gg[p] = (nr * lr + ni * li) / den; gg[64 + p] = (ni * lr - nr * li) / den; }
    __syncthreads();
    if (tid < 64) { A16[2 * tid] = apr[16 * 64 + tid]; A16[2 * tid + 1] = api[16 * 64 + tid]; }
    for (int idx = tid; idx < 1024; idx += NWAVES * 64) { const int p = idx >> 4;
        const float br = F.in[I_SBRE][(size_t)lg * 1024 + idx], bi = F.in[I_SBIM][(size_t)lg * 1024 + idx], gr = gg[p], gi = gg[64 + p];
        bbr[idx] = gr * br - gi * bi; bbi[idx] = gr * bi + gi * br;
        cr[idx] = F.in[I_SCRE][(size_t)lg * 1024 + idx]; ci[idx] = F.in[I_SCIM][(size_t)lg * 1024 + idx]; }
    __syncthreads();
    for (int e = tid; e < 32768; e += NWAVES * 64) { const int pp = e >> 8, k = e & 255, p = pp & 63, j = k >> 4, hh = k & 15, tau = 15 - j;
        const float ar = apr[tau * 64 + p], ai = api[tau * 64 + p], br = bbr[p * 16 + hh], bi = bbi[p * 16 + hh];
        WmT[e] = (bf16)f2bf(pp < 64 ? ar * br - ai * bi : ar * bi + ai * br); }
    for (int e = tid; e < 32768; e += NWAVES * 64) { const int n = e >> 7, pp = e & 127, p = pp & 63, t = n >> 4, hh = n & 15;
        const float ar = apr[(t + 1) * 64 + p], ai = api[(t + 1) * 64 + p], c_r = cr[hh * 64 + p], c_i = ci[hh * 64 + p];
        VmT[e] = (bf16)f2bf(pp < 64 ? c_r * ar - c_i * ai : -(c_r * ai + c_i * ar)); }
    for (int e = tid; e < 256; e += NWAVES * 64) Kt[e] = 0;
    for (int e = tid; e < 4096; e += NWAVES * 64) { const int tau = e >> 8, hh = (e >> 4) & 15, h2 = e & 15; float acc = 0.f;
        for (int p = 0; p < 64; ++p) { const float ar = apr[tau * 64 + p], ai = api[tau * 64 + p], c_r = cr[hh * 64 + p], c_i = ci[hh * 64 + p];
            const float xr = c_r * ar - c_i * ai, xi = c_r * ai + c_i * ar; acc += xr * bbr[p * 16 + h2] - xi * bbi[p * 16 + h2]; }
        if (tau == 0 && hh == h2) acc += F.in[I_SD][lg * 16 + hh];
        Kt[256 + e] = (bf16)f2bf(acc); }
    __syncthreads();
}
__device__ __forceinline__ void p0_prologue(Frame& F) {
    LAS float* scr = (LAS float*)(F.lds + RING_OFF + F.wave * 16384);
    const int gw = F.vcu * NWAVES + F.wave, NGW = F.G * NWAVES;
    constexpr int IT_IN = (DMODEL / 64) * (8192 / 32), IT_OUT = (DMODEL / 64) * (DMODEL / 32), IT_UP = (DMODEL / 64) * (FF / 32), IT_DN = (FF / 64) * (DMODEL / 32), IT_GLU = (2048 / 64) * (2048 / 32);
    constexpr int IT_LAYER = IT_IN + IT_OUT + IT_UP + IT_DN + IT_GLU, NITEMS = DEPTH * IT_LAYER;
    for (int it = gw; it < NITEMS; it += NGW) {
        const int l = it / IT_LAYER; int r = it % IT_LAYER;
        unsigned char* wl = F.ws + WS_W + (size_t)l * W_LAYER;
        if (r < IT_IN) { p0_transpose_item(F.in[I_WIN] + (size_t)l * DMODEL * 8192, DMODEL, 8192, F.in[I_NMIX] + l * DMODEL, (bf16*)(wl + W_IN), scr, r, F.lane); continue; } r -= IT_IN;
        if (r < IT_OUT) { p0_transpose_item(F.in[I_WOUT] + (size_t)l * DMODEL * DMODEL, DMODEL, DMODEL, nullptr, (bf16*)(wl + W_OUT), scr, r, F.lane); continue; } r -= IT_OUT;
        if (r < IT_UP) { p0_transpose_item(F.in[I_WUP] + (size_t)l * DMODEL * FF, DMODEL, FF, F.in[I_NMLP] + l * DMODEL, (bf16*)(wl + W_UP), scr, r, F.lane); continue; } r -= IT_UP;
        if (r < IT_DN) { p0_transpose_item(F.in[I_WDN] + (size_t)l * FF * DMODEL, FF, DMODEL, nullptr, (bf16*)(wl + W_DN), scr, r, F.lane); continue; } r -= IT_DN;
        p0_transpose_item(F.in[I_WGLU] + (size_t)l * 2048 * 2048, 2048, 2048, nullptr, (bf16*)(wl + W_GLU), scr, r, F.lane);
    }
    pg8::ssq_t* ssq0 = (pg8::ssq_t*)(F.ws + WS_CTL + SSQ_OFF);
    for (int m = gw; m < M; m += NGW) {
        const GAS f32x4* xr = (const GAS f32x4*)(F.in[I_X] + (size_t)m * DMODEL) + F.lane; GAS unsigned long long* o8 = (GAS unsigned long long*)(F.ws + WS_HB + (size_t)m * DMODEL * 2) + F.lane; float s = 0.f;
#pragma unroll 4
        for (int j = 0; j < 16; ++j) { const f32x4 v = xr[64 * j]; s += (v.x * v.x + v.y * v.y) + (v.z * v.z + v.w * v.w); o8[64 * j] = (unsigned long long)pk2(v.x, v.y) | ((unsigned long long)pk2(v.z, v.w) << 32); }
        s = wave_sum(s); if (F.lane == 0) ssq0[m] = (pg8::ssq_t)(s * pg8::SSQ_SCALE);
    }
    __syncthreads();
    for (int u = F.vcu; u < DEPTH * NGRP; u += F.G) ssm_setup_unit(F, u / NGRP, u % NGRP);
}
__device__ __forceinline__ float gelu_tanh(float y) { const float z = 0.7978845608028654f * (y + 0.044715f * y * y * y); return y * __builtin_amdgcn_rcpf(1.0f + __builtin_amdgcn_exp2f(-2.8853900817779268f * z)); }
__device__ __forceinline__ void ssm_unit(Frame& F, int l, int b, int g) {
    typedef short s16x8 __attribute__((ext_vector_type(8)));
    int lane_ = F.lane; asm volatile("" : "+v"(lane_));
    const int lane = lane_, w = F.wave, fr = lane & 15, fq = lane >> 4;
    const bf16* P = (const bf16*)(F.ws + WS_SSMP + (size_t)(l * NGRP + g) * SSMP_STRIDE); const bf16* WmT = P; const bf16* VmT = P + 32768; const bf16* Kt = P + 65536; const float* A16 = (const float*)(P + 65536 + 17 * 256);
    const bf16* U = (const bf16*)(F.ws + WS_UT) + ((size_t)g * M + (size_t)b * SEQ) * 16;
    bf16* YG = (bf16*)(F.ws + WS_YG);
    LAS float* S = (LAS float*)(F.lds + RING_OFF);
    s16x8 wf[8], kfl[4], kfh[8], vfl[4], vfh[4];
    const int tl = w, th = 15 - w;
#pragma unroll
    for (int kk = 0; kk < 8; ++kk) wf[kk] = *(const s16x8*)(WmT + (16 * w + fr) * 256 + 32 * kk + 8 * fq);
#pragma unroll
    for (int kk = 0; kk < 4; ++kk) { const int tau = tl - 2 * kk - (fq >> 1); kfl[kk] = *(const s16x8*)(Kt + (tau < 0 ? 0 : tau + 1) * 256 + fr * 16 + 8 * (fq & 1)); }
#pragma unroll
    for (int kk = 0; kk < 8; ++kk) { const int tau = th - 2 * kk - (fq >> 1); kfh[kk] = *(const s16x8*)(Kt + (tau < 0 ? 0 : tau + 1) * 256 + fr * 16 + 8 * (fq & 1)); }
#pragma unroll
    for (int kk = 0; kk < 4; ++kk) { vfl[kk] = *(const s16x8*)(VmT + (tl * 16 + fr) * 128 + 32 * kk + 8 * fq); vfh[kk] = *(const s16x8*)(VmT + (th * 16 + fr) * 128 + 32 * kk + 8 * fq); }
    float sr = 0.f, si = 0.f, a16r = 0.f, a16i = 0.f;
    if (w == 0) { a16r = A16[2 * lane]; a16i = A16[2 * lane + 1]; }
    for (int half = 0; half < 2; ++half) {
        for (int mt = 0; mt < 8; ++mt) {
            const bf16* ub = U + ((size_t)((half * 128 + mt * 16 + fr) * 16 + (fq >> 1))) * 16 + 8 * (fq & 1);
            f32x4 acc = {0.f, 0.f, 0.f, 0.f};
#pragma unroll
            for (int kk = 0; kk < 8; ++kk) { const s16x8 uf = *(const s16x8*)(ub + 32 * kk); acc = __builtin_amdgcn_mfma_f32_16x16x32_bf16(wf[kk], uf, acc, 0, 0, 0); }
            *(LAS f32x4*)(S + (mt * 16 + fr) * 132 + 16 * w + 4 * fq) = acc;
        }
        __syncthreads();
        if (w == 0) {
            for (int c = 0; c < 128; ++c) { const float tr = S[c * 132 + lane], ti = S[c * 132 + 64 + lane]; S[c * 132 + lane] = sr; S[c * 132 + 64 + lane] = si;
                const float nsr = a16r * sr - a16i * si + tr, nsi = a16r * si + a16i * sr + ti; sr = nsr; si = nsi; }
        }
        __syncthreads();
        for (int mt = 0; mt < 8; ++mt) {
            const int chunk = half * 128 + mt * 16 + fr;
            const bf16* ub = U + ((size_t)(chunk * 16 + (fq >> 1))) * 16 + 8 * (fq & 1);
            f32x4 accl = {0.f, 0.f, 0.f, 0.f}, acch = {0.f, 0.f, 0.f, 0.f};
#pragma unroll
            for (int kk = 0; kk < 8; ++kk) { const s16x8 uf = *(const s16x8*)(ub + 32 * kk);
                if (kk < 4) accl = __builtin_amdgcn_mfma_f32_16x16x32_bf16(kfl[kk], uf, accl, 0, 0, 0);
                acch = __builtin_amdgcn_mfma_f32_16x16x32_bf16(kfh[kk], uf, acch, 0, 0, 0); }
#pragma unroll
            for (int kk = 0; kk < 4; ++kk) { const LAS float* sp = S + (mt * 16 + fr) * 132 + 32 * kk + 8 * fq; const f32x4 s0 = *(const LAS f32x4*)sp, s1 = *(const LAS f32x4*)(sp + 4);
                const s16x8 sf = __builtin_bit_cast(s16x8, pg8::pack8(s0, s1));
                accl = __builtin_amdgcn_mfma_f32_16x16x32_bf16(vfl[kk], sf, accl, 0, 0, 0); acch = __builtin_amdgcn_mfma_f32_16x16x32_bf16(vfh[kk], sf, acch, 0, 0, 0); }
            const size_t tok = (size_t)b * SEQ + (size_t)chunk * 16;
            { typedef unsigned u32x2 __attribute__((ext_vector_type(2)));
              u32x2 o; o.x = pg8::cvt_pk_bf16(gelu_tanh(accl[0]), gelu_tanh(accl[1])); o.y = pg8::cvt_pk_bf16(gelu_tanh(accl[2]), gelu_tanh(accl[3]));
              *(u32x2*)(YG + (tok + tl) * 2048 + g * 16 + 4 * fq) = o;
              o.x = pg8::cvt_pk_bf16(gelu_tanh(acch[0]), gelu_tanh(acch[1])); o.y = pg8::cvt_pk_bf16(gelu_tanh(acch[2]), gelu_tanh(acch[3]));
              *(u32x2*)(YG + (tok + th) * 2048 + g * 16 + 4 * fq) = o; }
        }
        __syncthreads();
    }
}

struct Args { const float* in[N_IN]; float* out; unsigned char* ws; int ph_lo, ph_hi; };
__global__ void __launch_bounds__(NWAVES * 64, 2) hymba_fwd(Args args) {
    extern __shared__ __attribute__((aligned(16))) unsigned char lds[];
    Frame F;
    F.lds = (LAS unsigned char*)lds;
    F.MISC = (volatile LAS unsigned*)(F.lds + MISC_OFF);
    F.tid = threadIdx.x; F.lane = F.tid & 63; F.wave = __builtin_amdgcn_readfirstlane(F.tid >> 6);
    F.G = gridDim.x; { const int bx = blockIdx.x; F.vcu = (F.G % 8 == 0) ? (bx % 8) * (F.G / 8) + bx / 8 : bx; }
    F.in = args.in; F.out = args.out; F.ws = args.ws;
    unsigned char* ws = args.ws;
    F.ctl = (gu32*)(ws + WS_CTL);
    for (int u = F.tid; u < (LDS_BYTES - LDSCTL_OFF) / 4; u += NWAVES * 64) ((LAS unsigned*)(F.lds + LDSCTL_OFF))[u] = 0u;
    __syncthreads();
    XcdBarrier bar; bar.bar = (unsigned*)(F.ctl + CW_BAR); bar.x = 0; bar.st = nullptr;
    if (!MK_PER_PHASE) bar = xcd_barrier_post((unsigned*)(F.ctl + CW_BAR), F.MISC + 8);
#define GRID_BAR() do { if (MK_PER_PHASE) { if (F.tid == 0) __hip_atomic_store(F.ctl + 0, 0xBADBA0u, RLX_AGENT); } else { xcd_barrier(bar); } } while (0)
    const int lo = args.ph_lo, hi = args.ph_hi;
#define IN(k) (lo <= (k) && (k) < hi)
#define BOTH(k) (IN(k) && IN((k) + 1))
    pg8::ssq_t* const ssq = (pg8::ssq_t*)(ws + WS_CTL + SSQ_OFF);
    float* const H = (float*)(ws + WS_H);
    pg8::bf16_t* const HB = (pg8::bf16_t*)(ws + WS_HB); pg8::bf16_t* const QKV = (pg8::bf16_t*)(ws + WS_QKV); pg8::bf16_t* const UT = (pg8::bf16_t*)(ws + WS_UT);
    pg8::bf16_t* const YG = (pg8::bf16_t*)(ws + WS_YG); pg8::bf16_t* const CAT = (pg8::bf16_t*)(ws + WS_CAT); pg8::bf16_t* const HID = (pg8::bf16_t*)(ws + WS_HID);

#ifndef NO_PRO
    if (IN(0)) { p0_prologue(F); if (BOTH(0)) GRID_BAR(); }
#endif

    for (int l = 0; l < DEPTH; ++l) {
        const int pb = 1 + 6 * l;
        const unsigned char* wl = ws + WS_W + (size_t)l * W_LAYER;
        if (IN(pb)) {
            pg8::Gemm g{HB, (const pg8::bf16_t*)(wl + W_IN), M, 8192, DMODEL}; pg8::StaticOrder S; S.init(M, 8192, F.G, (int)blockIdx.x);
            pg8::EpiProj E{QKV, UT, ssq + (2 * l) * M, attn_body::C2};
            pg8::gemm_phase<pg8::EpiProj, pg8::StaticOrder, PG8_ALIGN, PG8_SP2>(F.lds + RING_OFF, g, S, E);
            if (BOTH(pb)) GRID_BAR();
        }
        if (IN(pb + 1)) {
#ifndef NO_SSM
            for (int u = F.vcu; u < BATCH * NGRP; u += F.G) ssm_unit(F, l, u / NGRP, u % NGRP);
#endif
            __syncthreads();
            const float lam_init = 0.8f - 0.6f * expf(-0.3f * (float)l);
            const float d1 = wave_sum(F.in[I_LQ1][l * 64 + F.lane] * F.in[I_LK1][l * 64 + F.lane]), d2 = wave_sum(F.in[I_LQ2][l * 64 + F.lane] * F.in[I_LK2][l * 64 + F.lane]);
            const float lam = expf(d1) - expf(d2) + lam_init;
#ifndef NO_ATTN
            for (int pu = F.vcu; pu < 256; pu += F.G) {
                const int bh = pu >> 3, pp = pu & 7, b = bh >> 4, h = bh & 15;
                for (int qi = 0; qi < 2; ++qi) { const int qb = qi ? 15 - pp : pp;
                    for (int kind = 0; kind < 4; ++kind) { const int s2 = (kind < 2) ? 64 : 0, vh = kind & 1;
                        attn_body::UnitArgs ua; ua.kind = kind; ua.qcol = h * 128 + s2; ua.kcol = 2048 + h * 128 + s2; ua.vcol = 4096 + h * 128 + vh * 64; ua.ocol = h * 128;
                        ua.relb = F.in[I_RELB]; ua.scr = (float*)(ws + WS_ATT) + (size_t)F.vcu * (2 * 256 * 64); ua.lam = lam; ua.oscale = 1.0f - lam_init; ua.gain = F.in[I_SUBG] + l * 128;
                        attn_body::attn_unit<8>(b, h, qb, (const attn_body::bf16*)QKV, (const attn_body::bf16*)QKV, (const attn_body::bf16*)QKV, (attn_body::bf16*)CAT, (char*)lds + RING_OFF, ua); } }
            }
#endif
            if (BOTH(pb + 1)) GRID_BAR();
        }
        if (IN(pb + 2)) {
            pg8::Gemm g{YG, (const pg8::bf16_t*)(wl + W_GLU), M, 2048, 2048}; pg8::StaticOrder S; S.init(M, 2048, F.G, (int)blockIdx.x);
            pg8::EpiGlu E{YG, CAT, F.in[I_BGLU] + l * 2048};
            pg8::gemm_phase<pg8::EpiGlu, pg8::StaticOrder, PG8_ALIGN, PG8_SP2>(F.lds + RING_OFF, g, S, E);
            if (BOTH(pb + 2)) GRID_BAR();
        }
        if (IN(pb + 3)) {
            pg8::Gemm g{CAT, (const pg8::bf16_t*)(wl + W_OUT), M, DMODEL, DMODEL}; pg8::StaticOrder S; S.init(M, DMODEL, F.G, (int)blockIdx.x);
            pg8::EpiRes E{l == 0 ? F.in[I_X] : H, H, HB, ssq + (2 * l + 1) * M};
            pg8::gemm_phase<pg8::EpiRes, pg8::StaticOrder, PG8_ALIGN, PG8_SP2>(F.lds + RING_OFF, g, S, E);
            if (BOTH(pb + 3)) GRID_BAR();
        }
        if (IN(pb + 4)) {
            pg8::Gemm g{HB, (const pg8::bf16_t*)(wl + W_UP), M, FF, DMODEL}; pg8::StaticOrder S; S.init(M, FF, F.G, (int)blockIdx.x);
            pg8::EpiUp E{HID, FF, ssq + (2 * l + 1) * M};
            pg8::gemm_phase<pg8::EpiUp, pg8::StaticOrder, PG8_ALIGN, PG8_SP2>(F.lds + RING_OFF, g, S, E);
            if (BOTH(pb + 4)) GRID_BAR();
        }
        if (IN(pb + 5)) {
            pg8::Gemm g{HID, (const pg8::bf16_t*)(wl + W_DN), M, DMODEL, FF}; pg8::StaticOrder S; S.init(M, DMODEL, F.G, (int)blockIdx.x);
            pg8::EpiRes E{H, H, HB, ssq + (2 * l + 2) * M};
            pg8::gemm_phase<pg8::EpiRes, pg8::StaticOrder, PG8_ALIGN, PG8_SP2>(F.lds + RING_OFF, g, S, E);
            if (BOTH(pb + 5)) GRID_BAR();
        }
    }
    if (IN(N_PHASES - 1)) {
        const int gw = F.vcu * NWAVES + F.wave, NGW = F.G * NWAVES; const float* gf = F.in[I_NFIN]; const pg8::ssq_t* sq = ssq + 8 * M;
        for (int m = gw; m < M; m += NGW) { const float rs = pg8::rstd_of(sq, m);
            const GAS f32x4* hr = (const GAS f32x4*)(H + (size_t)m * DMODEL) + F.lane; GAS f32x4* orow = (GAS f32x4*)(F.out + (size_t)m * DMODEL) + F.lane; const f32x4* g4 = (const f32x4*)gf + F.lane;
#pragma unroll 4
            for (int j = 0; j < 16; ++j) orow[64 * j] = hr[64 * j] * rs * g4[64 * j]; }
    }
#undef IN
#undef BOTH
}

extern "C" void kernel_launch(void* const* d_in, const int* in_sizes, int n_in, void* d_out, int out_size, void* d_ws, size_t ws_size, hipStream_t stream) {
    static int grid = 0;
    if (grid == 0) {
        if (n_in != N_IN || in_sizes[0] != M * DMODEL || out_size != M * DMODEL || ws_size < WS_END) { fprintf(stderr, "kernel_launch: built for %d inputs, x/out of %d floats, >= %zu bytes of workspace; got n_in %d, in0 %d, out %d, ws %zu; nothing launched\n", (int)N_IN, M * DMODEL, (size_t)WS_END, n_in, n_in > 0 ? in_sizes[0] : -1, out_size, ws_size); grid = -1; return; }
        int dev = 0, cus = 0, per_cu = 0;
        if (hipGetDevice(&dev) != hipSuccess || hipDeviceGetAttribute(&cus, hipDeviceAttributeMultiprocessorCount, dev) != hipSuccess) { fprintf(stderr, "kernel_launch: hipGetDevice / hipDeviceGetAttribute failed; nothing launched\n"); grid = -1; return; }
        if (hipFuncSetAttribute((const void*)hymba_fwd, hipFuncAttributeMaxDynamicSharedMemorySize, LDS_BYTES) != hipSuccess) { fprintf(stderr, "kernel_launch: hipFuncSetAttribute failed\n"); grid = -1; return; }
        if (hipOccupancyMaxActiveBlocksPerMultiprocessor(&per_cu, (const void*)hymba_fwd, NWAVES * 64, LDS_BYTES) != hipSuccess || per_cu < 1)
            fprintf(stderr, "kernel_launch: note: the occupancy query reports %d workgroups per CU\n", per_cu);
        (void)hipGetLastError();
        grid = cus;
    }
    if (grid < 0) return;
    if (hipMemsetAsync((char*)d_ws + WS_CTL, 0, CTL_ZERO_BYTES, stream) != hipSuccess) { fprintf(stderr, "kernel_launch: hipMemsetAsync failed\n"); return; }
    Args a{};
    for (int i = 0; i < N_IN; ++i) a.in[i] = (const float*)d_in[i];
    a.out = (float*)d_out; a.ws = (unsigned char*)d_ws;
#if MK_PER_PHASE
    for (int ph = 0; ph < N_PHASES; ++ph) { a.ph_lo = ph; a.ph_hi = ph + 1; hipLaunchKernelGGL(hymba_fwd, dim3(grid), dim3(NWAVES * 64), LDS_BYTES, stream, a); }
#else
    a.ph_lo = 0; a.ph_hi = N_PHASES; hipLaunchKernelGGL(hymba_fwd, dim3(grid), dim3(NWAVES * 64), LDS_BYTES, stream, a);
#endif
    const hipError_t le = hipPeekAtLastError();
    if (le != hipSuccess) fprintf(stderr, "kernel_launch: launch failed: %s\n", hipGetErrorName(le));
}
```

```cpp
#define MK_PER_PHASE 0
#define A_IMG 1
#define STG_UP 2
#include <hip/hip_runtime.h>
#include <cstdio>
#include <cstdint>
#ifndef A_IMG
#define A_IMG 0
#endif
namespace pg8 {
#define PG8_LAS __attribute__((address_space(3)))
typedef unsigned short bf16_t;
typedef short bf16x8 __attribute__((ext_vector_type(8)));
typedef float f32x4 __attribute__((ext_vector_type(4)));
typedef unsigned u32x4 __attribute__((ext_vector_type(4)));
constexpr int BM = 256, BK = 64, HALF = 128, HTB = HALF * BK * 2  , STAGE_BYTES = 8 * HTB, NXCD = 8, WGM = 8;

__host__ __device__ __forceinline__ int lds_byte(int r, int c) { const int st = (r >> 4) * 2 + (c >> 5), rr = r & 15, cc = c & 31, ob = rr * 64 + cc * 2; return st * 1024 + (ob ^ (((ob >> 9) & 1) << 5)); }
__host__ __device__ __forceinline__ void stage_rc(int b, int& R, int& C) { const int st = b / 1024, sb = b % 1024, swz = sb ^ (((sb >> 9) & 1) << 5); R = (st >> 1) * 16 + swz / 64; C = (st & 1) * 32 + (swz % 64) / 2; }
__host__ __device__ __forceinline__ int perm32(int rho) { const int n = rho >> 4, i = rho & 15; return 8 * (i >> 2) + 4 * n + (i & 3); }

struct Unit { int pm, pn; };
struct Gemm { const bf16_t* A; const bf16_t* Bt; int M, N, K; int a_img, b_img; };
#define PG8_AOFF(row, col, K) (A_IMG ? pg8::img_off((int)(row), (int)(col), (K), false) : ((size_t)(row) * (size_t)(K) + (size_t)(col)) * 2)
__host__ __device__ __forceinline__ int perm32_inv(int x) { return 16 * ((x >> 2) & 1) + 4 * (x >> 3) + (x & 3); }
__host__ __device__ __forceinline__ size_t img_off(int row, int col, int K, bool permB) {
    const int r = row & 127, R = permB ? ((r & ~31) + perm32_inv(r & 31)) : r;
    return ((size_t)((row >> 8) * (K >> 6) + (col >> 6)) * 2 + ((row >> 7) & 1)) * (size_t)HTB + (size_t)lds_byte(R, col & 63); }

struct StaticOrder {
    int nM, nN, nwg, G, c;
    __host__ __device__ void init(int M, int N, int G_, int c_) { nM = M / BM; nN = N / BM; nwg = nM * nN; G = G_; c = c_; }
    __host__ __device__ bool next(int i, Unit& u) const {
        const long L = (long)i * G + c; if (L >= nwg) return false;
        int wgid = (int)L; { const int q = nwg / NXCD, r = nwg % NXCD, xcd = wgid % NXCD, off = wgid / NXCD; wgid = (xcd < r ? xcd * (q + 1) : r * (q + 1) + (xcd - r) * q) + off; }
        const int nig = WGM * nN, gid = wgid / nig, fm = gid * WGM, gsz = (nM - fm) < WGM ? (nM - fm) : WGM;
        u.pm = fm + ((wgid % nig) % gsz); u.pn = (wgid % nig) / gsz; return true;
    }
    __device__ __forceinline__ void a_ready(const Unit&) const {}
    __device__ __forceinline__ void done(const Unit&) const {}
};

__device__ __forceinline__ unsigned cvt_pk_bf16(float lo, float hi) { unsigned r; asm volatile("v_cvt_pk_bf16_f32 %0, %1, %2" : "=v"(r) : "v"(lo), "v"(hi)); return r; }
typedef float f32x2 __attribute__((ext_vector_type(2)));
__device__ __forceinline__ f32x2 gelu_pk(f32x2 v) {
    const f32x2 av = __builtin_elementwise_abs(v), d = av * 0.2316418882f + 1.0f;
    f32x2 t; t.x = __builtin_amdgcn_rcpf(d.x); t.y = __builtin_amdgcn_rcpf(d.y);
    f32x2 q = t * 0.5307027145f + (-0.7265760135f); q = q * t + 0.7107068705f; q = q * t + (-0.142248368f); q = q * t + 0.127414796f; q = q * t;
    const f32x2 s = (v * v) * (-0.72134752044f);
    f32x2 e; e.x = __builtin_amdgcn_exp2f(s.x); e.y = __builtin_amdgcn_exp2f(s.y);
    const f32x2 m = v * (q * e), r = v - m;
    f32x2 o; o.x = v.x < 0.f ? m.x : r.x; o.y = v.y < 0.f ? m.y : r.y; return o;
}

template <int ACT  > struct EpiBf16 {
    static constexpr bool PERM = true, AFTER_DRAIN = false; static_assert(ACT == 0 || ACT == 1, "EpiBf16: ACT is 0 (none) or 1 (gelu_pk)");
    bf16_t* O; int ldc; const float* bias; int split_cols; size_t split_stride; float scale0;
    __device__ __forceinline__ void operator()(const f32x4 (&acc)[2][2][4][2], const Unit& u, int wr, int wc, int fr, int fq) const {
        const int row0 = u.pm * BM + wr * 64 + fr; int colt = u.pn * BM; bf16_t* base = O;
        float sc = 1.f; if (split_cols) { const int t = colt / split_cols; base += (size_t)t * split_stride; colt -= t * split_cols; if (t == 0) sc = scale0; }
        const int col0 = colt + wc * 32 + 8 * fq, bcol0 = u.pn * BM + wc * 32 + 8 * fq;
        f32x4 bv[2][2];
#pragma unroll
        for (int bj = 0; bj < 2; ++bj)
#pragma unroll
            for (int n = 0; n < 2; ++n) bv[bj][n] = bias ? *(const f32x4*)(bias + bcol0 + bj * HALF + 4 * n) : (f32x4){0.f, 0.f, 0.f, 0.f};
#pragma unroll
        for (int ai = 0; ai < 2; ++ai)
#pragma unroll
            for (int m = 0; m < 4; ++m) { bf16_t* rowp = base + (size_t)(row0 + ai * HALF + m * 16) * ldc + col0;
#pragma unroll
                for (int bj = 0; bj < 2; ++bj) { f32x4 v0 = acc[ai][bj][m][0] + bv[bj][0], v1 = acc[ai][bj][m][1] + bv[bj][1];
                    if (ACT == 1) { f32x2 a = gelu_pk((f32x2){v0[0], v0[1]}), b = gelu_pk((f32x2){v0[2], v0[3]}), c = gelu_pk((f32x2){v1[0], v1[1]}), d = gelu_pk((f32x2){v1[2], v1[3]});
                        v0 = (f32x4){a.x, a.y, b.x, b.y}; v1 = (f32x4){c.x, c.y, d.x, d.y}; }
                    v0 = v0 * sc; v1 = v1 * sc; u32x4 w; w.x = cvt_pk_bf16(v0[0], v0[1]); w.y = cvt_pk_bf16(v0[2], v0[3]); w.z = cvt_pk_bf16(v1[0], v1[1]); w.w = cvt_pk_bf16(v1[2], v1[3]);
                    *(u32x4*)(rowp + bj * HALF) = w; } }
    }
};

__device__ __forceinline__ u32x4 pack8(f32x4 v0, f32x4 v1) { u32x4 w; w.x = cvt_pk_bf16(v0[0], v0[1]); w.y = cvt_pk_bf16(v0[2], v0[3]); w.z = cvt_pk_bf16(v1[0], v1[1]); w.w = cvt_pk_bf16(v1[2], v1[3]); return w; }
__device__ __forceinline__ float bf_lo(unsigned w) { return __uint_as_float(w << 16); }
__device__ __forceinline__ float bf_hi(unsigned w) { return __uint_as_float(w & 0xffff0000u); }
constexpr float RMS_EPS = 1e-6f;
typedef unsigned long long ssq_t;
constexpr float SSQ_SCALE = 16777216.0f, SSQ_INV = 1.0f / (16777216.0f * 4096.0f);
__device__ __forceinline__ float rstd_of(ssq_t q) { const float x = fmaf((float)(unsigned)(q >> 32), 4294967296.0f, (float)(unsigned)q); return __builtin_amdgcn_rsqf(x * SSQ_INV + RMS_EPS); }
struct EpiProj {
    static constexpr bool PERM = true, AFTER_DRAIN = false, IDEMP = true;
    bf16_t* __restrict__ QKV; bf16_t* __restrict__ UT; const ssq_t* __restrict__ ssq; float c2; unsigned char* __restrict__ KI; unsigned char* __restrict__ VI;
    __device__ __forceinline__ void operator()(const f32x4 (&acc)[2][2][4][2], const Unit& u, int wr, int wc, int fr, int fq) const {
        const int row0 = u.pm * BM + wr * 64 + fr, colt = u.pn * BM;
        const float sc = (colt < 2048) ? c2 : 1.f;
        ssq_t q[2][4];
#pragma unroll
        for (int ai = 0; ai < 2; ++ai)
#pragma unroll
            for (int m = 0; m < 4; ++m) q[ai][m] = ssq[row0 + ai * HALF + m * 16];
#pragma unroll
        for (int ai = 0; ai < 2; ++ai)
#pragma unroll
            for (int m = 0; m < 4; ++m) { const int row = row0 + ai * HALF + m * 16;
                const float rs = sc * rstd_of(q[ai][m]);
#pragma unroll
                for (int bj = 0; bj < 2; ++bj) { const int col = colt + bj * HALF + wc * 32 + 8 * fq;
                    const u32x4 w = pack8(acc[ai][bj][m][0] * rs, acc[ai][bj][m][1] * rs);
                    if (colt < 2048) *(u32x4*)(QKV + (size_t)row * 6144 + col) = w;
                    else if (colt < 4096) { const int c = col - 2048, key = row & 4095;
                        *(u32x4*)(KI + ((size_t)(((row >> 12) * 16 + (c >> 7)) * 2 + ((c >> 6) & 1)) * 64 + (key >> 6)) * 8192 + ((c & 63) >> 3) * 1024 + (key & 63) * 16) = w; }
                    else if (colt < 6144) { const int c = col - 4096, key = row & 4095, cc = c & 127;
                        *(u32x4*)(VI + ((size_t)((row >> 12) * 16 + (c >> 7)) * 64 + (key >> 6)) * 16384 + ((cc >> 5) * 4 + ((key & 63) >> 4)) * 1024 + (key & 15) * 64 + ((cc & 31) >> 3) * 16) = w; }
                    else { const int cu = col - 6144; *(u32x4*)(UT + ((size_t)(cu >> 4) * 8192 + row) * 16 + (cu & 15)) = w; } } }
    }
};
struct EpiUp {
    static constexpr bool PERM = true, AFTER_DRAIN = false, IDEMP = true;
    bf16_t* __restrict__ O; int ldc; const ssq_t* __restrict__ ssq;
    __device__ __forceinline__ void operator()(const f32x4 (&acc)[2][2][4][2], const Unit& u, int wr, int wc, int fr, int fq) const {
        const int row0 = u.pm * BM + wr * 64 + fr, colt = u.pn * BM;
        ssq_t q[2][4];
#pragma unroll
        for (int ai = 0; ai < 2; ++ai)
#pragma unroll
            for (int m = 0; m < 4; ++m) q[ai][m] = ssq[row0 + ai * HALF + m * 16];
#pragma unroll
        for (int ai = 0; ai < 2; ++ai)
#pragma unroll
            for (int m = 0; m < 4; ++m) { const int row = row0 + ai * HALF + m * 16;
                const float rs = rstd_of(q[ai][m]);
#pragma unroll
                for (int bj = 0; bj < 2; ++bj) { const int col = colt + bj * HALF + wc * 32 + 8 * fq;
                    f32x4 v0 = acc[ai][bj][m][0] * rs, v1 = acc[ai][bj][m][1] * rs;
#pragma unroll
                    for (int e = 0; e < 4; ++e) { const float a = fmaxf(v0[e], 0.f), b = fmaxf(v1[e], 0.f); v0[e] = a * a; v1[e] = b * b; }
                    *(u32x4*)((char*)O + PG8_AOFF(row, col, ldc)) = pack8(v0, v1); } }
    }
};
struct EpiGlu {
    static constexpr bool PERM = true, AFTER_DRAIN = false, IDEMP = true;
    const bf16_t* __restrict__ YG; bf16_t* __restrict__ CAT; const float* __restrict__ bias;
    __device__ __forceinline__ void operator()(const f32x4 (&acc)[2][2][4][2], const Unit& u, int wr, int wc, int fr, int fq) const {
        const int row0 = u.pm * BM + wr * 64 + fr, colt = u.pn * BM;
        f32x4 bv[2][2];
#pragma unroll
        for (int bj = 0; bj < 2; ++bj)
#pragma unroll
            for (int n = 0; n < 2; ++n) bv[bj][n] = *(const f32x4*)(bias + colt + bj * HALF + wc * 32 + 8 * fq + 4 * n);
#pragma unroll
        for (int ai = 0; ai < 2; ++ai) {
            u32x4 yw[4][2];
#pragma unroll
            for (int m = 0; m < 4; ++m)
#pragma unroll
                for (int bj = 0; bj < 2; ++bj) yw[m][bj] = *(const u32x4*)((const char*)YG + PG8_AOFF(row0 + ai * HALF + m * 16, colt + bj * HALF + wc * 32 + 8 * fq, 2048));
#pragma unroll
            for (int m = 0; m < 4; ++m) { const int row = row0 + ai * HALF + m * 16;
#pragma unroll
                for (int bj = 0; bj < 2; ++bj) { const int col = colt + bj * HALF + wc * 32 + 8 * fq; const u32x4 y = yw[m][bj];
                    f32x4 v0 = acc[ai][bj][m][0] + bv[bj][0], v1 = acc[ai][bj][m][1] + bv[bj][1];
#pragma unroll
                    for (int e = 0; e < 4; ++e) { v0[e] = __builtin_amdgcn_rcpf(1.0f + __builtin_amdgcn_exp2f(-1.4426950408889634f * v0[e])); v1[e] = __builtin_amdgcn_rcpf(1.0f + __builtin_amdgcn_exp2f(-1.4426950408889634f * v1[e])); }
                    v0[0] *= bf_lo(y.x); v0[1] *= bf_hi(y.x); v0[2] *= bf_lo(y.y); v0[3] *= bf_hi(y.y);
                    v1[0] *= bf_lo(y.z); v1[1] *= bf_hi(y.z); v1[2] *= bf_lo(y.w); v1[3] *= bf_hi(y.w);
                    *(u32x4*)((char*)CAT + PG8_AOFF(row, 2048 + col, 4096)) = pack8(v0, v1); } }
            asm volatile("" ::: "memory"); }
    }
};
struct EpiRes {
    static constexpr bool PERM = true, AFTER_DRAIN = false, IDEMP = false;
    bf16_t* HB; ssq_t* __restrict__ ssq_out;
    __device__ __forceinline__ void operator()(const f32x4 (&acc)[2][2][4][2], const Unit& u, int wr, int wc, int fr, int fq) const {
        const int row0 = u.pm * BM + wr * 64 + fr, colt = u.pn * BM;
        u32x4 b[2][4][2];
#pragma unroll
        for (int ai = 0; ai < 2; ++ai)
#pragma unroll
            for (int m = 0; m < 4; ++m)
#pragma unroll
                for (int bj = 0; bj < 2; ++bj) b[ai][m][bj] = *(const u32x4*)((const char*)HB + PG8_AOFF(row0 + ai * HALF + m * 16, colt + bj * HALF + wc * 32 + 8 * fq, 4096));
#pragma unroll
        for (int ai = 0; ai < 2; ++ai) { float sm[4];
#pragma unroll
            for (int m = 0; m < 4; ++m) { const int row = row0 + ai * HALF + m * 16; float ss = 0.f;
#pragma unroll
                for (int bj = 0; bj < 2; ++bj) { const u32x4 w = b[ai][m][bj];
                    const f32x4 h0 = (f32x4){bf_lo(w.x), bf_hi(w.x), bf_lo(w.y), bf_hi(w.y)} + acc[ai][bj][m][0], h1 = (f32x4){bf_lo(w.z), bf_hi(w.z), bf_lo(w.w), bf_hi(w.w)} + acc[ai][bj][m][1];
                    *(u32x4*)((char*)HB + PG8_AOFF(row, colt + bj * HALF + wc * 32 + 8 * fq, 4096)) = pack8(h0, h1);
                    ss += (h0[0] * h0[0] + h0[1] * h0[1]) + (h0[2] * h0[2] + h0[3] * h0[3]) + (h1[0] * h1[0] + h1[1] * h1[1]) + (h1[2] * h1[2] + h1[3] * h1[3]); }
                ss += __shfl_xor(ss, 16); ss += __shfl_xor(ss, 32); sm[m] = ss; }
            const float mine = fq == 0 ? sm[0] : fq == 1 ? sm[1] : fq == 2 ? sm[2] : sm[3];
            __hip_atomic_fetch_add(ssq_out + row0 + ai * HALF + fq * 16, (ssq_t)(mine * SSQ_SCALE), __ATOMIC_RELAXED, __HIP_MEMORY_SCOPE_AGENT);
            asm volatile("" ::: "memory"); }
    }
};

template <class Epi, class Sched, bool ALIGN_EPI = false, bool SP2 = false>
__device__ __forceinline__ void gemm_phase(PG8_LAS unsigned char* lds, const Gemm g, const Sched& S, const Epi& E) {
    int tid_ = threadIdx.x; asm volatile("" : "+v"(tid_));
    const int tid = tid_, wid = __builtin_amdgcn_readfirstlane(tid >> 6), lane = tid & 63, wr = wid >> 2, wc = wid & 3, fr = lane & 15, fq = lane >> 4;
    const int K = g.K, nt = K / BK;
    unsigned voffA[2], voffB[2];
#pragma unroll
    for (int i = 0; i < 2; ++i) { int R, C; stage_rc(tid * 16 + i * 8192, R, C); const int Rb = Epi::PERM ? ((R & ~31) + perm32(R & 31)) : R;
        voffA[i] = g.a_img ? (unsigned)(tid * 16 + i * 8192) : (unsigned)(R * K + C) * 2u; voffB[i] = g.b_img ? (unsigned)(tid * 16 + i * 8192) : (unsigned)(Rb * K + C) * 2u; }
    const size_t kstA = g.a_img ? (size_t)2 * HTB : (size_t)(BK * 2), hstA = g.a_img ? (size_t)HTB : (size_t)HALF * K * 2, tstA = g.a_img ? (size_t)nt * 2 * HTB : (size_t)2 * HALF * K * 2;
    const size_t kstB = g.b_img ? (size_t)2 * HTB : (size_t)(BK * 2), hstB = g.b_img ? (size_t)HTB : (size_t)HALF * K * 2, tstB = g.b_img ? (size_t)nt * 2 * HTB : (size_t)2 * HALF * K * 2;
    const unsigned ldsw = (unsigned)wid * 1024u;
    const int aoff = lds_byte(wr * 64 + fr, fq * 8), boff = lds_byte(wc * 32 + fr, fq * 8);
#define PG8_SA(b, h) (((b) * 2 + (h)) * HTB)
#define PG8_SB(b, h) ((4 + (b) * 2 + (h)) * HTB)
#define PG8_STAGE(bufoff, rs, goff, voff) do { _Pragma("unroll") for (int _i = 0; _i < 2; ++_i) \
        __builtin_amdgcn_raw_ptr_buffer_load_lds(rs, (PG8_LAS unsigned*)(lds + (bufoff) + ldsw + _i * 8192), 16, (voff)[_i], (goff), 0, 0); } while (0)
#define PG8_LDA(dst, b, h) do { _Pragma("unroll") for (int m = 0; m < 4; ++m) _Pragma("unroll") for (int k = 0; k < 2; ++k) dst[m][k] = *(const PG8_LAS bf16x8*)(lds + PG8_SA(b, h) + aoff + m * 2048 + k * 1024); } while (0)
#define PG8_LDB(dst, b, h) do { _Pragma("unroll") for (int n = 0; n < 2; ++n) _Pragma("unroll") for (int k = 0; k < 2; ++k) dst[n][k] = *(const PG8_LAS bf16x8*)(lds + PG8_SB(b, h) + boff + n * 2048 + k * 1024); } while (0)
#define PG8_MMA(ai, bj, At, Bt) do { __builtin_amdgcn_s_setprio(1); _Pragma("unroll") for (int m = 0; m < 4; ++m) _Pragma("unroll") for (int n = 0; n < 2; ++n) _Pragma("unroll") for (int k = 0; k < 2; ++k) \
        acc[ai][bj][m][n] = __builtin_amdgcn_mfma_f32_16x16x32_bf16(Bt[n][k], At[m][k], acc[ai][bj][m][n], 0, 0, 0); __builtin_amdgcn_s_setprio(0); } while (0)
#define PG8_WAIT_V(n) asm volatile("s_waitcnt vmcnt(" #n ")" ::: "memory")
#define PG8_WAIT_V_SEL(flag, nrelax, nstd) asm volatile("s_cmp_lg_u32 %0, 0\n\ts_cbranch_scc1 .Lpg8r%=\n\ts_waitcnt vmcnt(" #nstd ")\n\ts_branch .Lpg8d%=\n.Lpg8r%=:\n\ts_waitcnt vmcnt(" #nrelax ")\n.Lpg8d%=:" :: "s"(flag) : "memory", "scc")
#define PG8_WAIT_L(n) asm volatile("s_waitcnt lgkmcnt(" #n ")" ::: "memory")
#define PG8_BAR __builtin_amdgcn_s_barrier()
#define PG8_SCHED __builtin_amdgcn_sched_barrier(0)
    Unit cur, nxt; int ui = 0;
    if (!S.next(0, cur)) return;
    f32x4 acc[2][2][4][2];
#pragma unroll
    for (int a = 0; a < 2; ++a)
#pragma unroll
        for (int b = 0; b < 2; ++b)
#pragma unroll
            for (int m = 0; m < 4; ++m)
#pragma unroll
                for (int n = 0; n < 2; ++n) acc[a][b][m][n] = (f32x4){0.f, 0.f, 0.f, 0.f};
    bf16x8 At[4][2], B0[2][2], B1[2][2];
    const __amdgpu_buffer_rsrc_t rsA = __builtin_amdgcn_make_buffer_rsrc((void*)g.A, 0, (unsigned)((size_t)g.M * K * 2), 0x00020000), rsB = __builtin_amdgcn_make_buffer_rsrc((void*)g.Bt, 0, (unsigned)((size_t)g.N * K * 2), 0x00020000);
    unsigned cA = (unsigned)((size_t)cur.pm * tstA), cB = (unsigned)((size_t)cur.pn * tstB);
    S.a_ready(cur);
    if constexpr (SP2) {
        PG8_STAGE(PG8_SB(0, 0), rsB, cB, voffB); PG8_STAGE(PG8_SB(0, 1), rsB, cB + (unsigned)hstB, voffB); PG8_STAGE(PG8_SA(0, 0), rsA, cA, voffA); PG8_STAGE(PG8_SA(0, 1), rsA, cA + (unsigned)hstA, voffA);
        if (wr == 1) PG8_BAR;
        PG8_WAIT_V(2); PG8_BAR;
        PG8_STAGE(PG8_SB(1, 0), rsB, cB + (unsigned)kstB, voffB); PG8_STAGE(PG8_SA(1, 0), rsA, cA + (unsigned)kstA, voffA); PG8_STAGE(PG8_SB(1, 1), rsB, cB + (unsigned)(hstB + kstB), voffB);
        PG8_WAIT_V(6); PG8_BAR;
    } else {
        PG8_STAGE(PG8_SB(0, 0), rsB, cB, voffB); PG8_STAGE(PG8_SA(0, 0), rsA, cA, voffA); PG8_STAGE(PG8_SB(0, 1), rsB, cB + (unsigned)hstB, voffB); PG8_STAGE(PG8_SA(0, 1), rsA, cA + (unsigned)hstA, voffA);
        if (wr == 1) PG8_BAR;
        PG8_WAIT_V(4); PG8_BAR;
        PG8_STAGE(PG8_SB(1, 0), rsB, cB + (unsigned)kstB, voffB); PG8_STAGE(PG8_SA(1, 0), rsA, cA + (unsigned)kstA, voffA); PG8_STAGE(PG8_SB(1, 1), rsB, cB + (unsigned)(hstB + kstB), voffB);
        PG8_WAIT_V(6); PG8_BAR;
    }
    for (;;) {
        const bool has_next = S.next(ui + 1, nxt);
        const unsigned nA = has_next ? (unsigned)((size_t)nxt.pm * tstA) : cA, nB = has_next ? (unsigned)((size_t)nxt.pn * tstB) : cB;
        for (int t = 0; t < nt; t += 2) {
            const bool last = (t == nt - 2);
            const unsigned a1 = cA + (unsigned)((size_t)(t + 1) * kstA);
            const unsigned a2 = last ? nA : cA + (unsigned)((size_t)(t + 2) * kstA), b2 = last ? nB : cB + (unsigned)((size_t)(t + 2) * kstB);
            const unsigned a3 = a2 + (unsigned)kstA, b3 = b2 + (unsigned)kstB;
            if (last && has_next) S.a_ready(nxt);
            if constexpr (SP2) {
            PG8_LDB(B0, 0, 0); PG8_LDB(B1, 0, 1); PG8_SCHED; PG8_LDA(At, 0, 0); PG8_STAGE(PG8_SA(1, 1), rsA, a1 + (unsigned)hstA, voffA);
            PG8_WAIT_V(8); PG8_WAIT_L(0); PG8_BAR; PG8_MMA(0, 0, At, B0); PG8_MMA(0, 1, At, B1); PG8_BAR; PG8_SCHED;
            PG8_LDA(At, 0, 1); PG8_STAGE(PG8_SB(0, 0), rsB, b2, voffB); PG8_STAGE(PG8_SB(0, 1), rsB, b2 + (unsigned)hstB, voffB); PG8_STAGE(PG8_SA(0, 0), rsA, a2, voffA);
            PG8_WAIT_V(8); PG8_WAIT_L(0); PG8_BAR; PG8_MMA(1, 0, At, B0); PG8_MMA(1, 1, At, B1); PG8_BAR; PG8_SCHED;
            PG8_LDB(B0, 1, 0); PG8_LDB(B1, 1, 1); PG8_SCHED; PG8_LDA(At, 1, 0); PG8_STAGE(PG8_SA(0, 1), rsA, a2 + (unsigned)hstA, voffA);
            PG8_WAIT_V(8); PG8_WAIT_L(0); PG8_BAR; PG8_MMA(0, 0, At, B0); PG8_MMA(0, 1, At, B1); PG8_BAR; PG8_SCHED;
            PG8_LDA(At, 1, 1); PG8_STAGE(PG8_SB(1, 0), rsB, b3, voffB); PG8_STAGE(PG8_SB(1, 1), rsB, b3 + (unsigned)hstB, voffB); PG8_STAGE(PG8_SA(1, 0), rsA, a3, voffA);
            PG8_WAIT_V(8); PG8_WAIT_L(0); PG8_BAR; PG8_MMA(1, 0, At, B0); PG8_MMA(1, 1, At, B1); PG8_BAR; PG8_SCHED;
            } else {
            PG8_LDB(B0, 0, 0); PG8_SCHED; PG8_LDA(At, 0, 0); PG8_STAGE(PG8_SA(1, 1), rsA, a1 + (unsigned)hstA, voffA);
            PG8_WAIT_L(8); PG8_BAR; PG8_WAIT_L(0); PG8_MMA(0, 0, At, B0); PG8_BAR; PG8_SCHED;
            PG8_LDB(B1, 0, 1); PG8_STAGE(PG8_SB(0, 0), rsB, b2, voffB);
            PG8_BAR; PG8_WAIT_L(0); PG8_MMA(0, 1, At, B1); PG8_BAR;
            PG8_LDA(At, 0, 1); PG8_STAGE(PG8_SA(0, 0), rsA, a2, voffA);
            PG8_BAR; PG8_WAIT_L(0); PG8_MMA(1, 0, At, B0); PG8_BAR; PG8_SCHED;
            PG8_STAGE(PG8_SB(0, 1), rsB, b2 + (unsigned)hstB, voffB);
            PG8_WAIT_V(6); PG8_BAR; PG8_MMA(1, 1, At, B1); PG8_BAR;
            PG8_LDB(B0, 1, 0); PG8_SCHED; PG8_LDA(At, 1, 0); PG8_STAGE(PG8_SA(0, 1), rsA, a2 + (unsigned)hstA, voffA);
            PG8_WAIT_L(8); PG8_BAR; PG8_WAIT_L(0); PG8_MMA(0, 0, At, B0); PG8_BAR; PG8_SCHED;
            PG8_LDB(B1, 1, 1); PG8_STAGE(PG8_SB(1, 0), rsB, b3, voffB);
            PG8_BAR; PG8_WAIT_L(0); PG8_MMA(0, 1, At, B1); PG8_BAR;
            PG8_LDA(At, 1, 1); PG8_STAGE(PG8_SA(1, 0), rsA, a3, voffA);
            PG8_BAR; PG8_WAIT_L(0); PG8_MMA(1, 0, At, B0); PG8_BAR; PG8_SCHED;
            PG8_STAGE(PG8_SB(1, 1), rsB, b3 + (unsigned)hstB, voffB);
            PG8_WAIT_V(6); PG8_BAR; PG8_MMA(1, 1, At, B1); PG8_BAR;
            }
        }
        if constexpr (ALIGN_EPI) { if (wr == 0) PG8_BAR; }
        if constexpr (!Epi::AFTER_DRAIN) { E(acc, cur, wr, wc, fr, fq);
#ifdef PROBE_EPI2
            if constexpr (Epi::IDEMP) { asm volatile("" ::: "memory"); E(acc, cur, wr, wc, fr, fq); }
#endif
            S.done(cur); }
        if (!has_next) break;
#pragma unroll
        for (int a = 0; a < 2; ++a)
#pragma unroll
            for (int b = 0; b < 2; ++b)
#pragma unroll
                for (int m = 0; m < 4; ++m)
#pragma unroll
                    for (int n = 0; n < 2; ++n) acc[a][b][m][n] = (f32x4){0.f, 0.f, 0.f, 0.f};
        cur = nxt; cA = nA; cB = nB; ++ui;
        if constexpr (ALIGN_EPI) { if (wr == 1) PG8_BAR; }
    }
    PG8_WAIT_V(0);
    if constexpr (!ALIGN_EPI) { if (wr == 0) PG8_BAR; }
    PG8_BAR;
    if constexpr (Epi::AFTER_DRAIN) { E.fused(acc, cur, wr, wc, fr, fq, lds, wid, lane); S.done(cur); }
#undef PG8_SA
#undef PG8_SB
#undef PG8_STAGE
#undef PG8_LDA
#undef PG8_LDB
#undef PG8_MMA
#undef PG8_WAIT_V
#undef PG8_WAIT_V_SEL
#undef PG8_WAIT_L
#undef PG8_BAR
#undef PG8_SCHED
}
}

#ifndef PG8_SP2
#define PG8_SP2 true
#endif
#ifndef PG8_ALIGN
#define PG8_ALIGN true
#endif
#include <hip/hip_bf16.h>
#include <cmath>
namespace attn_body {
using bf16=__hip_bfloat16;
using bf16x8=__attribute__((ext_vector_type(8)))short;
using s16x4=__attribute__((ext_vector_type(4)))short;
using f32x16=__attribute__((ext_vector_type(16)))float;
using u32x4=__attribute__((ext_vector_type(4)))unsigned;
constexpr int BATCH=2,NHEAD=16,SEQ=4096,D=64,DM=6144;
constexpr int OPITCH=4096;
constexpr int NW=8,QBLK=32,QB=QBLK*4,KVBLK=64,NQB=SEQ/QB;
constexpr int ATTN_PITCH=DM, ATTN_UNIT_ROWS=QB;
__device__ __forceinline__ int crow(int r,int hi){return (r&3)+8*(r>>2)+4*hi;}
#define SBAR() __builtin_amdgcn_sched_barrier(0)
__device__ __forceinline__ void cmask(f32x16&p0,f32x16&p1,int jb,int qrel,int hi){
  const float NEG=-INFINITY; int kb=64*jb+4*hi;
  #pragma unroll
  for(int r=0;r<16;++r){int kv=kb+(r&3)+8*(r>>2); if(kv>qrel)p0[r]=NEG; if(kv+32>qrel)p1[r]=NEG;}
}

__device__ __forceinline__ int t5_bucket(int n){ if(n<16)return n; const int st[15]={19,21,24,27,31,35,40,46,52,59,67,77,87,99,113}; int b=16;
  #pragma unroll
  for(int i=0;i<15;++i)b+=(n>=st[i])?1:0; return b; }
typedef const __attribute__((address_space(3))) float* lds_cfptr;
__device__ __forceinline__ void bmask(f32x16&p0,f32x16&p1,int jb,int qrel,int hi,lds_cfptr lut){
  const float NEG=-INFINITY; const int base=qrel-64*jb-4*hi;
  #pragma unroll
  for(int r=0;r<16;++r){const int n0=base-((r&3)+8*(r>>2)),n1=n0-32;
    const float b0=lut[n0<0?0:(n0>128?128:n0)],b1=lut[n1<0?0:(n1>128?128:n1)];
    p0[r]=(n0<0)?NEG:p0[r]+b0; p1[r]=(n1<0)?NEG:p1[r]+b1;}
}
constexpr int NSLOT=3, SLOTB=8192;
constexpr int VSLOTB=16384, NVSLOT=4;
constexpr int LDS_K=0, LDS_V=NSLOT*SLOTB, LDS_WS=NSLOT*SLOTB+NVSLOT*VSLOTB, LDS_OST=LDS_WS+NW*64*4, LDS_LUT=LDS_OST+NW*4096, LDS_BYTES=LDS_LUT+1024;
constexpr float C2=0.125f*1.4426950408889634f;
__device__ __forceinline__ void glds16(const void*gsrc,unsigned lds_dst){unsigned keep;
  asm volatile("s_mov_b32 %0, m0\n\ts_mov_b32 m0, %2\n\ts_nop 0\n\tglobal_load_lds_dwordx4 %1, off\n\ts_mov_b32 m0, %0":"=&s"(keep):"v"(gsrc),"s"(lds_dst):"memory");}
__device__ __forceinline__ float max3f(float a,float b,float c){float r;asm("v_max3_f32 %0, %1, %2, %3":"=v"(r):"v"(a),"v"(b),"v"(c));return r;}
__device__ __forceinline__ float max2f(float a,float b){float r;asm("v_max_f32_e32 %0, %1, %2":"=v"(r):"v"(a),"v"(b));return r;}
__device__ __forceinline__ float fadd_s(float a,float b){float r;asm("v_add_f32_e32 %0, %1, %2":"=v"(r):"v"(a),"v"(b));return r;}
__device__ __forceinline__ float fsub_s(float a,float b){float r;asm("v_sub_f32_e32 %0, %1, %2":"=v"(r):"v"(a),"v"(b));return r;}
typedef float f32x2_t __attribute__((ext_vector_type(2))); typedef __bf16 bf16x2_t __attribute__((ext_vector_type(2)));
__device__ __forceinline__ unsigned cvtpk_s(float lo,float hi){f32x2_t v={lo,hi};bf16x2_t b=__builtin_convertvector(v,bf16x2_t);return __builtin_bit_cast(unsigned,b);}
#define WAIT_BAR(N) asm volatile("s_waitcnt vmcnt(" #N ") lgkmcnt(0)\n\ts_barrier":::"memory")

__device__ __forceinline__ void qkt(f32x16&p0,f32x16&p1,const char*Kslot,const bf16x8*qr,const f32x16&negm,int r32,int hi){
  const char*kb=Kslot+hi*1024+r32*16;
  #pragma unroll
  for(int d0=0;d0<4;++d0){
    const bf16x8 b0=*reinterpret_cast<const bf16x8*>(kb+d0*2048);
    const bf16x8 b1=*reinterpret_cast<const bf16x8*>(kb+d0*2048+512);
    if(d0==0){p0=__builtin_amdgcn_mfma_f32_32x32x16_bf16(b0,qr[0],negm,0,0,0);p1=__builtin_amdgcn_mfma_f32_32x32x16_bf16(b1,qr[0],negm,0,0,0);}
    else{p0=__builtin_amdgcn_mfma_f32_32x32x16_bf16(b0,qr[d0],p0,0,0,0);p1=__builtin_amdgcn_mfma_f32_32x32x16_bf16(b1,qr[d0],p1,0,0,0);}}
}
typedef __attribute__((address_space(3))) const char* lds_cptr;
typedef short v4i16_t __attribute__((ext_vector_type(4)));
__device__ __forceinline__ void kload8(bf16x8*kf,lds_cptr kp){
  kf[0]=*(const __attribute__((address_space(3))) bf16x8*)(kp);      kf[1]=*(const __attribute__((address_space(3))) bf16x8*)(kp+512);
  kf[2]=*(const __attribute__((address_space(3))) bf16x8*)(kp+2048); kf[3]=*(const __attribute__((address_space(3))) bf16x8*)(kp+2560);
  kf[4]=*(const __attribute__((address_space(3))) bf16x8*)(kp+4096); kf[5]=*(const __attribute__((address_space(3))) bf16x8*)(kp+4608);
  kf[6]=*(const __attribute__((address_space(3))) bf16x8*)(kp+6144); kf[7]=*(const __attribute__((address_space(3))) bf16x8*)(kp+6656);
}
__device__ __forceinline__ void kload2(bf16x8*kf,lds_cptr kp,int j){ kf[2*j]=*(const __attribute__((address_space(3))) bf16x8*)(kp+j*2048); kf[2*j+1]=*(const __attribute__((address_space(3))) bf16x8*)(kp+j*2048+512); }
__device__ __forceinline__ s16x4 vtr(lds_cptr p){ return __builtin_bit_cast(s16x4,__builtin_amdgcn_ds_read_tr16_b64_v4i16((__attribute__((address_space(3))) v4i16_t*)p)); }
__device__ __forceinline__ void qkt1(f32x16&p0,const char*kb,const bf16x8*qr,const f32x16&negm){
  #pragma unroll
  for(int d0=0;d0<4;++d0){ const bf16x8 b0=*reinterpret_cast<const bf16x8*>(kb+d0*2048);
    if(d0==0)p0=__builtin_amdgcn_mfma_f32_32x32x16_bf16(b0,qr[0],negm,0,0,0); else p0=__builtin_amdgcn_mfma_f32_32x32x16_bf16(b0,qr[d0],p0,0,0,0);}
}
__device__ __forceinline__ void kload4(bf16x8*kf,lds_cptr kp){
  kf[0]=*(const __attribute__((address_space(3))) bf16x8*)(kp);      kf[1]=*(const __attribute__((address_space(3))) bf16x8*)(kp+2048);
  kf[2]=*(const __attribute__((address_space(3))) bf16x8*)(kp+4096); kf[3]=*(const __attribute__((address_space(3))) bf16x8*)(kp+6144);
}
__device__ __forceinline__ void kload1(bf16x8*kf,lds_cptr kp,int j){ kf[j]=*(const __attribute__((address_space(3))) bf16x8*)(kp+j*2048); }
__device__ __forceinline__ float rowmax1(const f32x16&p0){
  float a=max3f(p0[0],p0[1],p0[2]),b=max3f(p0[3],p0[4],p0[5]);
  a=max3f(a,p0[6],p0[7]);b=max3f(b,p0[8],p0[9]);a=max3f(a,p0[10],p0[11]);b=max3f(b,p0[12],p0[13]);a=max3f(a,p0[14],p0[15]);
  const float m=max2f(a,b);
  auto rr=__builtin_amdgcn_permlane32_swap(__float_as_uint(m),__float_as_uint(m),false,false);
  return max2f(__uint_as_float(rr[0]),__uint_as_float(rr[1]));
}
__device__ __forceinline__ void bmask1(f32x16&p0,int nb,lds_cfptr lut){
  #pragma unroll
  for(int r=0;r<16;++r){ int n0=nb-((r&3)+8*(r>>2)); n0=n0<-1?-1:(n0>128?128:n0); p0[r]+=lut[n0+1]; }
}
__device__ __forceinline__ void pv2(f32x16*o,int vb,bf16x8 pa0,bf16x8 pa1){
  #pragma unroll
  for(int d0=0;d0<4;++d0){s16x4 lo[2],hi[2];
    #pragma unroll
    for(int ks=0;ks<2;++ks){
      asm volatile("ds_read_b64_tr_b16 %0,%1 offset:%c2":"=&v"(lo[ks]):"v"(vb),"i"(d0*4096+ks*1024):"memory");
      asm volatile("ds_read_b64_tr_b16 %0,%1 offset:%c2":"=&v"(hi[ks]):"v"(vb),"i"(d0*4096+ks*1024+512):"memory");}
    asm volatile("s_waitcnt lgkmcnt(0)":::"memory");SBAR();
    #define PK(k) (bf16x8){lo[k][0],lo[k][1],lo[k][2],lo[k][3],hi[k][0],hi[k][1],hi[k][2],hi[k][3]}
    o[d0]=__builtin_amdgcn_mfma_f32_32x32x16_bf16(pa0,PK(0),o[d0],0,0,0);
    o[d0]=__builtin_amdgcn_mfma_f32_32x32x16_bf16(pa1,PK(1),o[d0],0,0,0);
    #undef PK
  }
}
__device__ __forceinline__ float rowmax(const f32x16&p0,const f32x16&p1){
  float a=max3f(p0[0],p0[1],p1[0]),b=max3f(p0[2],p0[3],p1[1]);a=max3f(a,p1[2],p1[3]);
  #pragma unroll
  for(int r=4;r<16;r+=4){a=max3f(a,p0[r],p0[r+1]);b=max3f(b,p0[r+2],p0[r+3]);a=max3f(a,p1[r],p1[r+1]);b=max3f(b,p1[r+2],p1[r+3]);}
  const float m=max2f(a,b);
  auto rr=__builtin_amdgcn_permlane32_swap(__float_as_uint(m),__float_as_uint(m),false,false);
  return max2f(__uint_as_float(rr[0]),__uint_as_float(rr[1]));
}
__device__ __forceinline__ void pv(f32x16*o,int vb,bf16x8 pa0,bf16x8 pa1,bf16x8 pa2,bf16x8 pa3){
  #pragma unroll
  for(int d0=0;d0<2;++d0){s16x4 lo[4],hi[4];
    #pragma unroll
    for(int ks=0;ks<4;++ks){
      asm volatile("ds_read_b64_tr_b16 %0,%1 offset:%c2":"=&v"(lo[ks]):"v"(vb),"i"(d0*4096+ks*1024):"memory");
      asm volatile("ds_read_b64_tr_b16 %0,%1 offset:%c2":"=&v"(hi[ks]):"v"(vb),"i"(d0*4096+ks*1024+512):"memory");}
    asm volatile("s_waitcnt lgkmcnt(0)":::"memory");SBAR();
    #define PK(k) (bf16x8){lo[k][0],lo[k][1],lo[k][2],lo[k][3],hi[k][0],hi[k][1],hi[k][2],hi[k][3]}
    o[d0]=__builtin_amdgcn_mfma_f32_32x32x16_bf16(pa0,PK(0),o[d0],0,0,0);
    o[d0]=__builtin_amdgcn_mfma_f32_32x32x16_bf16(pa1,PK(1),o[d0],0,0,0);
    o[d0]=__builtin_amdgcn_mfma_f32_32x32x16_bf16(pa2,PK(2),o[d0],0,0,0);
    o[d0]=__builtin_amdgcn_mfma_f32_32x32x16_bf16(pa3,PK(3),o[d0],0,0,0);
    #undef PK
  }
}

__device__ __forceinline__ void build_lut(char*shm,const float*relb,int h,int tid){
  __attribute__((address_space(3))) float* lw=(__attribute__((address_space(3))) float*)((__attribute__((address_space(3))) char*)shm+LDS_LUT);
  if(tid<129){ const int bk=t5_bucket(tid); lw[1+tid]=(relb[bk*NHEAD+h]-relb[31*NHEAD+h])*1.4426950408889634f; } else if(tid==129){ lw[0]=-INFINITY; }
}
#ifndef ATTN_STORE16
#define ATTN_STORE16(p,v) (*(u32x4*)(p)=(v))
#endif
struct UnitArgs { int kind; int qcol,kcol,vcol,ocol; const float* relb; float* scr; float lam,oscale; const float* gain; };
template<int THRL> __device__ __forceinline__ void attn_unit(int b,int h,int qb,const bf16*Q,const bf16*__restrict__ K,const bf16*__restrict__ V,bf16*O,char*shm,const UnitArgs&ua){
  int tid_=threadIdx.x; asm volatile("":"+v"(tid_)); const int tid=tid_,lane=tid&63,r32=lane&31,hi=lane>>5; const int wid=__builtin_amdgcn_readfirstlane(tid>>6);
  const int rg=wid&3,g=wid>>2;
#ifdef ATT_PRIO
  if(g)__builtin_amdgcn_s_setprio(ATT_PRIO);
#endif
  const long rowbase=(long)b*SEQ; const int q0=qb*QB;
  const bf16*Qw=Q+(rowbase+q0+rg*QBLK)*DM+ua.qcol;
  const unsigned lds0=(unsigned)(uintptr_t)shm;
  float*wsf=(float*)(shm+LDS_WS)+wid*64;
  const char*ksrc=(const char*)K+wid*1024+lane*16;
  const char*vsrc=(const char*)V+wid*1024+lane*16;
  const unsigned kdst=lds0+LDS_K+wid*1024, vdst=lds0+LDS_V+wid*1024;
  #define DMA_K(t,slot) glds16(ksrc+(long)(t)*8192,(unsigned)__builtin_amdgcn_readfirstlane(kdst+(slot)))
  #define VSL(t) (((t)&(NVSLOT-1))*VSLOTB)
  #define DMA_V(t) do{ glds16(vsrc+(long)(t)*16384,(unsigned)__builtin_amdgcn_readfirstlane(vdst+VSL(t))); glds16(vsrc+8192+(long)(t)*16384,(unsigned)__builtin_amdgcn_readfirstlane(vdst+VSL(t)+8192)); }while(0)
  const int vb0=(int)(lds0+LDS_V)+((lane>>4)&1)*32+(lane&3)*8+(4*hi+((lane&15)>>2))*64+g*2048;
  bf16x8 kf[4];
  const lds_cptr shm3=(lds_cptr)shm; const lds_cptr kp0=shm3+LDS_K+hi*1024+r32*16+g*512; const lds_cptr vp0=shm3+LDS_V+((lane>>4)&1)*32+(lane&3)*8+(4*hi+((lane&15)>>2))*64+g*2048;
  const int NTd=(q0+QB)/KVBLK, NT=NTd<4?4:NTd;
  const lds_cfptr lutp=(lds_cfptr)((lds_cptr)shm+LDS_LUT);
  DMA_K(0,0);DMA_V(0);DMA_K(1,SLOTB);
  bf16x8 qr[4];
  #pragma unroll
  for(int d0=0;d0<4;++d0)qr[d0]=*reinterpret_cast<const bf16x8*>(&Qw[(long)r32*DM+d0*16+hi*8]);
  float mhat=0.f,l_reg=0.f;f32x16 o[4];o[0]=f32x16{};o[1]=f32x16{};o[2]=f32x16{};o[3]=f32x16{};f32x16 negm=f32x16{};asm volatile("":"+v"(negm));
  const int qw=q0+rg*QBLK-32*g;
  const int qabs=q0+rg*QBLK+r32-32*g-4*hi;
  #define CMASK(P0,t) do{ if(qw-64*(t)<144)bmask1(P0,qabs-64*(t),lutp); }while(0)
  bool resc=false;
  #define START(P0) do{ const float rm=rowmax1(P0); resc=false; \
    { const float dl=(rm==-INFINITY)?0.f:rm; mhat=fadd_s(mhat,dl); \
      _Pragma("unroll") for(int r=0;r<16;++r){P0[r]=fsub_s(P0[r],dl);} \
      _Pragma("unroll") for(int r=0;r<16;++r)negm[r]=-mhat; asm volatile("":"+v"(negm)); } \
    _Pragma("unroll") for(int r=0;r<16;++r)P0[r]=__builtin_amdgcn_exp2f(P0[r]); }while(0)
  #define RESC() do{ if(resc){ asm volatile("s_waitcnt lgkmcnt(0)":::"memory"); \
      _Pragma("unroll") for(int d_=0;d_<4;++d_) _Pragma("unroll") for(int r=0;r<16;++r)o[d_][r]*=wsf[crow(r,hi)]; } }while(0)
  f32x16 pA0,pB0;
  int sl_prev=0,sl_cur=0,sl_next=SLOTB;
  #define ROT() do{sl_prev=sl_cur;sl_cur=sl_next;sl_next=(sl_next==(NSLOT-1)*SLOTB)?0:sl_next+SLOTB;}while(0)
  DMA_K(2,2*SLOTB);DMA_V(1);
  WAIT_BAR(6);
  qkt1(pA0,shm+LDS_K+hi*1024+r32*16+g*512,qr,negm);asm volatile("s_nop 15\n\ts_nop 7":"+v"(pA0));CMASK(pA0,0);
  START(pA0);
  WAIT_BAR(2);
  DMA_K(3,0);DMA_V(2);
  ROT();
  kload4(kf,kp0+sl_cur);
  WAIT_BAR(5);
  s16x4 vlo[8],vhi[8]; u32x4 pw0,pw1;
  #define PKW(P,B) cvtpk_s(P[B],P[B+1])
  #define PAF(k) __builtin_bit_cast(bf16x8,pw##k)
  #define VFR(i) (bf16x8){vlo[i][0],vlo[i][1],vlo[i][2],vlo[i][3],vhi[i][0],vhi[i][1],vhi[i][2],vhi[i][3]}
  #define PIN(x) asm volatile("":"+v"(x))
  #define MX3(a,b,c) __builtin_fmaxf(__builtin_fmaxf((a),(b)),(c))
  #define GAPA(MF,A0,A1,A2,A3,W0,W1,PW) do{ MF; sacc+=A0; sacc+=A1; sacc+=A2; sacc+=A3; PIN(sacc); W0; W1; PIN(PW); SBAR(); }while(0)
  #define EX(v) __builtin_amdgcn_exp2f(v)
  #define GAPB(MF,X,B) do{ MF; X[B]=EX(X[B]); X[B+1]=EX(X[B+1]); PIN(X); SBAR(); }while(0)
  #define VRD(w,d,k) do{ vlo[w]=vtr(vp_+((d)*4096+(k)*1024)); vhi[w]=vtr(vp_+((d)*4096+(k)*1024+512)); }while(0)
  #define KRD(G,j) do{ if(G){ kload1(kf,kp0+sl_next,j); SBAR(); } }while(0)
  #define STEP(C0,P0,t,GK,GV,GL) do{ SBAR(); \
    const lds_cptr vp_=vp0+VSL((t)-1); \
    VRD(0,0,0); VRD(1,1,0); SBAR(); float sacc=(P0[0]+P0[1]); \
    GAPA(C0=__builtin_amdgcn_mfma_f32_32x32x16_bf16(kf[0],qr[0],negm,0,0,0), P0[2],P0[3],P0[4],P0[5],     pw0[0]=PKW(P0,0), pw0[1]=PKW(P0,2), pw0); \
    VRD(2,2,0); VRD(3,3,0); SBAR(); GAPA(C0=__builtin_amdgcn_mfma_f32_32x32x16_bf16(kf[1],qr[1],C0,0,0,0), P0[6],P0[7],P0[8],P0[9],     pw0[2]=PKW(P0,4), pw0[3]=PKW(P0,6), pw0); \
    VRD(4,0,1); VRD(5,1,1); SBAR(); GAPA(C0=__builtin_amdgcn_mfma_f32_32x32x16_bf16(kf[2],qr[2],C0,0,0,0), P0[10],P0[11],P0[12],P0[13], pw1[0]=PKW(P0,8), pw1[1]=PKW(P0,10), pw1); \
    VRD(6,2,1); VRD(7,3,1); SBAR(); GAPA(C0=__builtin_amdgcn_mfma_f32_32x32x16_bf16(kf[3],qr[3],C0,0,0,0), P0[14],P0[15],0.f,0.f,       pw1[2]=PKW(P0,12),pw1[3]=PKW(P0,14), pw1); \
    l_reg+=sacc; \
    if(GK){DMA_K((t)+3,sl_cur);} if(GV){DMA_V((t)+2);} \
    CMASK(C0,t); \
    { float a=MX3(C0[0],C0[1],C0[2]),b=MX3(C0[3],C0[4],C0[5]); a=MX3(a,C0[6],C0[7]); b=MX3(b,C0[8],C0[9]); a=MX3(a,C0[10],C0[11]); b=MX3(b,C0[12],C0[13]); a=MX3(a,C0[14],C0[15]); \
      float rm=__builtin_fmaxf(a,b); { auto rr=__builtin_amdgcn_permlane32_swap(__float_as_uint(rm),__float_as_uint(rm),false,false); rm=__builtin_fmaxf(__uint_as_float(rr[0]),__uint_as_float(rr[1])); } \
      resc=false; \
      if(__builtin_expect(__any(rm>(float)THRL),0)){ const float dl=__builtin_fmaxf(rm,0.f); mhat+=dl; \
        _Pragma("unroll") for(int r=0;r<16;++r){C0[r]-=dl;} \
        _Pragma("unroll") for(int r=0;r<16;++r)negm[r]=-mhat; asm volatile("":"+v"(negm)); \
        const float f=__builtin_amdgcn_exp2f(-dl); l_reg*=f; if(hi==0)wsf[r32]=f; resc=true; } } \
    SBAR(); \
    GAPB(o[0]=__builtin_amdgcn_mfma_f32_32x32x16_bf16(PAF(0),VFR(0),o[0],0,0,0), C0,0); \
    GAPB(o[1]=__builtin_amdgcn_mfma_f32_32x32x16_bf16(PAF(0),VFR(1),o[1],0,0,0), C0,2); \
    KRD(GL,0); GAPB(o[2]=__builtin_amdgcn_mfma_f32_32x32x16_bf16(PAF(0),VFR(2),o[2],0,0,0), C0,4); \
    KRD(GL,1); GAPB(o[3]=__builtin_amdgcn_mfma_f32_32x32x16_bf16(PAF(0),VFR(3),o[3],0,0,0), C0,6); \
    KRD(GL,2); GAPB(o[0]=__builtin_amdgcn_mfma_f32_32x32x16_bf16(PAF(1),VFR(4),o[0],0,0,0), C0,8); \
    KRD(GL,3); GAPB(o[1]=__builtin_amdgcn_mfma_f32_32x32x16_bf16(PAF(1),VFR(5),o[1],0,0,0), C0,10); \
    GAPB(o[2]=__builtin_amdgcn_mfma_f32_32x32x16_bf16(PAF(1),VFR(6),o[2],0,0,0), C0,12); \
    GAPB(o[3]=__builtin_amdgcn_mfma_f32_32x32x16_bf16(PAF(1),VFR(7),o[3],0,0,0), C0,14); \
    }while(0)
  int t=1;
  #undef CMASK
  #define CMASK(P0,t) do{}while(0)
  for(;t+7<NT;t+=2){
    STEP(pB0,pA0,t,true,true,true);     WAIT_BAR(5); RESC(); ROT();
    STEP(pA0,pB0,t+1,true,true,true);   WAIT_BAR(5); RESC(); ROT();
  }
  #undef CMASK
  #define CMASK(P0,t) do{ if(qw-64*(t)<144)bmask1(P0,qabs-64*(t),lutp); }while(0)
  #define ENDW(tt) do{ if((tt)+3<NT){WAIT_BAR(5);} else if((tt)+2<NT){WAIT_BAR(4);} else {WAIT_BAR(0);} }while(0)
  for(;t+1<NT;t+=2){
    STEP(pB0,pA0,t,(t+3<NT),(t+2<NT),(t+1<NT));       ENDW(t);   RESC(); ROT();
    STEP(pA0,pB0,t+1,(t+4<NT),(t+3<NT),(t+2<NT));     ENDW(t+1); RESC(); ROT();
  }
  STEP(pB0,pA0,NT-1,false,false,false); RESC();
  { float sacc=pB0[0]+pB0[1]; _Pragma("unroll") for(int r=2;r<16;++r)sacc+=pB0[r]; l_reg+=sacc;
    pw0=(u32x4){PKW(pB0,0),PKW(pB0,2),PKW(pB0,4),PKW(pB0,6)};pw1=(u32x4){PKW(pB0,8),PKW(pB0,10),PKW(pB0,12),PKW(pB0,14)};
    SBAR(); pv2(o,vb0+VSL(NT-1),PAF(0),PAF(1)); }
  #undef PKW
  #undef PAF
  #undef VFR
  #undef PIN
  #undef MX3
  #undef GAPA
  #undef GAPB
  #undef EX
  #undef VRD
  #undef KRD
  #undef STEP
  #undef ENDW
  {auto rr=__builtin_amdgcn_permlane32_swap(__float_as_uint(l_reg),__float_as_uint(l_reg),false,false);l_reg=__uint_as_float(rr[0])+__uint_as_float(rr[1]);}
  asm volatile("s_waitcnt lgkmcnt(0)\n\ts_barrier":::"memory");
  typedef float f32x4v __attribute__((ext_vector_type(4)));
  float*xs=(float*)shm+rg*(64*64+64)+64*64;
  f32x4v*xo4=(f32x4v*)((float*)shm+rg*(64*64+64));
  if(g==1){
    #pragma unroll
    for(int d0=0;d0<4;++d0){
      #pragma unroll
      for(int r4=0;r4<4;++r4)xo4[(d0*4+r4)*64+lane]=(f32x4v){o[d0][4*r4],o[d0][4*r4+1],o[d0][4*r4+2],o[d0][4*r4+3]};}
    if(hi==0){xs[r32]=mhat;xs[32+r32]=l_reg;}
  }
  asm volatile("s_waitcnt lgkmcnt(0)\n\ts_barrier":::"memory");
  if(g==0){
    const float mb=xs[r32],lb=xs[32+r32];
    const float m=(lb>0.f)?__builtin_fmaxf(mhat,mb):mhat,wa=__builtin_amdgcn_exp2f(mhat-m),wb=(lb>0.f)?__builtin_amdgcn_exp2f(mb-m):0.f;
    const float linv=__builtin_amdgcn_rcpf(l_reg*wa+lb*wb);
    if(hi==0){wsf[r32]=wa*linv;wsf[32+r32]=wb*linv;}
    f32x4v*sc4=(f32x4v*)ua.scr+(rg*16)*64+lane;
    f32x4v t2[16];
    if(ua.kind!=0){
      #pragma unroll
      for(int i=0;i<16;++i)t2[i]=__builtin_nontemporal_load(sc4+i*64);
    }
    asm volatile("s_waitcnt lgkmcnt(0)":::"memory");
    #pragma unroll
    for(int r4=0;r4<4;++r4){ const f32x4v fa=*(const f32x4v*)(wsf+8*r4+4*hi),fb=*(const f32x4v*)(wsf+32+8*r4+4*hi);
      #pragma unroll
      for(int d0=0;d0<4;++d0){ const f32x4v ob=xo4[(d0*4+r4)*64+lane];
        #pragma unroll
        for(int j=0;j<4;++j)o[d0][4*r4+j]=o[d0][4*r4+j]*fa[j]+ob[j]*fb[j]; } }
    if(ua.kind==0){
      #pragma unroll
      for(int d0=0;d0<4;++d0){
        #pragma unroll
        for(int r4=0;r4<4;++r4)sc4[(d0*4+r4)*64]=(f32x4v){o[d0][4*r4],o[d0][4*r4+1],o[d0][4*r4+2],o[d0][4*r4+3]};} }
    else{
      float rs[16];
      #pragma unroll
      for(int r=0;r<16;++r){ float ss=0.f;
        #pragma unroll
        for(int d0=0;d0<4;++d0){const float a=o[d0][r]-ua.lam*t2[d0*4+(r>>2)][r&3]; o[d0][r]=a; ss+=a*a;}
        ss+=__shfl_xor(ss,1); ss+=__shfl_xor(ss,2); ss+=__shfl_xor(ss,4); ss+=__shfl_xor(ss,8); ss+=__shfl_xor(ss,16);
        rs[r]=ua.oscale*__builtin_amdgcn_rsqf(ss*(1.0f/128.0f)+1e-6f); }
      bf16*stg=(bf16*)(shm+LDS_OST)+wid*2048;
      #pragma unroll
      for(int vh=0;vh<2;++vh){
        const float g0=ua.gain[vh*64+r32],g1=ua.gain[vh*64+32+r32];
        #pragma unroll
        for(int r=0;r<16;++r){const int orow=crow(r,hi);
          stg[orow*64+r32]=__float2bfloat16(o[2*vh][r]*rs[r]*g0);
          stg[orow*64+32+r32]=__float2bfloat16(o[2*vh+1][r]*rs[r]*g1);}
        asm volatile("s_waitcnt lgkmcnt(0)":::"memory");
        #pragma unroll
        for(int i=0;i<4;++i){const int row=i*8+(lane>>3),ch=lane&7; const u32x4 v=*(const u32x4*)(stg+row*64+ch*8); ATTN_STORE16((char*)O+PG8_AOFF(rowbase+q0+rg*QBLK+row,ua.ocol+vh*64+ch*8,OPITCH),v);}
        asm volatile("s_waitcnt lgkmcnt(0)":::"memory");
      } }
  }
#ifdef ATT_PRIO
  __builtin_amdgcn_s_setprio(0);
#endif
  asm volatile("s_waitcnt lgkmcnt(0)\n\ts_barrier":::"memory");
  #undef DMA_K
  #undef DMA_V
  #undef VSL
  #undef CMASK
  #undef START
  #undef RESC
  #undef ROT
}
constexpr int ATTN_LDS_BYTES=LDS_BYTES;
#undef SBAR
#undef WAIT_BAR
}

constexpr int NWAVES = 8;
#ifndef MK_PER_PHASE
#define MK_PER_PHASE 0
#endif
constexpr int BATCH = 2, SEQ = 4096, DMODEL = 4096, M = BATCH * SEQ, DEPTH = 4, FF = 16384, NGRP = 128;
constexpr int N_PHASES = 2 + 6 * DEPTH;
constexpr size_t MiB = 1u << 20;
constexpr size_t WS_CTL = 0, CTL_ZERO_BYTES = 1 * MiB;
constexpr int CW_BAR = 4096;
constexpr size_t SSQ_OFF = 128 * 1024;
static_assert(SSQ_OFF + 9 * (size_t)M * 8 <= CTL_ZERO_BYTES, "ssq inside the memset region");
constexpr size_t WS_W = 16 * MiB, W_LAYER = 360 * MiB;
constexpr size_t W_IN = 0, W_OUT = 64 * MiB, W_UP = 96 * MiB, W_DN = 224 * MiB, W_GLU = 352 * MiB;
constexpr size_t WS_SSMP = WS_W + DEPTH * W_LAYER;
constexpr size_t SSMP_STRIDE = 144 * 1024;
constexpr size_t WS_KI = 1536 * MiB, WS_VI = 1568 * MiB;
constexpr size_t WS_H = 1536 * MiB, WS_HB = 1664 * MiB, WS_QKV = 1728 * MiB, WS_UT = 1824 * MiB, WS_YG = 1856 * MiB, WS_CAT = 1888 * MiB, WS_ATT = 1952 * MiB, WS_HID = 1984 * MiB, WS_END = 2240 * MiB;
static_assert(WS_SSMP + (size_t)DEPTH * NGRP * SSMP_STRIDE <= WS_H, "d_ws map");
constexpr int RING_OFF = 0, RING_BYTES = 131072;
constexpr int LDSCTL_OFF = RING_BYTES, MISC_OFF = LDSCTL_OFF + 320;
constexpr int LDS_BYTES = 147456;
static_assert(MISC_OFF + 128 <= LDS_BYTES, "LDS map");

#define GAS __attribute__((address_space(1)))
#define LAS __attribute__((address_space(3)))
typedef unsigned short bf16;
typedef unsigned v4u __attribute__((ext_vector_type(4)));
typedef float f32x4 __attribute__((ext_vector_type(4)));
typedef short bf16x8 __attribute__((ext_vector_type(8)));
typedef GAS unsigned gu32;
typedef GAS unsigned long long gu64;
#define RLX_AGENT __ATOMIC_RELAXED, __HIP_MEMORY_SCOPE_AGENT
#define LDS_WAIT() asm volatile("s_waitcnt lgkmcnt(0)" ::: "memory")
#define VM_WAIT() asm volatile("s_waitcnt vmcnt(0)" ::: "memory")
__device__ __forceinline__ unsigned long long rt() { return __builtin_amdgcn_s_memrealtime(); }
__device__ __forceinline__ unsigned f2bf(float f) { unsigned u = __builtin_bit_cast(unsigned, f); return (u + 0x7fffu + ((u >> 16) & 1u)) >> 16; }
__device__ __forceinline__ unsigned pk2(float lo, float hi) { return f2bf(lo) | (f2bf(hi) << 16); }

#define XB_TMO      128
#define XB_XCNT(j)  (256  + 64 * (j))
#define XB_XSUB(j)  (1280 + 64 * (j))
#define XB_XGEN(j)  (2304 + 64 * (j))
#define XB_TOP      3328
#define XB_TOPGEN   3392
#define XCD_BAR_WORDS 3456
#define XB_SPIN_CAP (1u << 18)

__device__ __forceinline__ unsigned xb_ld(unsigned* p)              { return __hip_atomic_load(p, __ATOMIC_RELAXED, __HIP_MEMORY_SCOPE_AGENT); }
__device__ __forceinline__ unsigned xb_add(unsigned* p, unsigned v) { return __hip_atomic_fetch_add(p, v, __ATOMIC_RELAXED, __HIP_MEMORY_SCOPE_AGENT); }
__device__ __forceinline__ unsigned xb_xcc_id() { return (unsigned)__builtin_amdgcn_s_getreg((3 << 11) | 20) & 0xFu; }
#define XB_SPIN(cond, bar) do { unsigned _sp = 0; while (cond) { __builtin_amdgcn_s_sleep(1); \
    if ((++_sp & 255u) == 0u) { if (xb_ld(&(bar)[XB_TMO])) break; if (_sp > XB_SPIN_CAP) { atomicAdd(&(bar)[XB_TMO], 1u); break; } } } } while (0)

struct XcdBarrier {
    unsigned* bar; unsigned x;
    volatile LAS unsigned* st;
};

__device__ __forceinline__ XcdBarrier xcd_barrier_post(unsigned* bar, volatile LAS unsigned* st) {
    XcdBarrier b; b.bar = bar; b.x = xb_xcc_id(); b.st = st;
    if (threadIdx.x == 0) (void)xb_add(&bar[XB_XCNT(b.x)], 1u);
    return b;
}
__device__ __forceinline__ void xcd_barrier_complete(unsigned* bar, unsigned x, unsigned& nloc, unsigned& nx) {
    const unsigned G = gridDim.x * gridDim.y * gridDim.z;
    unsigned sum, cnt, mine, sp = 0u;
    for (;;) {
        sum = 0u; cnt = 0u; mine = 0u;
#pragma unroll
        for (unsigned j = 0; j < 16; ++j) { const unsigned c = xb_ld(&bar[XB_XCNT(j)]); sum += c; cnt += (c > 0u) ? 1u : 0u; mine = (j == x) ? c : mine; }
        if (sum == G) break;
        __builtin_amdgcn_s_sleep(1);
        if ((++sp & 255u) == 0u) { if (xb_ld(&bar[XB_TMO])) break; if (sp > XB_SPIN_CAP) { atomicAdd(&bar[XB_TMO], 1u); break; } }
    }
    nloc = mine > 0u ? mine : 1u; nx = cnt > 0u ? cnt : 1u;
}

__device__ __forceinline__ void xcd_barrier(const XcdBarrier& b) {
    asm volatile("s_waitcnt vmcnt(0)" ::: "memory");
    __syncthreads();
    if (threadIdx.x == 0) {
        unsigned* bar = b.bar;
        __builtin_amdgcn_s_waitcnt(0);
        unsigned nloc = b.st[0], nx = b.st[1];
        if (nloc == 0u) { xcd_barrier_complete(bar, b.x, nloc, nx); b.st[0] = nloc; b.st[1] = nx; }
        const unsigned old = xb_add(&bar[XB_XSUB(b.x)], 1u);
        const unsigned gen = old / nloc;
        if (old + 1u == (gen + 1u) * nloc) {
            __builtin_amdgcn_fence(__ATOMIC_RELEASE, "agent");
            asm volatile("s_waitcnt vmcnt(0)" ::: "memory");
            const unsigned og = xb_add(&bar[XB_TOP], 1u);
            const unsigned tg = og / nx;
            if (og + 1u == (tg + 1u) * nx) xb_add(&bar[XB_TOPGEN], 1u);
            else XB_SPIN(xb_ld(&bar[XB_TOPGEN]) == tg, bar);
            __builtin_amdgcn_fence(__ATOMIC_ACQUIRE, "agent");
            xb_add(&bar[XB_XGEN(b.x)], 1u);
            asm volatile("s_waitcnt vmcnt(0)" ::: "memory");
        } else {
            XB_SPIN(xb_ld(&bar[XB_XGEN(b.x)]) == gen, bar);
            __builtin_amdgcn_fence(__ATOMIC_ACQUIRE, "agent");
            asm volatile("s_waitcnt vmcnt(0)" ::: "memory");
        }
    }
    __syncthreads();
}

struct Frame {
    LAS unsigned char* lds;
    volatile LAS unsigned* MISC;
    gu32* ctl;
    int tid, lane, wave;
    int vcu, G;
    const float* const* in;
    float* out; unsigned char* ws;
};
enum In { I_X = 0, I_WIN, I_WOUT, I_NMIX, I_NMLP, I_WUP, I_WDN, I_NFIN, I_RELB, I_LQ1, I_LK1, I_LQ2, I_LK2, I_SUBG, I_SLRE, I_SLIM, I_SLDT, I_SBRE, I_SBIM, I_SCRE, I_SCIM, I_SD, I_WGLU, I_BGLU, N_IN };

__device__ __forceinline__ float wave_sum(float v) {
#pragma unroll
    for (int o = 1; o < 64; o <<= 1) v += __shfl_xor(v, o);
    return v;
}
struct TItem { const float* src; const float* gain; bf16* dst; int N, K, n0, k0; };
struct TRegs { f32x4 v[8]; f32x4 g0, g1; };
__device__ __forceinline__ void tr_load(const TItem& t, TRegs& r, int lane) {
    const float* p = t.src + (size_t)(lane >> 4) * t.N + 4 * (lane & 15);
#pragma unroll
    for (int i = 0; i < 8; ++i) r.v[i] = *(const f32x4*)(p + (size_t)(4 * i) * t.N);
    if (t.gain) { r.g0 = *(const f32x4*)(t.gain + 8 * (lane >> 4)); r.g1 = *(const f32x4*)(t.gain + 8 * (lane >> 4) + 4); } else { r.g0 = (f32x4){1.f, 1.f, 1.f, 1.f}; r.g1 = r.g0; }
}
__device__ __forceinline__ void tr_store(const TItem& t, const TRegs& r, LAS float* scr, int lane) {
#pragma unroll
    for (int i = 0; i < 8; ++i) { LAS float* d = scr + (4 * i + (lane >> 4)) * 65 + 4 * (lane & 15); d[0] = r.v[i].x; d[1] = r.v[i].y; d[2] = r.v[i].z; d[3] = r.v[i].w; }
    LDS_WAIT(); asm volatile("" ::: "memory");
    const int c4 = lane >> 4;
#pragma unroll
    for (int j = 0; j < 4; ++j) { const int R = 16 * j + (lane & 15), nl = (R & ~31) + pg8::perm32(R & 31);
        const LAS float* s = scr + (8 * c4) * 65 + nl;
        v4u o; o.x = pg8::cvt_pk_bf16(s[0 * 65] * r.g0.x, s[1 * 65] * r.g0.y); o.y = pg8::cvt_pk_bf16(s[2 * 65] * r.g0.z, s[3 * 65] * r.g0.w); o.z = pg8::cvt_pk_bf16(s[4 * 65] * r.g1.x, s[5 * 65] * r.g1.y); o.w = pg8::cvt_pk_bf16(s[6 * 65] * r.g1.z, s[7 * 65] * r.g1.w);
        *(GAS v4u*)((GAS unsigned char*)t.dst + pg8::img_off(t.n0 + nl, t.k0 + 8 * c4, t.K, true)) = o; }
    LDS_WAIT(); asm volatile("" ::: "memory");
}
__device__ __forceinline__ void ssm_setup_unit(Frame& F, int l, int g) {
    LAS float* apr = (LAS float*)(F.lds + RING_OFF); LAS float* api = apr + 17 * 64; LAS float* bbr = api + 17 * 64; LAS float* bbi = bbr + 1024;
    LAS float* cr = bbi + 1024; LAS float* ci = cr + 1024; LAS float* gg = ci + 1024;
    const int lg = l * NGRP + g, tid = F.tid;
    bf16* P = (bf16*)(F.ws + WS_SSMP + (size_t)lg * SSMP_STRIDE); bf16* WmT = P; bf16* VmT = P + 32768; bf16* Kt = P + 65536; float* A16 = (float*)(P + 65536 + 17 * 256);
    if (tid < 64) { const int p = tid;
        const float dt = expf(F.in[I_SLDT][lg]), lr = F.in[I_SLRE][lg * 64 + p], li = F.in[I_SLIM][lg * 64 + p];
        const float mag = expf(lr * dt), th = li * dt, ar = mag * cosf(th), ai = mag * sinf(th);
        float pr = 1.f, pi = 0.f;
        for (int tau = 0; tau <= 16; ++tau) { apr[tau * 64 + p] = pr; api[tau * 64 + p] = pi; const float npr = pr * ar - pi * ai, npi = pr * ai + pi * ar; pr = npr; pi = npi; }
        const float den = lr * lr + li * li, nr = ar - 1.0f, ni = ai;
        gg[p] = (nr * lr + ni * li) / den; gg[64 + p] = (ni * lr - nr * li) / den; }
    __syncthreads();
    if (tid < 64) { A16[2 * tid] = apr[16 * 64 + tid]; A16[2 * tid + 1] = api[16 * 64 + tid]; }
    for (int idx = tid; idx < 1024; idx += NWAVES * 64) { const int p = idx >> 4;
        const float br = F.in[I_SBRE][(size_t)lg * 1024 + idx], bi = F.in[I_SBIM][(size_t)lg * 1024 + idx], gr = gg[p], gi = gg[64 + p];
        bbr[idx] = gr * br - gi * bi; bbi[idx] = gr * bi + gi * br;
        cr[idx] = F.in[I_SCRE][(size_t)lg * 1024 + idx]; ci[idx] = F.in[I_SCIM][(size_t)lg * 1024 + idx]; }
    __syncthreads();
    for (int e = tid; e < 32768; e += NWAVES * 64) { const int pp = e >> 8, k = e & 255, p = pp & 63, j = k >> 4, hh = k & 15, tau = 15 - j;
        const float ar = apr[tau * 64 + p], ai = api[tau * 64 + p], br = bbr[p * 16 + hh], bi = bbi[p * 16 + hh];
        WmT[e] = (bf16)f2bf(pp < 64 ? ar * br - ai * bi : ar * bi + ai * br); }
    for (int e = tid; e < 32768; e += NWAVES * 64) { const int n = e >> 7, pp = e & 127, p = pp & 63, t = n >> 4, hh = n & 15;
        const float ar = apr[(t + 1) * 64 + p], ai = api[(t + 1) * 64 + p], c_r = cr[hh * 64 + p], c_i = ci[hh * 64 + p];
        VmT[e] = (bf16)f2bf(pp < 64 ? c_r * ar - c_i * ai : -(c_r * ai + c_i * ar)); }
    for (int e = tid; e < 256; e += NWAVES * 64) Kt[e] = 0;
    for (int e = tid; e < 4096; e += NWAVES * 64) { const int tau = e >> 8, hh = (e >> 4) & 15, h2 = e & 15; float acc = 0.f;
        for (int p = 0; p < 64; ++p) { const float ar = apr[tau * 64 + p], ai = api[tau * 64 + p], c_r = cr[hh * 64 + p], c_i = ci[hh * 64 + p];
            const float xr = c_r * ar - c_i * ai, xi = c_r * ai + c_i * ar; acc += xr * bbr[p * 16 + h2] - xi * bbi[p * 16 + h2]; }
        if (tau == 0 && hh == h2) acc += F.in[I_SD][lg * 16 + hh];
        Kt[256 + e] = (bf16)f2bf(acc); }
    __syncthreads();
}
__device__ __forceinline__ void p0_prologue(Frame& F) {
    LAS float* scr = (LAS float*)(F.lds + RING_OFF + F.wave * 16384);
    const int gw = F.vcu * NWAVES + F.wave, NGW = F.G * NWAVES;
    constexpr int IT_IN = (DMODEL / 64) * (8192 / 32), IT_OUT = (DMODEL / 64) * (DMODEL / 32), IT_UP = (DMODEL / 64) * (FF / 32), IT_DN = (FF / 64) * (DMODEL / 32), IT_GLU = (2048 / 64) * (2048 / 32);
    constexpr int IT_LAYER = IT_IN + IT_OUT + IT_UP + IT_DN + IT_GLU, NITEMS = DEPTH * IT_LAYER;
    auto decode = [&](int it, TItem& t) {
        const int l = it / IT_LAYER; int r = it % IT_LAYER;
        unsigned char* wl = F.ws + WS_W + (size_t)l * W_LAYER;
        const float* W; const float* gain = nullptr; bf16* WT; int K, N;
        if (r < IT_IN) { W = F.in[I_WIN] + (size_t)l * DMODEL * 8192; K = DMODEL; N = 8192; gain = F.in[I_NMIX] + l * DMODEL; WT = (bf16*)(wl + W_IN); }
        else if ((r -= IT_IN) < IT_OUT) { W = F.in[I_WOUT] + (size_t)l * DMODEL * DMODEL; K = DMODEL; N = DMODEL; WT = (bf16*)(wl + W_OUT); }
        else if ((r -= IT_OUT) < IT_UP) { W = F.in[I_WUP] + (size_t)l * DMODEL * FF; K = DMODEL; N = FF; gain = F.in[I_NMLP] + l * DMODEL; WT = (bf16*)(wl + W_UP); }
        else if ((r -= IT_UP) < IT_DN) { W = F.in[I_WDN] + (size_t)l * FF * DMODEL; K = FF; N = DMODEL; WT = (bf16*)(wl + W_DN); }
        else { r -= IT_DN; W = F.in[I_WGLU] + (size_t)l * 2048 * 2048; K = 2048; N = 2048; WT = (bf16*)(wl + W_GLU); }
        const int nblk = N / 64, k0 = 32 * (r / nblk), n0 = 64 * (r % nblk);
        t.src = W + (size_t)k0 * N + n0; t.gain = gain ? gain + k0 : nullptr; t.dst = WT; t.N = N; t.K = K; t.n0 = n0; t.k0 = k0; };
    if (gw < NITEMS) {
        TItem ta, tb; TRegs ra, rb;
        decode(gw, ta); tr_load(ta, ra, F.lane);
        for (int it = gw;;) {
            const int i1 = it + NGW; const bool h1 = i1 < NITEMS;
            if (h1) { decode(i1, tb); tr_load(tb, rb, F.lane); }
            tr_store(ta, ra, scr, F.lane);
            if (!h1) break;
            const int i2 = i1 + NGW; const bool h2 = i2 < NITEMS;
            if (h2) { decode(i2, ta); tr_load(ta, ra, F.lane); }
            tr_store(tb, rb, scr, F.lane);
            if (!h2) break;
            it = i2;
        }
    }
    pg8::ssq_t* ssq0 = (pg8::ssq_t*)(F.ws + WS_CTL + SSQ_OFF);
    {
        f32x4 xv[16];
        if (gw < M) { const GAS f32x4* xr = (const GAS f32x4*)(F.in[I_X] + (size_t)gw * DMODEL) + F.lane;
#pragma unroll
            for (int j = 0; j < 16; ++j) xv[j] = xr[64 * j]; }
        for (int m = gw; m < M; m += NGW) {
            f32x4 xn[16]; const int mn = m + NGW;
            if (mn < M) { const GAS f32x4* xr = (const GAS f32x4*)(F.in[I_X] + (size_t)mn * DMODEL) + F.lane;
#pragma unroll
                for (int j = 0; j < 16; ++j) xn[j] = xr[64 * j]; }
            float s = 0.f;
#pragma unroll
            for (int j = 0; j < 16; ++j) { const f32x4 v = xv[j]; s += (v.x * v.x + v.y * v.y) + (v.z * v.z + v.w * v.w); *(GAS unsigned long long*)(F.ws + WS_HB + PG8_AOFF(m, 4 * (F.lane + 64 * j), DMODEL)) = (unsigned long long)pk2(v.x, v.y) | ((unsigned long long)pk2(v.z, v.w) << 32); }
            s = wave_sum(s); if (F.lane == 0) ssq0[m] = (pg8::ssq_t)(s * pg8::SSQ_SCALE);
#pragma unroll
            for (int j = 0; j < 16; ++j) xv[j] = xn[j];
        }
    }
    __syncthreads();
    for (int u = F.vcu; u < DEPTH * NGRP; u += F.G) ssm_setup_unit(F, u / NGRP, u % NGRP);
}
__device__ __forceinline__ float gelu_tanh(float y) { const float z = 0.7978845608028654f * (y + 0.044715f * y * y * y); return y * __builtin_amdgcn_rcpf(1.0f + __builtin_amdgcn_exp2f(-2.8853900817779268f * z)); }
__device__ __forceinline__ void ssm_unit(Frame& F, int l, int b, int g) {
    typedef short s16x8 __attribute__((ext_vector_type(8)));
#define SSM_SYNC() asm volatile("s_waitcnt lgkmcnt(0)\n\ts_barrier" ::: "memory")
    int lane_ = F.lane; asm volatile("" : "+v"(lane_));
    const int lane = lane_, w = F.wave, fr = lane & 15, fq = lane >> 4, tid = w * 64 + lane;
    const bf16* P = (const bf16*)(F.ws + WS_SSMP + (size_t)(l * NGRP + g) * SSMP_STRIDE); const bf16* WmT = P; const bf16* VmT = P + 32768; const bf16* Kt = P + 65536; const float* A16 = (const float*)(P + 65536 + 17 * 256);
    const bf16* U = (const bf16*)(F.ws + WS_UT) + ((size_t)g * M + (size_t)b * SEQ) * 16;
    bf16* YG = (bf16*)(F.ws + WS_YG);
    LAS float* S = (LAS float*)(F.lds + RING_OFF);
    LAS unsigned char* UQ = F.lds + RING_OFF + 64 * 132 * 4;
    s16x8 wf[8], kfl[4], kfh[8], vfl[4], vfh[4];
    const int tl = w, th = 15 - w;
    v4u pre[4];
#pragma unroll
    for (int i = 0; i < 4; ++i) pre[i] = *(const v4u*)(U + (size_t)(tid + 512 * i) * 8);
#pragma unroll
    for (int kk = 0; kk < 8; ++kk) wf[kk] = *(const s16x8*)(WmT + (16 * w + fr) * 256 + 32 * kk + 8 * fq);
#pragma unroll
    for (int kk = 0; kk < 4; ++kk) { const int tau = tl - 2 * kk - (fq >> 1); kfl[kk] = *(const s16x8*)(Kt + (tau < 0 ? 0 : tau + 1) * 256 + fr * 16 + 8 * (fq & 1)); }
#pragma unroll
    for (int kk = 0; kk < 8; ++kk) { const int tau = th - 2 * kk - (fq >> 1); kfh[kk] = *(const s16x8*)(Kt + (tau < 0 ? 0 : tau + 1) * 256 + fr * 16 + 8 * (fq & 1)); }
#pragma unroll
    for (int kk = 0; kk < 4; ++kk) { vfl[kk] = *(const s16x8*)(VmT + (tl * 16 + fr) * 128 + 32 * kk + 8 * fq); vfh[kk] = *(const s16x8*)(VmT + (th * 16 + fr) * 128 + 32 * kk + 8 * fq); }
    float sr = 0.f, si = 0.f, a16r = 0.f, a16i = 0.f;
    if (w == 0) { a16r = A16[2 * lane]; a16i = A16[2 * lane + 1]; }
    for (int q = 0; q < 4; ++q) {
#pragma unroll
        for (int i = 0; i < 4; ++i) { const int e = tid + 512 * i; *(LAS v4u*)(UQ + (e >> 5) * 528 + (e & 31) * 16) = pre[i]; }
        SSM_SYNC();
        if (q < 3) {
#pragma unroll
            for (int i = 0; i < 4; ++i) pre[i] = *(const v4u*)(U + (size_t)(q + 1) * 16384 + (size_t)(tid + 512 * i) * 8);
        }
#pragma unroll
        for (int mt = 0; mt < 4; ++mt) {
            const LAS unsigned char* ub = UQ + (mt * 16 + fr) * 528 + fq * 16;
            f32x4 acc = {0.f, 0.f, 0.f, 0.f};
#pragma unroll
            for (int kk = 0; kk < 8; ++kk) { const s16x8 uf = *(const LAS s16x8*)(ub + 64 * kk); acc = __builtin_amdgcn_mfma_f32_16x16x32_bf16(wf[kk], uf, acc, 0, 0, 0); }
            *(LAS f32x4*)(S + (mt * 16 + fr) * 132 + 16 * w + 4 * fq) = acc;
        }
        SSM_SYNC();
        if (w == 0) {
            for (int c0 = 0; c0 < 64; c0 += 8) { float tr[8], ti[8];
#pragma unroll
                for (int i = 0; i < 8; ++i) { tr[i] = S[(c0 + i) * 132 + lane]; ti[i] = S[(c0 + i) * 132 + 64 + lane]; }
#pragma unroll
                for (int i = 0; i < 8; ++i) { S[(c0 + i) * 132 + lane] = sr; S[(c0 + i) * 132 + 64 + lane] = si;
                    const float nsr = a16r * sr - a16i * si + tr[i], nsi = a16r * si + a16i * sr + ti[i]; sr = nsr; si = nsi; } }
        }
        SSM_SYNC();
#pragma unroll
        for (int mt = 0; mt < 4; ++mt) {
            const int chunk = q * 64 + mt * 16 + fr;
            const LAS unsigned char* ub = UQ + (mt * 16 + fr) * 528 + fq * 16;
            f32x4 accl = {0.f, 0.f, 0.f, 0.f}, acch = {0.f, 0.f, 0.f, 0.f};
#pragma unroll
            for (int kk = 0; kk < 8; ++kk) { const s16x8 uf = *(const LAS s16x8*)(ub + 64 * kk);
                if (kk < 4) accl = __builtin_amdgcn_mfma_f32_16x16x32_bf16(kfl[kk], uf, accl, 0, 0, 0);
                acch = __builtin_amdgcn_mfma_f32_16x16x32_bf16(kfh[kk], uf, acch, 0, 0, 0); }
#pragma unroll
            for (int kk = 0; kk < 4; ++kk) { const LAS float* sp = S + (mt * 16 + fr) * 132 + 32 * kk + 8 * fq; const f32x4 s0 = *(const LAS f32x4*)sp, s1 = *(const LAS f32x4*)(sp + 4);
                const s16x8 sf = __builtin_bit_cast(s16x8, pg8::pack8(s0, s1));
                accl = __builtin_amdgcn_mfma_f32_16x16x32_bf16(vfl[kk], sf, accl, 0, 0, 0); acch = __builtin_amdgcn_mfma_f32_16x16x32_bf16(vfh[kk], sf, acch, 0, 0, 0); }
            const size_t tok = (size_t)b * SEQ + (size_t)chunk * 16;
            { typedef unsigned u32x2 __attribute__((ext_vector_type(2)));
              u32x2 o; o.x = pg8::cvt_pk_bf16(gelu_tanh(accl[0]), gelu_tanh(accl[1])); o.y = pg8::cvt_pk_bf16(gelu_tanh(accl[2]), gelu_tanh(accl[3]));
              *(u32x2*)((char*)YG + PG8_AOFF(tok + tl, g * 16 + 4 * fq, 2048)) = o;
              o.x = pg8::cvt_pk_bf16(gelu_tanh(acch[0]), gelu_tanh(acch[1])); o.y = pg8::cvt_pk_bf16(gelu_tanh(acch[2]), gelu_tanh(acch[3]));
              *(u32x2*)((char*)YG + PG8_AOFF(tok + th, g * 16 + 4 * fq, 2048)) = o; }
        }
        SSM_SYNC();
    }
#undef SSM_SYNC
}

struct Args { const float* in[N_IN]; float* out; unsigned char* ws; int ph_lo, ph_hi; };
__global__ void __launch_bounds__(NWAVES * 64, 2) hymba_fwd(Args args) {
    extern __shared__ __attribute__((aligned(16))) unsigned char lds[];
    Frame F;
    F.lds = (LAS unsigned char*)lds;
    F.MISC = (volatile LAS unsigned*)(F.lds + MISC_OFF);
    F.tid = threadIdx.x; F.lane = F.tid & 63; F.wave = __builtin_amdgcn_readfirstlane(F.tid >> 6);
    F.G = gridDim.x; { const int bx = blockIdx.x; F.vcu = (F.G % 8 == 0) ? (bx % 8) * (F.G / 8) + bx / 8 : bx; }
    F.in = args.in; F.out = args.out; F.ws = args.ws;
    unsigned char* ws = args.ws;
    F.ctl = (gu32*)(ws + WS_CTL);
    for (int u = F.tid; u < (LDS_BYTES - LDSCTL_OFF) / 4; u += NWAVES * 64) ((LAS unsigned*)(F.lds + LDSCTL_OFF))[u] = 0u;
    __syncthreads();
    XcdBarrier bar; bar.bar = (unsigned*)(F.ctl + CW_BAR); bar.x = 0; bar.st = nullptr;
    if (!MK_PER_PHASE) bar = xcd_barrier_post((unsigned*)(F.ctl + CW_BAR), F.MISC + 8);
#ifndef REP_BAR
#define REP_BAR 1
#endif
#define GRID_BAR() do { if (MK_PER_PHASE) { if (F.tid == 0) __hip_atomic_store(F.ctl + 0, 0xBADBA0u, RLX_AGENT); } else { for (int rb_ = 0; rb_ < REP_BAR; ++rb_) xcd_barrier(bar); } } while (0)
    const int lo = args.ph_lo, hi = args.ph_hi;
#define IN(k) (lo <= (k) && (k) < hi)
#define BOTH(k) (IN(k) && IN((k) + 1))
    pg8::ssq_t* const ssq = (pg8::ssq_t*)(ws + WS_CTL + SSQ_OFF);
    pg8::bf16_t* const HB = (pg8::bf16_t*)(ws + WS_HB); pg8::bf16_t* const QKV = (pg8::bf16_t*)(ws + WS_QKV); pg8::bf16_t* const UT = (pg8::bf16_t*)(ws + WS_UT);
    pg8::bf16_t* const YG = (pg8::bf16_t*)(ws + WS_YG); pg8::bf16_t* const CAT = (pg8::bf16_t*)(ws + WS_CAT); pg8::bf16_t* const HID = (pg8::bf16_t*)(ws + WS_HID);

#ifndef REP_PRO
#define REP_PRO 1
#endif
#ifndef REP_SSM
#define REP_SSM 1
#endif
#ifndef REP_ATT
#define REP_ATT 1
#endif
#ifndef REP_GEMM
#define REP_GEMM 1
#endif
#ifndef REP_RES
#define REP_RES 1
#endif
    if (IN(0)) { for (int rep = 0; rep < REP_PRO; ++rep) { p0_prologue(F); __syncthreads(); } if (BOTH(0)) GRID_BAR(); }

    for (int l = 0; l < DEPTH; ++l) {
        const int pb = 1 + 6 * l;
        const unsigned char* wl = ws + WS_W + (size_t)l * W_LAYER;
        if (IN(pb)) {
            pg8::Gemm g{HB, (const pg8::bf16_t*)(wl + W_IN), M, 8192, DMODEL, A_IMG, 1}; pg8::StaticOrder S; S.init(M, 8192, F.G, (int)blockIdx.x);
            pg8::EpiProj E{QKV, UT, ssq + (2 * l) * M, attn_body::C2, ws + WS_KI, ws + WS_VI};
            for (int rep = 0; rep < REP_GEMM; ++rep) { pg8::gemm_phase<pg8::EpiProj, pg8::StaticOrder, PG8_ALIGN, PG8_SP2>(F.lds + RING_OFF, g, S, E); __syncthreads(); }
            if (BOTH(pb)) GRID_BAR();
        }
        if (IN(pb + 1)) {
            for (int rep = 0; rep < REP_SSM; ++rep) for (int u = F.vcu; u < BATCH * NGRP; u += F.G) ssm_unit(F, l, u / NGRP, u % NGRP);
            __syncthreads();
            const float lam_init = 0.8f - 0.6f * expf(-0.3f * (float)l);
            const float d1 = wave_sum(F.in[I_LQ1][l * 64 + F.lane] * F.in[I_LK1][l * 64 + F.lane]), d2 = wave_sum(F.in[I_LQ2][l * 64 + F.lane] * F.in[I_LK2][l * 64 + F.lane]);
            const float lam = expf(d1) - expf(d2) + lam_init;
            for (int rep = 0; rep < REP_ATT; ++rep) for (int pu = F.vcu; pu < 256; pu += F.G) {
                const int bh = pu >> 3, pp = pu & 7, b = bh >> 4, h = bh & 15;
#ifndef ATT_V64
                attn_body::build_lut((char*)lds + RING_OFF, F.in[I_RELB], h, F.tid);
#endif
#if defined(PROBE_ATT_QB)
                for (int xr = 0; xr < PROBE_ATT_N; ++xr) { attn_body::UnitArgs ua; ua.kind = 0; ua.qcol = h * 128 + 64; ua.kcol = 0; ua.vcol = 0; ua.ocol = h * 128;
                    ua.relb = F.in[I_RELB]; ua.scr = (float*)(ws + WS_ATT) + (size_t)F.vcu * (2 * 256 * 64); ua.lam = lam; ua.oscale = 1.0f - lam_init; ua.gain = F.in[I_SUBG] + l * 128;
                    attn_body::attn_unit<8>(b, h, PROBE_ATT_QB, (const attn_body::bf16*)QKV, (const attn_body::bf16*)(ws + WS_KI + (size_t)((bh * 2 + 1) * 64) * 8192), (const attn_body::bf16*)(ws + WS_VI + (size_t)(bh * 64) * 16384), (attn_body::bf16*)CAT, (char*)lds + RING_OFF, ua); }
#endif
#ifdef ATT_V64
                for (int qi = 0; qi < 2; ++qi) { const int qb = qi ? 15 - pp : pp;
                    for (int kind = 0; kind < 4; ++kind) { const int s2 = (kind < 2) ? 64 : 0, vh = kind & 1;
                        attn_body::UnitArgs ua; ua.kind = kind; ua.qcol = h * 128 + s2; ua.kcol = 2048 + h * 128 + s2; ua.vcol = 4096 + h * 128 + vh * 64; ua.ocol = h * 128;
#elif defined(ATT_PP)
                for (int qi = 0; qi < 2; ++qi) { const int qb = qi ? 15 - pp : pp;
                    for (int kind = 0; kind < 2; ++kind) { const int s2 = (kind < 1) ? 64 : 0;
                        attn_body::UnitArgs ua; ua.kind = kind; ua.qcol = h * 128 + s2; ua.kcol = 2048 + h * 128 + s2; ua.vcol = 4096 + h * 128; ua.ocol = h * 128;
#else
                for (int qi = 0; qi < 4; ++qi) { const int qb = (qi == 0) ? pp : (qi == 1) ? 15 - pp : (qi == 2) ? 16 + pp : 31 - pp;
                    for (int kind = 0; kind < 2; ++kind) { const int s2 = (kind < 1) ? 64 : 0;
                        attn_body::UnitArgs ua; ua.kind = kind; ua.qcol = h * 128 + s2; ua.kcol = 2048 + h * 128 + s2; ua.vcol = 4096 + h * 128; ua.ocol = h * 128;
#endif
                        ua.relb = F.in[I_RELB]; ua.scr = (float*)(ws + WS_ATT) + (size_t)F.vcu * (2 * 256 * 64); ua.lam = lam; ua.oscale = 1.0f - lam_init; ua.gain = F.in[I_SUBG] + l * 128;
                        attn_body::attn_unit<8>(b, h, qb, (const attn_body::bf16*)QKV, (const attn_body::bf16*)(ws + WS_KI + (size_t)((bh * 2 + (s2 >> 6)) * 64) * 8192), (const attn_body::bf16*)(ws + WS_VI + (size_t)(bh * 64) * 16384), (attn_body::bf16*)CAT, (char*)lds + RING_OFF, ua); } }
            }
            if (BOTH(pb + 1)) GRID_BAR();
        }
        if (IN(pb + 2)) {
            pg8::Gemm g{YG, (const pg8::bf16_t*)(wl + W_GLU), M, 2048, 2048, A_IMG, 1}; pg8::StaticOrder S; S.init(M, 2048, F.G, (int)blockIdx.x);
            pg8::EpiGlu E{YG, CAT, F.in[I_BGLU] + l * 2048};
            for (int rep = 0; rep < REP_GEMM; ++rep) { pg8::gemm_phase<pg8::EpiGlu, pg8::StaticOrder, PG8_ALIGN, PG8_SP2>(F.lds + RING_OFF, g, S, E); __syncthreads(); }
            if (BOTH(pb + 2)) GRID_BAR();
        }
        if (IN(pb + 3)) {
            pg8::Gemm g{CAT, (const pg8::bf16_t*)(wl + W_OUT), M, DMODEL, DMODEL, A_IMG, 1}; pg8::StaticOrder S; S.init(M, DMODEL, F.G, (int)blockIdx.x);
            pg8::EpiRes E{HB, ssq + (2 * l + 1) * M};
            pg8::gemm_phase<pg8::EpiRes, pg8::StaticOrder, PG8_ALIGN, PG8_SP2>(F.lds + RING_OFF, g, S, E);
            if (BOTH(pb + 3)) GRID_BAR();
        }
        if (IN(pb + 4)) {
            pg8::Gemm g{HB, (const pg8::bf16_t*)(wl + W_UP), M, FF, DMODEL, A_IMG, 1}; pg8::StaticOrder S; S.init(M, FF, F.G, (int)blockIdx.x);
            pg8::EpiUp E{HID, FF, ssq + (2 * l + 1) * M};
#ifndef STG_UP
#define STG_UP 0
#endif
            if (STG_UP && (F.vcu & 1)) { for (int s_ = 0; s_ < STG_UP; ++s_) __builtin_amdgcn_s_sleep(48); }
            for (int rep = 0; rep < REP_GEMM; ++rep) { pg8::gemm_phase<pg8::EpiUp, pg8::StaticOrder, PG8_ALIGN, PG8_SP2>(F.lds + RING_OFF, g, S, E); __syncthreads(); }
            if (BOTH(pb + 4)) GRID_BAR();
        }
        if (IN(pb + 5)) {
            pg8::Gemm g{HID, (const pg8::bf16_t*)(wl + W_DN), M, DMODEL, FF, A_IMG, 1}; pg8::StaticOrder S; S.init(M, DMODEL, F.G, (int)blockIdx.x);
            pg8::EpiRes E{HB, ssq + (2 * l + 2) * M};
            pg8::gemm_phase<pg8::EpiRes, pg8::StaticOrder, PG8_ALIGN, PG8_SP2>(F.lds + RING_OFF, g, S, E);
            if (BOTH(pb + 5)) GRID_BAR();
        }
    }
    if (IN(N_PHASES - 1)) {
        const int gw = F.vcu * NWAVES + F.wave, NGW = F.G * NWAVES; const float* gf = F.in[I_NFIN]; const pg8::ssq_t* sq = ssq + 8 * M;
        f32x4 gq[8][2];
#pragma unroll
        for (int j = 0; j < 8; ++j) { const int c = 8 * (F.lane + 64 * j); gq[j][0] = *(const f32x4*)(gf + c); gq[j][1] = *(const f32x4*)(gf + c + 4); }
        v4u hw[8]; pg8::ssq_t qc = 0;
        if (gw < M) { qc = sq[gw];
#pragma unroll
            for (int j = 0; j < 8; ++j) hw[j] = *(const GAS v4u*)((const GAS unsigned char*)HB + PG8_AOFF(gw, 8 * (F.lane + 64 * j), DMODEL)); }
        for (int m = gw; m < M; m += NGW) { const int mn = m + NGW; v4u hn[8]; pg8::ssq_t qn = 0;
            if (mn < M) { qn = sq[mn];
#pragma unroll
                for (int j = 0; j < 8; ++j) hn[j] = *(const GAS v4u*)((const GAS unsigned char*)HB + PG8_AOFF(mn, 8 * (F.lane + 64 * j), DMODEL)); }
            const float rs = pg8::rstd_of(qc);
#pragma unroll
            for (int j = 0; j < 8; ++j) { const int c = 8 * (F.lane + 64 * j); const v4u w = hw[j];
                const f32x4 h0 = {pg8::bf_lo(w.x), pg8::bf_hi(w.x), pg8::bf_lo(w.y), pg8::bf_hi(w.y)}, h1 = {pg8::bf_lo(w.z), pg8::bf_hi(w.z), pg8::bf_lo(w.w), pg8::bf_hi(w.w)};
                GAS f32x4* o = (GAS f32x4*)(F.out + (size_t)m * DMODEL + c); o[0] = h0 * rs * gq[j][0]; o[1] = h1 * rs * gq[j][1]; }
#pragma unroll
            for (int j = 0; j < 8; ++j) hw[j] = hn[j];
            qc = qn; }
    }
#undef IN
#undef BOTH
}

extern "C" void kernel_launch(void* const* d_in, const int* in_sizes, int n_in, void* d_out, int out_size, void* d_ws, size_t ws_size, hipStream_t stream) {
    static int grid = 0;
    if (grid == 0) {
        if (n_in != N_IN || in_sizes[0] != M * DMODEL || out_size != M * DMODEL || ws_size < WS_END) { fprintf(stderr, "kernel_launch: built for %d inputs, x/out of %d floats, >= %zu bytes of workspace; got n_in %d, in0 %d, out %d, ws %zu; nothing launched\n", (int)N_IN, M * DMODEL, (size_t)WS_END, n_in, n_in > 0 ? in_sizes[0] : -1, out_size, ws_size); grid = -1; return; }
        int dev = 0, cus = 0, per_cu = 0;
        if (hipGetDevice(&dev) != hipSuccess || hipDeviceGetAttribute(&cus, hipDeviceAttributeMultiprocessorCount, dev) != hipSuccess) { fprintf(stderr, "kernel_launch: hipGetDevice / hipDeviceGetAttribute failed; nothing launched\n"); grid = -1; return; }
        if (hipFuncSetAttribute((const void*)hymba_fwd, hipFuncAttributeMaxDynamicSharedMemorySize, LDS_BYTES) != hipSuccess) { fprintf(stderr, "kernel_launch: hipFuncSetAttribute failed\n"); grid = -1; return; }
        if (hipOccupancyMaxActiveBlocksPerMultiprocessor(&per_cu, (const void*)hymba_fwd, NWAVES * 64, LDS_BYTES) != hipSuccess || per_cu < 1)
            fprintf(stderr, "kernel_launch: note: the occupancy query reports %d workgroups per CU\n", per_cu);
        (void)hipGetLastError();
        grid = cus;
    }
    if (grid < 0) return;
    if (hipMemsetAsync((char*)d_ws + WS_CTL, 0, CTL_ZERO_BYTES, stream) != hipSuccess) { fprintf(stderr, "kernel_launch: hipMemsetAsync failed\n"); return; }
    Args a{};
    for (int i = 0; i < N_IN; ++i) a.in[i] = (const float*)d_in[i];
    a.out = (float*)d_out; a.ws = (unsigned char*)d_ws;
#if MK_PER_PHASE
    for (int ph = 0; ph < N_PHASES; ++ph) { a.ph_lo = ph; a.ph_hi = ph + 1; hipLaunchKernelGGL(hymba_fwd, dim3(grid), dim3(NWAVES * 64), LDS_BYTES, stream, a); }
#else
    a.ph_lo = 0; a.ph_hi = N_PHASES; hipLaunchKernelGGL(hymba_fwd, dim3(grid), dim3(NWAVES * 64), LDS_BYTES, stream, a);
#endif
    const hipError_t le = hipPeekAtLastError();
    if (le != hipSuccess) fprintf(stderr, "kernel_launch: launch failed: %s\n", hipGetErrorName(le));
}
```

```cpp
#define MK_PER_PHASE 0
#define A_IMG 1
#define STG_UP 2
#define STG_UP_WAYS 4
#define STG_IN 2
#include <hip/hip_runtime.h>
#include <cstdio>
#include <cstdint>
#ifndef A_IMG
#define A_IMG 0
#endif
namespace pg8 {
#define PG8_LAS __attribute__((address_space(3)))
typedef unsigned short bf16_t;
typedef short bf16x8 __attribute__((ext_vector_type(8)));
typedef float f32x4 __attribute__((ext_vector_type(4)));
typedef unsigned u32x4 __attribute__((ext_vector_type(4)));
constexpr int BM = 256, BK = 64, HALF = 128, HTB = HALF * BK * 2  , STAGE_BYTES = 8 * HTB, NXCD = 8, WGM = 8;

__host__ __device__ __forceinline__ int lds_byte(int r, int c) { const int st = (r >> 4) * 2 + (c >> 5), rr = r & 15, cc = c & 31, ob = rr * 64 + cc * 2; return st * 1024 + (ob ^ (((ob >> 9) & 1) << 5)); }
__host__ __device__ __forceinline__ void stage_rc(int b, int& R, int& C) { const int st = b / 1024, sb = b % 1024, swz = sb ^ (((sb >> 9) & 1) << 5); R = (st >> 1) * 16 + swz / 64; C = (st & 1) * 32 + (swz % 64) / 2; }
__host__ __device__ __forceinline__ int perm32(int rho) { const int n = rho >> 4, i = rho & 15; return 8 * (i >> 2) + 4 * n + (i & 3); }

struct Unit { int pm, pn; };
struct Gemm { const bf16_t* A; const bf16_t* Bt; int M, N, K; int a_img, b_img; };
#define PG8_AOFF(row, col, K) (A_IMG ? pg8::img_off((int)(row), (int)(col), (K), false) : ((size_t)(row) * (size_t)(K) + (size_t)(col)) * 2)
__host__ __device__ __forceinline__ int perm32_inv(int x) { return 16 * ((x >> 2) & 1) + 4 * (x >> 3) + (x & 3); }
__host__ __device__ __forceinline__ size_t img_off(int row, int col, int K, bool permB) {
    const int r = row & 127, R = permB ? ((r & ~31) + perm32_inv(r & 31)) : r;
    return ((size_t)((row >> 8) * (K >> 6) + (col >> 6)) * 2 + ((row >> 7) & 1)) * (size_t)HTB + (size_t)lds_byte(R, col & 63); }

struct StaticOrder {
    int nM, nN, nwg, G, c;
    __host__ __device__ void init(int M, int N, int G_, int c_) { nM = M / BM; nN = N / BM; nwg = nM * nN; G = G_; c = c_; }
    __host__ __device__ bool next(int i, Unit& u) const {
        const long L = (long)i * G + c; if (L >= nwg) return false;
        int wgid = (int)L; { const int q = nwg / NXCD, r = nwg % NXCD, xcd = wgid % NXCD, off = wgid / NXCD; wgid = (xcd < r ? xcd * (q + 1) : r * (q + 1) + (xcd - r) * q) + off; }
        const int nig = WGM * nN, gid = wgid / nig, fm = gid * WGM, gsz = (nM - fm) < WGM ? (nM - fm) : WGM;
        u.pm = fm + ((wgid % nig) % gsz); u.pn = (wgid % nig) / gsz; return true;
    }
    __device__ __forceinline__ void a_ready(const Unit&) const {}
    __device__ __forceinline__ void done(const Unit&) const {}
};

__device__ __forceinline__ unsigned cvt_pk_bf16(float lo, float hi) { unsigned r; asm volatile("v_cvt_pk_bf16_f32 %0, %1, %2" : "=v"(r) : "v"(lo), "v"(hi)); return r; }
typedef float f32x2 __attribute__((ext_vector_type(2)));
__device__ __forceinline__ f32x2 gelu_pk(f32x2 v) {
    const f32x2 av = __builtin_elementwise_abs(v), d = av * 0.2316418882f + 1.0f;
    f32x2 t; t.x = __builtin_amdgcn_rcpf(d.x); t.y = __builtin_amdgcn_rcpf(d.y);
    f32x2 q = t * 0.5307027145f + (-0.7265760135f); q = q * t + 0.7107068705f; q = q * t + (-0.142248368f); q = q * t + 0.127414796f; q = q * t;
    const f32x2 s = (v * v) * (-0.72134752044f);
    f32x2 e; e.x = __builtin_amdgcn_exp2f(s.x); e.y = __builtin_amdgcn_exp2f(s.y);
    const f32x2 m = v * (q * e), r = v - m;
    f32x2 o; o.x = v.x < 0.f ? m.x : r.x; o.y = v.y < 0.f ? m.y : r.y; return o;
}

template <int ACT  > struct EpiBf16 {
    static constexpr bool PERM = true, AFTER_DRAIN = false; static_assert(ACT == 0 || ACT == 1, "EpiBf16: ACT is 0 (none) or 1 (gelu_pk)");
    bf16_t* O; int ldc; const float* bias; int split_cols; size_t split_stride; float scale0;
    __device__ __forceinline__ void operator()(const f32x4 (&acc)[2][2][4][2], const Unit& u, int wr, int wc, int fr, int fq) const {
        const int row0 = u.pm * BM + wr * 64 + fr; int colt = u.pn * BM; bf16_t* base = O;
        float sc = 1.f; if (split_cols) { const int t = colt / split_cols; base += (size_t)t * split_stride; colt -= t * split_cols; if (t == 0) sc = scale0; }
        const int col0 = colt + wc * 32 + 8 * fq, bcol0 = u.pn * BM + wc * 32 + 8 * fq;
        f32x4 bv[2][2];
#pragma unroll
        for (int bj = 0; bj < 2; ++bj)
#pragma unroll
            for (int n = 0; n < 2; ++n) bv[bj][n] = bias ? *(const f32x4*)(bias + bcol0 + bj * HALF + 4 * n) : (f32x4){0.f, 0.f, 0.f, 0.f};
#pragma unroll
        for (int ai = 0; ai < 2; ++ai)
#pragma unroll
            for (int m = 0; m < 4; ++m) { bf16_t* rowp = base + (size_t)(row0 + ai * HALF + m * 16) * ldc + col0;
#pragma unroll
                for (int bj = 0; bj < 2; ++bj) { f32x4 v0 = acc[ai][bj][m][0] + bv[bj][0], v1 = acc[ai][bj][m][1] + bv[bj][1];
                    if (ACT == 1) { f32x2 a = gelu_pk((f32x2){v0[0], v0[1]}), b = gelu_pk((f32x2){v0[2], v0[3]}), c = gelu_pk((f32x2){v1[0], v1[1]}), d = gelu_pk((f32x2){v1[2], v1[3]});
                        v0 = (f32x4){a.x, a.y, b.x, b.y}; v1 = (f32x4){c.x, c.y, d.x, d.y}; }
                    v0 = v0 * sc; v1 = v1 * sc; u32x4 w; w.x = cvt_pk_bf16(v0[0], v0[1]); w.y = cvt_pk_bf16(v0[2], v0[3]); w.z = cvt_pk_bf16(v1[0], v1[1]); w.w = cvt_pk_bf16(v1[2], v1[3]);
                    *(u32x4*)(rowp + bj * HALF) = w; } }
    }
};

__device__ __forceinline__ u32x4 pack8(f32x4 v0, f32x4 v1) { u32x4 w; w.x = cvt_pk_bf16(v0[0], v0[1]); w.y = cvt_pk_bf16(v0[2], v0[3]); w.z = cvt_pk_bf16(v1[0], v1[1]); w.w = cvt_pk_bf16(v1[2], v1[3]); return w; }
__device__ __forceinline__ float bf_lo(unsigned w) { return __uint_as_float(w << 16); }
__device__ __forceinline__ float bf_hi(unsigned w) { return __uint_as_float(w & 0xffff0000u); }
constexpr float RMS_EPS = 1e-6f;
typedef unsigned long long ssq_t;
constexpr float SSQ_SCALE = 16777216.0f, SSQ_INV = 1.0f / (16777216.0f * 4096.0f);
__device__ __forceinline__ float rstd_of(ssq_t q) { const float x = fmaf((float)(unsigned)(q >> 32), 4294967296.0f, (float)(unsigned)q); return __builtin_amdgcn_rsqf(x * SSQ_INV + RMS_EPS); }
struct EpiProj {
    static constexpr bool PERM = true, AFTER_DRAIN = false, IDEMP = true;
    bf16_t* __restrict__ QKV; bf16_t* __restrict__ UT; const ssq_t* __restrict__ ssq; float c2; unsigned char* __restrict__ KI; unsigned char* __restrict__ VI;
    __device__ __forceinline__ void operator()(const f32x4 (&acc)[2][2][4][2], const Unit& u, int wr, int wc, int fr, int fq) const {
        const int row0 = u.pm * BM + wr * 64 + fr, colt = u.pn * BM;
        const float sc = (colt < 2048) ? c2 : 1.f;
        ssq_t q[2][4];
#pragma unroll
        for (int ai = 0; ai < 2; ++ai)
#pragma unroll
            for (int m = 0; m < 4; ++m) q[ai][m] = ssq[row0 + ai * HALF + m * 16];
#pragma unroll
        for (int ai = 0; ai < 2; ++ai)
#pragma unroll
            for (int m = 0; m < 4; ++m) { const int row = row0 + ai * HALF + m * 16;
                const float rs = sc * rstd_of(q[ai][m]);
#pragma unroll
                for (int bj = 0; bj < 2; ++bj) { const int col = colt + bj * HALF + wc * 32 + 8 * fq;
                    const u32x4 w = pack8(acc[ai][bj][m][0] * rs, acc[ai][bj][m][1] * rs);
                    if (colt < 2048) *(u32x4*)(QKV + (size_t)row * 6144 + col) = w;
                    else if (colt < 4096) { const int c = col - 2048, key = row & 4095;
                        *(u32x4*)(KI + ((size_t)(((row >> 12) * 16 + (c >> 7)) * 2 + ((c >> 6) & 1)) * 64 + (key >> 6)) * 8192 + ((c & 63) >> 3) * 1024 + (key & 63) * 16) = w; }
                    else if (colt < 6144) { const int c = col - 4096, key = row & 4095, cc = c & 127;
                        *(u32x4*)(VI + ((size_t)((row >> 12) * 16 + (c >> 7)) * 64 + (key >> 6)) * 16384 + ((cc >> 5) * 4 + ((key & 63) >> 4)) * 1024 + (key & 15) * 64 + ((cc & 31) >> 3) * 16) = w; }
                    else { const int cu = col - 6144; *(u32x4*)(UT + ((size_t)(cu >> 4) * 8192 + row) * 16 + (cu & 15)) = w; } } }
    }
};
struct EpiUp {
    static constexpr bool PERM = true, AFTER_DRAIN = false, IDEMP = true;
    bf16_t* __restrict__ O; int ldc; const ssq_t* __restrict__ ssq;
    __device__ __forceinline__ void operator()(const f32x4 (&acc)[2][2][4][2], const Unit& u, int wr, int wc, int fr, int fq) const {
        const int row0 = u.pm * BM + wr * 64 + fr, colt = u.pn * BM;
        ssq_t q[2][4];
#pragma unroll
        for (int ai = 0; ai < 2; ++ai)
#pragma unroll
            for (int m = 0; m < 4; ++m) q[ai][m] = ssq[row0 + ai * HALF + m * 16];
#pragma unroll
        for (int ai = 0; ai < 2; ++ai)
#pragma unroll
            for (int m = 0; m < 4; ++m) { const int row = row0 + ai * HALF + m * 16;
                const float rs = rstd_of(q[ai][m]);
#pragma unroll
                for (int bj = 0; bj < 2; ++bj) { const int col = colt + bj * HALF + wc * 32 + 8 * fq;
                    f32x4 v0 = acc[ai][bj][m][0] * rs, v1 = acc[ai][bj][m][1] * rs;
#pragma unroll
                    for (int e = 0; e < 4; ++e) { const float a = fmaxf(v0[e], 0.f), b = fmaxf(v1[e], 0.f); v0[e] = a * a; v1[e] = b * b; }
                    *(u32x4*)((char*)O + PG8_AOFF(row, col, ldc)) = pack8(v0, v1); } }
    }
};
struct EpiGlu {
    static constexpr bool PERM = true, AFTER_DRAIN = false, IDEMP = true;
    const bf16_t* __restrict__ YG; bf16_t* __restrict__ CAT; const float* __restrict__ bias;
    __device__ __forceinline__ void operator()(const f32x4 (&acc)[2][2][4][2], const Unit& u, int wr, int wc, int fr, int fq) const {
        const int row0 = u.pm * BM + wr * 64 + fr, colt = u.pn * BM;
        f32x4 bv[2][2];
#pragma unroll
        for (int bj = 0; bj < 2; ++bj)
#pragma unroll
            for (int n = 0; n < 2; ++n) bv[bj][n] = *(const f32x4*)(bias + colt + bj * HALF + wc * 32 + 8 * fq + 4 * n);
#pragma unroll
        for (int ai = 0; ai < 2; ++ai) {
            u32x4 yw[4][2];
#pragma unroll
            for (int m = 0; m < 4; ++m)
#pragma unroll
                for (int bj = 0; bj < 2; ++bj) yw[m][bj] = *(const u32x4*)((const char*)YG + PG8_AOFF(row0 + ai * HALF + m * 16, colt + bj * HALF + wc * 32 + 8 * fq, 2048));
#pragma unroll
            for (int m = 0; m < 4; ++m) { const int row = row0 + ai * HALF + m * 16;
#pragma unroll
                for (int bj = 0; bj < 2; ++bj) { const int col = colt + bj * HALF + wc * 32 + 8 * fq; const u32x4 y = yw[m][bj];
                    f32x4 v0 = acc[ai][bj][m][0] + bv[bj][0], v1 = acc[ai][bj][m][1] + bv[bj][1];
#pragma unroll
                    for (int e = 0; e < 4; ++e) { v0[e] = __builtin_amdgcn_rcpf(1.0f + __builtin_amdgcn_exp2f(-1.4426950408889634f * v0[e])); v1[e] = __builtin_amdgcn_rcpf(1.0f + __builtin_amdgcn_exp2f(-1.4426950408889634f * v1[e])); }
                    v0[0] *= bf_lo(y.x); v0[1] *= bf_hi(y.x); v0[2] *= bf_lo(y.y); v0[3] *= bf_hi(y.y);
                    v1[0] *= bf_lo(y.z); v1[1] *= bf_hi(y.z); v1[2] *= bf_lo(y.w); v1[3] *= bf_hi(y.w);
                    *(u32x4*)((char*)CAT + PG8_AOFF(row, 2048 + col, 4096)) = pack8(v0, v1); } }
            asm volatile("" ::: "memory"); }
    }
};
struct EpiRes {
    static constexpr bool PERM = true, AFTER_DRAIN = false, IDEMP = false;
    bf16_t* HB; ssq_t* __restrict__ ssq_out;
    __device__ __forceinline__ void operator()(const f32x4 (&acc)[2][2][4][2], const Unit& u, int wr, int wc, int fr, int fq) const {
        const int row0 = u.pm * BM + wr * 64 + fr, colt = u.pn * BM;
        u32x4 b[2][4][2];
#pragma unroll
        for (int ai = 0; ai < 2; ++ai)
#pragma unroll
            for (int m = 0; m < 4; ++m)
#pragma unroll
                for (int bj = 0; bj < 2; ++bj) b[ai][m][bj] = *(const u32x4*)((const char*)HB + PG8_AOFF(row0 + ai * HALF + m * 16, colt + bj * HALF + wc * 32 + 8 * fq, 4096));
#pragma unroll
        for (int ai = 0; ai < 2; ++ai) { float sm[4];
#pragma unroll
            for (int m = 0; m < 4; ++m) { const int row = row0 + ai * HALF + m * 16; float ss = 0.f;
#pragma unroll
                for (int bj = 0; bj < 2; ++bj) { const u32x4 w = b[ai][m][bj];
                    const f32x4 h0 = (f32x4){bf_lo(w.x), bf_hi(w.x), bf_lo(w.y), bf_hi(w.y)} + acc[ai][bj][m][0], h1 = (f32x4){bf_lo(w.z), bf_hi(w.z), bf_lo(w.w), bf_hi(w.w)} + acc[ai][bj][m][1];
                    *(u32x4*)((char*)HB + PG8_AOFF(row, colt + bj * HALF + wc * 32 + 8 * fq, 4096)) = pack8(h0, h1);
                    ss += (h0[0] * h0[0] + h0[1] * h0[1]) + (h0[2] * h0[2] + h0[3] * h0[3]) + (h1[0] * h1[0] + h1[1] * h1[1]) + (h1[2] * h1[2] + h1[3] * h1[3]); }
                ss += __shfl_xor(ss, 16); ss += __shfl_xor(ss, 32); sm[m] = ss; }
            const float mine = fq == 0 ? sm[0] : fq == 1 ? sm[1] : fq == 2 ? sm[2] : sm[3];
            __hip_atomic_fetch_add(ssq_out + row0 + ai * HALF + fq * 16, (ssq_t)(mine * SSQ_SCALE), __ATOMIC_RELAXED, __HIP_MEMORY_SCOPE_AGENT);
            asm volatile("" ::: "memory"); }
    }
};

template <class Epi, class Sched, bool ALIGN_EPI = false, bool SP2 = false>
__device__ __forceinline__ void gemm_phase(PG8_LAS unsigned char* lds, const Gemm g, const Sched& S, const Epi& E) {
    int tid_ = threadIdx.x; asm volatile("" : "+v"(tid_));
    const int tid = tid_, wid = __builtin_amdgcn_readfirstlane(tid >> 6), lane = tid & 63, wr = wid >> 2, wc = wid & 3, fr = lane & 15, fq = lane >> 4;
    const int K = g.K, nt = K / BK;
    unsigned voffA[2], voffB[2];
#pragma unroll
    for (int i = 0; i < 2; ++i) { int R, C; stage_rc(tid * 16 + i * 8192, R, C); const int Rb = Epi::PERM ? ((R & ~31) + perm32(R & 31)) : R;
        voffA[i] = g.a_img ? (unsigned)(tid * 16 + i * 8192) : (unsigned)(R * K + C) * 2u; voffB[i] = g.b_img ? (unsigned)(tid * 16 + i * 8192) : (unsigned)(Rb * K + C) * 2u; }
    const size_t kstA = g.a_img ? (size_t)2 * HTB : (size_t)(BK * 2), hstA = g.a_img ? (size_t)HTB : (size_t)HALF * K * 2, tstA = g.a_img ? (size_t)nt * 2 * HTB : (size_t)2 * HALF * K * 2;
    const size_t kstB = g.b_img ? (size_t)2 * HTB : (size_t)(BK * 2), hstB = g.b_img ? (size_t)HTB : (size_t)HALF * K * 2, tstB = g.b_img ? (size_t)nt * 2 * HTB : (size_t)2 * HALF * K * 2;
    const unsigned ldsw = (unsigned)wid * 1024u;
    const int aoff = lds_byte(wr * 64 + fr, fq * 8), boff = lds_byte(wc * 32 + fr, fq * 8);
#define PG8_SA(b, h) (((b) * 2 + (h)) * HTB)
#define PG8_SB(b, h) ((4 + (b) * 2 + (h)) * HTB)
#define PG8_STAGE(bufoff, rs, goff, voff) do { _Pragma("unroll") for (int _i = 0; _i < 2; ++_i) \
        __builtin_amdgcn_raw_ptr_buffer_load_lds(rs, (PG8_LAS unsigned*)(lds + (bufoff) + ldsw + _i * 8192), 16, (voff)[_i], (goff), 0, 0); } while (0)
#define PG8_LDA(dst, b, h) do { _Pragma("unroll") for (int m = 0; m < 4; ++m) _Pragma("unroll") for (int k = 0; k < 2; ++k) dst[m][k] = *(const PG8_LAS bf16x8*)(lds + PG8_SA(b, h) + aoff + m * 2048 + k * 1024); } while (0)
#define PG8_LDB(dst, b, h) do { _Pragma("unroll") for (int n = 0; n < 2; ++n) _Pragma("unroll") for (int k = 0; k < 2; ++k) dst[n][k] = *(const PG8_LAS bf16x8*)(lds + PG8_SB(b, h) + boff + n * 2048 + k * 1024); } while (0)
#define PG8_MMA(ai, bj, At, Bt) do { __builtin_amdgcn_s_setprio(1); _Pragma("unroll") for (int m = 0; m < 4; ++m) _Pragma("unroll") for (int n = 0; n < 2; ++n) _Pragma("unroll") for (int k = 0; k < 2; ++k) \
        acc[ai][bj][m][n] = __builtin_amdgcn_mfma_f32_16x16x32_bf16(Bt[n][k], At[m][k], acc[ai][bj][m][n], 0, 0, 0); __builtin_amdgcn_s_setprio(0); } while (0)
#define PG8_WAIT_V(n) asm volatile("s_waitcnt vmcnt(" #n ")" ::: "memory")
#define PG8_WAIT_V_SEL(flag, nrelax, nstd) asm volatile("s_cmp_lg_u32 %0, 0\n\ts_cbranch_scc1 .Lpg8r%=\n\ts_waitcnt vmcnt(" #nstd ")\n\ts_branch .Lpg8d%=\n.Lpg8r%=:\n\ts_waitcnt vmcnt(" #nrelax ")\n.Lpg8d%=:" :: "s"(flag) : "memory", "scc")
#define PG8_WAIT_L(n) asm volatile("s_waitcnt lgkmcnt(" #n ")" ::: "memory")
#define PG8_BAR __builtin_amdgcn_s_barrier()
#define PG8_SCHED __builtin_amdgcn_sched_barrier(0)
    Unit cur, nxt; int ui = 0;
    if (!S.next(0, cur)) return;
    f32x4 acc[2][2][4][2];
#pragma unroll
    for (int a = 0; a < 2; ++a)
#pragma unroll
        for (int b = 0; b < 2; ++b)
#pragma unroll
            for (int m = 0; m < 4; ++m)
#pragma unroll
                for (int n = 0; n < 2; ++n) acc[a][b][m][n] = (f32x4){0.f, 0.f, 0.f, 0.f};
    bf16x8 At[4][2], B0[2][2], B1[2][2];
    const __amdgpu_buffer_rsrc_t rsA = __builtin_amdgcn_make_buffer_rsrc((void*)g.A, 0, (unsigned)((size_t)g.M * K * 2), 0x00020000), rsB = __builtin_amdgcn_make_buffer_rsrc((void*)g.Bt, 0, (unsigned)((size_t)g.N * K * 2), 0x00020000);
    unsigned cA = (unsigned)((size_t)cur.pm * tstA), cB = (unsigned)((size_t)cur.pn * tstB);
    S.a_ready(cur);
    if constexpr (SP2) {
        PG8_STAGE(PG8_SB(0, 0), rsB, cB, voffB); PG8_STAGE(PG8_SB(0, 1), rsB, cB + (unsigned)hstB, voffB); PG8_STAGE(PG8_SA(0, 0), rsA, cA, voffA); PG8_STAGE(PG8_SA(0, 1), rsA, cA + (unsigned)hstA, voffA);
        if (wr == 1) PG8_BAR;
        PG8_WAIT_V(2); PG8_BAR;
        PG8_STAGE(PG8_SB(1, 0), rsB, cB + (unsigned)kstB, voffB); PG8_STAGE(PG8_SA(1, 0), rsA, cA + (unsigned)kstA, voffA); PG8_STAGE(PG8_SB(1, 1), rsB, cB + (unsigned)(hstB + kstB), voffB);
        PG8_WAIT_V(6); PG8_BAR;
    } else {
        PG8_STAGE(PG8_SB(0, 0), rsB, cB, voffB); PG8_STAGE(PG8_SA(0, 0), rsA, cA, voffA); PG8_STAGE(PG8_SB(0, 1), rsB, cB + (unsigned)hstB, voffB); PG8_STAGE(PG8_SA(0, 1), rsA, cA + (unsigned)hstA, voffA);
        if (wr == 1) PG8_BAR;
        PG8_WAIT_V(4); PG8_BAR;
        PG8_STAGE(PG8_SB(1, 0), rsB, cB + (unsigned)kstB, voffB); PG8_STAGE(PG8_SA(1, 0), rsA, cA + (unsigned)kstA, voffA); PG8_STAGE(PG8_SB(1, 1), rsB, cB + (unsigned)(hstB + kstB), voffB);
        PG8_WAIT_V(6); PG8_BAR;
    }
    for (;;) {
        const bool has_next = S.next(ui + 1, nxt);
        const unsigned nA = has_next ? (unsigned)((size_t)nxt.pm * tstA) : cA, nB = has_next ? (unsigned)((size_t)nxt.pn * tstB) : cB;
        for (int t = 0; t < nt; t += 2) {
            const bool last = (t == nt - 2);
            const unsigned a1 = cA + (unsigned)((size_t)(t + 1) * kstA);
            const unsigned a2 = last ? nA : cA + (unsigned)((size_t)(t + 2) * kstA), b2 = last ? nB : cB + (unsigned)((size_t)(t + 2) * kstB);
            const unsigned a3 = a2 + (unsigned)kstA, b3 = b2 + (unsigned)kstB;
            if (last && has_next) S.a_ready(nxt);
            if constexpr (SP2) {
            PG8_LDB(B0, 0, 0); PG8_LDB(B1, 0, 1); PG8_SCHED; PG8_LDA(At, 0, 0); PG8_STAGE(PG8_SA(1, 1), rsA, a1 + (unsigned)hstA, voffA);
            PG8_WAIT_V(8); PG8_WAIT_L(0); PG8_BAR; PG8_MMA(0, 0, At, B0); PG8_MMA(0, 1, At, B1); PG8_BAR; PG8_SCHED;
            PG8_LDA(At, 0, 1); PG8_STAGE(PG8_SB(0, 0), rsB, b2, voffB); PG8_STAGE(PG8_SB(0, 1), rsB, b2 + (unsigned)hstB, voffB); PG8_STAGE(PG8_SA(0, 0), rsA, a2, voffA);
            PG8_WAIT_V(8); PG8_WAIT_L(0); PG8_BAR; PG8_MMA(1, 0, At, B0); PG8_MMA(1, 1, At, B1); PG8_BAR; PG8_SCHED;
            PG8_LDB(B0, 1, 0); PG8_LDB(B1, 1, 1); PG8_SCHED; PG8_LDA(At, 1, 0); PG8_STAGE(PG8_SA(0, 1), rsA, a2 + (unsigned)hstA, voffA);
            PG8_WAIT_V(8); PG8_WAIT_L(0); PG8_BAR; PG8_MMA(0, 0, At, B0); PG8_MMA(0, 1, At, B1); PG8_BAR; PG8_SCHED;
            PG8_LDA(At, 1, 1); PG8_STAGE(PG8_SB(1, 0), rsB, b3, voffB); PG8_STAGE(PG8_SB(1, 1), rsB, b3 + (unsigned)hstB, voffB); PG8_STAGE(PG8_SA(1, 0), rsA, a3, voffA);
            PG8_WAIT_V(8); PG8_WAIT_L(0); PG8_BAR; PG8_MMA(1, 0, At, B0); PG8_MMA(1, 1, At, B1); PG8_BAR; PG8_SCHED;
            } else {
            PG8_LDB(B0, 0, 0); PG8_SCHED; PG8_LDA(At, 0, 0); PG8_STAGE(PG8_SA(1, 1), rsA, a1 + (unsigned)hstA, voffA);
            PG8_WAIT_L(8); PG8_BAR; PG8_WAIT_L(0); PG8_MMA(0, 0, At, B0); PG8_BAR; PG8_SCHED;
            PG8_LDB(B1, 0, 1); PG8_STAGE(PG8_SB(0, 0), rsB, b2, voffB);
            PG8_BAR; PG8_WAIT_L(0); PG8_MMA(0, 1, At, B1); PG8_BAR;
            PG8_LDA(At, 0, 1); PG8_STAGE(PG8_SA(0, 0), rsA, a2, voffA);
            PG8_BAR; PG8_WAIT_L(0); PG8_MMA(1, 0, At, B0); PG8_BAR; PG8_SCHED;
            PG8_STAGE(PG8_SB(0, 1), rsB, b2 + (unsigned)hstB, voffB);
            PG8_WAIT_V(6); PG8_BAR; PG8_MMA(1, 1, At, B1); PG8_BAR;
            PG8_LDB(B0, 1, 0); PG8_SCHED; PG8_LDA(At, 1, 0); PG8_STAGE(PG8_SA(0, 1), rsA, a2 + (unsigned)hstA, voffA);
            PG8_WAIT_L(8); PG8_BAR; PG8_WAIT_L(0); PG8_MMA(0, 0, At, B0); PG8_BAR; PG8_SCHED;
            PG8_LDB(B1, 1, 1); PG8_STAGE(PG8_SB(1, 0), rsB, b3, voffB);
            PG8_BAR; PG8_WAIT_L(0); PG8_MMA(0, 1, At, B1); PG8_BAR;
            PG8_LDA(At, 1, 1); PG8_STAGE(PG8_SA(1, 0), rsA, a3, voffA);
            PG8_BAR; PG8_WAIT_L(0); PG8_MMA(1, 0, At, B0); PG8_BAR; PG8_SCHED;
            PG8_STAGE(PG8_SB(1, 1), rsB, b3 + (unsigned)hstB, voffB);
            PG8_WAIT_V(6); PG8_BAR; PG8_MMA(1, 1, At, B1); PG8_BAR;
            }
        }
        if constexpr (ALIGN_EPI) { if (wr == 0) PG8_BAR; }
        if constexpr (!Epi::AFTER_DRAIN) { E(acc, cur, wr, wc, fr, fq);
#ifdef PROBE_EPI2
            if constexpr (Epi::IDEMP) { asm volatile("" ::: "memory"); E(acc, cur, wr, wc, fr, fq); }
#endif
            S.done(cur); }
        if (!has_next) break;
#pragma unroll
        for (int a = 0; a < 2; ++a)
#pragma unroll
            for (int b = 0; b < 2; ++b)
#pragma unroll
                for (int m = 0; m < 4; ++m)
#pragma unroll
                    for (int n = 0; n < 2; ++n) acc[a][b][m][n] = (f32x4){0.f, 0.f, 0.f, 0.f};
        cur = nxt; cA = nA; cB = nB; ++ui;
        if constexpr (ALIGN_EPI) { if (wr == 1) PG8_BAR; }
    }
    PG8_WAIT_V(0);
    if constexpr (!ALIGN_EPI) { if (wr == 0) PG8_BAR; }
    PG8_BAR;
    if constexpr (Epi::AFTER_DRAIN) { E.fused(acc, cur, wr, wc, fr, fq, lds, wid, lane); S.done(cur); }
#undef PG8_SA
#undef PG8_SB
#undef PG8_STAGE
#undef PG8_LDA
#undef PG8_LDB
#undef PG8_MMA
#undef PG8_WAIT_V
#undef PG8_WAIT_V_SEL
#undef PG8_WAIT_L
#undef PG8_BAR
#undef PG8_SCHED
}
}

#ifndef PG8_SP2
#define PG8_SP2 true
#endif
#ifndef PG8_ALIGN
#define PG8_ALIGN true
#endif
#include <hip/hip_bf16.h>
#include <cmath>
namespace attn_body {
using bf16=__hip_bfloat16;
using bf16x8=__attribute__((ext_vector_type(8)))short;
using s16x4=__attribute__((ext_vector_type(4)))short;
using f32x16=__attribute__((ext_vector_type(16)))float;
using u32x4=__attribute__((ext_vector_type(4)))unsigned;
constexpr int BATCH=2,NHEAD=16,SEQ=4096,D=64,DM=6144;
constexpr int OPITCH=4096;
constexpr int NW=8,QBLK=32,QB=QBLK*4,KVBLK=64,NQB=SEQ/QB;
constexpr int ATTN_PITCH=DM, ATTN_UNIT_ROWS=QB;
__device__ __forceinline__ int crow(int r,int hi){return (r&3)+8*(r>>2)+4*hi;}
#define SBAR() __builtin_amdgcn_sched_barrier(0)
__device__ __forceinline__ void cmask(f32x16&p0,f32x16&p1,int jb,int qrel,int hi){
  const float NEG=-INFINITY; int kb=64*jb+4*hi;
  #pragma unroll
  for(int r=0;r<16;++r){int kv=kb+(r&3)+8*(r>>2); if(kv>qrel)p0[r]=NEG; if(kv+32>qrel)p1[r]=NEG;}
}

__device__ __forceinline__ int t5_bucket(int n){ if(n<16)return n; const int st[15]={19,21,24,27,31,35,40,46,52,59,67,77,87,99,113}; int b=16;
  #pragma unroll
  for(int i=0;i<15;++i)b+=(n>=st[i])?1:0; return b; }
typedef const __attribute__((address_space(3))) float* lds_cfptr;
__device__ __forceinline__ void bmask(f32x16&p0,f32x16&p1,int jb,int qrel,int hi,lds_cfptr lut){
  const float NEG=-INFINITY; const int base=qrel-64*jb-4*hi;
  #pragma unroll
  for(int r=0;r<16;++r){const int n0=base-((r&3)+8*(r>>2)),n1=n0-32;
    const float b0=lut[n0<0?0:(n0>128?128:n0)],b1=lut[n1<0?0:(n1>128?128:n1)];
    p0[r]=(n0<0)?NEG:p0[r]+b0; p1[r]=(n1<0)?NEG:p1[r]+b1;}
}
constexpr int NSLOT=3, SLOTB=8192;
constexpr int VSLOTB=16384, NVSLOT=4;
constexpr int LDS_K=0, LDS_V=NSLOT*SLOTB, LDS_WS=NSLOT*SLOTB+NVSLOT*VSLOTB, LDS_OST=LDS_WS+NW*64*4, LDS_LUT=LDS_OST+NW*4096, LDS_BYTES=LDS_LUT+1024;
constexpr float C2=0.125f*1.4426950408889634f;
__device__ __forceinline__ void glds16(const void*gsrc,unsigned lds_dst){unsigned keep;
  asm volatile("s_mov_b32 %0, m0\n\ts_mov_b32 m0, %2\n\ts_nop 0\n\tglobal_load_lds_dwordx4 %1, off\n\ts_mov_b32 m0, %0":"=&s"(keep):"v"(gsrc),"s"(lds_dst):"memory");}
__device__ __forceinline__ float max3f(float a,float b,float c){float r;asm("v_max3_f32 %0, %1, %2, %3":"=v"(r):"v"(a),"v"(b),"v"(c));return r;}
__device__ __forceinline__ float max2f(float a,float b){float r;asm("v_max_f32_e32 %0, %1, %2":"=v"(r):"v"(a),"v"(b));return r;}
__device__ __forceinline__ float fadd_s(float a,float b){float r;asm("v_add_f32_e32 %0, %1, %2":"=v"(r):"v"(a),"v"(b));return r;}
__device__ __forceinline__ float fsub_s(float a,float b){float r;asm("v_sub_f32_e32 %0, %1, %2":"=v"(r):"v"(a),"v"(b));return r;}
typedef float f32x2_t __attribute__((ext_vector_type(2))); typedef __bf16 bf16x2_t __attribute__((ext_vector_type(2)));
__device__ __forceinline__ unsigned cvtpk_s(float lo,float hi){f32x2_t v={lo,hi};bf16x2_t b=__builtin_convertvector(v,bf16x2_t);return __builtin_bit_cast(unsigned,b);}
#define WAIT_BAR(N) asm volatile("s_waitcnt vmcnt(" #N ") lgkmcnt(0)\n\ts_barrier":::"memory")

__device__ __forceinline__ void qkt(f32x16&p0,f32x16&p1,const char*Kslot,const bf16x8*qr,const f32x16&negm,int r32,int hi){
  const char*kb=Kslot+hi*1024+r32*16;
  #pragma unroll
  for(int d0=0;d0<4;++d0){
    const bf16x8 b0=*reinterpret_cast<const bf16x8*>(kb+d0*2048);
    const bf16x8 b1=*reinterpret_cast<const bf16x8*>(kb+d0*2048+512);
    if(d0==0){p0=__builtin_amdgcn_mfma_f32_32x32x16_bf16(b0,qr[0],negm,0,0,0);p1=__builtin_amdgcn_mfma_f32_32x32x16_bf16(b1,qr[0],negm,0,0,0);}
    else{p0=__builtin_amdgcn_mfma_f32_32x32x16_bf16(b0,qr[d0],p0,0,0,0);p1=__builtin_amdgcn_mfma_f32_32x32x16_bf16(b1,qr[d0],p1,0,0,0);}}
}
typedef __attribute__((address_space(3))) const char* lds_cptr;
typedef short v4i16_t __attribute__((ext_vector_type(4)));
__device__ __forceinline__ void kload8(bf16x8*kf,lds_cptr kp){
  kf[0]=*(const __attribute__((address_space(3))) bf16x8*)(kp);      kf[1]=*(const __attribute__((address_space(3))) bf16x8*)(kp+512);
  kf[2]=*(const __attribute__((address_space(3))) bf16x8*)(kp+2048); kf[3]=*(const __attribute__((address_space(3))) bf16x8*)(kp+2560);
  kf[4]=*(const __attribute__((address_space(3))) bf16x8*)(kp+4096); kf[5]=*(const __attribute__((address_space(3))) bf16x8*)(kp+4608);
  kf[6]=*(const __attribute__((address_space(3))) bf16x8*)(kp+6144); kf[7]=*(const __attribute__((address_space(3))) bf16x8*)(kp+6656);
}
__device__ __forceinline__ void kload2(bf16x8*kf,lds_cptr kp,int j){ kf[2*j]=*(const __attribute__((address_space(3))) bf16x8*)(kp+j*2048); kf[2*j+1]=*(const __attribute__((address_space(3))) bf16x8*)(kp+j*2048+512); }
__device__ __forceinline__ s16x4 vtr(lds_cptr p){ return __builtin_bit_cast(s16x4,__builtin_amdgcn_ds_read_tr16_b64_v4i16((__attribute__((address_space(3))) v4i16_t*)p)); }
__device__ __forceinline__ void qkt1(f32x16&p0,const char*kb,const bf16x8*qr,const f32x16&negm){
  #pragma unroll
  for(int d0=0;d0<4;++d0){ const bf16x8 b0=*reinterpret_cast<const bf16x8*>(kb+d0*2048);
    if(d0==0)p0=__builtin_amdgcn_mfma_f32_32x32x16_bf16(b0,qr[0],negm,0,0,0); else p0=__builtin_amdgcn_mfma_f32_32x32x16_bf16(b0,qr[d0],p0,0,0,0);}
}
__device__ __forceinline__ void kload4(bf16x8*kf,lds_cptr kp){
  kf[0]=*(const __attribute__((address_space(3))) bf16x8*)(kp);      kf[1]=*(const __attribute__((address_space(3))) bf16x8*)(kp+2048);
  kf[2]=*(const __attribute__((address_space(3))) bf16x8*)(kp+4096); kf[3]=*(const __attribute__((address_space(3))) bf16x8*)(kp+6144);
}
__device__ __forceinline__ void kload1(bf16x8*kf,lds_cptr kp,int j){ kf[j]=*(const __attribute__((address_space(3))) bf16x8*)(kp+j*2048); }
__device__ __forceinline__ float rowmax1(const f32x16&p0){
  float a=max3f(p0[0],p0[1],p0[2]),b=max3f(p0[3],p0[4],p0[5]);
  a=max3f(a,p0[6],p0[7]);b=max3f(b,p0[8],p0[9]);a=max3f(a,p0[10],p0[11]);b=max3f(b,p0[12],p0[13]);a=max3f(a,p0[14],p0[15]);
  const float m=max2f(a,b);
  auto rr=__builtin_amdgcn_permlane32_swap(__float_as_uint(m),__float_as_uint(m),false,false);
  return max2f(__uint_as_float(rr[0]),__uint_as_float(rr[1]));
}
__device__ __forceinline__ void bmask1(f32x16&p0,int nb,lds_cfptr lut){
  #pragma unroll
  for(int r=0;r<16;++r){ int n0=nb-((r&3)+8*(r>>2)); n0=n0<-1?-1:(n0>128?128:n0); p0[r]+=lut[n0+1]; }
}
__device__ __forceinline__ void pv2(f32x16*o,int vb,bf16x8 pa0,bf16x8 pa1){
  #pragma unroll
  for(int d0=0;d0<4;++d0){s16x4 lo[2],hi[2];
    #pragma unroll
    for(int ks=0;ks<2;++ks){
      asm volatile("ds_read_b64_tr_b16 %0,%1 offset:%c2":"=&v"(lo[ks]):"v"(vb),"i"(d0*4096+ks*1024):"memory");
      asm volatile("ds_read_b64_tr_b16 %0,%1 offset:%c2":"=&v"(hi[ks]):"v"(vb),"i"(d0*4096+ks*1024+512):"memory");}
    asm volatile("s_waitcnt lgkmcnt(0)":::"memory");SBAR();
    #define PK(k) (bf16x8){lo[k][0],lo[k][1],lo[k][2],lo[k][3],hi[k][0],hi[k][1],hi[k][2],hi[k][3]}
    o[d0]=__builtin_amdgcn_mfma_f32_32x32x16_bf16(pa0,PK(0),o[d0],0,0,0);
    o[d0]=__builtin_amdgcn_mfma_f32_32x32x16_bf16(pa1,PK(1),o[d0],0,0,0);
    #undef PK
  }
}
__device__ __forceinline__ float rowmax(const f32x16&p0,const f32x16&p1){
  float a=max3f(p0[0],p0[1],p1[0]),b=max3f(p0[2],p0[3],p1[1]);a=max3f(a,p1[2],p1[3]);
  #pragma unroll
  for(int r=4;r<16;r+=4){a=max3f(a,p0[r],p0[r+1]);b=max3f(b,p0[r+2],p0[r+3]);a=max3f(a,p1[r],p1[r+1]);b=max3f(b,p1[r+2],p1[r+3]);}
  const float m=max2f(a,b);
  auto rr=__builtin_amdgcn_permlane32_swap(__float_as_uint(m),__float_as_uint(m),false,false);
  return max2f(__uint_as_float(rr[0]),__uint_as_float(rr[1]));
}
__device__ __forceinline__ void pv(f32x16*o,int vb,bf16x8 pa0,bf16x8 pa1,bf16x8 pa2,bf16x8 pa3){
  #pragma unroll
  for(int d0=0;d0<2;++d0){s16x4 lo[4],hi[4];
    #pragma unroll
    for(int ks=0;ks<4;++ks){
      asm volatile("ds_read_b64_tr_b16 %0,%1 offset:%c2":"=&v"(lo[ks]):"v"(vb),"i"(d0*4096+ks*1024):"memory");
      asm volatile("ds_read_b64_tr_b16 %0,%1 offset:%c2":"=&v"(hi[ks]):"v"(vb),"i"(d0*4096+ks*1024+512):"memory");}
    asm volatile("s_waitcnt lgkmcnt(0)":::"memory");SBAR();
    #define PK(k) (bf16x8){lo[k][0],lo[k][1],lo[k][2],lo[k][3],hi[k][0],hi[k][1],hi[k][2],hi[k][3]}
    o[d0]=__builtin_amdgcn_mfma_f32_32x32x16_bf16(pa0,PK(0),o[d0],0,0,0);
    o[d0]=__builtin_amdgcn_mfma_f32_32x32x16_bf16(pa1,PK(1),o[d0],0,0,0);
    o[d0]=__builtin_amdgcn_mfma_f32_32x32x16_bf16(pa2,PK(2),o[d0],0,0,0);
    o[d0]=__builtin_amdgcn_mfma_f32_32x32x16_bf16(pa3,PK(3),o[d0],0,0,0);
    #undef PK
  }
}

__device__ __forceinline__ void build_lut(char*shm,const float*relb,int h,int tid){
  __attribute__((address_space(3))) float* lw=(__attribute__((address_space(3))) float*)((__attribute__((address_space(3))) char*)shm+LDS_LUT);
  if(tid<129){ const int bk=t5_bucket(tid); lw[1+tid]=(relb[bk*NHEAD+h]-relb[31*NHEAD+h])*1.4426950408889634f; } else if(tid==129){ lw[0]=-INFINITY; }
}
#ifndef ATTN_STORE16
#define ATTN_STORE16(p,v) (*(u32x4*)(p)=(v))
#endif
struct UnitArgs { int kind; int qcol,kcol,vcol,ocol; const float* relb; float* scr; float lam,oscale; const float* gain; };
template<int THRL> __device__ __forceinline__ void attn_unit(int b,int h,int qb,const bf16*Q,const bf16*__restrict__ K,const bf16*__restrict__ V,bf16*O,char*shm,const UnitArgs&ua){
  int tid_=threadIdx.x; asm volatile("":"+v"(tid_)); const int tid=tid_,lane=tid&63,r32=lane&31,hi=lane>>5; const int wid=__builtin_amdgcn_readfirstlane(tid>>6);
  const int rg=wid&3,g=wid>>2;
#ifdef ATT_PRIO
  if(g)__builtin_amdgcn_s_setprio(ATT_PRIO);
#endif
  const long rowbase=(long)b*SEQ; const int q0=qb*QB;
  const bf16*Qw=Q+(rowbase+q0+rg*QBLK)*DM+ua.qcol;
  const unsigned lds0=(unsigned)(uintptr_t)shm;
  float*wsf=(float*)(shm+LDS_WS)+wid*64;
  const char*ksrc=(const char*)K+wid*1024+lane*16;
  const char*vsrc=(const char*)V+wid*1024+lane*16;
  const unsigned kdst=lds0+LDS_K+wid*1024, vdst=lds0+LDS_V+wid*1024;
  #define DMA_K(t,slot) glds16(ksrc+(long)(t)*8192,(unsigned)__builtin_amdgcn_readfirstlane(kdst+(slot)))
  #define VSL(t) (((t)&(NVSLOT-1))*VSLOTB)
  #define DMA_V(t) do{ glds16(vsrc+(long)(t)*16384,(unsigned)__builtin_amdgcn_readfirstlane(vdst+VSL(t))); glds16(vsrc+8192+(long)(t)*16384,(unsigned)__builtin_amdgcn_readfirstlane(vdst+VSL(t)+8192)); }while(0)
  const int vb0=(int)(lds0+LDS_V)+((lane>>4)&1)*32+(lane&3)*8+(4*hi+((lane&15)>>2))*64+g*2048;
  bf16x8 kf[4];
  const lds_cptr shm3=(lds_cptr)shm; const lds_cptr kp0=shm3+LDS_K+hi*1024+r32*16+g*512; const lds_cptr vp0=shm3+LDS_V+((lane>>4)&1)*32+(lane&3)*8+(4*hi+((lane&15)>>2))*64+g*2048;
  const int NTd=(q0+QB)/KVBLK, NT=NTd<4?4:NTd;
  const lds_cfptr lutp=(lds_cfptr)((lds_cptr)shm+LDS_LUT);
  DMA_K(0,0);DMA_V(0);DMA_K(1,SLOTB);
  bf16x8 qr[4];
  #pragma unroll
  for(int d0=0;d0<4;++d0)qr[d0]=*reinterpret_cast<const bf16x8*>(&Qw[(long)r32*DM+d0*16+hi*8]);
  float mhat=0.f,l_reg=0.f;f32x16 o[4];o[0]=f32x16{};o[1]=f32x16{};o[2]=f32x16{};o[3]=f32x16{};f32x16 negm=f32x16{};asm volatile("":"+v"(negm));
  const int qw=q0+rg*QBLK-32*g;
  const int qabs=q0+rg*QBLK+r32-32*g-4*hi;
  #define CMASK(P0,t) do{ if(qw-64*(t)<144)bmask1(P0,qabs-64*(t),lutp); }while(0)
  bool resc=false;
  #define START(P0) do{ const float rm=rowmax1(P0); resc=false; \
    { const float dl=(rm==-INFINITY)?0.f:rm; mhat=fadd_s(mhat,dl); \
      _Pragma("unroll") for(int r=0;r<16;++r){P0[r]=fsub_s(P0[r],dl);} \
      _Pragma("unroll") for(int r=0;r<16;++r)negm[r]=-mhat; asm volatile("":"+v"(negm)); } \
    _Pragma("unroll") for(int r=0;r<16;++r)P0[r]=__builtin_amdgcn_exp2f(P0[r]); }while(0)
  #define RESC() do{ if(resc){ asm volatile("s_waitcnt lgkmcnt(0)":::"memory"); \
      _Pragma("unroll") for(int d_=0;d_<4;++d_) _Pragma("unroll") for(int r=0;r<16;++r)o[d_][r]*=wsf[crow(r,hi)]; } }while(0)
  f32x16 pA0,pB0;
  int sl_prev=0,sl_cur=0,sl_next=SLOTB;
  #define ROT() do{sl_prev=sl_cur;sl_cur=sl_next;sl_next=(sl_next==(NSLOT-1)*SLOTB)?0:sl_next+SLOTB;}while(0)
  DMA_K(2,2*SLOTB);DMA_V(1);
  WAIT_BAR(6);
  qkt1(pA0,shm+LDS_K+hi*1024+r32*16+g*512,qr,negm);asm volatile("s_nop 15\n\ts_nop 7":"+v"(pA0));CMASK(pA0,0);
  START(pA0);
  WAIT_BAR(2);
  DMA_K(3,0);DMA_V(2);
  ROT();
  kload4(kf,kp0+sl_cur);
  WAIT_BAR(5);
  s16x4 vlo[8],vhi[8]; u32x4 pw0,pw1;
  #define PKW(P,B) cvtpk_s(P[B],P[B+1])
  #define PAF(k) __builtin_bit_cast(bf16x8,pw##k)
  #define VFR(i) (bf16x8){vlo[i][0],vlo[i][1],vlo[i][2],vlo[i][3],vhi[i][0],vhi[i][1],vhi[i][2],vhi[i][3]}
  #define PIN(x) asm volatile("":"+v"(x))
  #define MX3(a,b,c) __builtin_fmaxf(__builtin_fmaxf((a),(b)),(c))
  #define GAPA(MF,A0,A1,A2,A3,W0,W1,PW) do{ MF; sacc+=A0; sacc+=A1; sacc+=A2; sacc+=A3; PIN(sacc); W0; W1; PIN(PW); SBAR(); }while(0)
  #define EX(v) __builtin_amdgcn_exp2f(v)
  #define GAPB(MF,X,B) do{ MF; X[B]=EX(X[B]); X[B+1]=EX(X[B+1]); PIN(X); SBAR(); }while(0)
  #define VRD(w,d,k) do{ vlo[w]=vtr(vp_+((d)*4096+(k)*1024)); vhi[w]=vtr(vp_+((d)*4096+(k)*1024+512)); }while(0)
  #define KRD(G,j) do{ if(G){ kload1(kf,kp0+sl_next,j); SBAR(); } }while(0)
  #define STEP(C0,P0,t,GK,GV,GL) do{ SBAR(); \
    const lds_cptr vp_=vp0+VSL((t)-1); \
    VRD(0,0,0); VRD(1,1,0); SBAR(); float sacc=(P0[0]+P0[1]); \
    GAPA(C0=__builtin_amdgcn_mfma_f32_32x32x16_bf16(kf[0],qr[0],negm,0,0,0), P0[2],P0[3],P0[4],P0[5],     pw0[0]=PKW(P0,0), pw0[1]=PKW(P0,2), pw0); \
    VRD(2,2,0); VRD(3,3,0); SBAR(); GAPA(C0=__builtin_amdgcn_mfma_f32_32x32x16_bf16(kf[1],qr[1],C0,0,0,0), P0[6],P0[7],P0[8],P0[9],     pw0[2]=PKW(P0,4), pw0[3]=PKW(P0,6), pw0); \
    VRD(4,0,1); VRD(5,1,1); SBAR(); GAPA(C0=__builtin_amdgcn_mfma_f32_32x32x16_bf16(kf[2],qr[2],C0,0,0,0), P0[10],P0[11],P0[12],P0[13], pw1[0]=PKW(P0,8), pw1[1]=PKW(P0,10), pw1); \
    VRD(6,2,1); VRD(7,3,1); SBAR(); GAPA(C0=__builtin_amdgcn_mfma_f32_32x32x16_bf16(kf[3],qr[3],C0,0,0,0), P0[14],P0[15],0.f,0.f,       pw1[2]=PKW(P0,12),pw1[3]=PKW(P0,14), pw1); \
    l_reg+=sacc; \
    if(GK){DMA_K((t)+3,sl_cur);} if(GV){DMA_V((t)+2);} \
    CMASK(C0,t); \
    { float a=MX3(C0[0],C0[1],C0[2]),b=MX3(C0[3],C0[4],C0[5]); a=MX3(a,C0[6],C0[7]); b=MX3(b,C0[8],C0[9]); a=MX3(a,C0[10],C0[11]); b=MX3(b,C0[12],C0[13]); a=MX3(a,C0[14],C0[15]); \
      float rm=__builtin_fmaxf(a,b); { auto rr=__builtin_amdgcn_permlane32_swap(__float_as_uint(rm),__float_as_uint(rm),false,false); rm=__builtin_fmaxf(__uint_as_float(rr[0]),__uint_as_float(rr[1])); } \
      resc=false; \
      if(__builtin_expect(__any(rm>(float)THRL),0)){ const float dl=__builtin_fmaxf(rm,0.f); mhat+=dl; \
        _Pragma("unroll") for(int r=0;r<16;++r){C0[r]-=dl;} \
        _Pragma("unroll") for(int r=0;r<16;++r)negm[r]=-mhat; asm volatile("":"+v"(negm)); \
        const float f=__builtin_amdgcn_exp2f(-dl); l_reg*=f; if(hi==0)wsf[r32]=f; resc=true; } } \
    SBAR(); \
    GAPB(o[0]=__builtin_amdgcn_mfma_f32_32x32x16_bf16(PAF(0),VFR(0),o[0],0,0,0), C0,0); \
    GAPB(o[1]=__builtin_amdgcn_mfma_f32_32x32x16_bf16(PAF(0),VFR(1),o[1],0,0,0), C0,2); \
    KRD(GL,0); GAPB(o[2]=__builtin_amdgcn_mfma_f32_32x32x16_bf16(PAF(0),VFR(2),o[2],0,0,0), C0,4); \
    KRD(GL,1); GAPB(o[3]=__builtin_amdgcn_mfma_f32_32x32x16_bf16(PAF(0),VFR(3),o[3],0,0,0), C0,6); \
    KRD(GL,2); GAPB(o[0]=__builtin_amdgcn_mfma_f32_32x32x16_bf16(PAF(1),VFR(4),o[0],0,0,0), C0,8); \
    KRD(GL,3); GAPB(o[1]=__builtin_amdgcn_mfma_f32_32x32x16_bf16(PAF(1),VFR(5),o[1],0,0,0), C0,10); \
    GAPB(o[2]=__builtin_amdgcn_mfma_f32_32x32x16_bf16(PAF(1),VFR(6),o[2],0,0,0), C0,12); \
    GAPB(o[3]=__builtin_amdgcn_mfma_f32_32x32x16_bf16(PAF(1),VFR(7),o[3],0,0,0), C0,14); \
    }while(0)
  int t=1;
  #undef CMASK
  #define CMASK(P0,t) do{}while(0)
  for(;t+7<NT;t+=2){
    STEP(pB0,pA0,t,true,true,true);     WAIT_BAR(5); RESC(); ROT();
    STEP(pA0,pB0,t+1,true,true,true);   WAIT_BAR(5); RESC(); ROT();
  }
  #undef CMASK
  #define CMASK(P0,t) do{ if(qw-64*(t)<144)bmask1(P0,qabs-64*(t),lutp); }while(0)
  #define ENDW(tt) do{ if((tt)+3<NT){WAIT_BAR(5);} else if((tt)+2<NT){WAIT_BAR(4);} else {WAIT_BAR(0);} }while(0)
  for(;t+1<NT;t+=2){
    STEP(pB0,pA0,t,(t+3<NT),(t+2<NT),(t+1<NT));       ENDW(t);   RESC(); ROT();
    STEP(pA0,pB0,t+1,(t+4<NT),(t+3<NT),(t+2<NT));     ENDW(t+1); RESC(); ROT();
  }
  STEP(pB0,pA0,NT-1,false,false,false); RESC();
  { float sacc=pB0[0]+pB0[1]; _Pragma("unroll") for(int r=2;r<16;++r)sacc+=pB0[r]; l_reg+=sacc;
    pw0=(u32x4){PKW(pB0,0),PKW(pB0,2),PKW(pB0,4),PKW(pB0,6)};pw1=(u32x4){PKW(pB0,8),PKW(pB0,10),PKW(pB0,12),PKW(pB0,14)};
    SBAR(); pv2(o,vb0+VSL(NT-1),PAF(0),PAF(1)); }
  #undef PKW
  #undef PAF
  #undef VFR
  #undef PIN
  #undef MX3
  #undef GAPA
  #undef GAPB
  #undef EX
  #undef VRD
  #undef KRD
  #undef STEP
  #undef ENDW
  {auto rr=__builtin_amdgcn_permlane32_swap(__float_as_uint(l_reg),__float_as_uint(l_reg),false,false);l_reg=__uint_as_float(rr[0])+__uint_as_float(rr[1]);}
  asm volatile("s_waitcnt lgkmcnt(0)\n\ts_barrier":::"memory");
  typedef float f32x4v __attribute__((ext_vector_type(4)));
  float*xs=(float*)shm+rg*(64*64+64)+64*64;
  f32x4v*xo4=(f32x4v*)((float*)shm+rg*(64*64+64));
  if(g==1){
    #pragma unroll
    for(int d0=0;d0<4;++d0){
      #pragma unroll
      for(int r4=0;r4<4;++r4)xo4[(d0*4+r4)*64+lane]=(f32x4v){o[d0][4*r4],o[d0][4*r4+1],o[d0][4*r4+2],o[d0][4*r4+3]};}
    if(hi==0){xs[r32]=mhat;xs[32+r32]=l_reg;}
  }
  asm volatile("s_waitcnt lgkmcnt(0)\n\ts_barrier":::"memory");
  if(g==0){
    const float mb=xs[r32],lb=xs[32+r32];
    const float m=(lb>0.f)?__builtin_fmaxf(mhat,mb):mhat,wa=__builtin_amdgcn_exp2f(mhat-m),wb=(lb>0.f)?__builtin_amdgcn_exp2f(mb-m):0.f;
    const float linv=__builtin_amdgcn_rcpf(l_reg*wa+lb*wb);
    if(hi==0){wsf[r32]=wa*linv;wsf[32+r32]=wb*linv;}
    f32x4v*sc4=(f32x4v*)ua.scr+(rg*16)*64+lane;
    f32x4v t2[16];
    if(ua.kind!=0){
      #pragma unroll
      for(int i=0;i<16;++i)t2[i]=__builtin_nontemporal_load(sc4+i*64);
    }
    asm volatile("s_waitcnt lgkmcnt(0)":::"memory");
    #pragma unroll
    for(int r4=0;r4<4;++r4){ const f32x4v fa=*(const f32x4v*)(wsf+8*r4+4*hi),fb=*(const f32x4v*)(wsf+32+8*r4+4*hi);
      #pragma unroll
      for(int d0=0;d0<4;++d0){ const f32x4v ob=xo4[(d0*4+r4)*64+lane];
        #pragma unroll
        for(int j=0;j<4;++j)o[d0][4*r4+j]=o[d0][4*r4+j]*fa[j]+ob[j]*fb[j]; } }
    if(ua.kind==0){
      #pragma unroll
      for(int d0=0;d0<4;++d0){
        #pragma unroll
        for(int r4=0;r4<4;++r4)sc4[(d0*4+r4)*64]=(f32x4v){o[d0][4*r4],o[d0][4*r4+1],o[d0][4*r4+2],o[d0][4*r4+3]};} }
    else{
      float rs[16];
      #pragma unroll
      for(int r=0;r<16;++r){ float ss=0.f;
        #pragma unroll
        for(int d0=0;d0<4;++d0){const float a=o[d0][r]-ua.lam*t2[d0*4+(r>>2)][r&3]; o[d0][r]=a; ss+=a*a;}
        ss+=__shfl_xor(ss,1); ss+=__shfl_xor(ss,2); ss+=__shfl_xor(ss,4); ss+=__shfl_xor(ss,8); ss+=__shfl_xor(ss,16);
        rs[r]=ua.oscale*__builtin_amdgcn_rsqf(ss*(1.0f/128.0f)+1e-6f); }
      bf16*stg=(bf16*)(shm+LDS_OST)+wid*2048;
      #pragma unroll
      for(int vh=0;vh<2;++vh){
        const float g0=ua.gain[vh*64+r32],g1=ua.gain[vh*64+32+r32];
        #pragma unroll
        for(int r=0;r<16;++r){const int orow=crow(r,hi);
          stg[orow*64+r32]=__float2bfloat16(o[2*vh][r]*rs[r]*g0);
          stg[orow*64+32+r32]=__float2bfloat16(o[2*vh+1][r]*rs[r]*g1);}
        asm volatile("s_waitcnt lgkmcnt(0)":::"memory");
        #pragma unroll
        for(int i=0;i<4;++i){const int row=i*8+(lane>>3),ch=lane&7; const u32x4 v=*(const u32x4*)(stg+row*64+ch*8); ATTN_STORE16((char*)O+PG8_AOFF(rowbase+q0+rg*QBLK+row,ua.ocol+vh*64+ch*8,OPITCH),v);}
        asm volatile("s_waitcnt lgkmcnt(0)":::"memory");
      } }
  }
#ifdef ATT_PRIO
  __builtin_amdgcn_s_setprio(0);
#endif
  asm volatile("s_waitcnt lgkmcnt(0)\n\ts_barrier":::"memory");
  #undef DMA_K
  #undef DMA_V
  #undef VSL
  #undef CMASK
  #undef START
  #undef RESC
  #undef ROT
}
constexpr int ATTN_LDS_BYTES=LDS_BYTES;
#undef SBAR
#undef WAIT_BAR
}

constexpr int NWAVES = 8;
#ifndef MK_PER_PHASE
#define MK_PER_PHASE 0
#endif
constexpr int BATCH = 2, SEQ = 4096, DMODEL = 4096, M = BATCH * SEQ, DEPTH = 4, FF = 16384, NGRP = 128;
constexpr int N_PHASES = 2 + 6 * DEPTH;
constexpr size_t MiB = 1u << 20;
constexpr size_t WS_CTL = 0, CTL_ZERO_BYTES = 1 * MiB;
constexpr int CW_BAR = 4096;
constexpr size_t SSQ_OFF = 128 * 1024;
static_assert(SSQ_OFF + 9 * (size_t)M * 8 <= CTL_ZERO_BYTES, "ssq inside the memset region");
constexpr size_t WS_W = 16 * MiB, W_LAYER = 360 * MiB;
constexpr size_t W_IN = 0, W_OUT = 64 * MiB, W_UP = 96 * MiB, W_DN = 224 * MiB, W_GLU = 352 * MiB;
constexpr size_t WS_SSMP = WS_W + DEPTH * W_LAYER;
constexpr size_t SSMP_STRIDE = 144 * 1024;
constexpr size_t WS_KI = 1536 * MiB, WS_VI = 1568 * MiB;
constexpr size_t WS_H = 1536 * MiB, WS_HB = 1664 * MiB, WS_QKV = 1728 * MiB, WS_UT = 1824 * MiB, WS_YG = 1856 * MiB, WS_CAT = 1888 * MiB, WS_ATT = 1952 * MiB, WS_HID = 1984 * MiB, WS_END = 2240 * MiB;
static_assert(WS_SSMP + (size_t)DEPTH * NGRP * SSMP_STRIDE <= WS_H, "d_ws map");
constexpr int RING_OFF = 0, RING_BYTES = 131072;
constexpr int LDSCTL_OFF = RING_BYTES, MISC_OFF = LDSCTL_OFF + 320;
constexpr int LDS_BYTES = 147456;
static_assert(MISC_OFF + 128 <= LDS_BYTES, "LDS map");

#define GAS __attribute__((address_space(1)))
#define LAS __attribute__((address_space(3)))
typedef unsigned short bf16;
typedef unsigned v4u __attribute__((ext_vector_type(4)));
typedef float f32x4 __attribute__((ext_vector_type(4)));
typedef short bf16x8 __attribute__((ext_vector_type(8)));
typedef GAS unsigned gu32;
typedef GAS unsigned long long gu64;
#define RLX_AGENT __ATOMIC_RELAXED, __HIP_MEMORY_SCOPE_AGENT
#define LDS_WAIT() asm volatile("s_waitcnt lgkmcnt(0)" ::: "memory")
#define VM_WAIT() asm volatile("s_waitcnt vmcnt(0)" ::: "memory")
__device__ __forceinline__ unsigned long long rt() { return __builtin_amdgcn_s_memrealtime(); }
__device__ __forceinline__ unsigned f2bf(float f) { unsigned u = __builtin_bit_cast(unsigned, f); return (u + 0x7fffu + ((u >> 16) & 1u)) >> 16; }
__device__ __forceinline__ unsigned pk2(float lo, float hi) { return f2bf(lo) | (f2bf(hi) << 16); }

#define XB_TMO      128
#define XB_XCNT(j)  (256  + 64 * (j))
#define XB_XSUB(j)  (1280 + 64 * (j))
#define XB_XGEN(j)  (2304 + 64 * (j))
#define XB_TOP      3328
#define XB_TOPGEN   3392
#define XCD_BAR_WORDS 3456
#define XB_SPIN_CAP (1u << 18)

__device__ __forceinline__ unsigned xb_ld(unsigned* p)              { return __hip_atomic_load(p, __ATOMIC_RELAXED, __HIP_MEMORY_SCOPE_AGENT); }
__device__ __forceinline__ unsigned xb_add(unsigned* p, unsigned v) { return __hip_atomic_fetch_add(p, v, __ATOMIC_RELAXED, __HIP_MEMORY_SCOPE_AGENT); }
__device__ __forceinline__ unsigned xb_xcc_id() { return (unsigned)__builtin_amdgcn_s_getreg((3 << 11) | 20) & 0xFu; }
#define XB_SPIN(cond, bar) do { unsigned _sp = 0; while (cond) { __builtin_amdgcn_s_sleep(1); \
    if ((++_sp & 255u) == 0u) { if (xb_ld(&(bar)[XB_TMO])) break; if (_sp > XB_SPIN_CAP) { atomicAdd(&(bar)[XB_TMO], 1u); break; } } } } while (0)

struct XcdBarrier {
    unsigned* bar; unsigned x;
    volatile LAS unsigned* st;
};

__device__ __forceinline__ XcdBarrier xcd_barrier_post(unsigned* bar, volatile LAS unsigned* st) {
    XcdBarrier b; b.bar = bar; b.x = xb_xcc_id(); b.st = st;
    if (threadIdx.x == 0) (void)xb_add(&bar[XB_XCNT(b.x)], 1u);
    return b;
}
__device__ __forceinline__ void xcd_barrier_complete(unsigned* bar, unsigned x, unsigned& nloc, unsigned& nx) {
    const unsigned G = gridDim.x * gridDim.y * gridDim.z;
    unsigned sum, cnt, mine, sp = 0u;
    for (;;) {
        sum = 0u; cnt = 0u; mine = 0u;
#pragma unroll
        for (unsigned j = 0; j < 16; ++j) { const unsigned c = xb_ld(&bar[XB_XCNT(j)]); sum += c; cnt += (c > 0u) ? 1u : 0u; mine = (j == x) ? c : mine; }
        if (sum == G) break;
        __builtin_amdgcn_s_sleep(1);
        if ((++sp & 255u) == 0u) { if (xb_ld(&bar[XB_TMO])) break; if (sp > XB_SPIN_CAP) { atomicAdd(&bar[XB_TMO], 1u); break; } }
    }
    nloc = mine > 0u ? mine : 1u; nx = cnt > 0u ? cnt : 1u;
}

__device__ __forceinline__ void xcd_barrier(const XcdBarrier& b) {
    asm volatile("s_waitcnt vmcnt(0)" ::: "memory");
    __syncthreads();
    if (threadIdx.x == 0) {
        unsigned* bar = b.bar;
        __builtin_amdgcn_s_waitcnt(0);
        unsigned nloc = b.st[0], nx = b.st[1];
        if (nloc == 0u) { xcd_barrier_complete(bar, b.x, nloc, nx); b.st[0] = nloc; b.st[1] = nx; }
        const unsigned old = xb_add(&bar[XB_XSUB(b.x)], 1u);
        const unsigned gen = old / nloc;
        if (old + 1u == (gen + 1u) * nloc) {
            __builtin_amdgcn_fence(__ATOMIC_RELEASE, "agent");
            asm volatile("s_waitcnt vmcnt(0)" ::: "memory");
            const unsigned og = xb_add(&bar[XB_TOP], 1u);
            const unsigned tg = og / nx;
            if (og + 1u == (tg + 1u) * nx) xb_add(&bar[XB_TOPGEN], 1u);
            else XB_SPIN(xb_ld(&bar[XB_TOPGEN]) == tg, bar);
            __builtin_amdgcn_fence(__ATOMIC_ACQUIRE, "agent");
            xb_add(&bar[XB_XGEN(b.x)], 1u);
            asm volatile("s_waitcnt vmcnt(0)" ::: "memory");
        } else {
            XB_SPIN(xb_ld(&bar[XB_XGEN(b.x)]) == gen, bar);
            __builtin_amdgcn_fence(__ATOMIC_ACQUIRE, "agent");
            asm volatile("s_waitcnt vmcnt(0)" ::: "memory");
        }
    }
    __syncthreads();
}

struct Frame {
    LAS unsigned char* lds;
    volatile LAS unsigned* MISC;
    gu32* ctl;
    int tid, lane, wave;
    int vcu, G;
    const float* const* in;
    float* out; unsigned char* ws;
};
enum In { I_X = 0, I_WIN, I_WOUT, I_NMIX, I_NMLP, I_WUP, I_WDN, I_NFIN, I_RELB, I_LQ1, I_LK1, I_LQ2, I_LK2, I_SUBG, I_SLRE, I_SLIM, I_SLDT, I_SBRE, I_SBIM, I_SCRE, I_SCIM, I_SD, I_WGLU, I_BGLU, N_IN };

__device__ __forceinline__ float wave_sum(float v) {
#pragma unroll
    for (int o = 1; o < 64; o <<= 1) v += __shfl_xor(v, o);
    return v;
}
struct TItem { const float* src; const float* gain; bf16* dst; int N, K, n0, k0; };
struct TRegs { f32x4 v[8]; f32x4 g0, g1; };
__device__ __forceinline__ void tr_load(const TItem& t, TRegs& r, int lane) {
    const float* p = t.src + (size_t)(lane >> 4) * t.N + 4 * (lane & 15);
#pragma unroll
    for (int i = 0; i < 8; ++i) r.v[i] = *(const f32x4*)(p + (size_t)(4 * i) * t.N);
    if (t.gain) { r.g0 = *(const f32x4*)(t.gain + 8 * (lane >> 4)); r.g1 = *(const f32x4*)(t.gain + 8 * (lane >> 4) + 4); } else { r.g0 = (f32x4){1.f, 1.f, 1.f, 1.f}; r.g1 = r.g0; }
}
__device__ __forceinline__ void tr_store(const TItem& t, const TRegs& r, LAS float* scr, int lane) {
#pragma unroll
    for (int i = 0; i < 8; ++i) { LAS float* d = scr + (4 * i + (lane >> 4)) * 65 + 4 * (lane & 15); d[0] = r.v[i].x; d[1] = r.v[i].y; d[2] = r.v[i].z; d[3] = r.v[i].w; }
    LDS_WAIT(); asm volatile("" ::: "memory");
    const int c4 = lane >> 4;
#pragma unroll
    for (int j = 0; j < 4; ++j) { const int R = 16 * j + (lane & 15), nl = (R & ~31) + pg8::perm32(R & 31);
        const LAS float* s = scr + (8 * c4) * 65 + nl;
        v4u o; o.x = pg8::cvt_pk_bf16(s[0 * 65] * r.g0.x, s[1 * 65] * r.g0.y); o.y = pg8::cvt_pk_bf16(s[2 * 65] * r.g0.z, s[3 * 65] * r.g0.w); o.z = pg8::cvt_pk_bf16(s[4 * 65] * r.g1.x, s[5 * 65] * r.g1.y); o.w = pg8::cvt_pk_bf16(s[6 * 65] * r.g1.z, s[7 * 65] * r.g1.w);
        *(GAS v4u*)((GAS unsigned char*)t.dst + pg8::img_off(t.n0 + nl, t.k0 + 8 * c4, t.K, true)) = o; }
    LDS_WAIT(); asm volatile("" ::: "memory");
}
__device__ __forceinline__ void ssm_setup_unit(Frame& F, int l, int g) {
    LAS float* apr = (LAS float*)(F.lds + RING_OFF); LAS float* api = apr + 17 * 64; LAS float* bbr = api + 17 * 64; LAS float* bbi = bbr + 1024;
    LAS float* cr = bbi + 1024; LAS float* ci = cr + 1024; LAS float* gg = ci + 1024;
    const int lg = l * NGRP + g, tid = F.tid;
    bf16* P = (bf16*)(F.ws + WS_SSMP + (size_t)lg * SSMP_STRIDE); bf16* WmT = P; bf16* VmT = P + 32768; bf16* Kt = P + 65536; float* A16 = (float*)(P + 65536 + 17 * 256);
    if (tid < 64) { const int p = tid;
        const float dt = expf(F.in[I_SLDT][lg]), lr = F.in[I_SLRE][lg * 64 + p], li = F.in[I_SLIM][lg * 64 + p];
        const float mag = expf(lr * dt), th = li * dt, ar = mag * cosf(th), ai = mag * sinf(th);
        float pr = 1.f, pi = 0.f;
        for (int tau = 0; tau <= 16; ++tau) { apr[tau * 64 + p] = pr; api[tau * 64 + p] = pi; const float npr = pr * ar - pi * ai, npi = pr * ai + pi * ar; pr = npr; pi = npi; }
        const float den = lr * lr + li * li, nr = ar - 1.0f, ni = ai;
        gg[p] = (nr * lr + ni * li) / den; gg[64 + p] = (ni * lr - nr * li) / den; }
    __syncthreads();
    if (tid < 64) { A16[2 * tid] = apr[16 * 64 + tid]; A16[2 * tid + 1] = api[16 * 64 + tid]; }
    for (int idx = tid; idx < 1024; idx += NWAVES * 64) { const int p = idx >> 4;
        const float br = F.in[I_SBRE][(size_t)lg * 1024 + idx], bi = F.in[I_SBIM][(size_t)lg * 1024 + idx], gr = gg[p], gi = gg[64 + p];
        bbr[idx] = gr * br - gi * bi; bbi[idx] = gr * bi + gi * br;
        cr[idx] = F.in[I_SCRE][(size_t)lg * 1024 + idx]; ci[idx] = F.in[I_SCIM][(size_t)lg * 1024 + idx]; }
    __syncthreads();
    for (int e = tid; e < 32768; e += NWAVES * 64) { const int pp = e >> 8, k = e & 255, p = pp & 63, j = k >> 4, hh = k & 15, tau = 15 - j;
        const float ar = apr[tau * 64 + p], ai = api[tau * 64 + p], br = bbr[p * 16 + hh], bi = bbi[p * 16 + hh];
        WmT[e] = (bf16)f2bf(pp < 64 ? ar * br - ai * bi : ar * bi + ai * br); }
    for (int e = tid; e < 32768; e += NWAVES * 64) { const int n = e >> 7, pp = e & 127, p = pp & 63, t = n >> 4, hh = n & 15;
        const float ar = apr[(t + 1) * 64 + p], ai = api[(t + 1) * 64 + p], c_r = cr[hh * 64 + p], c_i = ci[hh * 64 + p];
        VmT[e] = (bf16)f2bf(pp < 64 ? c_r * ar - c_i * ai : -(c_r * ai + c_i * ar)); }
    for (int e = tid; e < 256; e += NWAVES * 64) Kt[e] = 0;
    for (int e = tid; e < 4096; e += NWAVES * 64) { const int tau = e >> 8, hh = (e >> 4) & 15, h2 = e & 15; float acc = 0.f;
        for (int p = 0; p < 64; ++p) { const float ar = apr[tau * 64 + p], ai = api[tau * 64 + p], c_r = cr[hh * 64 + p], c_i = ci[hh * 64 + p];
            const float xr = c_r * ar - c_i * ai, xi = c_r * ai + c_i * ar; acc += xr * bbr[p * 16 + h2] - xi * bbi[p * 16 + h2]; }
        if (tau == 0 && hh == h2) acc += F.in[I_SD][lg * 16 + hh];
        Kt[256 + e] = (bf16)f2bf(acc); }
    __syncthreads();
}
__device__ __forceinline__ void p0_prologue(Frame& F) {
    LAS float* scr = (LAS float*)(F.lds + RING_OFF + F.wave * 16384);
    const int gw = F.vcu * NWAVES + F.wave, NGW = F.G * NWAVES;
    constexpr int IT_IN = (DMODEL / 64) * (8192 / 32), IT_OUT = (DMODEL / 64) * (DMODEL / 32), IT_UP = (DMODEL / 64) * (FF / 32), IT_DN = (FF / 64) * (DMODEL / 32), IT_GLU = (2048 / 64) * (2048 / 32);
    constexpr int IT_LAYER = IT_IN + IT_OUT + IT_UP + IT_DN + IT_GLU, NITEMS = DEPTH * IT_LAYER;
    auto decode = [&](int it, TItem& t) {
        const int l = it / IT_LAYER; int r = it % IT_LAYER;
        unsigned char* wl = F.ws + WS_W + (size_t)l * W_LAYER;
        const float* W; const float* gain = nullptr; bf16* WT; int K, N;
        if (r < IT_IN) { W = F.in[I_WIN] + (size_t)l * DMODEL * 8192; K = DMODEL; N = 8192; gain = F.in[I_NMIX] + l * DMODEL; WT = (bf16*)(wl + W_IN); }
        else if ((r -= IT_IN) < IT_OUT) { W = F.in[I_WOUT] + (size_t)l * DMODEL * DMODEL; K = DMODEL; N = DMODEL; WT = (bf16*)(wl + W_OUT); }
        else if ((r -= IT_OUT) < IT_UP) { W = F.in[I_WUP] + (size_t)l * DMODEL * FF; K = DMODEL; N = FF; gain = F.in[I_NMLP] + l * DMODEL; WT = (bf16*)(wl + W_UP); }
        else if ((r -= IT_UP) < IT_DN) { W = F.in[I_WDN] + (size_t)l * FF * DMODEL; K = FF; N = DMODEL; WT = (bf16*)(wl + W_DN); }
        else { r -= IT_DN; W = F.in[I_WGLU] + (size_t)l * 2048 * 2048; K = 2048; N = 2048; WT = (bf16*)(wl + W_GLU); }
        const int nblk = N / 64, k0 = 32 * (r / nblk), n0 = 64 * (r % nblk);
        t.src = W + (size_t)k0 * N + n0; t.gain = gain ? gain + k0 : nullptr; t.dst = WT; t.N = N; t.K = K; t.n0 = n0; t.k0 = k0; };
    if (gw < NITEMS) {
        TItem ta, tb; TRegs ra, rb;
        decode(gw, ta); tr_load(ta, ra, F.lane);
        for (int it = gw;;) {
            const int i1 = it + NGW; const bool h1 = i1 < NITEMS;
            if (h1) { decode(i1, tb); tr_load(tb, rb, F.lane); }
            tr_store(ta, ra, scr, F.lane);
            if (!h1) break;
            const int i2 = i1 + NGW; const bool h2 = i2 < NITEMS;
            if (h2) { decode(i2, ta); tr_load(ta, ra, F.lane); }
            tr_store(tb, rb, scr, F.lane);
            if (!h2) break;
            it = i2;
        }
    }
    pg8::ssq_t* ssq0 = (pg8::ssq_t*)(F.ws + WS_CTL + SSQ_OFF);
    {
        f32x4 xv[16];
        if (gw < M) { const GAS f32x4* xr = (const GAS f32x4*)(F.in[I_X] + (size_t)gw * DMODEL) + F.lane;
#pragma unroll
            for (int j = 0; j < 16; ++j) xv[j] = xr[64 * j]; }
        for (int m = gw; m < M; m += NGW) {
            f32x4 xn[16]; const int mn = m + NGW;
            if (mn < M) { const GAS f32x4* xr = (const GAS f32x4*)(F.in[I_X] + (size_t)mn * DMODEL) + F.lane;
#pragma unroll
                for (int j = 0; j < 16; ++j) xn[j] = xr[64 * j]; }
            float s = 0.f;
#pragma unroll
            for (int j = 0; j < 16; ++j) { const f32x4 v = xv[j]; s += (v.x * v.x + v.y * v.y) + (v.z * v.z + v.w * v.w); *(GAS unsigned long long*)(F.ws + WS_HB + PG8_AOFF(m, 4 * (F.lane + 64 * j), DMODEL)) = (unsigned long long)pk2(v.x, v.y) | ((unsigned long long)pk2(v.z, v.w) << 32); }
            s = wave_sum(s); if (F.lane == 0) ssq0[m] = (pg8::ssq_t)(s * pg8::SSQ_SCALE);
#pragma unroll
            for (int j = 0; j < 16; ++j) xv[j] = xn[j];
        }
    }
    __syncthreads();
    for (int u = F.vcu; u < DEPTH * NGRP; u += F.G) ssm_setup_unit(F, u / NGRP, u % NGRP);
}
__device__ __forceinline__ float gelu_tanh(float y) { const float z = 0.7978845608028654f * (y + 0.044715f * y * y * y); return y * __builtin_amdgcn_rcpf(1.0f + __builtin_amdgcn_exp2f(-2.8853900817779268f * z)); }
__device__ __forceinline__ void ssm_unit(Frame& F, int l, int b, int g) {
    typedef short s16x8 __attribute__((ext_vector_type(8)));
#define SSM_SYNC() asm volatile("s_waitcnt lgkmcnt(0)\n\ts_barrier" ::: "memory")
    int lane_ = F.lane; asm volatile("" : "+v"(lane_));
    const int lane = lane_, w = F.wave, fr = lane & 15, fq = lane >> 4, tid = w * 64 + lane;
    const bf16* P = (const bf16*)(F.ws + WS_SSMP + (size_t)(l * NGRP + g) * SSMP_STRIDE); const bf16* WmT = P; const bf16* VmT = P + 32768; const bf16* Kt = P + 65536; const float* A16 = (const float*)(P + 65536 + 17 * 256);
    const bf16* U = (const bf16*)(F.ws + WS_UT) + ((size_t)g * M + (size_t)b * SEQ) * 16;
    bf16* YG = (bf16*)(F.ws + WS_YG);
    LAS float* S = (LAS float*)(F.lds + RING_OFF);
    LAS unsigned char* UQ = F.lds + RING_OFF + 64 * 132 * 4;
    s16x8 wf[8], kfl[4], kfh[8], vfl[4], vfh[4];
    const int tl = w, th = 15 - w;
    v4u pre[4];
#pragma unroll
    for (int i = 0; i < 4; ++i) pre[i] = *(const v4u*)(U + (size_t)(tid + 512 * i) * 8);
#pragma unroll
    for (int kk = 0; kk < 8; ++kk) wf[kk] = *(const s16x8*)(WmT + (16 * w + fr) * 256 + 32 * kk + 8 * fq);
#pragma unroll
    for (int kk = 0; kk < 4; ++kk) { const int tau = tl - 2 * kk - (fq >> 1); kfl[kk] = *(const s16x8*)(Kt + (tau < 0 ? 0 : tau + 1) * 256 + fr * 16 + 8 * (fq & 1)); }
#pragma unroll
    for (int kk = 0; kk < 8; ++kk) { const int tau = th - 2 * kk - (fq >> 1); kfh[kk] = *(const s16x8*)(Kt + (tau < 0 ? 0 : tau + 1) * 256 + fr * 16 + 8 * (fq & 1)); }
#pragma unroll
    for (int kk = 0; kk < 4; ++kk) { vfl[kk] = *(const s16x8*)(VmT + (tl * 16 + fr) * 128 + 32 * kk + 8 * fq); vfh[kk] = *(const s16x8*)(VmT + (th * 16 + fr) * 128 + 32 * kk + 8 * fq); }
    float sr = 0.f, si = 0.f, a16r = 0.f, a16i = 0.f;
    if (w == 0) { a16r = A16[2 * lane]; a16i = A16[2 * lane + 1]; }
    for (int q = 0; q < 4; ++q) {
#pragma unroll
        for (int i = 0; i < 4; ++i) { const int e = tid + 512 * i; *(LAS v4u*)(UQ + (e >> 5) * 528 + (e & 31) * 16) = pre[i]; }
        SSM_SYNC();
        if (q < 3) {
#pragma unroll
            for (int i = 0; i < 4; ++i) pre[i] = *(const v4u*)(U + (size_t)(q + 1) * 16384 + (size_t)(tid + 512 * i) * 8);
        }
#pragma unroll
        for (int mt = 0; mt < 4; ++mt) {
            const LAS unsigned char* ub = UQ + (mt * 16 + fr) * 528 + fq * 16;
            f32x4 acc = {0.f, 0.f, 0.f, 0.f};
#pragma unroll
            for (int kk = 0; kk < 8; ++kk) { const s16x8 uf = *(const LAS s16x8*)(ub + 64 * kk); acc = __builtin_amdgcn_mfma_f32_16x16x32_bf16(wf[kk], uf, acc, 0, 0, 0); }
            *(LAS f32x4*)(S + (mt * 16 + fr) * 132 + 16 * w + 4 * fq) = acc;
        }
        SSM_SYNC();
        if (w == 0) {
            for (int c0 = 0; c0 < 64; c0 += 8) { float tr[8], ti[8];
#pragma unroll
                for (int i = 0; i < 8; ++i) { tr[i] = S[(c0 + i) * 132 + lane]; ti[i] = S[(c0 + i) * 132 + 64 + lane]; }
#pragma unroll
                for (int i = 0; i < 8; ++i) { S[(c0 + i) * 132 + lane] = sr; S[(c0 + i) * 132 + 64 + lane] = si;
                    const float nsr = a16r * sr - a16i * si + tr[i], nsi = a16r * si + a16i * sr + ti[i]; sr = nsr; si = nsi; } }
        }
        SSM_SYNC();
#pragma unroll
        for (int mt = 0; mt < 4; ++mt) {
            const int chunk = q * 64 + mt * 16 + fr;
            const LAS unsigned char* ub = UQ + (mt * 16 + fr) * 528 + fq * 16;
            f32x4 accl = {0.f, 0.f, 0.f, 0.f}, acch = {0.f, 0.f, 0.f, 0.f};
#pragma unroll
            for (int kk = 0; kk < 8; ++kk) { const s16x8 uf = *(const LAS s16x8*)(ub + 64 * kk);
                if (kk < 4) accl = __builtin_amdgcn_mfma_f32_16x16x32_bf16(kfl[kk], uf, accl, 0, 0, 0);
                acch = __builtin_amdgcn_mfma_f32_16x16x32_bf16(kfh[kk], uf, acch, 0, 0, 0); }
#pragma unroll
            for (int kk = 0; kk < 4; ++kk) { const LAS float* sp = S + (mt * 16 + fr) * 132 + 32 * kk + 8 * fq; const f32x4 s0 = *(const LAS f32x4*)sp, s1 = *(const LAS f32x4*)(sp + 4);
                const s16x8 sf = __builtin_bit_cast(s16x8, pg8::pack8(s0, s1));
                accl = __builtin_amdgcn_mfma_f32_16x16x32_bf16(vfl[kk], sf, accl, 0, 0, 0); acch = __builtin_amdgcn_mfma_f32_16x16x32_bf16(vfh[kk], sf, acch, 0, 0, 0); }
            const size_t tok = (size_t)b * SEQ + (size_t)chunk * 16;
            { typedef unsigned u32x2 __attribute__((ext_vector_type(2)));
              u32x2 o; o.x = pg8::cvt_pk_bf16(gelu_tanh(accl[0]), gelu_tanh(accl[1])); o.y = pg8::cvt_pk_bf16(gelu_tanh(accl[2]), gelu_tanh(accl[3]));
              *(u32x2*)((char*)YG + PG8_AOFF(tok + tl, g * 16 + 4 * fq, 2048)) = o;
              o.x = pg8::cvt_pk_bf16(gelu_tanh(acch[0]), gelu_tanh(acch[1])); o.y = pg8::cvt_pk_bf16(gelu_tanh(acch[2]), gelu_tanh(acch[3]));
              *(u32x2*)((char*)YG + PG8_AOFF(tok + th, g * 16 + 4 * fq, 2048)) = o; }
        }
        SSM_SYNC();
    }
#undef SSM_SYNC
}

struct Args { const float* in[N_IN]; float* out; unsigned char* ws; int ph_lo, ph_hi; };
__global__ void __launch_bounds__(NWAVES * 64, 2) hymba_fwd(Args args) {
    extern __shared__ __attribute__((aligned(16))) unsigned char lds[];
    Frame F;
    F.lds = (LAS unsigned char*)lds;
    F.MISC = (volatile LAS unsigned*)(F.lds + MISC_OFF);
    F.tid = threadIdx.x; F.lane = F.tid & 63; F.wave = __builtin_amdgcn_readfirstlane(F.tid >> 6);
    F.G = gridDim.x; { const int bx = blockIdx.x; F.vcu = (F.G % 8 == 0) ? (bx % 8) * (F.G / 8) + bx / 8 : bx; }
    F.in = args.in; F.out = args.out; F.ws = args.ws;
    unsigned char* ws = args.ws;
    F.ctl = (gu32*)(ws + WS_CTL);
    for (int u = F.tid; u < (LDS_BYTES - LDSCTL_OFF) / 4; u += NWAVES * 64) ((LAS unsigned*)(F.lds + LDSCTL_OFF))[u] = 0u;
    __syncthreads();
    XcdBarrier bar; bar.bar = (unsigned*)(F.ctl + CW_BAR); bar.x = 0; bar.st = nullptr;
    if (!MK_PER_PHASE) bar = xcd_barrier_post((unsigned*)(F.ctl + CW_BAR), F.MISC + 8);
#ifndef REP_BAR
#define REP_BAR 1
#endif
#define GRID_BAR() do { if (MK_PER_PHASE) { if (F.tid == 0) __hip_atomic_store(F.ctl + 0, 0xBADBA0u, RLX_AGENT); } else { for (int rb_ = 0; rb_ < REP_BAR; ++rb_) xcd_barrier(bar); } } while (0)
    const int lo = args.ph_lo, hi = args.ph_hi;
#define IN(k) (lo <= (k) && (k) < hi)
#define BOTH(k) (IN(k) && IN((k) + 1))
    pg8::ssq_t* const ssq = (pg8::ssq_t*)(ws + WS_CTL + SSQ_OFF);
    pg8::bf16_t* const HB = (pg8::bf16_t*)(ws + WS_HB); pg8::bf16_t* const QKV = (pg8::bf16_t*)(ws + WS_QKV); pg8::bf16_t* const UT = (pg8::bf16_t*)(ws + WS_UT);
    pg8::bf16_t* const YG = (pg8::bf16_t*)(ws + WS_YG); pg8::bf16_t* const CAT = (pg8::bf16_t*)(ws + WS_CAT); pg8::bf16_t* const HID = (pg8::bf16_t*)(ws + WS_HID);

#ifndef REP_PRO
#define REP_PRO 1
#endif
#ifndef REP_SSM
#define REP_SSM 1
#endif
#ifndef REP_ATT
#define REP_ATT 1
#endif
#ifndef REP_GEMM
#define REP_GEMM 1
#endif
#ifndef REP_RES
#define REP_RES 1
#endif
    if (IN(0)) { for (int rep = 0; rep < REP_PRO; ++rep) { p0_prologue(F); __syncthreads(); } if (BOTH(0)) GRID_BAR(); }

    for (int l = 0; l < DEPTH; ++l) {
        const int pb = 1 + 6 * l;
        const unsigned char* wl = ws + WS_W + (size_t)l * W_LAYER;
        if (IN(pb)) {
            pg8::Gemm g{HB, (const pg8::bf16_t*)(wl + W_IN), M, 8192, DMODEL, A_IMG, 1}; pg8::StaticOrder S; S.init(M, 8192, F.G, (int)blockIdx.x);
            pg8::EpiProj E{QKV, UT, ssq + (2 * l) * M, attn_body::C2, ws + WS_KI, ws + WS_VI};
#ifndef STG_IN
#define STG_IN 0
#endif
            if (STG_IN && (F.vcu & 1)) { for (int s_ = 0; s_ < STG_IN; ++s_) __builtin_amdgcn_s_sleep(48); }
            for (int rep = 0; rep < REP_GEMM; ++rep) { pg8::gemm_phase<pg8::EpiProj, pg8::StaticOrder, PG8_ALIGN, PG8_SP2>(F.lds + RING_OFF, g, S, E); __syncthreads(); }
            if (BOTH(pb)) GRID_BAR();
        }
        if (IN(pb + 1)) {
            for (int rep = 0; rep < REP_SSM; ++rep) for (int u = F.vcu; u < BATCH * NGRP; u += F.G) ssm_unit(F, l, u / NGRP, u % NGRP);
            __syncthreads();
            const float lam_init = 0.8f - 0.6f * expf(-0.3f * (float)l);
            const float d1 = wave_sum(F.in[I_LQ1][l * 64 + F.lane] * F.in[I_LK1][l * 64 + F.lane]), d2 = wave_sum(F.in[I_LQ2][l * 64 + F.lane] * F.in[I_LK2][l * 64 + F.lane]);
            const float lam = expf(d1) - expf(d2) + lam_init;
            for (int rep = 0; rep < REP_ATT; ++rep) for (int pu = F.vcu; pu < 256; pu += F.G) {
                const int bh = pu >> 3, pp = pu & 7, b = bh >> 4, h = bh & 15;
#ifndef ATT_V64
                attn_body::build_lut((char*)lds + RING_OFF, F.in[I_RELB], h, F.tid);
#endif
#if defined(PROBE_ATT_QB)
                for (int xr = 0; xr < PROBE_ATT_N; ++xr) { attn_body::UnitArgs ua; ua.kind = 0; ua.qcol = h * 128 + 64; ua.kcol = 0; ua.vcol = 0; ua.ocol = h * 128;
                    ua.relb = F.in[I_RELB]; ua.scr = (float*)(ws + WS_ATT) + (size_t)F.vcu * (2 * 256 * 64); ua.lam = lam; ua.oscale = 1.0f - lam_init; ua.gain = F.in[I_SUBG] + l * 128;
                    attn_body::attn_unit<8>(b, h, PROBE_ATT_QB, (const attn_body::bf16*)QKV, (const attn_body::bf16*)(ws + WS_KI + (size_t)((bh * 2 + 1) * 64) * 8192), (const attn_body::bf16*)(ws + WS_VI + (size_t)(bh * 64) * 16384), (attn_body::bf16*)CAT, (char*)lds + RING_OFF, ua); }
#endif
#ifdef ATT_V64
                for (int qi = 0; qi < 2; ++qi) { const int qb = qi ? 15 - pp : pp;
                    for (int kind = 0; kind < 4; ++kind) { const int s2 = (kind < 2) ? 64 : 0, vh = kind & 1;
                        attn_body::UnitArgs ua; ua.kind = kind; ua.qcol = h * 128 + s2; ua.kcol = 2048 + h * 128 + s2; ua.vcol = 4096 + h * 128 + vh * 64; ua.ocol = h * 128;
#elif defined(ATT_PP)
                for (int qi = 0; qi < 2; ++qi) { const int qb = qi ? 15 - pp : pp;
                    for (int kind = 0; kind < 2; ++kind) { const int s2 = (kind < 1) ? 64 : 0;
                        attn_body::UnitArgs ua; ua.kind = kind; ua.qcol = h * 128 + s2; ua.kcol = 2048 + h * 128 + s2; ua.vcol = 4096 + h * 128; ua.ocol = h * 128;
#else
                for (int qi = 0; qi < 4; ++qi) { const int qb = (qi == 0) ? pp : (qi == 1) ? 15 - pp : (qi == 2) ? 16 + pp : 31 - pp;
                    for (int kind = 0; kind < 2; ++kind) { const int s2 = (kind < 1) ? 64 : 0;
                        attn_body::UnitArgs ua; ua.kind = kind; ua.qcol = h * 128 + s2; ua.kcol = 2048 + h * 128 + s2; ua.vcol = 4096 + h * 128; ua.ocol = h * 128;
#endif
                        ua.relb = F.in[I_RELB]; ua.scr = (float*)(ws + WS_ATT) + (size_t)F.vcu * (2 * 256 * 64); ua.lam = lam; ua.oscale = 1.0f - lam_init; ua.gain = F.in[I_SUBG] + l * 128;
                        attn_body::attn_unit<8>(b, h, qb, (const attn_body::bf16*)QKV, (const attn_body::bf16*)(ws + WS_KI + (size_t)((bh * 2 + (s2 >> 6)) * 64) * 8192), (const attn_body::bf16*)(ws + WS_VI + (size_t)(bh * 64) * 16384), (attn_body::bf16*)CAT, (char*)lds + RING_OFF, ua); } }
            }
            if (BOTH(pb + 1)) GRID_BAR();
        }
        if (IN(pb + 2)) {
            pg8::Gemm g{YG, (const pg8::bf16_t*)(wl + W_GLU), M, 2048, 2048, A_IMG, 1}; pg8::StaticOrder S; S.init(M, 2048, F.G, (int)blockIdx.x);
            pg8::EpiGlu E{YG, CAT, F.in[I_BGLU] + l * 2048};
            for (int rep = 0; rep < REP_GEMM; ++rep) { pg8::gemm_phase<pg8::EpiGlu, pg8::StaticOrder, PG8_ALIGN, PG8_SP2>(F.lds + RING_OFF, g, S, E); __syncthreads(); }
            if (BOTH(pb + 2)) GRID_BAR();
        }
        if (IN(pb + 3)) {
            pg8::Gemm g{CAT, (const pg8::bf16_t*)(wl + W_OUT), M, DMODEL, DMODEL, A_IMG, 1}; pg8::StaticOrder S; S.init(M, DMODEL, F.G, (int)blockIdx.x);
            pg8::EpiRes E{HB, ssq + (2 * l + 1) * M};
            pg8::gemm_phase<pg8::EpiRes, pg8::StaticOrder, PG8_ALIGN, PG8_SP2>(F.lds + RING_OFF, g, S, E);
            if (BOTH(pb + 3)) GRID_BAR();
        }
        if (IN(pb + 4)) {
            pg8::Gemm g{HB, (const pg8::bf16_t*)(wl + W_UP), M, FF, DMODEL, A_IMG, 1}; pg8::StaticOrder S; S.init(M, FF, F.G, (int)blockIdx.x);
            pg8::EpiUp E{HID, FF, ssq + (2 * l + 1) * M};
#ifndef STG_UP
#define STG_UP 0
#endif
#ifndef STG_UP_WAYS
#define STG_UP_WAYS 2
#endif
            if (STG_UP) { const int k_ = F.vcu & (STG_UP_WAYS - 1); for (int s_ = 0; s_ < STG_UP * k_; ++s_) __builtin_amdgcn_s_sleep(48 * 2 / STG_UP_WAYS); }
            for (int rep = 0; rep < REP_GEMM; ++rep) { pg8::gemm_phase<pg8::EpiUp, pg8::StaticOrder, PG8_ALIGN, PG8_SP2>(F.lds + RING_OFF, g, S, E); __syncthreads(); }
            if (BOTH(pb + 4)) GRID_BAR();
        }
        if (IN(pb + 5)) {
            pg8::Gemm g{HID, (const pg8::bf16_t*)(wl + W_DN), M, DMODEL, FF, A_IMG, 1}; pg8::StaticOrder S; S.init(M, DMODEL, F.G, (int)blockIdx.x);
            pg8::EpiRes E{HB, ssq + (2 * l + 2) * M};
            pg8::gemm_phase<pg8::EpiRes, pg8::StaticOrder, PG8_ALIGN, PG8_SP2>(F.lds + RING_OFF, g, S, E);
            if (BOTH(pb + 5)) GRID_BAR();
        }
    }
    if (IN(N_PHASES - 1)) {
        const int gw = F.vcu * NWAVES + F.wave, NGW = F.G * NWAVES; const float* gf = F.in[I_NFIN]; const pg8::ssq_t* sq = ssq + 8 * M;
        f32x4 gq[8][2];
#pragma unroll
        for (int j = 0; j < 8; ++j) { const int c = 8 * (F.lane + 64 * j); gq[j][0] = *(const f32x4*)(gf + c); gq[j][1] = *(const f32x4*)(gf + c + 4); }
        v4u hw[8]; pg8::ssq_t qc = 0;
        if (gw < M) { qc = sq[gw];
#pragma unroll
            for (int j = 0; j < 8; ++j) hw[j] = *(const GAS v4u*)((const GAS unsigned char*)HB + PG8_AOFF(gw, 8 * (F.lane + 64 * j), DMODEL)); }
        for (int m = gw; m < M; m += NGW) { const int mn = m + NGW; v4u hn[8]; pg8::ssq_t qn = 0;
            if (mn < M) { qn = sq[mn];
#pragma unroll
                for (int j = 0; j < 8; ++j) hn[j] = *(const GAS v4u*)((const GAS unsigned char*)HB + PG8_AOFF(mn, 8 * (F.lane + 64 * j), DMODEL)); }
            const float rs = pg8::rstd_of(qc);
#pragma unroll
            for (int j = 0; j < 8; ++j) { const int c = 8 * (F.lane + 64 * j); const v4u w = hw[j];
                const f32x4 h0 = {pg8::bf_lo(w.x), pg8::bf_hi(w.x), pg8::bf_lo(w.y), pg8::bf_hi(w.y)}, h1 = {pg8::bf_lo(w.z), pg8::bf_hi(w.z), pg8::bf_lo(w.w), pg8::bf_hi(w.w)};
                GAS f32x4* o = (GAS f32x4*)(F.out + (size_t)m * DMODEL + c); o[0] = h0 * rs * gq[j][0]; o[1] = h1 * rs * gq[j][1]; }
#pragma unroll
            for (int j = 0; j < 8; ++j) hw[j] = hn[j];
            qc = qn; }
    }
#undef IN
#undef BOTH
}

extern "C" void kernel_launch(void* const* d_in, const int* in_sizes, int n_in, void* d_out, int out_size, void* d_ws, size_t ws_size, hipStream_t stream) {
    static int grid = 0;
    if (grid == 0) {
        if (n_in != N_IN || in_sizes[0] != M * DMODEL || out_size != M * DMODEL || ws_size < WS_END) { fprintf(stderr, "kernel_launch: built for %d inputs, x/out of %d floats, >= %zu bytes of workspace; got n_in %d, in0 %d, out %d, ws %zu; nothing launched\n", (int)N_IN, M * DMODEL, (size_t)WS_END, n_in, n_in > 0 ? in_sizes[0] : -1, out_size, ws_size); grid = -1; return; }
        int dev = 0, cus = 0, per_cu = 0;
        if (hipGetDevice(&dev) != hipSuccess || hipDeviceGetAttribute(&cus, hipDeviceAttributeMultiprocessorCount, dev) != hipSuccess) { fprintf(stderr, "kernel_launch: hipGetDevice / hipDeviceGetAttribute failed; nothing launched\n"); grid = -1; return; }
        if (hipFuncSetAttribute((const void*)hymba_fwd, hipFuncAttributeMaxDynamicSharedMemorySize, LDS_BYTES) != hipSuccess) { fprintf(stderr, "kernel_launch: hipFuncSetAttribute failed\n"); grid = -1; return; }
        if (hipOccupancyMaxActiveBlocksPerMultiprocessor(&per_cu, (const void*)hymba_fwd, NWAVES * 64, LDS_BYTES) != hipSuccess || per_cu < 1)
            fprintf(stderr, "kernel_launch: note: the occupancy query reports %d workgroups per CU\n", per_cu);
        (void)hipGetLastError();
        grid = cus;
    }
    if (grid < 0) return;
    if (hipMemsetAsync((char*)d_ws + WS_CTL, 0, CTL_ZERO_BYTES, stream) != hipSuccess) { fprintf(stderr, "kernel_launch: hipMemsetAsync failed\n"); return; }
    Args a{};
    for (int i = 0; i < N_IN; ++i) a.in[i] = (const float*)d_in[i];
    a.out = (float*)d_out; a.ws = (unsigned char*)d_ws;
#if MK_PER_PHASE
    for (int ph = 0; ph < N_PHASES; ++ph) { a.ph_lo = ph; a.ph_hi = ph + 1; hipLaunchKernelGGL(hymba_fwd, dim3(grid), dim3(NWAVES * 64), LDS_BYTES, stream, a); }
#else
    a.ph_lo = 0; a.ph_hi = N_PHASES; hipLaunchKernelGGL(hymba_fwd, dim3(grid), dim3(NWAVES * 64), LDS_BYTES, stream, a);
#endif
    const hipError_t le = hipPeekAtLastError();
    if (le != hipSuccess) fprintf(stderr, "kernel_launch: launch failed: %s\n", hipGetErrorName(le));
}
```

```cpp
#define MK_PER_PHASE 0
#define A_IMG 1
#define STG_UP 2
#define PROBE_ATT_2BAR 1
#include <hip/hip_runtime.h>
#include <cstdio>
#include <cstdint>
#ifndef A_IMG
#define A_IMG 0
#endif
namespace pg8 {
#define PG8_LAS __attribute__((address_space(3)))
typedef unsigned short bf16_t;
typedef short bf16x8 __attribute__((ext_vector_type(8)));
typedef float f32x4 __attribute__((ext_vector_type(4)));
typedef unsigned u32x4 __attribute__((ext_vector_type(4)));
constexpr int BM = 256, BK = 64, HALF = 128, HTB = HALF * BK * 2  , STAGE_BYTES = 8 * HTB, NXCD = 8, WGM = 8;

__host__ __device__ __forceinline__ int lds_byte(int r, int c) { const int st = (r >> 4) * 2 + (c >> 5), rr = r & 15, cc = c & 31, ob = rr * 64 + cc * 2; return st * 1024 + (ob ^ (((ob >> 9) & 1) << 5)); }
__host__ __device__ __forceinline__ void stage_rc(int b, int& R, int& C) { const int st = b / 1024, sb = b % 1024, swz = sb ^ (((sb >> 9) & 1) << 5); R = (st >> 1) * 16 + swz / 64; C = (st & 1) * 32 + (swz % 64) / 2; }
__host__ __device__ __forceinline__ int perm32(int rho) { const int n = rho >> 4, i = rho & 15; return 8 * (i >> 2) + 4 * n + (i & 3); }

struct Unit { int pm, pn; };
struct Gemm { const bf16_t* A; const bf16_t* Bt; int M, N, K; int a_img, b_img; };
#define PG8_AOFF(row, col, K) (A_IMG ? pg8::img_off((int)(row), (int)(col), (K), false) : ((size_t)(row) * (size_t)(K) + (size_t)(col)) * 2)
__host__ __device__ __forceinline__ int perm32_inv(int x) { return 16 * ((x >> 2) & 1) + 4 * (x >> 3) + (x & 3); }
__host__ __device__ __forceinline__ size_t img_off(int row, int col, int K, bool permB) {
    const int r = row & 127, R = permB ? ((r & ~31) + perm32_inv(r & 31)) : r;
    return ((size_t)((row >> 8) * (K >> 6) + (col >> 6)) * 2 + ((row >> 7) & 1)) * (size_t)HTB + (size_t)lds_byte(R, col & 63); }

struct StaticOrder {
    int nM, nN, nwg, G, c;
    __host__ __device__ void init(int M, int N, int G_, int c_) { nM = M / BM; nN = N / BM; nwg = nM * nN; G = G_; c = c_; }
    __host__ __device__ bool next(int i, Unit& u) const {
        const long L = (long)i * G + c; if (L >= nwg) return false;
        int wgid = (int)L; { const int q = nwg / NXCD, r = nwg % NXCD, xcd = wgid % NXCD, off = wgid / NXCD; wgid = (xcd < r ? xcd * (q + 1) : r * (q + 1) + (xcd - r) * q) + off; }
        const int nig = WGM * nN, gid = wgid / nig, fm = gid * WGM, gsz = (nM - fm) < WGM ? (nM - fm) : WGM;
        u.pm = fm + ((wgid % nig) % gsz); u.pn = (wgid % nig) / gsz; return true;
    }
    __device__ __forceinline__ void a_ready(const Unit&) const {}
    __device__ __forceinline__ void done(const Unit&) const {}
};

__device__ __forceinline__ unsigned cvt_pk_bf16(float lo, float hi) { unsigned r; asm volatile("v_cvt_pk_bf16_f32 %0, %1, %2" : "=v"(r) : "v"(lo), "v"(hi)); return r; }
typedef float f32x2 __attribute__((ext_vector_type(2)));
__device__ __forceinline__ f32x2 gelu_pk(f32x2 v) {
    const f32x2 av = __builtin_elementwise_abs(v), d = av * 0.2316418882f + 1.0f;
    f32x2 t; t.x = __builtin_amdgcn_rcpf(d.x); t.y = __builtin_amdgcn_rcpf(d.y);
    f32x2 q = t * 0.5307027145f + (-0.7265760135f); q = q * t + 0.7107068705f; q = q * t + (-0.142248368f); q = q * t + 0.127414796f; q = q * t;
    const f32x2 s = (v * v) * (-0.72134752044f);
    f32x2 e; e.x = __builtin_amdgcn_exp2f(s.x); e.y = __builtin_amdgcn_exp2f(s.y);
    const f32x2 m = v * (q * e), r = v - m;
    f32x2 o; o.x = v.x < 0.f ? m.x : r.x; o.y = v.y < 0.f ? m.y : r.y; return o;
}

template <int ACT  > struct EpiBf16 {
    static constexpr bool PERM = true, AFTER_DRAIN = false; static_assert(ACT == 0 || ACT == 1, "EpiBf16: ACT is 0 (none) or 1 (gelu_pk)");
    bf16_t* O; int ldc; const float* bias; int split_cols; size_t split_stride; float scale0;
    __device__ __forceinline__ void operator()(const f32x4 (&acc)[2][2][4][2], const Unit& u, int wr, int wc, int fr, int fq) const {
        const int row0 = u.pm * BM + wr * 64 + fr; int colt = u.pn * BM; bf16_t* base = O;
        float sc = 1.f; if (split_cols) { const int t = colt / split_cols; base += (size_t)t * split_stride; colt -= t * split_cols; if (t == 0) sc = scale0; }
        const int col0 = colt + wc * 32 + 8 * fq, bcol0 = u.pn * BM + wc * 32 + 8 * fq;
        f32x4 bv[2][2];
#pragma unroll
        for (int bj = 0; bj < 2; ++bj)
#pragma unroll
            for (int n = 0; n < 2; ++n) bv[bj][n] = bias ? *(const f32x4*)(bias + bcol0 + bj * HALF + 4 * n) : (f32x4){0.f, 0.f, 0.f, 0.f};
#pragma unroll
        for (int ai = 0; ai < 2; ++ai)
#pragma unroll
            for (int m = 0; m < 4; ++m) { bf16_t* rowp = base + (size_t)(row0 + ai * HALF + m * 16) * ldc + col0;
#pragma unroll
                for (int bj = 0; bj < 2; ++bj) { f32x4 v0 = acc[ai][bj][m][0] + bv[bj][0], v1 = acc[ai][bj][m][1] + bv[bj][1];
                    if (ACT == 1) { f32x2 a = gelu_pk((f32x2){v0[0], v0[1]}), b = gelu_pk((f32x2){v0[2], v0[3]}), c = gelu_pk((f32x2){v1[0], v1[1]}), d = gelu_pk((f32x2){v1[2], v1[3]});
                        v0 = (f32x4){a.x, a.y, b.x, b.y}; v1 = (f32x4){c.x, c.y, d.x, d.y}; }
                    v0 = v0 * sc; v1 = v1 * sc; u32x4 w; w.x = cvt_pk_bf16(v0[0], v0[1]); w.y = cvt_pk_bf16(v0[2], v0[3]); w.z = cvt_pk_bf16(v1[0], v1[1]); w.w = cvt_pk_bf16(v1[2], v1[3]);
                    *(u32x4*)(rowp + bj * HALF) = w; } }
    }
};

__device__ __forceinline__ u32x4 pack8(f32x4 v0, f32x4 v1) { u32x4 w; w.x = cvt_pk_bf16(v0[0], v0[1]); w.y = cvt_pk_bf16(v0[2], v0[3]); w.z = cvt_pk_bf16(v1[0], v1[1]); w.w = cvt_pk_bf16(v1[2], v1[3]); return w; }
__device__ __forceinline__ float bf_lo(unsigned w) { return __uint_as_float(w << 16); }
__device__ __forceinline__ float bf_hi(unsigned w) { return __uint_as_float(w & 0xffff0000u); }
constexpr float RMS_EPS = 1e-6f;
typedef unsigned long long ssq_t;
constexpr float SSQ_SCALE = 16777216.0f, SSQ_INV = 1.0f / (16777216.0f * 4096.0f);
__device__ __forceinline__ float rstd_of(ssq_t q) { const float x = fmaf((float)(unsigned)(q >> 32), 4294967296.0f, (float)(unsigned)q); return __builtin_amdgcn_rsqf(x * SSQ_INV + RMS_EPS); }
struct EpiProj {
    static constexpr bool PERM = true, AFTER_DRAIN = false, IDEMP = true;
    bf16_t* __restrict__ QKV; bf16_t* __restrict__ UT; const ssq_t* __restrict__ ssq; float c2; unsigned char* __restrict__ KI; unsigned char* __restrict__ VI;
    __device__ __forceinline__ void operator()(const f32x4 (&acc)[2][2][4][2], const Unit& u, int wr, int wc, int fr, int fq) const {
        const int row0 = u.pm * BM + wr * 64 + fr, colt = u.pn * BM;
        const float sc = (colt < 2048) ? c2 : 1.f;
        ssq_t q[2][4];
#pragma unroll
        for (int ai = 0; ai < 2; ++ai)
#pragma unroll
            for (int m = 0; m < 4; ++m) q[ai][m] = ssq[row0 + ai * HALF + m * 16];
#pragma unroll
        for (int ai = 0; ai < 2; ++ai)
#pragma unroll
            for (int m = 0; m < 4; ++m) { const int row = row0 + ai * HALF + m * 16;
                const float rs = sc * rstd_of(q[ai][m]);
#pragma unroll
                for (int bj = 0; bj < 2; ++bj) { const int col = colt + bj * HALF + wc * 32 + 8 * fq;
                    const u32x4 w = pack8(acc[ai][bj][m][0] * rs, acc[ai][bj][m][1] * rs);
                    if (colt < 2048) *(u32x4*)(QKV + (size_t)row * 6144 + col) = w;
                    else if (colt < 4096) { const int c = col - 2048, key = row & 4095;
                        *(u32x4*)(KI + ((size_t)(((row >> 12) * 16 + (c >> 7)) * 2 + ((c >> 6) & 1)) * 64 + (key >> 6)) * 8192 + ((c & 63) >> 3) * 1024 + (key & 63) * 16) = w; }
                    else if (colt < 6144) { const int c = col - 4096, key = row & 4095, cc = c & 127;
                        *(u32x4*)(VI + ((size_t)((row >> 12) * 16 + (c >> 7)) * 64 + (key >> 6)) * 16384 + ((cc >> 5) * 4 + ((key & 63) >> 4)) * 1024 + (key & 15) * 64 + ((cc & 31) >> 3) * 16) = w; }
                    else { const int cu = col - 6144; *(u32x4*)(UT + ((size_t)(cu >> 4) * 8192 + row) * 16 + (cu & 15)) = w; } } }
    }
};
struct EpiUp {
    static constexpr bool PERM = true, AFTER_DRAIN = false, IDEMP = true;
    bf16_t* __restrict__ O; int ldc; const ssq_t* __restrict__ ssq;
    __device__ __forceinline__ void operator()(const f32x4 (&acc)[2][2][4][2], const Unit& u, int wr, int wc, int fr, int fq) const {
        const int row0 = u.pm * BM + wr * 64 + fr, colt = u.pn * BM;
        ssq_t q[2][4];
#pragma unroll
        for (int ai = 0; ai < 2; ++ai)
#pragma unroll
            for (int m = 0; m < 4; ++m) q[ai][m] = ssq[row0 + ai * HALF + m * 16];
#pragma unroll
        for (int ai = 0; ai < 2; ++ai)
#pragma unroll
            for (int m = 0; m < 4; ++m) { const int row = row0 + ai * HALF + m * 16;
                const float rs = rstd_of(q[ai][m]);
#pragma unroll
                for (int bj = 0; bj < 2; ++bj) { const int col = colt + bj * HALF + wc * 32 + 8 * fq;
                    f32x4 v0 = acc[ai][bj][m][0] * rs, v1 = acc[ai][bj][m][1] * rs;
#pragma unroll
                    for (int e = 0; e < 4; ++e) { const float a = fmaxf(v0[e], 0.f), b = fmaxf(v1[e], 0.f); v0[e] = a * a; v1[e] = b * b; }
                    *(u32x4*)((char*)O + PG8_AOFF(row, col, ldc)) = pack8(v0, v1); } }
    }
};
struct EpiGlu {
    static constexpr bool PERM = true, AFTER_DRAIN = false, IDEMP = true;
    const bf16_t* __restrict__ YG; bf16_t* __restrict__ CAT; const float* __restrict__ bias;
    __device__ __forceinline__ void operator()(const f32x4 (&acc)[2][2][4][2], const Unit& u, int wr, int wc, int fr, int fq) const {
        const int row0 = u.pm * BM + wr * 64 + fr, colt = u.pn * BM;
        f32x4 bv[2][2];
#pragma unroll
        for (int bj = 0; bj < 2; ++bj)
#pragma unroll
            for (int n = 0; n < 2; ++n) bv[bj][n] = *(const f32x4*)(bias + colt + bj * HALF + wc * 32 + 8 * fq + 4 * n);
#pragma unroll
        for (int ai = 0; ai < 2; ++ai) {
            u32x4 yw[4][2];
#pragma unroll
            for (int m = 0; m < 4; ++m)
#pragma unroll
                for (int bj = 0; bj < 2; ++bj) yw[m][bj] = *(const u32x4*)((const char*)YG + PG8_AOFF(row0 + ai * HALF + m * 16, colt + bj * HALF + wc * 32 + 8 * fq, 2048));
#pragma unroll
            for (int m = 0; m < 4; ++m) { const int row = row0 + ai * HALF + m * 16;
#pragma unroll
                for (int bj = 0; bj < 2; ++bj) { const int col = colt + bj * HALF + wc * 32 + 8 * fq; const u32x4 y = yw[m][bj];
                    f32x4 v0 = acc[ai][bj][m][0] + bv[bj][0], v1 = acc[ai][bj][m][1] + bv[bj][1];
#pragma unroll
                    for (int e = 0; e < 4; ++e) { v0[e] = __builtin_amdgcn_rcpf(1.0f + __builtin_amdgcn_exp2f(-1.4426950408889634f * v0[e])); v1[e] = __builtin_amdgcn_rcpf(1.0f + __builtin_amdgcn_exp2f(-1.4426950408889634f * v1[e])); }
                    v0[0] *= bf_lo(y.x); v0[1] *= bf_hi(y.x); v0[2] *= bf_lo(y.y); v0[3] *= bf_hi(y.y);
                    v1[0] *= bf_lo(y.z); v1[1] *= bf_hi(y.z); v1[2] *= bf_lo(y.w); v1[3] *= bf_hi(y.w);
                    *(u32x4*)((char*)CAT + PG8_AOFF(row, 2048 + col, 4096)) = pack8(v0, v1); } }
            asm volatile("" ::: "memory"); }
    }
};
struct EpiRes {
    static constexpr bool PERM = true, AFTER_DRAIN = false, IDEMP = false;
    bf16_t* HB; ssq_t* __restrict__ ssq_out;
    __device__ __forceinline__ void operator()(const f32x4 (&acc)[2][2][4][2], const Unit& u, int wr, int wc, int fr, int fq) const {
        const int row0 = u.pm * BM + wr * 64 + fr, colt = u.pn * BM;
        u32x4 b[2][4][2];
#pragma unroll
        for (int ai = 0; ai < 2; ++ai)
#pragma unroll
            for (int m = 0; m < 4; ++m)
#pragma unroll
                for (int bj = 0; bj < 2; ++bj) b[ai][m][bj] = *(const u32x4*)((const char*)HB + PG8_AOFF(row0 + ai * HALF + m * 16, colt + bj * HALF + wc * 32 + 8 * fq, 4096));
#pragma unroll
        for (int ai = 0; ai < 2; ++ai) { float sm[4];
#pragma unroll
            for (int m = 0; m < 4; ++m) { const int row = row0 + ai * HALF + m * 16; float ss = 0.f;
#pragma unroll
                for (int bj = 0; bj < 2; ++bj) { const u32x4 w = b[ai][m][bj];
                    const f32x4 h0 = (f32x4){bf_lo(w.x), bf_hi(w.x), bf_lo(w.y), bf_hi(w.y)} + acc[ai][bj][m][0], h1 = (f32x4){bf_lo(w.z), bf_hi(w.z), bf_lo(w.w), bf_hi(w.w)} + acc[ai][bj][m][1];
                    *(u32x4*)((char*)HB + PG8_AOFF(row, colt + bj * HALF + wc * 32 + 8 * fq, 4096)) = pack8(h0, h1);
                    ss += (h0[0] * h0[0] + h0[1] * h0[1]) + (h0[2] * h0[2] + h0[3] * h0[3]) + (h1[0] * h1[0] + h1[1] * h1[1]) + (h1[2] * h1[2] + h1[3] * h1[3]); }
                ss += __shfl_xor(ss, 16); ss += __shfl_xor(ss, 32); sm[m] = ss; }
            const float mine = fq == 0 ? sm[0] : fq == 1 ? sm[1] : fq == 2 ? sm[2] : sm[3];
            __hip_atomic_fetch_add(ssq_out + row0 + ai * HALF + fq * 16, (ssq_t)(mine * SSQ_SCALE), __ATOMIC_RELAXED, __HIP_MEMORY_SCOPE_AGENT);
            asm volatile("" ::: "memory"); }
    }
};

template <class Epi, class Sched, bool ALIGN_EPI = false, bool SP2 = false>
__device__ __forceinline__ void gemm_phase(PG8_LAS unsigned char* lds, const Gemm g, const Sched& S, const Epi& E) {
    int tid_ = threadIdx.x; asm volatile("" : "+v"(tid_));
    const int tid = tid_, wid = __builtin_amdgcn_readfirstlane(tid >> 6), lane = tid & 63, wr = wid >> 2, wc = wid & 3, fr = lane & 15, fq = lane >> 4;
    const int K = g.K, nt = K / BK;
    unsigned voffA[2], voffB[2];
#pragma unroll
    for (int i = 0; i < 2; ++i) { int R, C; stage_rc(tid * 16 + i * 8192, R, C); const int Rb = Epi::PERM ? ((R & ~31) + perm32(R & 31)) : R;
        voffA[i] = g.a_img ? (unsigned)(tid * 16 + i * 8192) : (unsigned)(R * K + C) * 2u; voffB[i] = g.b_img ? (unsigned)(tid * 16 + i * 8192) : (unsigned)(Rb * K + C) * 2u; }
    const size_t kstA = g.a_img ? (size_t)2 * HTB : (size_t)(BK * 2), hstA = g.a_img ? (size_t)HTB : (size_t)HALF * K * 2, tstA = g.a_img ? (size_t)nt * 2 * HTB : (size_t)2 * HALF * K * 2;
    const size_t kstB = g.b_img ? (size_t)2 * HTB : (size_t)(BK * 2), hstB = g.b_img ? (size_t)HTB : (size_t)HALF * K * 2, tstB = g.b_img ? (size_t)nt * 2 * HTB : (size_t)2 * HALF * K * 2;
    const unsigned ldsw = (unsigned)wid * 1024u;
    const int aoff = lds_byte(wr * 64 + fr, fq * 8), boff = lds_byte(wc * 32 + fr, fq * 8);
#define PG8_SA(b, h) (((b) * 2 + (h)) * HTB)
#define PG8_SB(b, h) ((4 + (b) * 2 + (h)) * HTB)
#define PG8_STAGE(bufoff, rs, goff, voff) do { _Pragma("unroll") for (int _i = 0; _i < 2; ++_i) \
        __builtin_amdgcn_raw_ptr_buffer_load_lds(rs, (PG8_LAS unsigned*)(lds + (bufoff) + ldsw + _i * 8192), 16, (voff)[_i], (goff), 0, 0); } while (0)
#define PG8_LDA(dst, b, h) do { _Pragma("unroll") for (int m = 0; m < 4; ++m) _Pragma("unroll") for (int k = 0; k < 2; ++k) dst[m][k] = *(const PG8_LAS bf16x8*)(lds + PG8_SA(b, h) + aoff + m * 2048 + k * 1024); } while (0)
#define PG8_LDB(dst, b, h) do { _Pragma("unroll") for (int n = 0; n < 2; ++n) _Pragma("unroll") for (int k = 0; k < 2; ++k) dst[n][k] = *(const PG8_LAS bf16x8*)(lds + PG8_SB(b, h) + boff + n * 2048 + k * 1024); } while (0)
#define PG8_MMA(ai, bj, At, Bt) do { __builtin_amdgcn_s_setprio(1); _Pragma("unroll") for (int m = 0; m < 4; ++m) _Pragma("unroll") for (int n = 0; n < 2; ++n) _Pragma("unroll") for (int k = 0; k < 2; ++k) \
        acc[ai][bj][m][n] = __builtin_amdgcn_mfma_f32_16x16x32_bf16(Bt[n][k], At[m][k], acc[ai][bj][m][n], 0, 0, 0); __builtin_amdgcn_s_setprio(0); } while (0)
#define PG8_WAIT_V(n) asm volatile("s_waitcnt vmcnt(" #n ")" ::: "memory")
#define PG8_WAIT_V_SEL(flag, nrelax, nstd) asm volatile("s_cmp_lg_u32 %0, 0\n\ts_cbranch_scc1 .Lpg8r%=\n\ts_waitcnt vmcnt(" #nstd ")\n\ts_branch .Lpg8d%=\n.Lpg8r%=:\n\ts_waitcnt vmcnt(" #nrelax ")\n.Lpg8d%=:" :: "s"(flag) : "memory", "scc")
#define PG8_WAIT_L(n) asm volatile("s_waitcnt lgkmcnt(" #n ")" ::: "memory")
#define PG8_BAR __builtin_amdgcn_s_barrier()
#define PG8_SCHED __builtin_amdgcn_sched_barrier(0)
    Unit cur, nxt; int ui = 0;
    if (!S.next(0, cur)) return;
    f32x4 acc[2][2][4][2];
#pragma unroll
    for (int a = 0; a < 2; ++a)
#pragma unroll
        for (int b = 0; b < 2; ++b)
#pragma unroll
            for (int m = 0; m < 4; ++m)
#pragma unroll
                for (int n = 0; n < 2; ++n) acc[a][b][m][n] = (f32x4){0.f, 0.f, 0.f, 0.f};
    bf16x8 At[4][2], B0[2][2], B1[2][2];
    const __amdgpu_buffer_rsrc_t rsA = __builtin_amdgcn_make_buffer_rsrc((void*)g.A, 0, (unsigned)((size_t)g.M * K * 2), 0x00020000), rsB = __builtin_amdgcn_make_buffer_rsrc((void*)g.Bt, 0, (unsigned)((size_t)g.N * K * 2), 0x00020000);
    unsigned cA = (unsigned)((size_t)cur.pm * tstA), cB = (unsigned)((size_t)cur.pn * tstB);
    S.a_ready(cur);
    if constexpr (SP2) {
        PG8_STAGE(PG8_SB(0, 0), rsB, cB, voffB); PG8_STAGE(PG8_SB(0, 1), rsB, cB + (unsigned)hstB, voffB); PG8_STAGE(PG8_SA(0, 0), rsA, cA, voffA); PG8_STAGE(PG8_SA(0, 1), rsA, cA + (unsigned)hstA, voffA);
        if (wr == 1) PG8_BAR;
        PG8_WAIT_V(2); PG8_BAR;
        PG8_STAGE(PG8_SB(1, 0), rsB, cB + (unsigned)kstB, voffB); PG8_STAGE(PG8_SA(1, 0), rsA, cA + (unsigned)kstA, voffA); PG8_STAGE(PG8_SB(1, 1), rsB, cB + (unsigned)(hstB + kstB), voffB);
        PG8_WAIT_V(6); PG8_BAR;
    } else {
        PG8_STAGE(PG8_SB(0, 0), rsB, cB, voffB); PG8_STAGE(PG8_SA(0, 0), rsA, cA, voffA); PG8_STAGE(PG8_SB(0, 1), rsB, cB + (unsigned)hstB, voffB); PG8_STAGE(PG8_SA(0, 1), rsA, cA + (unsigned)hstA, voffA);
        if (wr == 1) PG8_BAR;
        PG8_WAIT_V(4); PG8_BAR;
        PG8_STAGE(PG8_SB(1, 0), rsB, cB + (unsigned)kstB, voffB); PG8_STAGE(PG8_SA(1, 0), rsA, cA + (unsigned)kstA, voffA); PG8_STAGE(PG8_SB(1, 1), rsB, cB + (unsigned)(hstB + kstB), voffB);
        PG8_WAIT_V(6); PG8_BAR;
    }
    for (;;) {
        const bool has_next = S.next(ui + 1, nxt);
        const unsigned nA = has_next ? (unsigned)((size_t)nxt.pm * tstA) : cA, nB = has_next ? (unsigned)((size_t)nxt.pn * tstB) : cB;
        for (int t = 0; t < nt; t += 2) {
            const bool last = (t == nt - 2);
            const unsigned a1 = cA + (unsigned)((size_t)(t + 1) * kstA);
            const unsigned a2 = last ? nA : cA + (unsigned)((size_t)(t + 2) * kstA), b2 = last ? nB : cB + (unsigned)((size_t)(t + 2) * kstB);
            const unsigned a3 = a2 + (unsigned)kstA, b3 = b2 + (unsigned)kstB;
            if (last && has_next) S.a_ready(nxt);
            if constexpr (SP2) {
            PG8_LDB(B0, 0, 0); PG8_LDB(B1, 0, 1); PG8_SCHED; PG8_LDA(At, 0, 0); PG8_STAGE(PG8_SA(1, 1), rsA, a1 + (unsigned)hstA, voffA);
            PG8_WAIT_V(8); PG8_WAIT_L(0); PG8_BAR; PG8_MMA(0, 0, At, B0); PG8_MMA(0, 1, At, B1); PG8_BAR; PG8_SCHED;
            PG8_LDA(At, 0, 1); PG8_STAGE(PG8_SB(0, 0), rsB, b2, voffB); PG8_STAGE(PG8_SB(0, 1), rsB, b2 + (unsigned)hstB, voffB); PG8_STAGE(PG8_SA(0, 0), rsA, a2, voffA);
            PG8_WAIT_V(8); PG8_WAIT_L(0); PG8_BAR; PG8_MMA(1, 0, At, B0); PG8_MMA(1, 1, At, B1); PG8_BAR; PG8_SCHED;
            PG8_LDB(B0, 1, 0); PG8_LDB(B1, 1, 1); PG8_SCHED; PG8_LDA(At, 1, 0); PG8_STAGE(PG8_SA(0, 1), rsA, a2 + (unsigned)hstA, voffA);
            PG8_WAIT_V(8); PG8_WAIT_L(0); PG8_BAR; PG8_MMA(0, 0, At, B0); PG8_MMA(0, 1, At, B1); PG8_BAR; PG8_SCHED;
            PG8_LDA(At, 1, 1); PG8_STAGE(PG8_SB(1, 0), rsB, b3, voffB); PG8_STAGE(PG8_SB(1, 1), rsB, b3 + (unsigned)hstB, voffB); PG8_STAGE(PG8_SA(1, 0), rsA, a3, voffA);
            PG8_WAIT_V(8); PG8_WAIT_L(0); PG8_BAR; PG8_MMA(1, 0, At, B0); PG8_MMA(1, 1, At, B1); PG8_BAR; PG8_SCHED;
            } else {
            PG8_LDB(B0, 0, 0); PG8_SCHED; PG8_LDA(At, 0, 0); PG8_STAGE(PG8_SA(1, 1), rsA, a1 + (unsigned)hstA, voffA);
            PG8_WAIT_L(8); PG8_BAR; PG8_WAIT_L(0); PG8_MMA(0, 0, At, B0); PG8_BAR; PG8_SCHED;
            PG8_LDB(B1, 0, 1); PG8_STAGE(PG8_SB(0, 0), rsB, b2, voffB);
            PG8_BAR; PG8_WAIT_L(0); PG8_MMA(0, 1, At, B1); PG8_BAR;
            PG8_LDA(At, 0, 1); PG8_STAGE(PG8_SA(0, 0), rsA, a2, voffA);
            PG8_BAR; PG8_WAIT_L(0); PG8_MMA(1, 0, At, B0); PG8_BAR; PG8_SCHED;
            PG8_STAGE(PG8_SB(0, 1), rsB, b2 + (unsigned)hstB, voffB);
            PG8_WAIT_V(6); PG8_BAR; PG8_MMA(1, 1, At, B1); PG8_BAR;
            PG8_LDB(B0, 1, 0); PG8_SCHED; PG8_LDA(At, 1, 0); PG8_STAGE(PG8_SA(0, 1), rsA, a2 + (unsigned)hstA, voffA);
            PG8_WAIT_L(8); PG8_BAR; PG8_WAIT_L(0); PG8_MMA(0, 0, At, B0); PG8_BAR; PG8_SCHED;
            PG8_LDB(B1, 1, 1); PG8_STAGE(PG8_SB(1, 0), rsB, b3, voffB);
            PG8_BAR; PG8_WAIT_L(0); PG8_MMA(0, 1, At, B1); PG8_BAR;
            PG8_LDA(At, 1, 1); PG8_STAGE(PG8_SA(1, 0), rsA, a3, voffA);
            PG8_BAR; PG8_WAIT_L(0); PG8_MMA(1, 0, At, B0); PG8_BAR; PG8_SCHED;
            PG8_STAGE(PG8_SB(1, 1), rsB, b3 + (unsigned)hstB, voffB);
            PG8_WAIT_V(6); PG8_BAR; PG8_MMA(1, 1, At, B1); PG8_BAR;
            }
        }
        if constexpr (ALIGN_EPI) { if (wr == 0) PG8_BAR; }
        if constexpr (!Epi::AFTER_DRAIN) { E(acc, cur, wr, wc, fr, fq);
#ifdef PROBE_EPI2
            if constexpr (Epi::IDEMP) { asm volatile("" ::: "memory"); E(acc, cur, wr, wc, fr, fq); }
#endif
            S.done(cur); }
        if (!has_next) break;
#pragma unroll
        for (int a = 0; a < 2; ++a)
#pragma unroll
            for (int b = 0; b < 2; ++b)
#pragma unroll
                for (int m = 0; m < 4; ++m)
#pragma unroll
                    for (int n = 0; n < 2; ++n) acc[a][b][m][n] = (f32x4){0.f, 0.f, 0.f, 0.f};
        cur = nxt; cA = nA; cB = nB; ++ui;
        if constexpr (ALIGN_EPI) { if (wr == 1) PG8_BAR; }
    }
    PG8_WAIT_V(0);
    if constexpr (!ALIGN_EPI) { if (wr == 0) PG8_BAR; }
    PG8_BAR;
    if constexpr (Epi::AFTER_DRAIN) { E.fused(acc, cur, wr, wc, fr, fq, lds, wid, lane); S.done(cur); }
#undef PG8_SA
#undef PG8_SB
#undef PG8_STAGE
#undef PG8_LDA
#undef PG8_LDB
#undef PG8_MMA
#undef PG8_WAIT_V
#undef PG8_WAIT_V_SEL
#undef PG8_WAIT_L
#undef PG8_BAR
#undef PG8_SCHED
}
}

#ifndef PG8_SP2
#define PG8_SP2 true
#endif
#ifndef PG8_ALIGN
#define PG8_ALIGN true
#endif
#include <hip/hip_bf16.h>
#include <cmath>
namespace attn_body {
using bf16=__hip_bfloat16;
using bf16x8=__attribute__((ext_vector_type(8)))short;
using s16x4=__attribute__((ext_vector_type(4)))short;
using f32x16=__attribute__((ext_vector_type(16)))float;
using u32x4=__attribute__((ext_vector_type(4)))unsigned;
constexpr int BATCH=2,NHEAD=16,SEQ=4096,D=64,DM=6144;
constexpr int OPITCH=4096;
constexpr int NW=8,QBLK=32,QB=QBLK*4,KVBLK=64,NQB=SEQ/QB;
constexpr int ATTN_PITCH=DM, ATTN_UNIT_ROWS=QB;
__device__ __forceinline__ int crow(int r,int hi){return (r&3)+8*(r>>2)+4*hi;}
#define SBAR() __builtin_amdgcn_sched_barrier(0)
__device__ __forceinline__ void cmask(f32x16&p0,f32x16&p1,int jb,int qrel,int hi){
  const float NEG=-INFINITY; int kb=64*jb+4*hi;
  #pragma unroll
  for(int r=0;r<16;++r){int kv=kb+(r&3)+8*(r>>2); if(kv>qrel)p0[r]=NEG; if(kv+32>qrel)p1[r]=NEG;}
}

__device__ __forceinline__ int t5_bucket(int n){ if(n<16)return n; const int st[15]={19,21,24,27,31,35,40,46,52,59,67,77,87,99,113}; int b=16;
  #pragma unroll
  for(int i=0;i<15;++i)b+=(n>=st[i])?1:0; return b; }
typedef const __attribute__((address_space(3))) float* lds_cfptr;
__device__ __forceinline__ void bmask(f32x16&p0,f32x16&p1,int jb,int qrel,int hi,lds_cfptr lut){
  const float NEG=-INFINITY; const int base=qrel-64*jb-4*hi;
  #pragma unroll
  for(int r=0;r<16;++r){const int n0=base-((r&3)+8*(r>>2)),n1=n0-32;
    const float b0=lut[n0<0?0:(n0>128?128:n0)],b1=lut[n1<0?0:(n1>128?128:n1)];
    p0[r]=(n0<0)?NEG:p0[r]+b0; p1[r]=(n1<0)?NEG:p1[r]+b1;}
}
constexpr int NSLOT=3, SLOTB=8192;
constexpr int VSLOTB=16384, NVSLOT=4;
constexpr int LDS_K=0, LDS_V=NSLOT*SLOTB, LDS_WS=NSLOT*SLOTB+NVSLOT*VSLOTB, LDS_OST=LDS_WS+NW*64*4, LDS_LUT=LDS_OST+NW*4096, LDS_BYTES=LDS_LUT+1024;
constexpr float C2=0.125f*1.4426950408889634f;
__device__ __forceinline__ void glds16(const void*gsrc,unsigned lds_dst){unsigned keep;
  asm volatile("s_mov_b32 %0, m0\n\ts_mov_b32 m0, %2\n\ts_nop 0\n\tglobal_load_lds_dwordx4 %1, off\n\ts_mov_b32 m0, %0":"=&s"(keep):"v"(gsrc),"s"(lds_dst):"memory");}
__device__ __forceinline__ float max3f(float a,float b,float c){float r;asm("v_max3_f32 %0, %1, %2, %3":"=v"(r):"v"(a),"v"(b),"v"(c));return r;}
__device__ __forceinline__ float max2f(float a,float b){float r;asm("v_max_f32_e32 %0, %1, %2":"=v"(r):"v"(a),"v"(b));return r;}
__device__ __forceinline__ float fadd_s(float a,float b){float r;asm("v_add_f32_e32 %0, %1, %2":"=v"(r):"v"(a),"v"(b));return r;}
__device__ __forceinline__ float fsub_s(float a,float b){float r;asm("v_sub_f32_e32 %0, %1, %2":"=v"(r):"v"(a),"v"(b));return r;}
typedef float f32x2_t __attribute__((ext_vector_type(2))); typedef __bf16 bf16x2_t __attribute__((ext_vector_type(2)));
__device__ __forceinline__ unsigned cvtpk_s(float lo,float hi){f32x2_t v={lo,hi};bf16x2_t b=__builtin_convertvector(v,bf16x2_t);return __builtin_bit_cast(unsigned,b);}
#ifdef PROBE_ATT_2BAR
#define WAIT_BAR(N) asm volatile("s_waitcnt vmcnt(" #N ") lgkmcnt(0)\n\ts_barrier\n\ts_barrier":::"memory")
#else
#define WAIT_BAR(N) asm volatile("s_waitcnt vmcnt(" #N ") lgkmcnt(0)\n\ts_barrier":::"memory")
#endif

__device__ __forceinline__ void qkt(f32x16&p0,f32x16&p1,const char*Kslot,const bf16x8*qr,const f32x16&negm,int r32,int hi){
  const char*kb=Kslot+hi*1024+r32*16;
  #pragma unroll
  for(int d0=0;d0<4;++d0){
    const bf16x8 b0=*reinterpret_cast<const bf16x8*>(kb+d0*2048);
    const bf16x8 b1=*reinterpret_cast<const bf16x8*>(kb+d0*2048+512);
    if(d0==0){p0=__builtin_amdgcn_mfma_f32_32x32x16_bf16(b0,qr[0],negm,0,0,0);p1=__builtin_amdgcn_mfma_f32_32x32x16_bf16(b1,qr[0],negm,0,0,0);}
    else{p0=__builtin_amdgcn_mfma_f32_32x32x16_bf16(b0,qr[d0],p0,0,0,0);p1=__builtin_amdgcn_mfma_f32_32x32x16_bf16(b1,qr[d0],p1,0,0,0);}}
}
typedef __attribute__((address_space(3))) const char* lds_cptr;
typedef short v4i16_t __attribute__((ext_vector_type(4)));
__device__ __forceinline__ void kload8(bf16x8*kf,lds_cptr kp){
  kf[0]=*(const __attribute__((address_space(3))) bf16x8*)(kp);      kf[1]=*(const __attribute__((address_space(3))) bf16x8*)(kp+512);
  kf[2]=*(const __attribute__((address_space(3))) bf16x8*)(kp+2048); kf[3]=*(const __attribute__((address_space(3))) bf16x8*)(kp+2560);
  kf[4]=*(const __attribute__((address_space(3))) bf16x8*)(kp+4096); kf[5]=*(const __attribute__((address_space(3))) bf16x8*)(kp+4608);
  kf[6]=*(const __attribute__((address_space(3))) bf16x8*)(kp+6144); kf[7]=*(const __attribute__((address_space(3))) bf16x8*)(kp+6656);
}
__device__ __forceinline__ void kload2(bf16x8*kf,lds_cptr kp,int j){ kf[2*j]=*(const __attribute__((address_space(3))) bf16x8*)(kp+j*2048); kf[2*j+1]=*(const __attribute__((address_space(3))) bf16x8*)(kp+j*2048+512); }
__device__ __forceinline__ s16x4 vtr(lds_cptr p){ return __builtin_bit_cast(s16x4,__builtin_amdgcn_ds_read_tr16_b64_v4i16((__attribute__((address_space(3))) v4i16_t*)p)); }
__device__ __forceinline__ void qkt1(f32x16&p0,const char*kb,const bf16x8*qr,const f32x16&negm){
  #pragma unroll
  for(int d0=0;d0<4;++d0){ const bf16x8 b0=*reinterpret_cast<const bf16x8*>(kb+d0*2048);
    if(d0==0)p0=__builtin_amdgcn_mfma_f32_32x32x16_bf16(b0,qr[0],negm,0,0,0); else p0=__builtin_amdgcn_mfma_f32_32x32x16_bf16(b0,qr[d0],p0,0,0,0);}
}
__device__ __forceinline__ void kload4(bf16x8*kf,lds_cptr kp){
  kf[0]=*(const __attribute__((address_space(3))) bf16x8*)(kp);      kf[1]=*(const __attribute__((address_space(3))) bf16x8*)(kp+2048);
  kf[2]=*(const __attribute__((address_space(3))) bf16x8*)(kp+4096); kf[3]=*(const __attribute__((address_space(3))) bf16x8*)(kp+6144);
}
__device__ __forceinline__ void kload1(bf16x8*kf,lds_cptr kp,int j){ kf[j]=*(const __attribute__((address_space(3))) bf16x8*)(kp+j*2048); }
__device__ __forceinline__ float rowmax1(const f32x16&p0){
  float a=max3f(p0[0],p0[1],p0[2]),b=max3f(p0[3],p0[4],p0[5]);
  a=max3f(a,p0[6],p0[7]);b=max3f(b,p0[8],p0[9]);a=max3f(a,p0[10],p0[11]);b=max3f(b,p0[12],p0[13]);a=max3f(a,p0[14],p0[15]);
  const float m=max2f(a,b);
  auto rr=__builtin_amdgcn_permlane32_swap(__float_as_uint(m),__float_as_uint(m),false,false);
  return max2f(__uint_as_float(rr[0]),__uint_as_float(rr[1]));
}
__device__ __forceinline__ void bmask1(f32x16&p0,int nb,lds_cfptr lut){
  #pragma unroll
  for(int r=0;r<16;++r){ int n0=nb-((r&3)+8*(r>>2)); n0=n0<-1?-1:(n0>128?128:n0); p0[r]+=lut[n0+1]; }
}
__device__ __forceinline__ void pv2(f32x16*o,int vb,bf16x8 pa0,bf16x8 pa1){
  #pragma unroll
  for(int d0=0;d0<4;++d0){s16x4 lo[2],hi[2];
    #pragma unroll
    for(int ks=0;ks<2;++ks){
      asm volatile("ds_read_b64_tr_b16 %0,%1 offset:%c2":"=&v"(lo[ks]):"v"(vb),"i"(d0*4096+ks*1024):"memory");
      asm volatile("ds_read_b64_tr_b16 %0,%1 offset:%c2":"=&v"(hi[ks]):"v"(vb),"i"(d0*4096+ks*1024+512):"memory");}
    asm volatile("s_waitcnt lgkmcnt(0)":::"memory");SBAR();
    #define PK(k) (bf16x8){lo[k][0],lo[k][1],lo[k][2],lo[k][3],hi[k][0],hi[k][1],hi[k][2],hi[k][3]}
    o[d0]=__builtin_amdgcn_mfma_f32_32x32x16_bf16(pa0,PK(0),o[d0],0,0,0);
    o[d0]=__builtin_amdgcn_mfma_f32_32x32x16_bf16(pa1,PK(1),o[d0],0,0,0);
    #undef PK
  }
}
__device__ __forceinline__ float rowmax(const f32x16&p0,const f32x16&p1){
  float a=max3f(p0[0],p0[1],p1[0]),b=max3f(p0[2],p0[3],p1[1]);a=max3f(a,p1[2],p1[3]);
  #pragma unroll
  for(int r=4;r<16;r+=4){a=max3f(a,p0[r],p0[r+1]);b=max3f(b,p0[r+2],p0[r+3]);a=max3f(a,p1[r],p1[r+1]);b=max3f(b,p1[r+2],p1[r+3]);}
  const float m=max2f(a,b);
  auto rr=__builtin_amdgcn_permlane32_swap(__float_as_uint(m),__float_as_uint(m),false,false);
  return max2f(__uint_as_float(rr[0]),__uint_as_float(rr[1]));
}
__device__ __forceinline__ void pv(f32x16*o,int vb,bf16x8 pa0,bf16x8 pa1,bf16x8 pa2,bf16x8 pa3){
  #pragma unroll
  for(int d0=0;d0<2;++d0){s16x4 lo[4],hi[4];
    #pragma unroll
    for(int ks=0;ks<4;++ks){
      asm volatile("ds_read_b64_tr_b16 %0,%1 offset:%c2":"=&v"(lo[ks]):"v"(vb),"i"(d0*4096+ks*1024):"memory");
      asm volatile("ds_read_b64_tr_b16 %0,%1 offset:%c2":"=&v"(hi[ks]):"v"(vb),"i"(d0*4096+ks*1024+512):"memory");}
    asm volatile("s_waitcnt lgkmcnt(0)":::"memory");SBAR();
    #define PK(k) (bf16x8){lo[k][0],lo[k][1],lo[k][2],lo[k][3],hi[k][0],hi[k][1],hi[k][2],hi[k][3]}
    o[d0]=__builtin_amdgcn_mfma_f32_32x32x16_bf16(pa0,PK(0),o[d0],0,0,0);
    o[d0]=__builtin_amdgcn_mfma_f32_32x32x16_bf16(pa1,PK(1),o[d0],0,0,0);
    o[d0]=__builtin_amdgcn_mfma_f32_32x32x16_bf16(pa2,PK(2),o[d0],0,0,0);
    o[d0]=__builtin_amdgcn_mfma_f32_32x32x16_bf16(pa3,PK(3),o[d0],0,0,0);
    #undef PK
  }
}

__device__ __forceinline__ void build_lut(char*shm,const float*relb,int h,int tid){
  __attribute__((address_space(3))) float* lw=(__attribute__((address_space(3))) float*)((__attribute__((address_space(3))) char*)shm+LDS_LUT);
  if(tid<129){ const int bk=t5_bucket(tid); lw[1+tid]=(relb[bk*NHEAD+h]-relb[31*NHEAD+h])*1.4426950408889634f; } else if(tid==129){ lw[0]=-INFINITY; }
}
#ifndef ATTN_STORE16
#define ATTN_STORE16(p,v) (*(u32x4*)(p)=(v))
#endif
struct UnitArgs { int kind; int qcol,kcol,vcol,ocol; const float* relb; float* scr; float lam,oscale; const float* gain; };
template<int THRL> __device__ __forceinline__ void attn_unit(int b,int h,int qb,const bf16*Q,const bf16*__restrict__ K,const bf16*__restrict__ V,bf16*O,char*shm,const UnitArgs&ua){
  int tid_=threadIdx.x; asm volatile("":"+v"(tid_)); const int tid=tid_,lane=tid&63,r32=lane&31,hi=lane>>5; const int wid=__builtin_amdgcn_readfirstlane(tid>>6);
  const int rg=wid&3,g=wid>>2;
#ifdef ATT_PRIO
  if(g)__builtin_amdgcn_s_setprio(ATT_PRIO);
#endif
  const long rowbase=(long)b*SEQ; const int q0=qb*QB;
  const bf16*Qw=Q+(rowbase+q0+rg*QBLK)*DM+ua.qcol;
  const unsigned lds0=(unsigned)(uintptr_t)shm;
  float*wsf=(float*)(shm+LDS_WS)+wid*64;
  const char*ksrc=(const char*)K+wid*1024+lane*16;
  const char*vsrc=(const char*)V+wid*1024+lane*16;
  const unsigned kdst=lds0+LDS_K+wid*1024, vdst=lds0+LDS_V+wid*1024;
  #define DMA_K(t,slot) glds16(ksrc+(long)(t)*8192,(unsigned)__builtin_amdgcn_readfirstlane(kdst+(slot)))
  #define VSL(t) (((t)&(NVSLOT-1))*VSLOTB)
  #define DMA_V(t) do{ glds16(vsrc+(long)(t)*16384,(unsigned)__builtin_amdgcn_readfirstlane(vdst+VSL(t))); glds16(vsrc+8192+(long)(t)*16384,(unsigned)__builtin_amdgcn_readfirstlane(vdst+VSL(t)+8192)); }while(0)
  const int vb0=(int)(lds0+LDS_V)+((lane>>4)&1)*32+(lane&3)*8+(4*hi+((lane&15)>>2))*64+g*2048;
  bf16x8 kf[4];
  const lds_cptr shm3=(lds_cptr)shm; const lds_cptr kp0=shm3+LDS_K+hi*1024+r32*16+g*512; const lds_cptr vp0=shm3+LDS_V+((lane>>4)&1)*32+(lane&3)*8+(4*hi+((lane&15)>>2))*64+g*2048;
  const int NTd=(q0+QB)/KVBLK, NT=NTd<4?4:NTd;
  const lds_cfptr lutp=(lds_cfptr)((lds_cptr)shm+LDS_LUT);
  DMA_K(0,0);DMA_V(0);DMA_K(1,SLOTB);
  bf16x8 qr[4];
  #pragma unroll
  for(int d0=0;d0<4;++d0)qr[d0]=*reinterpret_cast<const bf16x8*>(&Qw[(long)r32*DM+d0*16+hi*8]);
  float mhat=0.f,l_reg=0.f;f32x16 o[4];o[0]=f32x16{};o[1]=f32x16{};o[2]=f32x16{};o[3]=f32x16{};f32x16 negm=f32x16{};asm volatile("":"+v"(negm));
  const int qw=q0+rg*QBLK-32*g;
  const int qabs=q0+rg*QBLK+r32-32*g-4*hi;
  #define CMASK(P0,t) do{ if(qw-64*(t)<144)bmask1(P0,qabs-64*(t),lutp); }while(0)
  bool resc=false;
  #define START(P0) do{ const float rm=rowmax1(P0); resc=false; \
    { const float dl=(rm==-INFINITY)?0.f:rm; mhat=fadd_s(mhat,dl); \
      _Pragma("unroll") for(int r=0;r<16;++r){P0[r]=fsub_s(P0[r],dl);} \
      _Pragma("unroll") for(int r=0;r<16;++r)negm[r]=-mhat; asm volatile("":"+v"(negm)); } \
    _Pragma("unroll") for(int r=0;r<16;++r)P0[r]=__builtin_amdgcn_exp2f(P0[r]); }while(0)
  #define RESC() do{ if(resc){ asm volatile("s_waitcnt lgkmcnt(0)":::"memory"); \
      _Pragma("unroll") for(int d_=0;d_<4;++d_) _Pragma("unroll") for(int r=0;r<16;++r)o[d_][r]*=wsf[crow(r,hi)]; } }while(0)
  f32x16 pA0,pB0;
  int sl_prev=0,sl_cur=0,sl_next=SLOTB;
  #define ROT() do{sl_prev=sl_cur;sl_cur=sl_next;sl_next=(sl_next==(NSLOT-1)*SLOTB)?0:sl_next+SLOTB;}while(0)
  DMA_K(2,2*SLOTB);DMA_V(1);
  WAIT_BAR(6);
  qkt1(pA0,shm+LDS_K+hi*1024+r32*16+g*512,qr,negm);asm volatile("s_nop 15\n\ts_nop 7":"+v"(pA0));CMASK(pA0,0);
  START(pA0);
  WAIT_BAR(2);
  DMA_K(3,0);DMA_V(2);
  ROT();
  kload4(kf,kp0+sl_cur);
  WAIT_BAR(5);
  s16x4 vlo[8],vhi[8]; u32x4 pw0,pw1;
  #define PKW(P,B) cvtpk_s(P[B],P[B+1])
  #define PAF(k) __builtin_bit_cast(bf16x8,pw##k)
  #define VFR(i) (bf16x8){vlo[i][0],vlo[i][1],vlo[i][2],vlo[i][3],vhi[i][0],vhi[i][1],vhi[i][2],vhi[i][3]}
  #define PIN(x) asm volatile("":"+v"(x))
  #define MX3(a,b,c) __builtin_fmaxf(__builtin_fmaxf((a),(b)),(c))
  #define GAPA(MF,A0,A1,A2,A3,W0,W1,PW) do{ MF; sacc+=A0; sacc+=A1; sacc+=A2; sacc+=A3; PIN(sacc); W0; W1; PIN(PW); SBAR(); }while(0)
  #define EX(v) __builtin_amdgcn_exp2f(v)
  #define GAPB(MF,X,B) do{ MF; X[B]=EX(X[B]); X[B+1]=EX(X[B+1]); PIN(X); SBAR(); }while(0)
  #define VRD(w,d,k) do{ vlo[w]=vtr(vp_+((d)*4096+(k)*1024)); vhi[w]=vtr(vp_+((d)*4096+(k)*1024+512)); }while(0)
  #define KRD(G,j) do{ if(G){ kload1(kf,kp0+sl_next,j); SBAR(); } }while(0)
  #define STEP(C0,P0,t,GK,GV,GL) do{ SBAR(); \
    const lds_cptr vp_=vp0+VSL((t)-1); \
    VRD(0,0,0); VRD(1,1,0); SBAR(); float sacc=(P0[0]+P0[1]); \
    GAPA(C0=__builtin_amdgcn_mfma_f32_32x32x16_bf16(kf[0],qr[0],negm,0,0,0), P0[2],P0[3],P0[4],P0[5],     pw0[0]=PKW(P0,0), pw0[1]=PKW(P0,2), pw0); \
    VRD(2,2,0); VRD(3,3,0); SBAR(); GAPA(C0=__builtin_amdgcn_mfma_f32_32x32x16_bf16(kf[1],qr[1],C0,0,0,0), P0[6],P0[7],P0[8],P0[9],     pw0[2]=PKW(P0,4), pw0[3]=PKW(P0,6), pw0); \
    VRD(4,0,1); VRD(5,1,1); SBAR(); GAPA(C0=__builtin_amdgcn_mfma_f32_32x32x16_bf16(kf[2],qr[2],C0,0,0,0), P0[10],P0[11],P0[12],P0[13], pw1[0]=PKW(P0,8), pw1[1]=PKW(P0,10), pw1); \
    VRD(6,2,1); VRD(7,3,1); SBAR(); GAPA(C0=__builtin_amdgcn_mfma_f32_32x32x16_bf16(kf[3],qr[3],C0,0,0,0), P0[14],P0[15],0.f,0.f,       pw1[2]=PKW(P0,12),pw1[3]=PKW(P0,14), pw1); \
    l_reg+=sacc; \
    if(GK){DMA_K((t)+3,sl_cur);} if(GV){DMA_V((t)+2);} \
    CMASK(C0,t); \
    { float a=MX3(C0[0],C0[1],C0[2]),b=MX3(C0[3],C0[4],C0[5]); a=MX3(a,C0[6],C0[7]); b=MX3(b,C0[8],C0[9]); a=MX3(a,C0[10],C0[11]); b=MX3(b,C0[12],C0[13]); a=MX3(a,C0[14],C0[15]); \
      float rm=__builtin_fmaxf(a,b); { auto rr=__builtin_amdgcn_permlane32_swap(__float_as_uint(rm),__float_as_uint(rm),false,false); rm=__builtin_fmaxf(__uint_as_float(rr[0]),__uint_as_float(rr[1])); } \
      resc=false; \
      if(__builtin_expect(__any(rm>(float)THRL),0)){ const float dl=__builtin_fmaxf(rm,0.f); mhat+=dl; \
        _Pragma("unroll") for(int r=0;r<16;++r){C0[r]-=dl;} \
        _Pragma("unroll") for(int r=0;r<16;++r)negm[r]=-mhat; asm volatile("":"+v"(negm)); \
        const float f=__builtin_amdgcn_exp2f(-dl); l_reg*=f; if(hi==0)wsf[r32]=f; resc=true; } } \
    SBAR(); \
    GAPB(o[0]=__builtin_amdgcn_mfma_f32_32x32x16_bf16(PAF(0),VFR(0),o[0],0,0,0), C0,0); \
    GAPB(o[1]=__builtin_amdgcn_mfma_f32_32x32x16_bf16(PAF(0),VFR(1),o[1],0,0,0), C0,2); \
    KRD(GL,0); GAPB(o[2]=__builtin_amdgcn_mfma_f32_32x32x16_bf16(PAF(0),VFR(2),o[2],0,0,0), C0,4); \
    KRD(GL,1); GAPB(o[3]=__builtin_amdgcn_mfma_f32_32x32x16_bf16(PAF(0),VFR(3),o[3],0,0,0), C0,6); \
    KRD(GL,2); GAPB(o[0]=__builtin_amdgcn_mfma_f32_32x32x16_bf16(PAF(1),VFR(4),o[0],0,0,0), C0,8); \
    KRD(GL,3); GAPB(o[1]=__builtin_amdgcn_mfma_f32_32x32x16_bf16(PAF(1),VFR(5),o[1],0,0,0), C0,10); \
    GAPB(o[2]=__builtin_amdgcn_mfma_f32_32x32x16_bf16(PAF(1),VFR(6),o[2],0,0,0), C0,12); \
    GAPB(o[3]=__builtin_amdgcn_mfma_f32_32x32x16_bf16(PAF(1),VFR(7),o[3],0,0,0), C0,14); \
    }while(0)
  int t=1;
  #undef CMASK
  #define CMASK(P0,t) do{}while(0)
  for(;t+7<NT;t+=2){
    STEP(pB0,pA0,t,true,true,true);     WAIT_BAR(5); RESC(); ROT();
    STEP(pA0,pB0,t+1,true,true,true);   WAIT_BAR(5); RESC(); ROT();
  }
  #undef CMASK
  #define CMASK(P0,t) do{ if(qw-64*(t)<144)bmask1(P0,qabs-64*(t),lutp); }while(0)
  #define ENDW(tt) do{ if((tt)+3<NT){WAIT_BAR(5);} else if((tt)+2<NT){WAIT_BAR(4);} else {WAIT_BAR(0);} }while(0)
  for(;t+1<NT;t+=2){
    STEP(pB0,pA0,t,(t+3<NT),(t+2<NT),(t+1<NT));       ENDW(t);   RESC(); ROT();
    STEP(pA0,pB0,t+1,(t+4<NT),(t+3<NT),(t+2<NT));     ENDW(t+1); RESC(); ROT();
  }
  STEP(pB0,pA0,NT-1,false,false,false); RESC();
  { float sacc=pB0[0]+pB0[1]; _Pragma("unroll") for(int r=2;r<16;++r)sacc+=pB0[r]; l_reg+=sacc;
    pw0=(u32x4){PKW(pB0,0),PKW(pB0,2),PKW(pB0,4),PKW(pB0,6)};pw1=(u32x4){PKW(pB0,8),PKW(pB0,10),PKW(pB0,12),PKW(pB0,14)};
    SBAR(); pv2(o,vb0+VSL(NT-1),PAF(0),PAF(1)); }
  #undef PKW
  #undef PAF
  #undef VFR
  #undef PIN
  #undef MX3
  #undef GAPA
  #undef GAPB
  #undef EX
  #undef VRD
  #undef KRD
  #undef STEP
  #undef ENDW
  {auto rr=__builtin_amdgcn_permlane32_swap(__float_as_uint(l_reg),__float_as_uint(l_reg),false,false);l_reg=__uint_as_float(rr[0])+__uint_as_float(rr[1]);}
  asm volatile("s_waitcnt lgkmcnt(0)\n\ts_barrier":::"memory");
  typedef float f32x4v __attribute__((ext_vector_type(4)));
  float*xs=(float*)shm+rg*(64*64+64)+64*64;
  f32x4v*xo4=(f32x4v*)((float*)shm+rg*(64*64+64));
  if(g==1){
    #pragma unroll
    for(int d0=0;d0<4;++d0){
      #pragma unroll
      for(int r4=0;r4<4;++r4)xo4[(d0*4+r4)*64+lane]=(f32x4v){o[d0][4*r4],o[d0][4*r4+1],o[d0][4*r4+2],o[d0][4*r4+3]};}
    if(hi==0){xs[r32]=mhat;xs[32+r32]=l_reg;}
  }
  asm volatile("s_waitcnt lgkmcnt(0)\n\ts_barrier":::"memory");
  if(g==0){
    const float mb=xs[r32],lb=xs[32+r32];
    const float m=(lb>0.f)?__builtin_fmaxf(mhat,mb):mhat,wa=__builtin_amdgcn_exp2f(mhat-m),wb=(lb>0.f)?__builtin_amdgcn_exp2f(mb-m):0.f;
    const float linv=__builtin_amdgcn_rcpf(l_reg*wa+lb*wb);
    if(hi==0){wsf[r32]=wa*linv;wsf[32+r32]=wb*linv;}
    f32x4v*sc4=(f32x4v*)ua.scr+(rg*16)*64+lane;
    f32x4v t2[16];
    if(ua.kind!=0){
      #pragma unroll
      for(int i=0;i<16;++i)t2[i]=__builtin_nontemporal_load(sc4+i*64);
    }
    asm volatile("s_waitcnt lgkmcnt(0)":::"memory");
    #pragma unroll
    for(int r4=0;r4<4;++r4){ const f32x4v fa=*(const f32x4v*)(wsf+8*r4+4*hi),fb=*(const f32x4v*)(wsf+32+8*r4+4*hi);
      #pragma unroll
      for(int d0=0;d0<4;++d0){ const f32x4v ob=xo4[(d0*4+r4)*64+lane];
        #pragma unroll
        for(int j=0;j<4;++j)o[d0][4*r4+j]=o[d0][4*r4+j]*fa[j]+ob[j]*fb[j]; } }
    if(ua.kind==0){
      #pragma unroll
      for(int d0=0;d0<4;++d0){
        #pragma unroll
        for(int r4=0;r4<4;++r4)sc4[(d0*4+r4)*64]=(f32x4v){o[d0][4*r4],o[d0][4*r4+1],o[d0][4*r4+2],o[d0][4*r4+3]};} }
    else{
      float rs[16];
      #pragma unroll
      for(int r=0;r<16;++r){ float ss=0.f;
        #pragma unroll
        for(int d0=0;d0<4;++d0){const float a=o[d0][r]-ua.lam*t2[d0*4+(r>>2)][r&3]; o[d0][r]=a; ss+=a*a;}
        ss+=__shfl_xor(ss,1); ss+=__shfl_xor(ss,2); ss+=__shfl_xor(ss,4); ss+=__shfl_xor(ss,8); ss+=__shfl_xor(ss,16);
        rs[r]=ua.oscale*__builtin_amdgcn_rsqf(ss*(1.0f/128.0f)+1e-6f); }
      bf16*stg=(bf16*)(shm+LDS_OST)+wid*2048;
      #pragma unroll
      for(int vh=0;vh<2;++vh){
        const float g0=ua.gain[vh*64+r32],g1=ua.gain[vh*64+32+r32];
        #pragma unroll
        for(int r=0;r<16;++r){const int orow=crow(r,hi);
          stg[orow*64+r32]=__float2bfloat16(o[2*vh][r]*rs[r]*g0);
          stg[orow*64+32+r32]=__float2bfloat16(o[2*vh+1][r]*rs[r]*g1);}
        asm volatile("s_waitcnt lgkmcnt(0)":::"memory");
        #pragma unroll
        for(int i=0;i<4;++i){const int row=i*8+(lane>>3),ch=lane&7; const u32x4 v=*(const u32x4*)(stg+row*64+ch*8); ATTN_STORE16((char*)O+PG8_AOFF(rowbase+q0+rg*QBLK+row,ua.ocol+vh*64+ch*8,OPITCH),v);}
        asm volatile("s_waitcnt lgkmcnt(0)":::"memory");
      } }
  }
#ifdef ATT_PRIO
  __builtin_amdgcn_s_setprio(0);
#endif
  asm volatile("s_waitcnt lgkmcnt(0)\n\ts_barrier":::"memory");
  #undef DMA_K
  #undef DMA_V
  #undef VSL
  #undef CMASK
  #undef START
  #undef RESC
  #undef ROT
}
constexpr int ATTN_LDS_BYTES=LDS_BYTES;
#undef SBAR
#undef WAIT_BAR
}

constexpr int NWAVES = 8;
#ifndef MK_PER_PHASE
#define MK_PER_PHASE 0
#endif
constexpr int BATCH = 2, SEQ = 4096, DMODEL = 4096, M = BATCH * SEQ, DEPTH = 4, FF = 16384, NGRP = 128;
constexpr int N_PHASES = 2 + 6 * DEPTH;
constexpr size_t MiB = 1u << 20;
constexpr size_t WS_CTL = 0, CTL_ZERO_BYTES = 1 * MiB;
constexpr int CW_BAR = 4096;
constexpr size_t SSQ_OFF = 128 * 1024;
static_assert(SSQ_OFF + 9 * (size_t)M * 8 <= CTL_ZERO_BYTES, "ssq inside the memset region");
constexpr size_t WS_W = 16 * MiB, W_LAYER = 360 * MiB;
constexpr size_t W_IN = 0, W_OUT = 64 * MiB, W_UP = 96 * MiB, W_DN = 224 * MiB, W_GLU = 352 * MiB;
constexpr size_t WS_SSMP = WS_W + DEPTH * W_LAYER;
constexpr size_t SSMP_STRIDE = 144 * 1024;
constexpr size_t WS_KI = 1536 * MiB, WS_VI = 1568 * MiB;
constexpr size_t WS_H = 1536 * MiB, WS_HB = 1664 * MiB, WS_QKV = 1728 * MiB, WS_UT = 1824 * MiB, WS_YG = 1856 * MiB, WS_CAT = 1888 * MiB, WS_ATT = 1952 * MiB, WS_HID = 1984 * MiB, WS_END = 2240 * MiB;
static_assert(WS_SSMP + (size_t)DEPTH * NGRP * SSMP_STRIDE <= WS_H, "d_ws map");
constexpr int RING_OFF = 0, RING_BYTES = 131072;
constexpr int LDSCTL_OFF = RING_BYTES, MISC_OFF = LDSCTL_OFF + 320;
constexpr int LDS_BYTES = 147456;
static_assert(MISC_OFF + 128 <= LDS_BYTES, "LDS map");

#define GAS __attribute__((address_space(1)))
#define LAS __attribute__((address_space(3)))
typedef unsigned short bf16;
typedef unsigned v4u __attribute__((ext_vector_type(4)));
typedef float f32x4 __attribute__((ext_vector_type(4)));
typedef short bf16x8 __attribute__((ext_vector_type(8)));
typedef GAS unsigned gu32;
typedef GAS unsigned long long gu64;
#define RLX_AGENT __ATOMIC_RELAXED, __HIP_MEMORY_SCOPE_AGENT
#define LDS_WAIT() asm volatile("s_waitcnt lgkmcnt(0)" ::: "memory")
#define VM_WAIT() asm volatile("s_waitcnt vmcnt(0)" ::: "memory")
__device__ __forceinline__ unsigned long long rt() { return __builtin_amdgcn_s_memrealtime(); }
__device__ __forceinline__ unsigned f2bf(float f) { unsigned u = __builtin_bit_cast(unsigned, f); return (u + 0x7fffu + ((u >> 16) & 1u)) >> 16; }
__device__ __forceinline__ unsigned pk2(float lo, float hi) { return f2bf(lo) | (f2bf(hi) << 16); }

#define XB_TMO      128
#define XB_XCNT(j)  (256  + 64 * (j))
#define XB_XSUB(j)  (1280 + 64 * (j))
#define XB_XGEN(j)  (2304 + 64 * (j))
#define XB_TOP      3328
#define XB_TOPGEN   3392
#define XCD_BAR_WORDS 3456
#define XB_SPIN_CAP (1u << 18)

__device__ __forceinline__ unsigned xb_ld(unsigned* p)              { return __hip_atomic_load(p, __ATOMIC_RELAXED, __HIP_MEMORY_SCOPE_AGENT); }
__device__ __forceinline__ unsigned xb_add(unsigned* p, unsigned v) { return __hip_atomic_fetch_add(p, v, __ATOMIC_RELAXED, __HIP_MEMORY_SCOPE_AGENT); }
__device__ __forceinline__ unsigned xb_xcc_id() { return (unsigned)__builtin_amdgcn_s_getreg((3 << 11) | 20) & 0xFu; }
#define XB_SPIN(cond, bar) do { unsigned _sp = 0; while (cond) { __builtin_amdgcn_s_sleep(1); \
    if ((++_sp & 255u) == 0u) { if (xb_ld(&(bar)[XB_TMO])) break; if (_sp > XB_SPIN_CAP) { atomicAdd(&(bar)[XB_TMO], 1u); break; } } } } while (0)

struct XcdBarrier {
    unsigned* bar; unsigned x;
    volatile LAS unsigned* st;
};

__device__ __forceinline__ XcdBarrier xcd_barrier_post(unsigned* bar, volatile LAS unsigned* st) {
    XcdBarrier b; b.bar = bar; b.x = xb_xcc_id(); b.st = st;
    if (threadIdx.x == 0) (void)xb_add(&bar[XB_XCNT(b.x)], 1u);
    return b;
}
__device__ __forceinline__ void xcd_barrier_complete(unsigned* bar, unsigned x, unsigned& nloc, unsigned& nx) {
    const unsigned G = gridDim.x * gridDim.y * gridDim.z;
    unsigned sum, cnt, mine, sp = 0u;
    for (;;) {
        sum = 0u; cnt = 0u; mine = 0u;
#pragma unroll
        for (unsigned j = 0; j < 16; ++j) { const unsigned c = xb_ld(&bar[XB_XCNT(j)]); sum += c; cnt += (c > 0u) ? 1u : 0u; mine = (j == x) ? c : mine; }
        if (sum == G) break;
        __builtin_amdgcn_s_sleep(1);
        if ((++sp & 255u) == 0u) { if (xb_ld(&bar[XB_TMO])) break; if (sp > XB_SPIN_CAP) { atomicAdd(&bar[XB_TMO], 1u); break; } }
    }
    nloc = mine > 0u ? mine : 1u; nx = cnt > 0u ? cnt : 1u;
}

__device__ __forceinline__ void xcd_barrier(const XcdBarrier& b) {
    asm volatile("s_waitcnt vmcnt(0)" ::: "memory");
    __syncthreads();
    if (threadIdx.x == 0) {
        unsigned* bar = b.bar;
        __builtin_amdgcn_s_waitcnt(0);
        unsigned nloc = b.st[0], nx = b.st[1];
        if (nloc == 0u) { xcd_barrier_complete(bar, b.x, nloc, nx); b.st[0] = nloc; b.st[1] = nx; }
        const unsigned old = xb_add(&bar[XB_XSUB(b.x)], 1u);
        const unsigned gen = old / nloc;
        if (old + 1u == (gen + 1u) * nloc) {
            __builtin_amdgcn_fence(__ATOMIC_RELEASE, "agent");
            asm volatile("s_waitcnt vmcnt(0)" ::: "memory");
            const unsigned og = xb_add(&bar[XB_TOP], 1u);
            const unsigned tg = og / nx;
            if (og + 1u == (tg + 1u) * nx) xb_add(&bar[XB_TOPGEN], 1u);
            else XB_SPIN(xb_ld(&bar[XB_TOPGEN]) == tg, bar);
            __builtin_amdgcn_fence(__ATOMIC_ACQUIRE, "agent");
            xb_add(&bar[XB_XGEN(b.x)], 1u);
            asm volatile("s_waitcnt vmcnt(0)" ::: "memory");
        } else {
            XB_SPIN(xb_ld(&bar[XB_XGEN(b.x)]) == gen, bar);
            __builtin_amdgcn_fence(__ATOMIC_ACQUIRE, "agent");
            asm volatile("s_waitcnt vmcnt(0)" ::: "memory");
        }
    }
    __syncthreads();
}

struct Frame {
    LAS unsigned char* lds;
    volatile LAS unsigned* MISC;
    gu32* ctl;
    int tid, lane, wave;
    int vcu, G;
    const float* const* in;
    float* out; unsigned char* ws;
};
enum In { I_X = 0, I_WIN, I_WOUT, I_NMIX, I_NMLP, I_WUP, I_WDN, I_NFIN, I_RELB, I_LQ1, I_LK1, I_LQ2, I_LK2, I_SUBG, I_SLRE, I_SLIM, I_SLDT, I_SBRE, I_SBIM, I_SCRE, I_SCIM, I_SD, I_WGLU, I_BGLU, N_IN };

__device__ __forceinline__ float wave_sum(float v) {
#pragma unroll
    for (int o = 1; o < 64; o <<= 1) v += __shfl_xor(v, o);
    return v;
}
struct TItem { const float* src; const float* gain; bf16* dst; int N, K, n0, k0; };
struct TRegs { f32x4 v[8]; f32x4 g0, g1; };
__device__ __forceinline__ void tr_load(const TItem& t, TRegs& r, int lane) {
    const float* p = t.src + (size_t)(lane >> 4) * t.N + 4 * (lane & 15);
#pragma unroll
    for (int i = 0; i < 8; ++i) r.v[i] = *(const f32x4*)(p + (size_t)(4 * i) * t.N);
    if (t.gain) { r.g0 = *(const f32x4*)(t.gain + 8 * (lane >> 4)); r.g1 = *(const f32x4*)(t.gain + 8 * (lane >> 4) + 4); } else { r.g0 = (f32x4){1.f, 1.f, 1.f, 1.f}; r.g1 = r.g0; }
}
__device__ __forceinline__ void tr_store(const TItem& t, const TRegs& r, LAS float* scr, int lane) {
#pragma unroll
    for (int i = 0; i < 8; ++i) { LAS float* d = scr + (4 * i + (lane >> 4)) * 65 + 4 * (lane & 15); d[0] = r.v[i].x; d[1] = r.v[i].y; d[2] = r.v[i].z; d[3] = r.v[i].w; }
    LDS_WAIT(); asm volatile("" ::: "memory");
    const int c4 = lane >> 4;
#pragma unroll
    for (int j = 0; j < 4; ++j) { const int R = 16 * j + (lane & 15), nl = (R & ~31) + pg8::perm32(R & 31);
        const LAS float* s = scr + (8 * c4) * 65 + nl;
        v4u o; o.x = pg8::cvt_pk_bf16(s[0 * 65] * r.g0.x, s[1 * 65] * r.g0.y); o.y = pg8::cvt_pk_bf16(s[2 * 65] * r.g0.z, s[3 * 65] * r.g0.w); o.z = pg8::cvt_pk_bf16(s[4 * 65] * r.g1.x, s[5 * 65] * r.g1.y); o.w = pg8::cvt_pk_bf16(s[6 * 65] * r.g1.z, s[7 * 65] * r.g1.w);
        *(GAS v4u*)((GAS unsigned char*)t.dst + pg8::img_off(t.n0 + nl, t.k0 + 8 * c4, t.K, true)) = o; }
    LDS_WAIT(); asm volatile("" ::: "memory");
}
__device__ __forceinline__ void ssm_setup_unit(Frame& F, int l, int g) {
    LAS float* apr = (LAS float*)(F.lds + RING_OFF); LAS float* api = apr + 17 * 64; LAS float* bbr = api + 17 * 64; LAS float* bbi = bbr + 1024;
    LAS float* cr = bbi + 1024; LAS float* ci = cr + 1024; LAS float* gg = ci + 1024;
    const int lg = l * NGRP + g, tid = F.tid;
    bf16* P = (bf16*)(F.ws + WS_SSMP + (size_t)lg * SSMP_STRIDE); bf16* WmT = P; bf16* VmT = P + 32768; bf16* Kt = P + 65536; float* A16 = (float*)(P + 65536 + 17 * 256);
    if (tid < 64) { const int p = tid;
        const float dt = expf(F.in[I_SLDT][lg]), lr = F.in[I_SLRE][lg * 64 + p], li = F.in[I_SLIM][lg * 64 + p];
        const float mag = expf(lr * dt), th = li * dt, ar = mag * cosf(th), ai = mag * sinf(th);
        float pr = 1.f, pi = 0.f;
        for (int tau = 0; tau <= 16; ++tau) { apr[tau * 64 + p] = pr; api[tau * 64 + p] = pi; const float npr = pr * ar - pi * ai, npi = pr * ai + pi * ar; pr = npr; pi = npi; }
        const float den = lr * lr + li * li, nr = ar - 1.0f, ni = ai;
        gg[p] = (nr * lr + ni * li) / den; gg[64 + p] = (ni * lr - nr * li) / den; }
    __syncthreads();
    if (tid < 64) { A16[2 * tid] = apr[16 * 64 + tid]; A16[2 * tid + 1] = api[16 * 64 + tid]; }
    for (int idx = tid; idx < 1024; idx += NWAVES * 64) { const int p = idx >> 4;
        const float br = F.in[I_SBRE][(size_t)lg * 1024 + idx], bi = F.in[I_SBIM][(size_t)lg * 1024 + idx], gr = gg[p], gi = gg[64 + p];
        bbr[idx] = gr * br - gi * bi; bbi[idx] = gr * bi + gi * br;
        cr[idx] = F.in[I_SCRE][(size_t)lg * 1024 + idx]; ci[idx] = F.in[I_SCIM][(size_t)lg * 1024 + idx]; }
    __syncthreads();
    for (int e = tid; e < 32768; e += NWAVES * 64) { const int pp = e >> 8, k = e & 255, p = pp & 63, j = k >> 4, hh = k & 15, tau = 15 - j;
        const float ar = apr[tau * 64 + p], ai = api[tau * 64 + p], br = bbr[p * 16 + hh], bi = bbi[p * 16 + hh];
        WmT[e] = (bf16)f2bf(pp < 64 ? ar * br - ai * bi : ar * bi + ai * br); }
    for (int e = tid; e < 32768; e += NWAVES * 64) { const int n = e >> 7, pp = e & 127, p = pp & 63, t = n >> 4, hh = n & 15;
        const float ar = apr[(t + 1) * 64 + p], ai = api[(t + 1) * 64 + p], c_r = cr[hh * 64 + p], c_i = ci[hh * 64 + p];
        VmT[e] = (bf16)f2bf(pp < 64 ? c_r * ar - c_i * ai : -(c_r * ai + c_i * ar)); }
    for (int e = tid; e < 256; e += NWAVES * 64) Kt[e] = 0;
    for (int e = tid; e < 4096; e += NWAVES * 64) { const int tau = e >> 8, hh = (e >> 4) & 15, h2 = e & 15; float acc = 0.f;
        for (int p = 0; p < 64; ++p) { const float ar = apr[tau * 64 + p], ai = api[tau * 64 + p], c_r = cr[hh * 64 + p], c_i = ci[hh * 64 + p];
            const float xr = c_r * ar - c_i * ai, xi = c_r * ai + c_i * ar; acc += xr * bbr[p * 16 + h2] - xi * bbi[p * 16 + h2]; }
        if (tau == 0 && hh == h2) acc += F.in[I_SD][lg * 16 + hh];
        Kt[256 + e] = (bf16)f2bf(acc); }
    __syncthreads();
}
__device__ __forceinline__ void p0_prologue(Frame& F) {
    LAS float* scr = (LAS float*)(F.lds + RING_OFF + F.wave * 16384);
    const int gw = F.vcu * NWAVES + F.wave, NGW = F.G * NWAVES;
    constexpr int IT_IN = (DMODEL / 64) * (8192 / 32), IT_OUT = (DMODEL / 64) * (DMODEL / 32), IT_UP = (DMODEL / 64) * (FF / 32), IT_DN = (FF / 64) * (DMODEL / 32), IT_GLU = (2048 / 64) * (2048 / 32);
    constexpr int IT_LAYER = IT_IN + IT_OUT + IT_UP + IT_DN + IT_GLU, NITEMS = DEPTH * IT_LAYER;
    auto decode = [&](int it, TItem& t) {
        const int l = it / IT_LAYER; int r = it % IT_LAYER;
        unsigned char* wl = F.ws + WS_W + (size_t)l * W_LAYER;
        const float* W; const float* gain = nullptr; bf16* WT; int K, N;
        if (r < IT_IN) { W = F.in[I_WIN] + (size_t)l * DMODEL * 8192; K = DMODEL; N = 8192; gain = F.in[I_NMIX] + l * DMODEL; WT = (bf16*)(wl + W_IN); }
        else if ((r -= IT_IN) < IT_OUT) { W = F.in[I_WOUT] + (size_t)l * DMODEL * DMODEL; K = DMODEL; N = DMODEL; WT = (bf16*)(wl + W_OUT); }
        else if ((r -= IT_OUT) < IT_UP) { W = F.in[I_WUP] + (size_t)l * DMODEL * FF; K = DMODEL; N = FF; gain = F.in[I_NMLP] + l * DMODEL; WT = (bf16*)(wl + W_UP); }
        else if ((r -= IT_UP) < IT_DN) { W = F.in[I_WDN] + (size_t)l * FF * DMODEL; K = FF; N = DMODEL; WT = (bf16*)(wl + W_DN); }
        else { r -= IT_DN; W = F.in[I_WGLU] + (size_t)l * 2048 * 2048; K = 2048; N = 2048; WT = (bf16*)(wl + W_GLU); }
        const int nblk = N / 64, k0 = 32 * (r / nblk), n0 = 64 * (r % nblk);
        t.src = W + (size_t)k0 * N + n0; t.gain = gain ? gain + k0 : nullptr; t.dst = WT; t.N = N; t.K = K; t.n0 = n0; t.k0 = k0; };
    if (gw < NITEMS) {
        TItem ta, tb; TRegs ra, rb;
        decode(gw, ta); tr_load(ta, ra, F.lane);
        for (int it = gw;;) {
            const int i1 = it + NGW; const bool h1 = i1 < NITEMS;
            if (h1) { decode(i1, tb); tr_load(tb, rb, F.lane); }
            tr_store(ta, ra, scr, F.lane);
            if (!h1) break;
            const int i2 = i1 + NGW; const bool h2 = i2 < NITEMS;
            if (h2) { decode(i2, ta); tr_load(ta, ra, F.lane); }
            tr_store(tb, rb, scr, F.lane);
            if (!h2) break;
            it = i2;
        }
    }
    pg8::ssq_t* ssq0 = (pg8::ssq_t*)(F.ws + WS_CTL + SSQ_OFF);
    {
        f32x4 xv[16];
        if (gw < M) { const GAS f32x4* xr = (const GAS f32x4*)(F.in[I_X] + (size_t)gw * DMODEL) + F.lane;
#pragma unroll
            for (int j = 0; j < 16; ++j) xv[j] = xr[64 * j]; }
        for (int m = gw; m < M; m += NGW) {
            f32x4 xn[16]; const int mn = m + NGW;
            if (mn < M) { const GAS f32x4* xr = (const GAS f32x4*)(F.in[I_X] + (size_t)mn * DMODEL) + F.lane;
#pragma unroll
                for (int j = 0; j < 16; ++j) xn[j] = xr[64 * j]; }
            float s = 0.f;
#pragma unroll
            for (int j = 0; j < 16; ++j) { const f32x4 v = xv[j]; s += (v.x * v.x + v.y * v.y) + (v.z * v.z + v.w * v.w); *(GAS unsigned long long*)(F.ws + WS_HB + PG8_AOFF(m, 4 * (F.lane + 64 * j), DMODEL)) = (unsigned long long)pk2(v.x, v.y) | ((unsigned long long)pk2(v.z, v.w) << 32); }
            s = wave_sum(s); if (F.lane == 0) ssq0[m] = (pg8::ssq_t)(s * pg8::SSQ_SCALE);
#pragma unroll
            for (int j = 0; j < 16; ++j) xv[j] = xn[j];
        }
    }
    __syncthreads();
    for (int u = F.vcu; u < DEPTH * NGRP; u += F.G) ssm_setup_unit(F, u / NGRP, u % NGRP);
}
__device__ __forceinline__ float gelu_tanh(float y) { const float z = 0.7978845608028654f * (y + 0.044715f * y * y * y); return y * __builtin_amdgcn_rcpf(1.0f + __builtin_amdgcn_exp2f(-2.8853900817779268f * z)); }
__device__ __forceinline__ void ssm_unit(Frame& F, int l, int b, int g) {
    typedef short s16x8 __attribute__((ext_vector_type(8)));
#define SSM_SYNC() asm volatile("s_waitcnt lgkmcnt(0)\n\ts_barrier" ::: "memory")
    int lane_ = F.lane; asm volatile("" : "+v"(lane_));
    const int lane = lane_, w = F.wave, fr = lane & 15, fq = lane >> 4, tid = w * 64 + lane;
    const bf16* P = (const bf16*)(F.ws + WS_SSMP + (size_t)(l * NGRP + g) * SSMP_STRIDE); const bf16* WmT = P; const bf16* VmT = P + 32768; const bf16* Kt = P + 65536; const float* A16 = (const float*)(P + 65536 + 17 * 256);
    const bf16* U = (const bf16*)(F.ws + WS_UT) + ((size_t)g * M + (size_t)b * SEQ) * 16;
    bf16* YG = (bf16*)(F.ws + WS_YG);
    LAS float* S = (LAS float*)(F.lds + RING_OFF);
    LAS unsigned char* UQ = F.lds + RING_OFF + 64 * 132 * 4;
    s16x8 wf[8], kfl[4], kfh[8], vfl[4], vfh[4];
    const int tl = w, th = 15 - w;
    v4u pre[4];
#pragma unroll
    for (int i = 0; i < 4; ++i) pre[i] = *(const v4u*)(U + (size_t)(tid + 512 * i) * 8);
#pragma unroll
    for (int kk = 0; kk < 8; ++kk) wf[kk] = *(const s16x8*)(WmT + (16 * w + fr) * 256 + 32 * kk + 8 * fq);
#pragma unroll
    for (int kk = 0; kk < 4; ++kk) { const int tau = tl - 2 * kk - (fq >> 1); kfl[kk] = *(const s16x8*)(Kt + (tau < 0 ? 0 : tau + 1) * 256 + fr * 16 + 8 * (fq & 1)); }
#pragma unroll
    for (int kk = 0; kk < 8; ++kk) { const int tau = th - 2 * kk - (fq >> 1); kfh[kk] = *(const s16x8*)(Kt + (tau < 0 ? 0 : tau + 1) * 256 + fr * 16 + 8 * (fq & 1)); }
#pragma unroll
    for (int kk = 0; kk < 4; ++kk) { vfl[kk] = *(const s16x8*)(VmT + (tl * 16 + fr) * 128 + 32 * kk + 8 * fq); vfh[kk] = *(const s16x8*)(VmT + (th * 16 + fr) * 128 + 32 * kk + 8 * fq); }
    float sr = 0.f, si = 0.f, a16r = 0.f, a16i = 0.f;
    if (w == 0) { a16r = A16[2 * lane]; a16i = A16[2 * lane + 1]; }
    for (int q = 0; q < 4; ++q) {
#pragma unroll
        for (int i = 0; i < 4; ++i) { const int e = tid + 512 * i; *(LAS v4u*)(UQ + (e >> 5) * 528 + (e & 31) * 16) = pre[i]; }
        SSM_SYNC();
        if (q < 3) {
#pragma unroll
            for (int i = 0; i < 4; ++i) pre[i] = *(const v4u*)(U + (size_t)(q + 1) * 16384 + (size_t)(tid + 512 * i) * 8);
        }
#pragma unroll
        for (int mt = 0; mt < 4; ++mt) {
            const LAS unsigned char* ub = UQ + (mt * 16 + fr) * 528 + fq * 16;
            f32x4 acc = {0.f, 0.f, 0.f, 0.f};
#pragma unroll
            for (int kk = 0; kk < 8; ++kk) { const s16x8 uf = *(const LAS s16x8*)(ub + 64 * kk); acc = __builtin_amdgcn_mfma_f32_16x16x32_bf16(wf[kk], uf, acc, 0, 0, 0); }
            *(LAS f32x4*)(S + (mt * 16 + fr) * 132 + 16 * w + 4 * fq) = acc;
        }
        SSM_SYNC();
        if (w == 0) {
            for (int c0 = 0; c0 < 64; c0 += 8) { float tr[8], ti[8];
#pragma unroll
                for (int i = 0; i < 8; ++i) { tr[i] = S[(c0 + i) * 132 + lane]; ti[i] = S[(c0 + i) * 132 + 64 + lane]; }
#pragma unroll
                for (int i = 0; i < 8; ++i) { S[(c0 + i) * 132 + lane] = sr; S[(c0 + i) * 132 + 64 + lane] = si;
                    const float nsr = a16r * sr - a16i * si + tr[i], nsi = a16r * si + a16i * sr + ti[i]; sr = nsr; si = nsi; } }
        }
        SSM_SYNC();
#pragma unroll
        for (int mt = 0; mt < 4; ++mt) {
            const int chunk = q * 64 + mt * 16 + fr;
            const LAS unsigned char* ub = UQ + (mt * 16 + fr) * 528 + fq * 16;
            f32x4 accl = {0.f, 0.f, 0.f, 0.f}, acch = {0.f, 0.f, 0.f, 0.f};
#pragma unroll
            for (int kk = 0; kk < 8; ++kk) { const s16x8 uf = *(const LAS s16x8*)(ub + 64 * kk);
                if (kk < 4) accl = __builtin_amdgcn_mfma_f32_16x16x32_bf16(kfl[kk], uf, accl, 0, 0, 0);
                acch = __builtin_amdgcn_mfma_f32_16x16x32_bf16(kfh[kk], uf, acch, 0, 0, 0); }
#pragma unroll
            for (int kk = 0; kk < 4; ++kk) { const LAS float* sp = S + (mt * 16 + fr) * 132 + 32 * kk + 8 * fq; const f32x4 s0 = *(const LAS f32x4*)sp, s1 = *(const LAS f32x4*)(sp + 4);
                const s16x8 sf = __builtin_bit_cast(s16x8, pg8::pack8(s0, s1));
                accl = __builtin_amdgcn_mfma_f32_16x16x32_bf16(vfl[kk], sf, accl, 0, 0, 0); acch = __builtin_amdgcn_mfma_f32_16x16x32_bf16(vfh[kk], sf, acch, 0, 0, 0); }
            const size_t tok = (size_t)b * SEQ + (size_t)chunk * 16;
            { typedef unsigned u32x2 __attribute__((ext_vector_type(2)));
              u32x2 o; o.x = pg8::cvt_pk_bf16(gelu_tanh(accl[0]), gelu_tanh(accl[1])); o.y = pg8::cvt_pk_bf16(gelu_tanh(accl[2]), gelu_tanh(accl[3]));
              *(u32x2*)((char*)YG + PG8_AOFF(tok + tl, g * 16 + 4 * fq, 2048)) = o;
              o.x = pg8::cvt_pk_bf16(gelu_tanh(acch[0]), gelu_tanh(acch[1])); o.y = pg8::cvt_pk_bf16(gelu_tanh(acch[2]), gelu_tanh(acch[3]));
              *(u32x2*)((char*)YG + PG8_AOFF(tok + th, g * 16 + 4 * fq, 2048)) = o; }
        }
        SSM_SYNC();
    }
#undef SSM_SYNC
}

struct Args { const float* in[N_IN]; float* out; unsigned char* ws; int ph_lo, ph_hi; };
__global__ void __launch_bounds__(NWAVES * 64, 2) hymba_fwd(Args args) {
    extern __shared__ __attribute__((aligned(16))) unsigned char lds[];
    Frame F;
    F.lds = (LAS unsigned char*)lds;
    F.MISC = (volatile LAS unsigned*)(F.lds + MISC_OFF);
    F.tid = threadIdx.x; F.lane = F.tid & 63; F.wave = __builtin_amdgcn_readfirstlane(F.tid >> 6);
    F.G = gridDim.x; { const int bx = blockIdx.x; F.vcu = (F.G % 8 == 0) ? (bx % 8) * (F.G / 8) + bx / 8 : bx; }
    F.in = args.in; F.out = args.out; F.ws = args.ws;
    unsigned char* ws = args.ws;
    F.ctl = (gu32*)(ws + WS_CTL);
    for (int u = F.tid; u < (LDS_BYTES - LDSCTL_OFF) / 4; u += NWAVES * 64) ((LAS unsigned*)(F.lds + LDSCTL_OFF))[u] = 0u;
    __syncthreads();
    XcdBarrier bar; bar.bar = (unsigned*)(F.ctl + CW_BAR); bar.x = 0; bar.st = nullptr;
    if (!MK_PER_PHASE) bar = xcd_barrier_post((unsigned*)(F.ctl + CW_BAR), F.MISC + 8);
#ifndef REP_BAR
#define REP_BAR 1
#endif
#define GRID_BAR() do { if (MK_PER_PHASE) { if (F.tid == 0) __hip_atomic_store(F.ctl + 0, 0xBADBA0u, RLX_AGENT); } else { for (int rb_ = 0; rb_ < REP_BAR; ++rb_) xcd_barrier(bar); } } while (0)
    const int lo = args.ph_lo, hi = args.ph_hi;
#define IN(k) (lo <= (k) && (k) < hi)
#define BOTH(k) (IN(k) && IN((k) + 1))
    pg8::ssq_t* const ssq = (pg8::ssq_t*)(ws + WS_CTL + SSQ_OFF);
    pg8::bf16_t* const HB = (pg8::bf16_t*)(ws + WS_HB); pg8::bf16_t* const QKV = (pg8::bf16_t*)(ws + WS_QKV); pg8::bf16_t* const UT = (pg8::bf16_t*)(ws + WS_UT);
    pg8::bf16_t* const YG = (pg8::bf16_t*)(ws + WS_YG); pg8::bf16_t* const CAT = (pg8::bf16_t*)(ws + WS_CAT); pg8::bf16_t* const HID = (pg8::bf16_t*)(ws + WS_HID);

#ifndef REP_PRO
#define REP_PRO 1
#endif
#ifndef REP_SSM
#define REP_SSM 1
#endif
#ifndef REP_ATT
#define REP_ATT 1
#endif
#ifndef REP_GEMM
#define REP_GEMM 1
#endif
#ifndef REP_RES
#define REP_RES 1
#endif
    if (IN(0)) { for (int rep = 0; rep < REP_PRO; ++rep) { p0_prologue(F); __syncthreads(); } if (BOTH(0)) GRID_BAR(); }

    for (int l = 0; l < DEPTH; ++l) {
        const int pb = 1 + 6 * l;
        const unsigned char* wl = ws + WS_W + (size_t)l * W_LAYER;
        if (IN(pb)) {
            pg8::Gemm g{HB, (const pg8::bf16_t*)(wl + W_IN), M, 8192, DMODEL, A_IMG, 1}; pg8::StaticOrder S; S.init(M, 8192, F.G, (int)blockIdx.x);
            pg8::EpiProj E{QKV, UT, ssq + (2 * l) * M, attn_body::C2, ws + WS_KI, ws + WS_VI};
#ifndef STG_IN
#define STG_IN 0
#endif
            if (STG_IN && (F.vcu & 1)) { for (int s_ = 0; s_ < STG_IN; ++s_) __builtin_amdgcn_s_sleep(48); }
            for (int rep = 0; rep < REP_GEMM; ++rep) { pg8::gemm_phase<pg8::EpiProj, pg8::StaticOrder, PG8_ALIGN, PG8_SP2>(F.lds + RING_OFF, g, S, E); __syncthreads(); }
            if (BOTH(pb)) GRID_BAR();
        }
        if (IN(pb + 1)) {
            for (int rep = 0; rep < REP_SSM; ++rep) for (int u = F.vcu; u < BATCH * NGRP; u += F.G) ssm_unit(F, l, u / NGRP, u % NGRP);
            __syncthreads();
            const float lam_init = 0.8f - 0.6f * expf(-0.3f * (float)l);
            const float d1 = wave_sum(F.in[I_LQ1][l * 64 + F.lane] * F.in[I_LK1][l * 64 + F.lane]), d2 = wave_sum(F.in[I_LQ2][l * 64 + F.lane] * F.in[I_LK2][l * 64 + F.lane]);
            const float lam = expf(d1) - expf(d2) + lam_init;
            for (int rep = 0; rep < REP_ATT; ++rep) for (int pu = F.vcu; pu < 256; pu += F.G) {
                const int bh = pu >> 3, pp = pu & 7, b = bh >> 4, h = bh & 15;
#ifndef ATT_V64
                attn_body::build_lut((char*)lds + RING_OFF, F.in[I_RELB], h, F.tid);
#endif
#if defined(PROBE_ATT_QB)
                for (int xr = 0; xr < PROBE_ATT_N; ++xr) { attn_body::UnitArgs ua; ua.kind = 0; ua.qcol = h * 128 + 64; ua.kcol = 0; ua.vcol = 0; ua.ocol = h * 128;
                    ua.relb = F.in[I_RELB]; ua.scr = (float*)(ws + WS_ATT) + (size_t)F.vcu * (2 * 256 * 64); ua.lam = lam; ua.oscale = 1.0f - lam_init; ua.gain = F.in[I_SUBG] + l * 128;
                    attn_body::attn_unit<8>(b, h, PROBE_ATT_QB, (const attn_body::bf16*)QKV, (const attn_body::bf16*)(ws + WS_KI + (size_t)((bh * 2 + 1) * 64) * 8192), (const attn_body::bf16*)(ws + WS_VI + (size_t)(bh * 64) * 16384), (attn_body::bf16*)CAT, (char*)lds + RING_OFF, ua); }
#endif
#ifdef ATT_V64
                for (int qi = 0; qi < 2; ++qi) { const int qb = qi ? 15 - pp : pp;
                    for (int kind = 0; kind < 4; ++kind) { const int s2 = (kind < 2) ? 64 : 0, vh = kind & 1;
                        attn_body::UnitArgs ua; ua.kind = kind; ua.qcol = h * 128 + s2; ua.kcol = 2048 + h * 128 + s2; ua.vcol = 4096 + h * 128 + vh * 64; ua.ocol = h * 128;
#elif defined(ATT_PP)
                for (int qi = 0; qi < 2; ++qi) { const int qb = qi ? 15 - pp : pp;
                    for (int kind = 0; kind < 2; ++kind) { const int s2 = (kind < 1) ? 64 : 0;
                        attn_body::UnitArgs ua; ua.kind = kind; ua.qcol = h * 128 + s2; ua.kcol = 2048 + h * 128 + s2; ua.vcol = 4096 + h * 128; ua.ocol = h * 128;
#else
                for (int qi = 0; qi < 4; ++qi) { const int qb = (qi == 0) ? pp : (qi == 1) ? 15 - pp : (qi == 2) ? 16 + pp : 31 - pp;
                    for (int kind = 0; kind < 2; ++kind) { const int s2 = (kind < 1) ? 64 : 0;
                        attn_body::UnitArgs ua; ua.kind = kind; ua.qcol = h * 128 + s2; ua.kcol = 2048 + h * 128 + s2; ua.vcol = 4096 + h * 128; ua.ocol = h * 128;
#endif
                        ua.relb = F.in[I_RELB]; ua.scr = (float*)(ws + WS_ATT) + (size_t)F.vcu * (2 * 256 * 64); ua.lam = lam; ua.oscale = 1.0f - lam_init; ua.gain = F.in[I_SUBG] + l * 128;
                        attn_body::attn_unit<8>(b, h, qb, (const attn_body::bf16*)QKV, (const attn_body::bf16*)(ws + WS_KI + (size_t)((bh * 2 + (s2 >> 6)) * 64) * 8192), (const attn_body::bf16*)(ws + WS_VI + (size_t)(bh * 64) * 16384), (attn_body::bf16*)CAT, (char*)lds + RING_OFF, ua); } }
            }
            if (BOTH(pb + 1)) GRID_BAR();
        }
        if (IN(pb + 2)) {
            pg8::Gemm g{YG, (const pg8::bf16_t*)(wl + W_GLU), M, 2048, 2048, A_IMG, 1}; pg8::StaticOrder S; S.init(M, 2048, F.G, (int)blockIdx.x);
            pg8::EpiGlu E{YG, CAT, F.in[I_BGLU] + l * 2048};
            for (int rep = 0; rep < REP_GEMM; ++rep) { pg8::gemm_phase<pg8::EpiGlu, pg8::StaticOrder, PG8_ALIGN, PG8_SP2>(F.lds + RING_OFF, g, S, E); __syncthreads(); }
            if (BOTH(pb + 2)) GRID_BAR();
        }
        if (IN(pb + 3)) {
            pg8::Gemm g{CAT, (const pg8::bf16_t*)(wl + W_OUT), M, DMODEL, DMODEL, A_IMG, 1}; pg8::StaticOrder S; S.init(M, DMODEL, F.G, (int)blockIdx.x);
            pg8::EpiRes E{HB, ssq + (2 * l + 1) * M};
            pg8::gemm_phase<pg8::EpiRes, pg8::StaticOrder, PG8_ALIGN, PG8_SP2>(F.lds + RING_OFF, g, S, E);
            if (BOTH(pb + 3)) GRID_BAR();
        }
        if (IN(pb + 4)) {
            pg8::Gemm g{HB, (const pg8::bf16_t*)(wl + W_UP), M, FF, DMODEL, A_IMG, 1}; pg8::StaticOrder S; S.init(M, FF, F.G, (int)blockIdx.x);
            pg8::EpiUp E{HID, FF, ssq + (2 * l + 1) * M};
#ifndef STG_UP
#define STG_UP 0
#endif
#ifndef STG_UP_WAYS
#define STG_UP_WAYS 2
#endif
            if (STG_UP) { const int k_ = F.vcu & (STG_UP_WAYS - 1); for (int s_ = 0; s_ < STG_UP * k_; ++s_) __builtin_amdgcn_s_sleep(48 * 2 / STG_UP_WAYS); }
            for (int rep = 0; rep < REP_GEMM; ++rep) { pg8::gemm_phase<pg8::EpiUp, pg8::StaticOrder, PG8_ALIGN, PG8_SP2>(F.lds + RING_OFF, g, S, E); __syncthreads(); }
            if (BOTH(pb + 4)) GRID_BAR();
        }
        if (IN(pb + 5)) {
            pg8::Gemm g{HID, (const pg8::bf16_t*)(wl + W_DN), M, DMODEL, FF, A_IMG, 1}; pg8::StaticOrder S; S.init(M, DMODEL, F.G, (int)blockIdx.x);
            pg8::EpiRes E{HB, ssq + (2 * l + 2) * M};
            pg8::gemm_phase<pg8::EpiRes, pg8::StaticOrder, PG8_ALIGN, PG8_SP2>(F.lds + RING_OFF, g, S, E);
            if (BOTH(pb + 5)) GRID_BAR();
        }
    }
    if (IN(N_PHASES - 1)) {
        const int gw = F.vcu * NWAVES + F.wave, NGW = F.G * NWAVES; const float* gf = F.in[I_NFIN]; const pg8::ssq_t* sq = ssq + 8 * M;
        f32x4 gq[8][2];
#pragma unroll
        for (int j = 0; j < 8; ++j) { const int c = 8 * (F.lane + 64 * j); gq[j][0] = *(const f32x4*)(gf + c); gq[j][1] = *(const f32x4*)(gf + c + 4); }
        v4u hw[8]; pg8::ssq_t qc = 0;
        if (gw < M) { qc = sq[gw];
#pragma unroll
            for (int j = 0; j < 8; ++j) hw[j] = *(const GAS v4u*)((const GAS unsigned char*)HB + PG8_AOFF(gw, 8 * (F.lane + 64 * j), DMODEL)); }
        for (int m = gw; m < M; m += NGW) { const int mn = m + NGW; v4u hn[8]; pg8::ssq_t qn = 0;
            if (mn < M) { qn = sq[mn];
#pragma unroll
                for (int j = 0; j < 8; ++j) hn[j] = *(const GAS v4u*)((const GAS unsigned char*)HB + PG8_AOFF(mn, 8 * (F.lane + 64 * j), DMODEL)); }
            const float rs = pg8::rstd_of(qc);
#pragma unroll
            for (int j = 0; j < 8; ++j) { const int c = 8 * (F.lane + 64 * j); const v4u w = hw[j];
                const f32x4 h0 = {pg8::bf_lo(w.x), pg8::bf_hi(w.x), pg8::bf_lo(w.y), pg8::bf_hi(w.y)}, h1 = {pg8::bf_lo(w.z), pg8::bf_hi(w.z), pg8::bf_lo(w.w), pg8::bf_hi(w.w)};
                GAS f32x4* o = (GAS f32x4*)(F.out + (size_t)m * DMODEL + c); o[0] = h0 * rs * gq[j][0]; o[1] = h1 * rs * gq[j][1]; }
#pragma unroll
            for (int j = 0; j < 8; ++j) hw[j] = hn[j];
            qc = qn; }
    }
#undef IN
#undef BOTH
}

extern "C" void kernel_launch(void* const* d_in, const int* in_sizes, int n_in, void* d_out, int out_size, void* d_ws, size_t ws_size, hipStream_t stream) {
    static int grid = 0;
    if (grid == 0) {
        if (n_in != N_IN || in_sizes[0] != M * DMODEL || out_size != M * DMODEL || ws_size < WS_END) { fprintf(stderr, "kernel_launch: built for %d inputs, x/out of %d floats, >= %zu bytes of workspace; got n_in %d, in0 %d, out %d, ws %zu; nothing launched\n", (int)N_IN, M * DMODEL, (size_t)WS_END, n_in, n_in > 0 ? in_sizes[0] : -1, out_size, ws_size); grid = -1; return; }
        int dev = 0, cus = 0, per_cu = 0;
        if (hipGetDevice(&dev) != hipSuccess || hipDeviceGetAttribute(&cus, hipDeviceAttributeMultiprocessorCount, dev) != hipSuccess) { fprintf(stderr, "kernel_launch: hipGetDevice / hipDeviceGetAttribute failed; nothing launched\n"); grid = -1; return; }
        if (hipFuncSetAttribute((const void*)hymba_fwd, hipFuncAttributeMaxDynamicSharedMemorySize, LDS_BYTES) != hipSuccess) { fprintf(stderr, "kernel_launch: hipFuncSetAttribute failed\n"); grid = -1; return; }
        if (hipOccupancyMaxActiveBlocksPerMultiprocessor(&per_cu, (const void*)hymba_fwd, NWAVES * 64, LDS_BYTES) != hipSuccess || per_cu < 1)
            fprintf(stderr, "kernel_launch: note: the occupancy query reports %d workgroups per CU\n", per_cu);
        (void)hipGetLastError();
        grid = cus;
    }
    if (grid < 0) return;
    if (hipMemsetAsync((char*)d_ws + WS_CTL, 0, CTL_ZERO_BYTES, stream) != hipSuccess) { fprintf(stderr, "kernel_launch: hipMemsetAsync failed\n"); return; }
    Args a{};
    for (int i = 0; i < N_IN; ++i) a.in[i] = (const float*)d_in[i];
    a.out = (float*)d_out; a.ws = (unsigned char*)d_ws;
#if MK_PER_PHASE
    for (int ph = 0; ph < N_PHASES; ++ph) { a.ph_lo = ph; a.ph_hi = ph + 1; hipLaunchKernelGGL(hymba_fwd, dim3(grid), dim3(NWAVES * 64), LDS_BYTES, stream, a); }
#else
    a.ph_lo = 0; a.ph_hi = N_PHASES; hipLaunchKernelGGL(hymba_fwd, dim3(grid), dim3(NWAVES * 64), LDS_BYTES, stream, a);
#endif
    const hipError_t le = hipPeekAtLastError();
    if (le != hipSuccess) fprintf(stderr, "kernel_launch: launch failed: %s\n", hipGetErrorName(le));
}
```

```cpp
#define MK_PER_PHASE 0
#define A_IMG 1
#define STG_UP 2
#define PROBE_ATT_2BAR 1
#define CONV_SPLIT 1
#include <hip/hip_runtime.h>
#include <cstdio>
#include <cstdint>
#ifndef A_IMG
#define A_IMG 0
#endif
namespace pg8 {
#define PG8_LAS __attribute__((address_space(3)))
typedef unsigned short bf16_t;
typedef short bf16x8 __attribute__((ext_vector_type(8)));
typedef float f32x4 __attribute__((ext_vector_type(4)));
typedef unsigned u32x4 __attribute__((ext_vector_type(4)));
constexpr int BM = 256, BK = 64, HALF = 128, HTB = HALF * BK * 2  , STAGE_BYTES = 8 * HTB, NXCD = 8, WGM = 8;

__host__ __device__ __forceinline__ int lds_byte(int r, int c) { const int st = (r >> 4) * 2 + (c >> 5), rr = r & 15, cc = c & 31, ob = rr * 64 + cc * 2; return st * 1024 + (ob ^ (((ob >> 9) & 1) << 5)); }
__host__ __device__ __forceinline__ void stage_rc(int b, int& R, int& C) { const int st = b / 1024, sb = b % 1024, swz = sb ^ (((sb >> 9) & 1) << 5); R = (st >> 1) * 16 + swz / 64; C = (st & 1) * 32 + (swz % 64) / 2; }
__host__ __device__ __forceinline__ int perm32(int rho) { const int n = rho >> 4, i = rho & 15; return 8 * (i >> 2) + 4 * n + (i & 3); }

struct Unit { int pm, pn; };
struct Gemm { const bf16_t* A; const bf16_t* Bt; int M, N, K; int a_img, b_img; };
#define PG8_AOFF(row, col, K) (A_IMG ? pg8::img_off((int)(row), (int)(col), (K), false) : ((size_t)(row) * (size_t)(K) + (size_t)(col)) * 2)
__host__ __device__ __forceinline__ int perm32_inv(int x) { return 16 * ((x >> 2) & 1) + 4 * (x >> 3) + (x & 3); }
__host__ __device__ __forceinline__ size_t img_off(int row, int col, int K, bool permB) {
    const int r = row & 127, R = permB ? ((r & ~31) + perm32_inv(r & 31)) : r;
    return ((size_t)((row >> 8) * (K >> 6) + (col >> 6)) * 2 + ((row >> 7) & 1)) * (size_t)HTB + (size_t)lds_byte(R, col & 63); }

struct StaticOrder {
    int nM, nN, nwg, G, c;
    __host__ __device__ void init(int M, int N, int G_, int c_) { nM = M / BM; nN = N / BM; nwg = nM * nN; G = G_; c = c_; }
    __host__ __device__ bool next(int i, Unit& u) const {
        const long L = (long)i * G + c; if (L >= nwg) return false;
        int wgid = (int)L; { const int q = nwg / NXCD, r = nwg % NXCD, xcd = wgid % NXCD, off = wgid / NXCD; wgid = (xcd < r ? xcd * (q + 1) : r * (q + 1) + (xcd - r) * q) + off; }
        const int nig = WGM * nN, gid = wgid / nig, fm = gid * WGM, gsz = (nM - fm) < WGM ? (nM - fm) : WGM;
        u.pm = fm + ((wgid % nig) % gsz); u.pn = (wgid % nig) / gsz; return true;
    }
    __device__ __forceinline__ void a_ready(const Unit&) const {}
    __device__ __forceinline__ void done(const Unit&) const {}
};

__device__ __forceinline__ unsigned cvt_pk_bf16(float lo, float hi) { unsigned r; asm volatile("v_cvt_pk_bf16_f32 %0, %1, %2" : "=v"(r) : "v"(lo), "v"(hi)); return r; }
typedef float f32x2 __attribute__((ext_vector_type(2)));
__device__ __forceinline__ f32x2 gelu_pk(f32x2 v) {
    const f32x2 av = __builtin_elementwise_abs(v), d = av * 0.2316418882f + 1.0f;
    f32x2 t; t.x = __builtin_amdgcn_rcpf(d.x); t.y = __builtin_amdgcn_rcpf(d.y);
    f32x2 q = t * 0.5307027145f + (-0.7265760135f); q = q * t + 0.7107068705f; q = q * t + (-0.142248368f); q = q * t + 0.127414796f; q = q * t;
    const f32x2 s = (v * v) * (-0.72134752044f);
    f32x2 e; e.x = __builtin_amdgcn_exp2f(s.x); e.y = __builtin_amdgcn_exp2f(s.y);
    const f32x2 m = v * (q * e), r = v - m;
    f32x2 o; o.x = v.x < 0.f ? m.x : r.x; o.y = v.y < 0.f ? m.y : r.y; return o;
}

template <int ACT  > struct EpiBf16 {
    static constexpr bool PERM = true, AFTER_DRAIN = false; static_assert(ACT == 0 || ACT == 1, "EpiBf16: ACT is 0 (none) or 1 (gelu_pk)");
    bf16_t* O; int ldc; const float* bias; int split_cols; size_t split_stride; float scale0;
    __device__ __forceinline__ void operator()(const f32x4 (&acc)[2][2][4][2], const Unit& u, int wr, int wc, int fr, int fq) const {
        const int row0 = u.pm * BM + wr * 64 + fr; int colt = u.pn * BM; bf16_t* base = O;
        float sc = 1.f; if (split_cols) { const int t = colt / split_cols; base += (size_t)t * split_stride; colt -= t * split_cols; if (t == 0) sc = scale0; }
        const int col0 = colt + wc * 32 + 8 * fq, bcol0 = u.pn * BM + wc * 32 + 8 * fq;
        f32x4 bv[2][2];
#pragma unroll
        for (int bj = 0; bj < 2; ++bj)
#pragma unroll
            for (int n = 0; n < 2; ++n) bv[bj][n] = bias ? *(const f32x4*)(bias + bcol0 + bj * HALF + 4 * n) : (f32x4){0.f, 0.f, 0.f, 0.f};
#pragma unroll
        for (int ai = 0; ai < 2; ++ai)
#pragma unroll
            for (int m = 0; m < 4; ++m) { bf16_t* rowp = base + (size_t)(row0 + ai * HALF + m * 16) * ldc + col0;
#pragma unroll
                for (int bj = 0; bj < 2; ++bj) { f32x4 v0 = acc[ai][bj][m][0] + bv[bj][0], v1 = acc[ai][bj][m][1] + bv[bj][1];
                    if (ACT == 1) { f32x2 a = gelu_pk((f32x2){v0[0], v0[1]}), b = gelu_pk((f32x2){v0[2], v0[3]}), c = gelu_pk((f32x2){v1[0], v1[1]}), d = gelu_pk((f32x2){v1[2], v1[3]});
                        v0 = (f32x4){a.x, a.y, b.x, b.y}; v1 = (f32x4){c.x, c.y, d.x, d.y}; }
                    v0 = v0 * sc; v1 = v1 * sc; u32x4 w; w.x = cvt_pk_bf16(v0[0], v0[1]); w.y = cvt_pk_bf16(v0[2], v0[3]); w.z = cvt_pk_bf16(v1[0], v1[1]); w.w = cvt_pk_bf16(v1[2], v1[3]);
                    *(u32x4*)(rowp + bj * HALF) = w; } }
    }
};

__device__ __forceinline__ u32x4 pack8(f32x4 v0, f32x4 v1) { u32x4 w; w.x = cvt_pk_bf16(v0[0], v0[1]); w.y = cvt_pk_bf16(v0[2], v0[3]); w.z = cvt_pk_bf16(v1[0], v1[1]); w.w = cvt_pk_bf16(v1[2], v1[3]); return w; }
__device__ __forceinline__ float bf_lo(unsigned w) { return __uint_as_float(w << 16); }
__device__ __forceinline__ float bf_hi(unsigned w) { return __uint_as_float(w & 0xffff0000u); }
constexpr float RMS_EPS = 1e-6f;
typedef unsigned long long ssq_t;
constexpr float SSQ_SCALE = 16777216.0f, SSQ_INV = 1.0f / (16777216.0f * 4096.0f);
__device__ __forceinline__ float rstd_of(ssq_t q) { const float x = fmaf((float)(unsigned)(q >> 32), 4294967296.0f, (float)(unsigned)q); return __builtin_amdgcn_rsqf(x * SSQ_INV + RMS_EPS); }
struct EpiProj {
    static constexpr bool PERM = true, AFTER_DRAIN = false, IDEMP = true;
    bf16_t* __restrict__ QKV; bf16_t* __restrict__ UT; const ssq_t* __restrict__ ssq; float c2; unsigned char* __restrict__ KI; unsigned char* __restrict__ VI;
    __device__ __forceinline__ void operator()(const f32x4 (&acc)[2][2][4][2], const Unit& u, int wr, int wc, int fr, int fq) const {
        const int row0 = u.pm * BM + wr * 64 + fr, colt = u.pn * BM;
        const float sc = (colt < 2048) ? c2 : 1.f;
        ssq_t q[2][4];
#pragma unroll
        for (int ai = 0; ai < 2; ++ai)
#pragma unroll
            for (int m = 0; m < 4; ++m) q[ai][m] = ssq[row0 + ai * HALF + m * 16];
#pragma unroll
        for (int ai = 0; ai < 2; ++ai)
#pragma unroll
            for (int m = 0; m < 4; ++m) { const int row = row0 + ai * HALF + m * 16;
                const float rs = sc * rstd_of(q[ai][m]);
#pragma unroll
                for (int bj = 0; bj < 2; ++bj) { const int col = colt + bj * HALF + wc * 32 + 8 * fq;
                    const u32x4 w = pack8(acc[ai][bj][m][0] * rs, acc[ai][bj][m][1] * rs);
                    if (colt < 2048) *(u32x4*)(QKV + (size_t)row * 6144 + col) = w;
                    else if (colt < 4096) { const int c = col - 2048, key = row & 4095;
                        *(u32x4*)(KI + ((size_t)(((row >> 12) * 16 + (c >> 7)) * 2 + ((c >> 6) & 1)) * 64 + (key >> 6)) * 8192 + ((c & 63) >> 3) * 1024 + (key & 63) * 16) = w; }
                    else if (colt < 6144) { const int c = col - 4096, key = row & 4095, cc = c & 127;
                        *(u32x4*)(VI + ((size_t)((row >> 12) * 16 + (c >> 7)) * 64 + (key >> 6)) * 16384 + ((cc >> 5) * 4 + ((key & 63) >> 4)) * 1024 + (key & 15) * 64 + ((cc & 31) >> 3) * 16) = w; }
                    else { const int cu = col - 6144; *(u32x4*)(UT + ((size_t)(cu >> 4) * 8192 + row) * 16 + (cu & 15)) = w; } } }
    }
};
struct EpiUp {
    static constexpr bool PERM = true, AFTER_DRAIN = false, IDEMP = true;
    bf16_t* __restrict__ O; int ldc; const ssq_t* __restrict__ ssq;
    __device__ __forceinline__ void operator()(const f32x4 (&acc)[2][2][4][2], const Unit& u, int wr, int wc, int fr, int fq) const {
        const int row0 = u.pm * BM + wr * 64 + fr, colt = u.pn * BM;
        ssq_t q[2][4];
#pragma unroll
        for (int ai = 0; ai < 2; ++ai)
#pragma unroll
            for (int m = 0; m < 4; ++m) q[ai][m] = ssq[row0 + ai * HALF + m * 16];
#pragma unroll
        for (int ai = 0; ai < 2; ++ai)
#pragma unroll
            for (int m = 0; m < 4; ++m) { const int row = row0 + ai * HALF + m * 16;
                const float rs = rstd_of(q[ai][m]);
#pragma unroll
                for (int bj = 0; bj < 2; ++bj) { const int col = colt + bj * HALF + wc * 32 + 8 * fq;
                    f32x4 v0 = acc[ai][bj][m][0] * rs, v1 = acc[ai][bj][m][1] * rs;
#pragma unroll
                    for (int e = 0; e < 4; ++e) { const float a = fmaxf(v0[e], 0.f), b = fmaxf(v1[e], 0.f); v0[e] = a * a; v1[e] = b * b; }
                    *(u32x4*)((char*)O + PG8_AOFF(row, col, ldc)) = pack8(v0, v1); } }
    }
};
struct EpiGlu {
    static constexpr bool PERM = true, AFTER_DRAIN = false, IDEMP = true;
    const bf16_t* __restrict__ YG; bf16_t* __restrict__ CAT; const float* __restrict__ bias;
    __device__ __forceinline__ void operator()(const f32x4 (&acc)[2][2][4][2], const Unit& u, int wr, int wc, int fr, int fq) const {
        const int row0 = u.pm * BM + wr * 64 + fr, colt = u.pn * BM;
        f32x4 bv[2][2];
#pragma unroll
        for (int bj = 0; bj < 2; ++bj)
#pragma unroll
            for (int n = 0; n < 2; ++n) bv[bj][n] = *(const f32x4*)(bias + colt + bj * HALF + wc * 32 + 8 * fq + 4 * n);
#pragma unroll
        for (int ai = 0; ai < 2; ++ai) {
            u32x4 yw[4][2];
#pragma unroll
            for (int m = 0; m < 4; ++m)
#pragma unroll
                for (int bj = 0; bj < 2; ++bj) yw[m][bj] = *(const u32x4*)((const char*)YG + PG8_AOFF(row0 + ai * HALF + m * 16, colt + bj * HALF + wc * 32 + 8 * fq, 2048));
#pragma unroll
            for (int m = 0; m < 4; ++m) { const int row = row0 + ai * HALF + m * 16;
#pragma unroll
                for (int bj = 0; bj < 2; ++bj) { const int col = colt + bj * HALF + wc * 32 + 8 * fq; const u32x4 y = yw[m][bj];
                    f32x4 v0 = acc[ai][bj][m][0] + bv[bj][0], v1 = acc[ai][bj][m][1] + bv[bj][1];
#pragma unroll
                    for (int e = 0; e < 4; ++e) { v0[e] = __builtin_amdgcn_rcpf(1.0f + __builtin_amdgcn_exp2f(-1.4426950408889634f * v0[e])); v1[e] = __builtin_amdgcn_rcpf(1.0f + __builtin_amdgcn_exp2f(-1.4426950408889634f * v1[e])); }
                    v0[0] *= bf_lo(y.x); v0[1] *= bf_hi(y.x); v0[2] *= bf_lo(y.y); v0[3] *= bf_hi(y.y);
                    v1[0] *= bf_lo(y.z); v1[1] *= bf_hi(y.z); v1[2] *= bf_lo(y.w); v1[3] *= bf_hi(y.w);
                    *(u32x4*)((char*)CAT + PG8_AOFF(row, 2048 + col, 4096)) = pack8(v0, v1); } }
            asm volatile("" ::: "memory"); }
    }
};
struct EpiRes {
    static constexpr bool PERM = true, AFTER_DRAIN = false, IDEMP = false;
    bf16_t* HB; ssq_t* __restrict__ ssq_out;
    __device__ __forceinline__ void operator()(const f32x4 (&acc)[2][2][4][2], const Unit& u, int wr, int wc, int fr, int fq) const {
        const int row0 = u.pm * BM + wr * 64 + fr, colt = u.pn * BM;
        u32x4 b[2][4][2];
#pragma unroll
        for (int ai = 0; ai < 2; ++ai)
#pragma unroll
            for (int m = 0; m < 4; ++m)
#pragma unroll
                for (int bj = 0; bj < 2; ++bj) b[ai][m][bj] = *(const u32x4*)((const char*)HB + PG8_AOFF(row0 + ai * HALF + m * 16, colt + bj * HALF + wc * 32 + 8 * fq, 4096));
#pragma unroll
        for (int ai = 0; ai < 2; ++ai) { float sm[4];
#pragma unroll
            for (int m = 0; m < 4; ++m) { const int row = row0 + ai * HALF + m * 16; float ss = 0.f;
#pragma unroll
                for (int bj = 0; bj < 2; ++bj) { const u32x4 w = b[ai][m][bj];
                    const f32x4 h0 = (f32x4){bf_lo(w.x), bf_hi(w.x), bf_lo(w.y), bf_hi(w.y)} + acc[ai][bj][m][0], h1 = (f32x4){bf_lo(w.z), bf_hi(w.z), bf_lo(w.w), bf_hi(w.w)} + acc[ai][bj][m][1];
                    *(u32x4*)((char*)HB + PG8_AOFF(row, colt + bj * HALF + wc * 32 + 8 * fq, 4096)) = pack8(h0, h1);
                    ss += (h0[0] * h0[0] + h0[1] * h0[1]) + (h0[2] * h0[2] + h0[3] * h0[3]) + (h1[0] * h1[0] + h1[1] * h1[1]) + (h1[2] * h1[2] + h1[3] * h1[3]); }
                ss += __shfl_xor(ss, 16); ss += __shfl_xor(ss, 32); sm[m] = ss; }
            const float mine = fq == 0 ? sm[0] : fq == 1 ? sm[1] : fq == 2 ? sm[2] : sm[3];
            __hip_atomic_fetch_add(ssq_out + row0 + ai * HALF + fq * 16, (ssq_t)(mine * SSQ_SCALE), __ATOMIC_RELAXED, __HIP_MEMORY_SCOPE_AGENT);
            asm volatile("" ::: "memory"); }
    }
};

template <class Epi, class Sched, bool ALIGN_EPI = false, bool SP2 = false>
__device__ __forceinline__ void gemm_phase(PG8_LAS unsigned char* lds, const Gemm g, const Sched& S, const Epi& E) {
    int tid_ = threadIdx.x; asm volatile("" : "+v"(tid_));
    const int tid = tid_, wid = __builtin_amdgcn_readfirstlane(tid >> 6), lane = tid & 63, wr = wid >> 2, wc = wid & 3, fr = lane & 15, fq = lane >> 4;
    const int K = g.K, nt = K / BK;
    unsigned voffA[2], voffB[2];
#pragma unroll
    for (int i = 0; i < 2; ++i) { int R, C; stage_rc(tid * 16 + i * 8192, R, C); const int Rb = Epi::PERM ? ((R & ~31) + perm32(R & 31)) : R;
        voffA[i] = g.a_img ? (unsigned)(tid * 16 + i * 8192) : (unsigned)(R * K + C) * 2u; voffB[i] = g.b_img ? (unsigned)(tid * 16 + i * 8192) : (unsigned)(Rb * K + C) * 2u; }
    const size_t kstA = g.a_img ? (size_t)2 * HTB : (size_t)(BK * 2), hstA = g.a_img ? (size_t)HTB : (size_t)HALF * K * 2, tstA = g.a_img ? (size_t)nt * 2 * HTB : (size_t)2 * HALF * K * 2;
    const size_t kstB = g.b_img ? (size_t)2 * HTB : (size_t)(BK * 2), hstB = g.b_img ? (size_t)HTB : (size_t)HALF * K * 2, tstB = g.b_img ? (size_t)nt * 2 * HTB : (size_t)2 * HALF * K * 2;
    const unsigned ldsw = (unsigned)wid * 1024u;
    const int aoff = lds_byte(wr * 64 + fr, fq * 8), boff = lds_byte(wc * 32 + fr, fq * 8);
#define PG8_SA(b, h) (((b) * 2 + (h)) * HTB)
#define PG8_SB(b, h) ((4 + (b) * 2 + (h)) * HTB)
#define PG8_STAGE(bufoff, rs, goff, voff) do { _Pragma("unroll") for (int _i = 0; _i < 2; ++_i) \
        __builtin_amdgcn_raw_ptr_buffer_load_lds(rs, (PG8_LAS unsigned*)(lds + (bufoff) + ldsw + _i * 8192), 16, (voff)[_i], (goff), 0, 0); } while (0)
#define PG8_LDA(dst, b, h) do { _Pragma("unroll") for (int m = 0; m < 4; ++m) _Pragma("unroll") for (int k = 0; k < 2; ++k) dst[m][k] = *(const PG8_LAS bf16x8*)(lds + PG8_SA(b, h) + aoff + m * 2048 + k * 1024); } while (0)
#define PG8_LDB(dst, b, h) do { _Pragma("unroll") for (int n = 0; n < 2; ++n) _Pragma("unroll") for (int k = 0; k < 2; ++k) dst[n][k] = *(const PG8_LAS bf16x8*)(lds + PG8_SB(b, h) + boff + n * 2048 + k * 1024); } while (0)
#define PG8_MMA(ai, bj, At, Bt) do { __builtin_amdgcn_s_setprio(1); _Pragma("unroll") for (int m = 0; m < 4; ++m) _Pragma("unroll") for (int n = 0; n < 2; ++n) _Pragma("unroll") for (int k = 0; k < 2; ++k) \
        acc[ai][bj][m][n] = __builtin_amdgcn_mfma_f32_16x16x32_bf16(Bt[n][k], At[m][k], acc[ai][bj][m][n], 0, 0, 0); __builtin_amdgcn_s_setprio(0); } while (0)
#define PG8_WAIT_V(n) asm volatile("s_waitcnt vmcnt(" #n ")" ::: "memory")
#define PG8_WAIT_V_SEL(flag, nrelax, nstd) asm volatile("s_cmp_lg_u32 %0, 0\n\ts_cbranch_scc1 .Lpg8r%=\n\ts_waitcnt vmcnt(" #nstd ")\n\ts_branch .Lpg8d%=\n.Lpg8r%=:\n\ts_waitcnt vmcnt(" #nrelax ")\n.Lpg8d%=:" :: "s"(flag) : "memory", "scc")
#define PG8_WAIT_L(n) asm volatile("s_waitcnt lgkmcnt(" #n ")" ::: "memory")
#ifdef PG8_BAR2
#define PG8_BAR do { __builtin_amdgcn_s_barrier(); __builtin_amdgcn_s_barrier(); } while (0)
#else
#define PG8_BAR __builtin_amdgcn_s_barrier()
#endif
#define PG8_SCHED __builtin_amdgcn_sched_barrier(0)
    Unit cur, nxt; int ui = 0;
    if (!S.next(0, cur)) return;
    f32x4 acc[2][2][4][2];
#pragma unroll
    for (int a = 0; a < 2; ++a)
#pragma unroll
        for (int b = 0; b < 2; ++b)
#pragma unroll
            for (int m = 0; m < 4; ++m)
#pragma unroll
                for (int n = 0; n < 2; ++n) acc[a][b][m][n] = (f32x4){0.f, 0.f, 0.f, 0.f};
    bf16x8 At[4][2], B0[2][2], B1[2][2];
    const __amdgpu_buffer_rsrc_t rsA = __builtin_amdgcn_make_buffer_rsrc((void*)g.A, 0, (unsigned)((size_t)g.M * K * 2), 0x00020000), rsB = __builtin_amdgcn_make_buffer_rsrc((void*)g.Bt, 0, (unsigned)((size_t)g.N * K * 2), 0x00020000);
    unsigned cA = (unsigned)((size_t)cur.pm * tstA), cB = (unsigned)((size_t)cur.pn * tstB);
    S.a_ready(cur);
    if constexpr (SP2) {
        PG8_STAGE(PG8_SB(0, 0), rsB, cB, voffB); PG8_STAGE(PG8_SB(0, 1), rsB, cB + (unsigned)hstB, voffB); PG8_STAGE(PG8_SA(0, 0), rsA, cA, voffA); PG8_STAGE(PG8_SA(0, 1), rsA, cA + (unsigned)hstA, voffA);
        if (wr == 1) PG8_BAR;
        PG8_WAIT_V(2); PG8_BAR;
        PG8_STAGE(PG8_SB(1, 0), rsB, cB + (unsigned)kstB, voffB); PG8_STAGE(PG8_SA(1, 0), rsA, cA + (unsigned)kstA, voffA); PG8_STAGE(PG8_SB(1, 1), rsB, cB + (unsigned)(hstB + kstB), voffB);
        PG8_WAIT_V(6); PG8_BAR;
    } else {
        PG8_STAGE(PG8_SB(0, 0), rsB, cB, voffB); PG8_STAGE(PG8_SA(0, 0), rsA, cA, voffA); PG8_STAGE(PG8_SB(0, 1), rsB, cB + (unsigned)hstB, voffB); PG8_STAGE(PG8_SA(0, 1), rsA, cA + (unsigned)hstA, voffA);
        if (wr == 1) PG8_BAR;
        PG8_WAIT_V(4); PG8_BAR;
        PG8_STAGE(PG8_SB(1, 0), rsB, cB + (unsigned)kstB, voffB); PG8_STAGE(PG8_SA(1, 0), rsA, cA + (unsigned)kstA, voffA); PG8_STAGE(PG8_SB(1, 1), rsB, cB + (unsigned)(hstB + kstB), voffB);
        PG8_WAIT_V(6); PG8_BAR;
    }
    for (;;) {
        const bool has_next = S.next(ui + 1, nxt);
        const unsigned nA = has_next ? (unsigned)((size_t)nxt.pm * tstA) : cA, nB = has_next ? (unsigned)((size_t)nxt.pn * tstB) : cB;
        for (int t = 0; t < nt; t += 2) {
            const bool last = (t == nt - 2);
            const unsigned a1 = cA + (unsigned)((size_t)(t + 1) * kstA);
            const unsigned a2 = last ? nA : cA + (unsigned)((size_t)(t + 2) * kstA), b2 = last ? nB : cB + (unsigned)((size_t)(t + 2) * kstB);
            const unsigned a3 = a2 + (unsigned)kstA, b3 = b2 + (unsigned)kstB;
            if (last && has_next) S.a_ready(nxt);
            if constexpr (SP2) {
            PG8_LDB(B0, 0, 0); PG8_LDB(B1, 0, 1); PG8_SCHED; PG8_LDA(At, 0, 0); PG8_STAGE(PG8_SA(1, 1), rsA, a1 + (unsigned)hstA, voffA);
            PG8_WAIT_V(8); PG8_WAIT_L(0); PG8_BAR; PG8_MMA(0, 0, At, B0); PG8_MMA(0, 1, At, B1); PG8_BAR; PG8_SCHED;
            PG8_LDA(At, 0, 1); PG8_STAGE(PG8_SB(0, 0), rsB, b2, voffB); PG8_STAGE(PG8_SB(0, 1), rsB, b2 + (unsigned)hstB, voffB); PG8_STAGE(PG8_SA(0, 0), rsA, a2, voffA);
            PG8_WAIT_V(8); PG8_WAIT_L(0); PG8_BAR; PG8_MMA(1, 0, At, B0); PG8_MMA(1, 1, At, B1); PG8_BAR; PG8_SCHED;
            PG8_LDB(B0, 1, 0); PG8_LDB(B1, 1, 1); PG8_SCHED; PG8_LDA(At, 1, 0); PG8_STAGE(PG8_SA(0, 1), rsA, a2 + (unsigned)hstA, voffA);
            PG8_WAIT_V(8); PG8_WAIT_L(0); PG8_BAR; PG8_MMA(0, 0, At, B0); PG8_MMA(0, 1, At, B1); PG8_BAR; PG8_SCHED;
            PG8_LDA(At, 1, 1); PG8_STAGE(PG8_SB(1, 0), rsB, b3, voffB); PG8_STAGE(PG8_SB(1, 1), rsB, b3 + (unsigned)hstB, voffB); PG8_STAGE(PG8_SA(1, 0), rsA, a3, voffA);
            PG8_WAIT_V(8); PG8_WAIT_L(0); PG8_BAR; PG8_MMA(1, 0, At, B0); PG8_MMA(1, 1, At, B1); PG8_BAR; PG8_SCHED;
            } else {
            PG8_LDB(B0, 0, 0); PG8_SCHED; PG8_LDA(At, 0, 0); PG8_STAGE(PG8_SA(1, 1), rsA, a1 + (unsigned)hstA, voffA);
            PG8_WAIT_L(8); PG8_BAR; PG8_WAIT_L(0); PG8_MMA(0, 0, At, B0); PG8_BAR; PG8_SCHED;
            PG8_LDB(B1, 0, 1); PG8_STAGE(PG8_SB(0, 0), rsB, b2, voffB);
            PG8_BAR; PG8_WAIT_L(0); PG8_MMA(0, 1, At, B1); PG8_BAR;
            PG8_LDA(At, 0, 1); PG8_STAGE(PG8_SA(0, 0), rsA, a2, voffA);
            PG8_BAR; PG8_WAIT_L(0); PG8_MMA(1, 0, At, B0); PG8_BAR; PG8_SCHED;
            PG8_STAGE(PG8_SB(0, 1), rsB, b2 + (unsigned)hstB, voffB);
            PG8_WAIT_V(6); PG8_BAR; PG8_MMA(1, 1, At, B1); PG8_BAR;
            PG8_LDB(B0, 1, 0); PG8_SCHED; PG8_LDA(At, 1, 0); PG8_STAGE(PG8_SA(0, 1), rsA, a2 + (unsigned)hstA, voffA);
            PG8_WAIT_L(8); PG8_BAR; PG8_WAIT_L(0); PG8_MMA(0, 0, At, B0); PG8_BAR; PG8_SCHED;
            PG8_LDB(B1, 1, 1); PG8_STAGE(PG8_SB(1, 0), rsB, b3, voffB);
            PG8_BAR; PG8_WAIT_L(0); PG8_MMA(0, 1, At, B1); PG8_BAR;
            PG8_LDA(At, 1, 1); PG8_STAGE(PG8_SA(1, 0), rsA, a3, voffA);
            PG8_BAR; PG8_WAIT_L(0); PG8_MMA(1, 0, At, B0); PG8_BAR; PG8_SCHED;
            PG8_STAGE(PG8_SB(1, 1), rsB, b3 + (unsigned)hstB, voffB);
            PG8_WAIT_V(6); PG8_BAR; PG8_MMA(1, 1, At, B1); PG8_BAR;
            }
        }
        if constexpr (ALIGN_EPI) { if (wr == 0) PG8_BAR; }
        if constexpr (!Epi::AFTER_DRAIN) { E(acc, cur, wr, wc, fr, fq);
#ifdef PROBE_EPI2
            if constexpr (Epi::IDEMP) { asm volatile("" ::: "memory"); E(acc, cur, wr, wc, fr, fq); }
#endif
            S.done(cur); }
        if (!has_next) break;
#pragma unroll
        for (int a = 0; a < 2; ++a)
#pragma unroll
            for (int b = 0; b < 2; ++b)
#pragma unroll
                for (int m = 0; m < 4; ++m)
#pragma unroll
                    for (int n = 0; n < 2; ++n) acc[a][b][m][n] = (f32x4){0.f, 0.f, 0.f, 0.f};
        cur = nxt; cA = nA; cB = nB; ++ui;
        if constexpr (ALIGN_EPI) { if (wr == 1) PG8_BAR; }
    }
    PG8_WAIT_V(0);
    if constexpr (!ALIGN_EPI) { if (wr == 0) PG8_BAR; }
    PG8_BAR;
    if constexpr (Epi::AFTER_DRAIN) { E.fused(acc, cur, wr, wc, fr, fq, lds, wid, lane); S.done(cur); }
#undef PG8_SA
#undef PG8_SB
#undef PG8_STAGE
#undef PG8_LDA
#undef PG8_LDB
#undef PG8_MMA
#undef PG8_WAIT_V
#undef PG8_WAIT_V_SEL
#undef PG8_WAIT_L
#undef PG8_BAR
#undef PG8_SCHED
}
}

#ifndef PG8_SP2
#define PG8_SP2 true
#endif
#ifndef PG8_ALIGN
#define PG8_ALIGN true
#endif
#include <hip/hip_bf16.h>
#include <cmath>
namespace attn_body {
using bf16=__hip_bfloat16;
using bf16x8=__attribute__((ext_vector_type(8)))short;
using s16x4=__attribute__((ext_vector_type(4)))short;
using f32x16=__attribute__((ext_vector_type(16)))float;
using u32x4=__attribute__((ext_vector_type(4)))unsigned;
constexpr int BATCH=2,NHEAD=16,SEQ=4096,D=64,DM=6144;
constexpr int OPITCH=4096;
constexpr int NW=8,QBLK=32,QB=QBLK*4,KVBLK=64,NQB=SEQ/QB;
constexpr int ATTN_PITCH=DM, ATTN_UNIT_ROWS=QB;
__device__ __forceinline__ int crow(int r,int hi){return (r&3)+8*(r>>2)+4*hi;}
#define SBAR() __builtin_amdgcn_sched_barrier(0)
__device__ __forceinline__ void cmask(f32x16&p0,f32x16&p1,int jb,int qrel,int hi){
  const float NEG=-INFINITY; int kb=64*jb+4*hi;
  #pragma unroll
  for(int r=0;r<16;++r){int kv=kb+(r&3)+8*(r>>2); if(kv>qrel)p0[r]=NEG; if(kv+32>qrel)p1[r]=NEG;}
}

__device__ __forceinline__ int t5_bucket(int n){ if(n<16)return n; const int st[15]={19,21,24,27,31,35,40,46,52,59,67,77,87,99,113}; int b=16;
  #pragma unroll
  for(int i=0;i<15;++i)b+=(n>=st[i])?1:0; return b; }
typedef const __attribute__((address_space(3))) float* lds_cfptr;
__device__ __forceinline__ void bmask(f32x16&p0,f32x16&p1,int jb,int qrel,int hi,lds_cfptr lut){
  const float NEG=-INFINITY; const int base=qrel-64*jb-4*hi;
  #pragma unroll
  for(int r=0;r<16;++r){const int n0=base-((r&3)+8*(r>>2)),n1=n0-32;
    const float b0=lut[n0<0?0:(n0>128?128:n0)],b1=lut[n1<0?0:(n1>128?128:n1)];
    p0[r]=(n0<0)?NEG:p0[r]+b0; p1[r]=(n1<0)?NEG:p1[r]+b1;}
}
constexpr int NSLOT=3, SLOTB=8192;
constexpr int VSLOTB=16384, NVSLOT=4;
constexpr int LDS_K=0, LDS_V=NSLOT*SLOTB, LDS_WS=NSLOT*SLOTB+NVSLOT*VSLOTB, LDS_OST=LDS_WS+NW*64*4, LDS_LUT=LDS_OST+NW*4096, LDS_BYTES=LDS_LUT+1024;
constexpr float C2=0.125f*1.4426950408889634f;
__device__ __forceinline__ void glds16(const void*gsrc,unsigned lds_dst){unsigned keep;
  asm volatile("s_mov_b32 %0, m0\n\ts_mov_b32 m0, %2\n\ts_nop 0\n\tglobal_load_lds_dwordx4 %1, off\n\ts_mov_b32 m0, %0":"=&s"(keep):"v"(gsrc),"s"(lds_dst):"memory");}
__device__ __forceinline__ float max3f(float a,float b,float c){float r;asm("v_max3_f32 %0, %1, %2, %3":"=v"(r):"v"(a),"v"(b),"v"(c));return r;}
__device__ __forceinline__ float max2f(float a,float b){float r;asm("v_max_f32_e32 %0, %1, %2":"=v"(r):"v"(a),"v"(b));return r;}
__device__ __forceinline__ float fadd_s(float a,float b){float r;asm("v_add_f32_e32 %0, %1, %2":"=v"(r):"v"(a),"v"(b));return r;}
__device__ __forceinline__ float fsub_s(float a,float b){float r;asm("v_sub_f32_e32 %0, %1, %2":"=v"(r):"v"(a),"v"(b));return r;}
typedef float f32x2_t __attribute__((ext_vector_type(2))); typedef __bf16 bf16x2_t __attribute__((ext_vector_type(2)));
__device__ __forceinline__ unsigned cvtpk_s(float lo,float hi){f32x2_t v={lo,hi};bf16x2_t b=__builtin_convertvector(v,bf16x2_t);return __builtin_bit_cast(unsigned,b);}
#ifdef PROBE_ATT_2BAR
#if PROBE_ATT_2BAR == 3
#define WAIT_BAR(N) asm volatile("s_waitcnt vmcnt(" #N ") lgkmcnt(0)\n\ts_barrier\n\ts_barrier\n\ts_barrier":::"memory")
#elif PROBE_ATT_2BAR == 2
#define WAIT_BAR(N) asm volatile("s_waitcnt vmcnt(" #N ") lgkmcnt(0)\n\ts_barrier\n\ts_nop 7\n\ts_nop 7":::"memory")
#else
#define WAIT_BAR(N) asm volatile("s_waitcnt vmcnt(" #N ") lgkmcnt(0)\n\ts_barrier\n\ts_barrier":::"memory")
#endif
#else
#define WAIT_BAR(N) asm volatile("s_waitcnt vmcnt(" #N ") lgkmcnt(0)\n\ts_barrier":::"memory")
#endif

__device__ __forceinline__ void qkt(f32x16&p0,f32x16&p1,const char*Kslot,const bf16x8*qr,const f32x16&negm,int r32,int hi){
  const char*kb=Kslot+hi*1024+r32*16;
  #pragma unroll
  for(int d0=0;d0<4;++d0){
    const bf16x8 b0=*reinterpret_cast<const bf16x8*>(kb+d0*2048);
    const bf16x8 b1=*reinterpret_cast<const bf16x8*>(kb+d0*2048+512);
    if(d0==0){p0=__builtin_amdgcn_mfma_f32_32x32x16_bf16(b0,qr[0],negm,0,0,0);p1=__builtin_amdgcn_mfma_f32_32x32x16_bf16(b1,qr[0],negm,0,0,0);}
    else{p0=__builtin_amdgcn_mfma_f32_32x32x16_bf16(b0,qr[d0],p0,0,0,0);p1=__builtin_amdgcn_mfma_f32_32x32x16_bf16(b1,qr[d0],p1,0,0,0);}}
}
typedef __attribute__((address_space(3))) const char* lds_cptr;
typedef short v4i16_t __attribute__((ext_vector_type(4)));
__device__ __forceinline__ void kload8(bf16x8*kf,lds_cptr kp){
  kf[0]=*(const __attribute__((address_space(3))) bf16x8*)(kp);      kf[1]=*(const __attribute__((address_space(3))) bf16x8*)(kp+512);
  kf[2]=*(const __attribute__((address_space(3))) bf16x8*)(kp+2048); kf[3]=*(const __attribute__((address_space(3))) bf16x8*)(kp+2560);
  kf[4]=*(const __attribute__((address_space(3))) bf16x8*)(kp+4096); kf[5]=*(const __attribute__((address_space(3))) bf16x8*)(kp+4608);
  kf[6]=*(const __attribute__((address_space(3))) bf16x8*)(kp+6144); kf[7]=*(const __attribute__((address_space(3))) bf16x8*)(kp+6656);
}
__device__ __forceinline__ void kload2(bf16x8*kf,lds_cptr kp,int j){ kf[2*j]=*(const __attribute__((address_space(3))) bf16x8*)(kp+j*2048); kf[2*j+1]=*(const __attribute__((address_space(3))) bf16x8*)(kp+j*2048+512); }
__device__ __forceinline__ s16x4 vtr(lds_cptr p){ return __builtin_bit_cast(s16x4,__builtin_amdgcn_ds_read_tr16_b64_v4i16((__attribute__((address_space(3))) v4i16_t*)p)); }
__device__ __forceinline__ void qkt1(f32x16&p0,const char*kb,const bf16x8*qr,const f32x16&negm){
  #pragma unroll
  for(int d0=0;d0<4;++d0){ const bf16x8 b0=*reinterpret_cast<const bf16x8*>(kb+d0*2048);
    if(d0==0)p0=__builtin_amdgcn_mfma_f32_32x32x16_bf16(b0,qr[0],negm,0,0,0); else p0=__builtin_amdgcn_mfma_f32_32x32x16_bf16(b0,qr[d0],p0,0,0,0);}
}
__device__ __forceinline__ void kload4(bf16x8*kf,lds_cptr kp){
  kf[0]=*(const __attribute__((address_space(3))) bf16x8*)(kp);      kf[1]=*(const __attribute__((address_space(3))) bf16x8*)(kp+2048);
  kf[2]=*(const __attribute__((address_space(3))) bf16x8*)(kp+4096); kf[3]=*(const __attribute__((address_space(3))) bf16x8*)(kp+6144);
}
__device__ __forceinline__ void kload1(bf16x8*kf,lds_cptr kp,int j){ kf[j]=*(const __attribute__((address_space(3))) bf16x8*)(kp+j*2048); }
__device__ __forceinline__ float rowmax1(const f32x16&p0){
  float a=max3f(p0[0],p0[1],p0[2]),b=max3f(p0[3],p0[4],p0[5]);
  a=max3f(a,p0[6],p0[7]);b=max3f(b,p0[8],p0[9]);a=max3f(a,p0[10],p0[11]);b=max3f(b,p0[12],p0[13]);a=max3f(a,p0[14],p0[15]);
  const float m=max2f(a,b);
  auto rr=__builtin_amdgcn_permlane32_swap(__float_as_uint(m),__float_as_uint(m),false,false);
  return max2f(__uint_as_float(rr[0]),__uint_as_float(rr[1]));
}
__device__ __forceinline__ void bmask1(f32x16&p0,int nb,lds_cfptr lut){
  #pragma unroll
  for(int r=0;r<16;++r){ int n0=nb-((r&3)+8*(r>>2)); n0=n0<-1?-1:(n0>128?128:n0); p0[r]+=lut[n0+1]; }
}
__device__ __forceinline__ void pv2(f32x16*o,int vb,bf16x8 pa0,bf16x8 pa1){
  #pragma unroll
  for(int d0=0;d0<4;++d0){s16x4 lo[2],hi[2];
    #pragma unroll
    for(int ks=0;ks<2;++ks){
      asm volatile("ds_read_b64_tr_b16 %0,%1 offset:%c2":"=&v"(lo[ks]):"v"(vb),"i"(d0*4096+ks*1024):"memory");
      asm volatile("ds_read_b64_tr_b16 %0,%1 offset:%c2":"=&v"(hi[ks]):"v"(vb),"i"(d0*4096+ks*1024+512):"memory");}
    asm volatile("s_waitcnt lgkmcnt(0)":::"memory");SBAR();
    #define PK(k) (bf16x8){lo[k][0],lo[k][1],lo[k][2],lo[k][3],hi[k][0],hi[k][1],hi[k][2],hi[k][3]}
    o[d0]=__builtin_amdgcn_mfma_f32_32x32x16_bf16(pa0,PK(0),o[d0],0,0,0);
    o[d0]=__builtin_amdgcn_mfma_f32_32x32x16_bf16(pa1,PK(1),o[d0],0,0,0);
    #undef PK
  }
}
__device__ __forceinline__ float rowmax(const f32x16&p0,const f32x16&p1){
  float a=max3f(p0[0],p0[1],p1[0]),b=max3f(p0[2],p0[3],p1[1]);a=max3f(a,p1[2],p1[3]);
  #pragma unroll
  for(int r=4;r<16;r+=4){a=max3f(a,p0[r],p0[r+1]);b=max3f(b,p0[r+2],p0[r+3]);a=max3f(a,p1[r],p1[r+1]);b=max3f(b,p1[r+2],p1[r+3]);}
  const float m=max2f(a,b);
  auto rr=__builtin_amdgcn_permlane32_swap(__float_as_uint(m),__float_as_uint(m),false,false);
  return max2f(__uint_as_float(rr[0]),__uint_as_float(rr[1]));
}
__device__ __forceinline__ void pv(f32x16*o,int vb,bf16x8 pa0,bf16x8 pa1,bf16x8 pa2,bf16x8 pa3){
  #pragma unroll
  for(int d0=0;d0<2;++d0){s16x4 lo[4],hi[4];
    #pragma unroll
    for(int ks=0;ks<4;++ks){
      asm volatile("ds_read_b64_tr_b16 %0,%1 offset:%c2":"=&v"(lo[ks]):"v"(vb),"i"(d0*4096+ks*1024):"memory");
      asm volatile("ds_read_b64_tr_b16 %0,%1 offset:%c2":"=&v"(hi[ks]):"v"(vb),"i"(d0*4096+ks*1024+512):"memory");}
    asm volatile("s_waitcnt lgkmcnt(0)":::"memory");SBAR();
    #define PK(k) (bf16x8){lo[k][0],lo[k][1],lo[k][2],lo[k][3],hi[k][0],hi[k][1],hi[k][2],hi[k][3]}
    o[d0]=__builtin_amdgcn_mfma_f32_32x32x16_bf16(pa0,PK(0),o[d0],0,0,0);
    o[d0]=__builtin_amdgcn_mfma_f32_32x32x16_bf16(pa1,PK(1),o[d0],0,0,0);
    o[d0]=__builtin_amdgcn_mfma_f32_32x32x16_bf16(pa2,PK(2),o[d0],0,0,0);
    o[d0]=__builtin_amdgcn_mfma_f32_32x32x16_bf16(pa3,PK(3),o[d0],0,0,0);
    #undef PK
  }
}

__device__ __forceinline__ void build_lut(char*shm,const float*relb,int h,int tid){
  __attribute__((address_space(3))) float* lw=(__attribute__((address_space(3))) float*)((__attribute__((address_space(3))) char*)shm+LDS_LUT);
  if(tid<129){ const int bk=t5_bucket(tid); lw[1+tid]=(relb[bk*NHEAD+h]-relb[31*NHEAD+h])*1.4426950408889634f; } else if(tid==129){ lw[0]=-INFINITY; }
}
#ifndef ATTN_STORE16
#define ATTN_STORE16(p,v) (*(u32x4*)(p)=(v))
#endif
struct UnitArgs { int kind; int qcol,kcol,vcol,ocol; const float* relb; float* scr; float lam,oscale; const float* gain; };
template<int THRL> __device__ __forceinline__ void attn_unit(int b,int h,int qb,const bf16*Q,const bf16*__restrict__ K,const bf16*__restrict__ V,bf16*O,char*shm,const UnitArgs&ua){
  int tid_=threadIdx.x; asm volatile("":"+v"(tid_)); const int tid=tid_,lane=tid&63,r32=lane&31,hi=lane>>5; const int wid=__builtin_amdgcn_readfirstlane(tid>>6);
  const int rg=wid&3,g=wid>>2;
#ifdef ATT_PRIO
  if(g)__builtin_amdgcn_s_setprio(ATT_PRIO);
#endif
  const long rowbase=(long)b*SEQ; const int q0=qb*QB;
  const bf16*Qw=Q+(rowbase+q0+rg*QBLK)*DM+ua.qcol;
  const unsigned lds0=(unsigned)(uintptr_t)shm;
  float*wsf=(float*)(shm+LDS_WS)+wid*64;
  const char*ksrc=(const char*)K+wid*1024+lane*16;
  const char*vsrc=(const char*)V+wid*1024+lane*16;
  const unsigned kdst=lds0+LDS_K+wid*1024, vdst=lds0+LDS_V+wid*1024;
  #define DMA_K(t,slot) glds16(ksrc+(long)(t)*8192,(unsigned)__builtin_amdgcn_readfirstlane(kdst+(slot)))
  #define VSL(t) (((t)&(NVSLOT-1))*VSLOTB)
  #define DMA_V(t) do{ glds16(vsrc+(long)(t)*16384,(unsigned)__builtin_amdgcn_readfirstlane(vdst+VSL(t))); glds16(vsrc+8192+(long)(t)*16384,(unsigned)__builtin_amdgcn_readfirstlane(vdst+VSL(t)+8192)); }while(0)
  const int vb0=(int)(lds0+LDS_V)+((lane>>4)&1)*32+(lane&3)*8+(4*hi+((lane&15)>>2))*64+g*2048;
  bf16x8 kf[4];
  const lds_cptr shm3=(lds_cptr)shm; const lds_cptr kp0=shm3+LDS_K+hi*1024+r32*16+g*512; const lds_cptr vp0=shm3+LDS_V+((lane>>4)&1)*32+(lane&3)*8+(4*hi+((lane&15)>>2))*64+g*2048;
  const int NTd=(q0+QB)/KVBLK, NT=NTd<4?4:NTd;
  const lds_cfptr lutp=(lds_cfptr)((lds_cptr)shm+LDS_LUT);
  DMA_K(0,0);DMA_V(0);DMA_K(1,SLOTB);
  bf16x8 qr[4];
  #pragma unroll
  for(int d0=0;d0<4;++d0)qr[d0]=*reinterpret_cast<const bf16x8*>(&Qw[(long)r32*DM+d0*16+hi*8]);
  float mhat=0.f,l_reg=0.f;f32x16 o[4];o[0]=f32x16{};o[1]=f32x16{};o[2]=f32x16{};o[3]=f32x16{};f32x16 negm=f32x16{};asm volatile("":"+v"(negm));
  const int qw=q0+rg*QBLK-32*g;
  const int qabs=q0+rg*QBLK+r32-32*g-4*hi;
  #define CMASK(P0,t) do{ if(qw-64*(t)<144)bmask1(P0,qabs-64*(t),lutp); }while(0)
  bool resc=false;
  #define START(P0) do{ const float rm=rowmax1(P0); resc=false; \
    { const float dl=(rm==-INFINITY)?0.f:rm; mhat=fadd_s(mhat,dl); \
      _Pragma("unroll") for(int r=0;r<16;++r){P0[r]=fsub_s(P0[r],dl);} \
      _Pragma("unroll") for(int r=0;r<16;++r)negm[r]=-mhat; asm volatile("":"+v"(negm)); } \
    _Pragma("unroll") for(int r=0;r<16;++r)P0[r]=__builtin_amdgcn_exp2f(P0[r]); }while(0)
  #define RESC() do{ if(resc){ asm volatile("s_waitcnt lgkmcnt(0)":::"memory"); \
      _Pragma("unroll") for(int d_=0;d_<4;++d_) _Pragma("unroll") for(int r=0;r<16;++r)o[d_][r]*=wsf[crow(r,hi)]; } }while(0)
  f32x16 pA0,pB0;
  int sl_prev=0,sl_cur=0,sl_next=SLOTB;
  #define ROT() do{sl_prev=sl_cur;sl_cur=sl_next;sl_next=(sl_next==(NSLOT-1)*SLOTB)?0:sl_next+SLOTB;}while(0)
  DMA_K(2,2*SLOTB);DMA_V(1);
  WAIT_BAR(6);
  qkt1(pA0,shm+LDS_K+hi*1024+r32*16+g*512,qr,negm);asm volatile("s_nop 15\n\ts_nop 7":"+v"(pA0));CMASK(pA0,0);
  START(pA0);
  WAIT_BAR(2);
  DMA_K(3,0);DMA_V(2);
  ROT();
  kload4(kf,kp0+sl_cur);
  WAIT_BAR(5);
  s16x4 vlo[8],vhi[8]; u32x4 pw0,pw1;
  #define PKW(P,B) cvtpk_s(P[B],P[B+1])
  #define PAF(k) __builtin_bit_cast(bf16x8,pw##k)
  #define VFR(i) (bf16x8){vlo[i][0],vlo[i][1],vlo[i][2],vlo[i][3],vhi[i][0],vhi[i][1],vhi[i][2],vhi[i][3]}
  #define PIN(x) asm volatile("":"+v"(x))
  #define MX3(a,b,c) __builtin_fmaxf(__builtin_fmaxf((a),(b)),(c))
  #define GAPA(MF,A0,A1,A2,A3,W0,W1,PW) do{ MF; sacc+=A0; sacc+=A1; sacc+=A2; sacc+=A3; PIN(sacc); W0; W1; PIN(PW); SBAR(); }while(0)
  #define EX(v) __builtin_amdgcn_exp2f(v)
  #define GAPB(MF,X,B) do{ MF; X[B]=EX(X[B]); X[B+1]=EX(X[B+1]); PIN(X); SBAR(); }while(0)
  #define VRD(w,d,k) do{ vlo[w]=vtr(vp_+((d)*4096+(k)*1024)); vhi[w]=vtr(vp_+((d)*4096+(k)*1024+512)); }while(0)
  #define KRD(G,j) do{ if(G){ kload1(kf,kp0+sl_next,j); SBAR(); } }while(0)
  #define STEP(C0,P0,t,GK,GV,GL) do{ SBAR(); \
    const lds_cptr vp_=vp0+VSL((t)-1); \
    VRD(0,0,0); VRD(1,1,0); SBAR(); float sacc=(P0[0]+P0[1]); \
    GAPA(C0=__builtin_amdgcn_mfma_f32_32x32x16_bf16(kf[0],qr[0],negm,0,0,0), P0[2],P0[3],P0[4],P0[5],     pw0[0]=PKW(P0,0), pw0[1]=PKW(P0,2), pw0); \
    VRD(2,2,0); VRD(3,3,0); SBAR(); GAPA(C0=__builtin_amdgcn_mfma_f32_32x32x16_bf16(kf[1],qr[1],C0,0,0,0), P0[6],P0[7],P0[8],P0[9],     pw0[2]=PKW(P0,4), pw0[3]=PKW(P0,6), pw0); \
    VRD(4,0,1); VRD(5,1,1); SBAR(); GAPA(C0=__builtin_amdgcn_mfma_f32_32x32x16_bf16(kf[2],qr[2],C0,0,0,0), P0[10],P0[11],P0[12],P0[13], pw1[0]=PKW(P0,8), pw1[1]=PKW(P0,10), pw1); \
    VRD(6,2,1); VRD(7,3,1); SBAR(); GAPA(C0=__builtin_amdgcn_mfma_f32_32x32x16_bf16(kf[3],qr[3],C0,0,0,0), P0[14],P0[15],0.f,0.f,       pw1[2]=PKW(P0,12),pw1[3]=PKW(P0,14), pw1); \
    l_reg+=sacc; \
    if(GK){DMA_K((t)+3,sl_cur);} if(GV){DMA_V((t)+2);} \
    CMASK(C0,t); \
    { float a=MX3(C0[0],C0[1],C0[2]),b=MX3(C0[3],C0[4],C0[5]); a=MX3(a,C0[6],C0[7]); b=MX3(b,C0[8],C0[9]); a=MX3(a,C0[10],C0[11]); b=MX3(b,C0[12],C0[13]); a=MX3(a,C0[14],C0[15]); \
      float rm=__builtin_fmaxf(a,b); { auto rr=__builtin_amdgcn_permlane32_swap(__float_as_uint(rm),__float_as_uint(rm),false,false); rm=__builtin_fmaxf(__uint_as_float(rr[0]),__uint_as_float(rr[1])); } \
      resc=false; \
      if(__builtin_expect(__any(rm>(float)THRL),0)){ const float dl=__builtin_fmaxf(rm,0.f); mhat+=dl; \
        _Pragma("unroll") for(int r=0;r<16;++r){C0[r]-=dl;} \
        _Pragma("unroll") for(int r=0;r<16;++r)negm[r]=-mhat; asm volatile("":"+v"(negm)); \
        const float f=__builtin_amdgcn_exp2f(-dl); l_reg*=f; if(hi==0)wsf[r32]=f; resc=true; } } \
    SBAR(); MIDBAR(); \
    GAPB(o[0]=__builtin_amdgcn_mfma_f32_32x32x16_bf16(PAF(0),VFR(0),o[0],0,0,0), C0,0); \
    GAPB(o[1]=__builtin_amdgcn_mfma_f32_32x32x16_bf16(PAF(0),VFR(1),o[1],0,0,0), C0,2); \
    KRD(GL,0); GAPB(o[2]=__builtin_amdgcn_mfma_f32_32x32x16_bf16(PAF(0),VFR(2),o[2],0,0,0), C0,4); \
    KRD(GL,1); GAPB(o[3]=__builtin_amdgcn_mfma_f32_32x32x16_bf16(PAF(0),VFR(3),o[3],0,0,0), C0,6); \
    KRD(GL,2); GAPB(o[0]=__builtin_amdgcn_mfma_f32_32x32x16_bf16(PAF(1),VFR(4),o[0],0,0,0), C0,8); \
    KRD(GL,3); GAPB(o[1]=__builtin_amdgcn_mfma_f32_32x32x16_bf16(PAF(1),VFR(5),o[1],0,0,0), C0,10); \
    GAPB(o[2]=__builtin_amdgcn_mfma_f32_32x32x16_bf16(PAF(1),VFR(6),o[2],0,0,0), C0,12); \
    GAPB(o[3]=__builtin_amdgcn_mfma_f32_32x32x16_bf16(PAF(1),VFR(7),o[3],0,0,0), C0,14); \
    }while(0)
#ifdef ATT_SKEW
  #define SKEW() do{ if(g)__builtin_amdgcn_s_sleep(ATT_SKEW); }while(0)
#else
  #define SKEW() do{}while(0)
#endif
#ifdef ATT_MIDBAR
  #define MIDBAR() do{ asm volatile("s_barrier":::"memory"); SBAR(); }while(0)
#else
  #define MIDBAR() do{}while(0)
#endif
  int t=1;
  #undef CMASK
  #define CMASK(P0,t) do{}while(0)
  for(;t+7<NT;t+=2){
#ifdef PROBE_ATT_STRICT
    STEP(pB0,pA0,t,true,true,true);     WAIT_BAR(2); SKEW(); RESC(); ROT();
    STEP(pA0,pB0,t+1,true,true,true);   WAIT_BAR(2); SKEW(); RESC(); ROT();
#else
    STEP(pB0,pA0,t,true,true,true);     WAIT_BAR(5); SKEW(); RESC(); ROT();
    STEP(pA0,pB0,t+1,true,true,true);   WAIT_BAR(5); SKEW(); RESC(); ROT();
#endif
  }
  #undef CMASK
  #define CMASK(P0,t) do{ if(qw-64*(t)<144)bmask1(P0,qabs-64*(t),lutp); }while(0)
  #define ENDW(tt) do{ if((tt)+3<NT){WAIT_BAR(5);} else if((tt)+2<NT){WAIT_BAR(4);} else {WAIT_BAR(0);} }while(0)
  for(;t+1<NT;t+=2){
    STEP(pB0,pA0,t,(t+3<NT),(t+2<NT),(t+1<NT));       ENDW(t);   RESC(); ROT();
    STEP(pA0,pB0,t+1,(t+4<NT),(t+3<NT),(t+2<NT));     ENDW(t+1); RESC(); ROT();
  }
  STEP(pB0,pA0,NT-1,false,false,false); RESC();
  { float sacc=pB0[0]+pB0[1]; _Pragma("unroll") for(int r=2;r<16;++r)sacc+=pB0[r]; l_reg+=sacc;
    pw0=(u32x4){PKW(pB0,0),PKW(pB0,2),PKW(pB0,4),PKW(pB0,6)};pw1=(u32x4){PKW(pB0,8),PKW(pB0,10),PKW(pB0,12),PKW(pB0,14)};
    SBAR(); pv2(o,vb0+VSL(NT-1),PAF(0),PAF(1)); }
  #undef PKW
  #undef PAF
  #undef VFR
  #undef PIN
  #undef MX3
  #undef GAPA
  #undef GAPB
  #undef EX
  #undef VRD
  #undef KRD
  #undef STEP
  #undef ENDW
  {auto rr=__builtin_amdgcn_permlane32_swap(__float_as_uint(l_reg),__float_as_uint(l_reg),false,false);l_reg=__uint_as_float(rr[0])+__uint_as_float(rr[1]);}
  asm volatile("s_waitcnt lgkmcnt(0)\n\ts_barrier":::"memory");
  typedef float f32x4v __attribute__((ext_vector_type(4)));
  float*xs=(float*)shm+rg*(64*64+64)+64*64;
  f32x4v*xo4=(f32x4v*)((float*)shm+rg*(64*64+64));
  if(g==1){
    #pragma unroll
    for(int d0=0;d0<4;++d0){
      #pragma unroll
      for(int r4=0;r4<4;++r4)xo4[(d0*4+r4)*64+lane]=(f32x4v){o[d0][4*r4],o[d0][4*r4+1],o[d0][4*r4+2],o[d0][4*r4+3]};}
    if(hi==0){xs[r32]=mhat;xs[32+r32]=l_reg;}
  }
  asm volatile("s_waitcnt lgkmcnt(0)\n\ts_barrier":::"memory");
  if(g==0){
    const float mb=xs[r32],lb=xs[32+r32];
    const float m=(lb>0.f)?__builtin_fmaxf(mhat,mb):mhat,wa=__builtin_amdgcn_exp2f(mhat-m),wb=(lb>0.f)?__builtin_amdgcn_exp2f(mb-m):0.f;
    const float linv=__builtin_amdgcn_rcpf(l_reg*wa+lb*wb);
    if(hi==0){wsf[r32]=wa*linv;wsf[32+r32]=wb*linv;}
    f32x4v*sc4=(f32x4v*)ua.scr+(rg*16)*64+lane;
    f32x4v t2[16];
    if(ua.kind!=0){
      #pragma unroll
      for(int i=0;i<16;++i)t2[i]=__builtin_nontemporal_load(sc4+i*64);
    }
    asm volatile("s_waitcnt lgkmcnt(0)":::"memory");
    #pragma unroll
    for(int r4=0;r4<4;++r4){ const f32x4v fa=*(const f32x4v*)(wsf+8*r4+4*hi),fb=*(const f32x4v*)(wsf+32+8*r4+4*hi);
      #pragma unroll
      for(int d0=0;d0<4;++d0){ const f32x4v ob=xo4[(d0*4+r4)*64+lane];
        #pragma unroll
        for(int j=0;j<4;++j)o[d0][4*r4+j]=o[d0][4*r4+j]*fa[j]+ob[j]*fb[j]; } }
    if(ua.kind==0){
      #pragma unroll
      for(int d0=0;d0<4;++d0){
        #pragma unroll
        for(int r4=0;r4<4;++r4)sc4[(d0*4+r4)*64]=(f32x4v){o[d0][4*r4],o[d0][4*r4+1],o[d0][4*r4+2],o[d0][4*r4+3]};} }
    else{
      float rs[16];
      #pragma unroll
      for(int r=0;r<16;++r){ float ss=0.f;
        #pragma unroll
        for(int d0=0;d0<4;++d0){const float a=o[d0][r]-ua.lam*t2[d0*4+(r>>2)][r&3]; o[d0][r]=a; ss+=a*a;}
        ss+=__shfl_xor(ss,1); ss+=__shfl_xor(ss,2); ss+=__shfl_xor(ss,4); ss+=__shfl_xor(ss,8); ss+=__shfl_xor(ss,16);
        rs[r]=ua.oscale*__builtin_amdgcn_rsqf(ss*(1.0f/128.0f)+1e-6f); }
      bf16*stg=(bf16*)(shm+LDS_OST)+wid*2048;
      #pragma unroll
      for(int vh=0;vh<2;++vh){
        const float g0=ua.gain[vh*64+r32],g1=ua.gain[vh*64+32+r32];
        #pragma unroll
        for(int r=0;r<16;++r){const int orow=crow(r,hi);
          stg[orow*64+r32]=__float2bfloat16(o[2*vh][r]*rs[r]*g0);
          stg[orow*64+32+r32]=__float2bfloat16(o[2*vh+1][r]*rs[r]*g1);}
        asm volatile("s_waitcnt lgkmcnt(0)":::"memory");
        #pragma unroll
        for(int i=0;i<4;++i){const int row=i*8+(lane>>3),ch=lane&7; const u32x4 v=*(const u32x4*)(stg+row*64+ch*8); ATTN_STORE16((char*)O+PG8_AOFF(rowbase+q0+rg*QBLK+row,ua.ocol+vh*64+ch*8,OPITCH),v);}
        asm volatile("s_waitcnt lgkmcnt(0)":::"memory");
      } }
  }
#ifdef ATT_PRIO
  __builtin_amdgcn_s_setprio(0);
#endif
  asm volatile("s_waitcnt lgkmcnt(0)\n\ts_barrier":::"memory");
  #undef DMA_K
  #undef DMA_V
  #undef VSL
  #undef CMASK
  #undef START
  #undef RESC
  #undef ROT
}
constexpr int ATTN_LDS_BYTES=LDS_BYTES;
#undef SBAR
#undef WAIT_BAR
}

constexpr int NWAVES = 8;
#ifndef MK_PER_PHASE
#define MK_PER_PHASE 0
#endif
constexpr int BATCH = 2, SEQ = 4096, DMODEL = 4096, M = BATCH * SEQ, DEPTH = 4, FF = 16384, NGRP = 128;
constexpr int N_PHASES = 2 + 6 * DEPTH;
constexpr size_t MiB = 1u << 20;
constexpr size_t WS_CTL = 0, CTL_ZERO_BYTES = 1 * MiB;
constexpr int CW_BAR = 4096;
constexpr size_t SSQ_OFF = 128 * 1024;
static_assert(SSQ_OFF + 9 * (size_t)M * 8 <= CTL_ZERO_BYTES, "ssq inside the memset region");
constexpr size_t WS_W = 16 * MiB, W_LAYER = 360 * MiB;
constexpr size_t W_IN = 0, W_OUT = 64 * MiB, W_UP = 96 * MiB, W_DN = 224 * MiB, W_GLU = 352 * MiB;
constexpr size_t WS_SSMP = WS_W + DEPTH * W_LAYER;
constexpr size_t SSMP_STRIDE = 144 * 1024;
constexpr size_t WS_KI = 1536 * MiB, WS_VI = 1568 * MiB;
constexpr size_t WS_H = 1536 * MiB, WS_HB = 1664 * MiB, WS_QKV = 1728 * MiB, WS_UT = 1824 * MiB, WS_YG = 1856 * MiB, WS_CAT = 1888 * MiB, WS_ATT = 1952 * MiB, WS_HID = 1984 * MiB, WS_END = 2240 * MiB;
static_assert(WS_SSMP + (size_t)DEPTH * NGRP * SSMP_STRIDE <= WS_H, "d_ws map");
constexpr int RING_OFF = 0, RING_BYTES = 131072;
constexpr int LDSCTL_OFF = RING_BYTES, MISC_OFF = LDSCTL_OFF + 320;
constexpr int LDS_BYTES = 147456;
static_assert(MISC_OFF + 128 <= LDS_BYTES, "LDS map");

#define GAS __attribute__((address_space(1)))
#define LAS __attribute__((address_space(3)))
typedef unsigned short bf16;
typedef unsigned v4u __attribute__((ext_vector_type(4)));
typedef float f32x4 __attribute__((ext_vector_type(4)));
typedef short bf16x8 __attribute__((ext_vector_type(8)));
typedef GAS unsigned gu32;
typedef GAS unsigned long long gu64;
#define RLX_AGENT __ATOMIC_RELAXED, __HIP_MEMORY_SCOPE_AGENT
#define LDS_WAIT() asm volatile("s_waitcnt lgkmcnt(0)" ::: "memory")
#define VM_WAIT() asm volatile("s_waitcnt vmcnt(0)" ::: "memory")
__device__ __forceinline__ unsigned long long rt() { return __builtin_amdgcn_s_memrealtime(); }
__device__ __forceinline__ unsigned f2bf(float f) { unsigned u = __builtin_bit_cast(unsigned, f); return (u + 0x7fffu + ((u >> 16) & 1u)) >> 16; }
__device__ __forceinline__ unsigned pk2(float lo, float hi) { return f2bf(lo) | (f2bf(hi) << 16); }

#define XB_TMO      128
#define XB_XCNT(j)  (256  + 64 * (j))
#define XB_XSUB(j)  (1280 + 64 * (j))
#define XB_XGEN(j)  (2304 + 64 * (j))
#define XB_TOP      3328
#define XB_TOPGEN   3392
#define XCD_BAR_WORDS 3456
#define XB_SPIN_CAP (1u << 18)

__device__ __forceinline__ unsigned xb_ld(unsigned* p)              { return __hip_atomic_load(p, __ATOMIC_RELAXED, __HIP_MEMORY_SCOPE_AGENT); }
__device__ __forceinline__ unsigned xb_add(unsigned* p, unsigned v) { return __hip_atomic_fetch_add(p, v, __ATOMIC_RELAXED, __HIP_MEMORY_SCOPE_AGENT); }
__device__ __forceinline__ unsigned xb_xcc_id() { return (unsigned)__builtin_amdgcn_s_getreg((3 << 11) | 20) & 0xFu; }
#define XB_SPIN(cond, bar) do { unsigned _sp = 0; while (cond) { __builtin_amdgcn_s_sleep(1); \
    if ((++_sp & 255u) == 0u) { if (xb_ld(&(bar)[XB_TMO])) break; if (_sp > XB_SPIN_CAP) { atomicAdd(&(bar)[XB_TMO], 1u); break; } } } } while (0)

struct XcdBarrier {
    unsigned* bar; unsigned x;
    volatile LAS unsigned* st;
};

__device__ __forceinline__ XcdBarrier xcd_barrier_post(unsigned* bar, volatile LAS unsigned* st) {
    XcdBarrier b; b.bar = bar; b.x = xb_xcc_id(); b.st = st;
    if (threadIdx.x == 0) (void)xb_add(&bar[XB_XCNT(b.x)], 1u);
    return b;
}
__device__ __forceinline__ void xcd_barrier_complete(unsigned* bar, unsigned x, unsigned& nloc, unsigned& nx) {
    const unsigned G = gridDim.x * gridDim.y * gridDim.z;
    unsigned sum, cnt, mine, sp = 0u;
    for (;;) {
        sum = 0u; cnt = 0u; mine = 0u;
#pragma unroll
        for (unsigned j = 0; j < 16; ++j) { const unsigned c = xb_ld(&bar[XB_XCNT(j)]); sum += c; cnt += (c > 0u) ? 1u : 0u; mine = (j == x) ? c : mine; }
        if (sum == G) break;
        __builtin_amdgcn_s_sleep(1);
        if ((++sp & 255u) == 0u) { if (xb_ld(&bar[XB_TMO])) break; if (sp > XB_SPIN_CAP) { atomicAdd(&bar[XB_TMO], 1u); break; } }
    }
    nloc = mine > 0u ? mine : 1u; nx = cnt > 0u ? cnt : 1u;
}

__device__ __forceinline__ void xcd_barrier(const XcdBarrier& b) {
    asm volatile("s_waitcnt vmcnt(0)" ::: "memory");
    __syncthreads();
    if (threadIdx.x == 0) {
        unsigned* bar = b.bar;
        __builtin_amdgcn_s_waitcnt(0);
        unsigned nloc = b.st[0], nx = b.st[1];
        if (nloc == 0u) { xcd_barrier_complete(bar, b.x, nloc, nx); b.st[0] = nloc; b.st[1] = nx; }
        const unsigned old = xb_add(&bar[XB_XSUB(b.x)], 1u);
        const unsigned gen = old / nloc;
        if (old + 1u == (gen + 1u) * nloc) {
            __builtin_amdgcn_fence(__ATOMIC_RELEASE, "agent");
            asm volatile("s_waitcnt vmcnt(0)" ::: "memory");
            const unsigned og = xb_add(&bar[XB_TOP], 1u);
            const unsigned tg = og / nx;
            if (og + 1u == (tg + 1u) * nx) xb_add(&bar[XB_TOPGEN], 1u);
            else XB_SPIN(xb_ld(&bar[XB_TOPGEN]) == tg, bar);
            __builtin_amdgcn_fence(__ATOMIC_ACQUIRE, "agent");
            xb_add(&bar[XB_XGEN(b.x)], 1u);
            asm volatile("s_waitcnt vmcnt(0)" ::: "memory");
        } else {
            XB_SPIN(xb_ld(&bar[XB_XGEN(b.x)]) == gen, bar);
            __builtin_amdgcn_fence(__ATOMIC_ACQUIRE, "agent");
            asm volatile("s_waitcnt vmcnt(0)" ::: "memory");
        }
    }
    __syncthreads();
}

struct Frame {
    LAS unsigned char* lds;
    volatile LAS unsigned* MISC;
    gu32* ctl;
    int tid, lane, wave;
    int vcu, G;
    const float* const* in;
    float* out; unsigned char* ws;
};
enum In { I_X = 0, I_WIN, I_WOUT, I_NMIX, I_NMLP, I_WUP, I_WDN, I_NFIN, I_RELB, I_LQ1, I_LK1, I_LQ2, I_LK2, I_SUBG, I_SLRE, I_SLIM, I_SLDT, I_SBRE, I_SBIM, I_SCRE, I_SCIM, I_SD, I_WGLU, I_BGLU, N_IN };

__device__ __forceinline__ float wave_sum(float v) {
#pragma unroll
    for (int o = 1; o < 64; o <<= 1) v += __shfl_xor(v, o);
    return v;
}
struct TItem { const float* src; const float* gain; bf16* dst; int N, K, n0, k0; };
struct TRegs { f32x4 v[8]; f32x4 g0, g1; };
__device__ __forceinline__ void tr_load(const TItem& t, TRegs& r, int lane) {
    const float* p = t.src + (size_t)(lane >> 4) * t.N + 4 * (lane & 15);
#pragma unroll
    for (int i = 0; i < 8; ++i) r.v[i] = *(const f32x4*)(p + (size_t)(4 * i) * t.N);
    if (t.gain) { r.g0 = *(const f32x4*)(t.gain + 8 * (lane >> 4)); r.g1 = *(const f32x4*)(t.gain + 8 * (lane >> 4) + 4); } else { r.g0 = (f32x4){1.f, 1.f, 1.f, 1.f}; r.g1 = r.g0; }
}
__device__ __forceinline__ void tr_store(const TItem& t, const TRegs& r, LAS float* scr, int lane) {
#pragma unroll
    for (int i = 0; i < 8; ++i) { LAS float* d = scr + (4 * i + (lane >> 4)) * 65 + 4 * (lane & 15); d[0] = r.v[i].x; d[1] = r.v[i].y; d[2] = r.v[i].z; d[3] = r.v[i].w; }
    LDS_WAIT(); asm volatile("" ::: "memory");
    const int c4 = lane >> 4;
#pragma unroll
    for (int j = 0; j < 4; ++j) { const int R = 16 * j + (lane & 15), nl = (R & ~31) + pg8::perm32(R & 31);
        const LAS float* s = scr + (8 * c4) * 65 + nl;
        v4u o; o.x = pg8::cvt_pk_bf16(s[0 * 65] * r.g0.x, s[1 * 65] * r.g0.y); o.y = pg8::cvt_pk_bf16(s[2 * 65] * r.g0.z, s[3 * 65] * r.g0.w); o.z = pg8::cvt_pk_bf16(s[4 * 65] * r.g1.x, s[5 * 65] * r.g1.y); o.w = pg8::cvt_pk_bf16(s[6 * 65] * r.g1.z, s[7 * 65] * r.g1.w);
        *(GAS v4u*)((GAS unsigned char*)t.dst + pg8::img_off(t.n0 + nl, t.k0 + 8 * c4, t.K, true)) = o; }
    LDS_WAIT(); asm volatile("" ::: "memory");
}
__device__ __forceinline__ void ssm_setup_unit(Frame& F, int l, int g) {
    LAS float* apr = (LAS float*)(F.lds + RING_OFF); LAS float* api = apr + 17 * 64; LAS float* bbr = api + 17 * 64; LAS float* bbi = bbr + 1024;
    LAS float* cr = bbi + 1024; LAS float* ci = cr + 1024; LAS float* gg = ci + 1024;
    const int lg = l * NGRP + g, tid = F.tid;
    bf16* P = (bf16*)(F.ws + WS_SSMP + (size_t)lg * SSMP_STRIDE); bf16* WmT = P; bf16* VmT = P + 32768; bf16* Kt = P + 65536; float* A16 = (float*)(P + 65536 + 17 * 256);
    if (tid < 64) { const int p = tid;
        const float dt = expf(F.in[I_SLDT][lg]), lr = F.in[I_SLRE][lg * 64 + p], li = F.in[I_SLIM][lg * 64 + p];
        const float mag = expf(lr * dt), th = li * dt, ar = mag * cosf(th), ai = mag * sinf(th);
        float pr = 1.f, pi = 0.f;
        for (int tau = 0; tau <= 16; ++tau) { apr[tau * 64 + p] = pr; api[tau * 64 + p] = pi; const float npr = pr * ar - pi * ai, npi = pr * ai + pi * ar; pr = npr; pi = npi; }
        const float den = lr * lr + li * li, nr = ar - 1.0f, ni = ai;
        gg[p] = (nr * lr + ni * li) / den; gg[64 + p] = (ni * lr - nr * li) / den; }
    __syncthreads();
    if (tid < 64) { A16[2 * tid] = apr[16 * 64 + tid]; A16[2 * tid + 1] = api[16 * 64 + tid]; }
    for (int idx = tid; idx < 1024; idx += NWAVES * 64) { const int p = idx >> 4;
        const float br = F.in[I_SBRE][(size_t)lg * 1024 + idx], bi = F.in[I_SBIM][(size_t)lg * 1024 + idx], gr = gg[p], gi = gg[64 + p];
        bbr[idx] = gr * br - gi * bi; bbi[idx] = gr * bi + gi * br;
        cr[idx] = F.in[I_SCRE][(size_t)lg * 1024 + idx]; ci[idx] = F.in[I_SCIM][(size_t)lg * 1024 + idx]; }
    __syncthreads();
    for (int e = tid; e < 32768; e += NWAVES * 64) { const int pp = e >> 8, k = e & 255, p = pp & 63, j = k >> 4, hh = k & 15, tau = 15 - j;
        const float ar = apr[tau * 64 + p], ai = api[tau * 64 + p], br = bbr[p * 16 + hh], bi = bbi[p * 16 + hh];
        WmT[e] = (bf16)f2bf(pp < 64 ? ar * br - ai * bi : ar * bi + ai * br); }
    for (int e = tid; e < 32768; e += NWAVES * 64) { const int n = e >> 7, pp = e & 127, p = pp & 63, t = n >> 4, hh = n & 15;
        const float ar = apr[(t + 1) * 64 + p], ai = api[(t + 1) * 64 + p], c_r = cr[hh * 64 + p], c_i = ci[hh * 64 + p];
        VmT[e] = (bf16)f2bf(pp < 64 ? c_r * ar - c_i * ai : -(c_r * ai + c_i * ar)); }
    for (int e = tid; e < 256; e += NWAVES * 64) Kt[e] = 0;
    for (int e = tid; e < 4096; e += NWAVES * 64) { const int tau = e >> 8, hh = (e >> 4) & 15, h2 = e & 15; float acc = 0.f;
        for (int p = 0; p < 64; ++p) { const float ar = apr[tau * 64 + p], ai = api[tau * 64 + p], c_r = cr[hh * 64 + p], c_i = ci[hh * 64 + p];
            const float xr = c_r * ar - c_i * ai, xi = c_r * ai + c_i * ar; acc += xr * bbr[p * 16 + h2] - xi * bbi[p * 16 + h2]; }
        if (tau == 0 && hh == h2) acc += F.in[I_SD][lg * 16 + hh];
        Kt[256 + e] = (bf16)f2bf(acc); }
    __syncthreads();
}
constexpr int IT_IN = (DMODEL / 64) * (8192 / 32), IT_OUT = (DMODEL / 64) * (DMODEL / 32), IT_UP = (DMODEL / 64) * (FF / 32), IT_DN = (FF / 64) * (DMODEL / 32), IT_GLU = (2048 / 64) * (2048 / 32);
constexpr int IT_LAYER = IT_IN + IT_OUT + IT_UP + IT_DN + IT_GLU;
#ifndef CONV_SPLIT
#define CONV_SPLIT 0
#endif
__device__ __forceinline__ void convert_items(Frame& F, int it_lo, int it_hi, int gw, int ngw) {
    int lane_ = F.lane; asm volatile("" : "+v"(lane_)); const int lane = lane_;
    LAS float* scr = (LAS float*)(F.lds + RING_OFF + F.wave * 16384);
    auto decode = [&](int it, TItem& t) {
        const int l = it / IT_LAYER; int r = it % IT_LAYER;
        unsigned char* wl = F.ws + WS_W + (size_t)l * W_LAYER;
        const float* W; const float* gain = nullptr; bf16* WT; int K, N;
        if (r < IT_IN) { W = F.in[I_WIN] + (size_t)l * DMODEL * 8192; K = DMODEL; N = 8192; gain = F.in[I_NMIX] + l * DMODEL; WT = (bf16*)(wl + W_IN); }
        else if ((r -= IT_IN) < IT_OUT) { W = F.in[I_WOUT] + (size_t)l * DMODEL * DMODEL; K = DMODEL; N = DMODEL; WT = (bf16*)(wl + W_OUT); }
        else if ((r -= IT_OUT) < IT_UP) { W = F.in[I_WUP] + (size_t)l * DMODEL * FF; K = DMODEL; N = FF; gain = F.in[I_NMLP] + l * DMODEL; WT = (bf16*)(wl + W_UP); }
        else if ((r -= IT_UP) < IT_DN) { W = F.in[I_WDN] + (size_t)l * FF * DMODEL; K = FF; N = DMODEL; WT = (bf16*)(wl + W_DN); }
        else { r -= IT_DN; W = F.in[I_WGLU] + (size_t)l * 2048 * 2048; K = 2048; N = 2048; WT = (bf16*)(wl + W_GLU); }
        const int nblk = N / 64, k0 = 32 * (r / nblk), n0 = 64 * (r % nblk);
        t.src = W + (size_t)k0 * N + n0; t.gain = gain ? gain + k0 : nullptr; t.dst = WT; t.N = N; t.K = K; t.n0 = n0; t.k0 = k0; };
    const int first = it_lo + gw;
    if (first < it_hi) {
        TItem ta, tb; TRegs ra, rb;
        decode(first, ta); tr_load(ta, ra, lane);
        for (int it = first;;) {
            const int i1 = it + ngw; const bool h1 = i1 < it_hi;
            if (h1) { decode(i1, tb); tr_load(tb, rb, lane); }
            tr_store(ta, ra, scr, lane);
            if (!h1) break;
            const int i2 = i1 + ngw; const bool h2 = i2 < it_hi;
            if (h2) { decode(i2, ta); tr_load(ta, ra, lane); }
            tr_store(tb, rb, scr, lane);
            if (!h2) break;
            it = i2;
        }
    }
}
__device__ __forceinline__ void p0_prologue(Frame& F) {
    const int gw = F.vcu * NWAVES + F.wave, NGW = F.G * NWAVES;
    convert_items(F, 0, ((CONV_SPLIT && F.G == 256) ? 2 : DEPTH) * IT_LAYER, gw, NGW);
    pg8::ssq_t* ssq0 = (pg8::ssq_t*)(F.ws + WS_CTL + SSQ_OFF);
    {
        f32x4 xv[16];
        if (gw < M) { const GAS f32x4* xr = (const GAS f32x4*)(F.in[I_X] + (size_t)gw * DMODEL) + F.lane;
#pragma unroll
            for (int j = 0; j < 16; ++j) xv[j] = xr[64 * j]; }
        for (int m = gw; m < M; m += NGW) {
            f32x4 xn[16]; const int mn = m + NGW;
            if (mn < M) { const GAS f32x4* xr = (const GAS f32x4*)(F.in[I_X] + (size_t)mn * DMODEL) + F.lane;
#pragma unroll
                for (int j = 0; j < 16; ++j) xn[j] = xr[64 * j]; }
            float s = 0.f;
#pragma unroll
            for (int j = 0; j < 16; ++j) { const f32x4 v = xv[j]; s += (v.x * v.x + v.y * v.y) + (v.z * v.z + v.w * v.w); *(GAS unsigned long long*)(F.ws + WS_HB + PG8_AOFF(m, 4 * (F.lane + 64 * j), DMODEL)) = (unsigned long long)pk2(v.x, v.y) | ((unsigned long long)pk2(v.z, v.w) << 32); }
            s = wave_sum(s); if (F.lane == 0) ssq0[m] = (pg8::ssq_t)(s * pg8::SSQ_SCALE);
#pragma unroll
            for (int j = 0; j < 16; ++j) xv[j] = xn[j];
        }
    }
    __syncthreads();
    for (int u = F.vcu; u < DEPTH * NGRP; u += F.G) ssm_setup_unit(F, u / NGRP, u % NGRP);
}
__device__ __forceinline__ float gelu_tanh(float y) { const float z = 0.7978845608028654f * (y + 0.044715f * y * y * y); return y * __builtin_amdgcn_rcpf(1.0f + __builtin_amdgcn_exp2f(-2.8853900817779268f * z)); }
__device__ __forceinline__ void ssm_unit(Frame& F, int l, int b, int g) {
    typedef short s16x8 __attribute__((ext_vector_type(8)));
#define SSM_SYNC() asm volatile("s_waitcnt lgkmcnt(0)\n\ts_barrier" ::: "memory")
    int lane_ = F.lane; asm volatile("" : "+v"(lane_));
    const int lane = lane_, w = F.wave, fr = lane & 15, fq = lane >> 4, tid = w * 64 + lane;
    const bf16* P = (const bf16*)(F.ws + WS_SSMP + (size_t)(l * NGRP + g) * SSMP_STRIDE); const bf16* WmT = P; const bf16* VmT = P + 32768; const bf16* Kt = P + 65536; const float* A16 = (const float*)(P + 65536 + 17 * 256);
    const bf16* U = (const bf16*)(F.ws + WS_UT) + ((size_t)g * M + (size_t)b * SEQ) * 16;
    bf16* YG = (bf16*)(F.ws + WS_YG);
    LAS float* S = (LAS float*)(F.lds + RING_OFF);
    LAS unsigned char* UQ = F.lds + RING_OFF + 64 * 132 * 4;
    s16x8 wf[8], kfl[4], kfh[8], vfl[4], vfh[4];
    const int tl = w, th = 15 - w;
    v4u pre[4];
#pragma unroll
    for (int i = 0; i < 4; ++i) pre[i] = *(const v4u*)(U + (size_t)(tid + 512 * i) * 8);
#pragma unroll
    for (int kk = 0; kk < 8; ++kk) wf[kk] = *(const s16x8*)(WmT + (16 * w + fr) * 256 + 32 * kk + 8 * fq);
#pragma unroll
    for (int kk = 0; kk < 4; ++kk) { const int tau = tl - 2 * kk - (fq >> 1); kfl[kk] = *(const s16x8*)(Kt + (tau < 0 ? 0 : tau + 1) * 256 + fr * 16 + 8 * (fq & 1)); }
#pragma unroll
    for (int kk = 0; kk < 8; ++kk) { const int tau = th - 2 * kk - (fq >> 1); kfh[kk] = *(const s16x8*)(Kt + (tau < 0 ? 0 : tau + 1) * 256 + fr * 16 + 8 * (fq & 1)); }
#pragma unroll
    for (int kk = 0; kk < 4; ++kk) { vfl[kk] = *(const s16x8*)(VmT + (tl * 16 + fr) * 128 + 32 * kk + 8 * fq); vfh[kk] = *(const s16x8*)(VmT + (th * 16 + fr) * 128 + 32 * kk + 8 * fq); }
    float sr = 0.f, si = 0.f, a16r = 0.f, a16i = 0.f;
    if (w == 0) { a16r = A16[2 * lane]; a16i = A16[2 * lane + 1]; }
    for (int q = 0; q < 4; ++q) {
#pragma unroll
        for (int i = 0; i < 4; ++i) { const int e = tid + 512 * i; *(LAS v4u*)(UQ + (e >> 5) * 528 + (e & 31) * 16) = pre[i]; }
        SSM_SYNC();
        if (q < 3) {
#pragma unroll
            for (int i = 0; i < 4; ++i) pre[i] = *(const v4u*)(U + (size_t)(q + 1) * 16384 + (size_t)(tid + 512 * i) * 8);
        }
#pragma unroll
        for (int mt = 0; mt < 4; ++mt) {
            const LAS unsigned char* ub = UQ + (mt * 16 + fr) * 528 + fq * 16;
            f32x4 acc = {0.f, 0.f, 0.f, 0.f};
#pragma unroll
            for (int kk = 0; kk < 8; ++kk) { const s16x8 uf = *(const LAS s16x8*)(ub + 64 * kk); acc = __builtin_amdgcn_mfma_f32_16x16x32_bf16(wf[kk], uf, acc, 0, 0, 0); }
            *(LAS f32x4*)(S + (mt * 16 + fr) * 132 + 16 * w + 4 * fq) = acc;
        }
        SSM_SYNC();
        if (w == 0) {
            for (int c0 = 0; c0 < 64; c0 += 8) { float tr[8], ti[8];
#pragma unroll
                for (int i = 0; i < 8; ++i) { tr[i] = S[(c0 + i) * 132 + lane]; ti[i] = S[(c0 + i) * 132 + 64 + lane]; }
#pragma unroll
                for (int i = 0; i < 8; ++i) { S[(c0 + i) * 132 + lane] = sr; S[(c0 + i) * 132 + 64 + lane] = si;
                    const float nsr = a16r * sr - a16i * si + tr[i], nsi = a16r * si + a16i * sr + ti[i]; sr = nsr; si = nsi; } }
        }
        SSM_SYNC();
#pragma unroll
        for (int mt = 0; mt < 4; ++mt) {
            const int chunk = q * 64 + mt * 16 + fr;
            const LAS unsigned char* ub = UQ + (mt * 16 + fr) * 528 + fq * 16;
            f32x4 accl = {0.f, 0.f, 0.f, 0.f}, acch = {0.f, 0.f, 0.f, 0.f};
#pragma unroll
            for (int kk = 0; kk < 8; ++kk) { const s16x8 uf = *(const LAS s16x8*)(ub + 64 * kk);
                if (kk < 4) accl = __builtin_amdgcn_mfma_f32_16x16x32_bf16(kfl[kk], uf, accl, 0, 0, 0);
                acch = __builtin_amdgcn_mfma_f32_16x16x32_bf16(kfh[kk], uf, acch, 0, 0, 0); }
#pragma unroll
            for (int kk = 0; kk < 4; ++kk) { const LAS float* sp = S + (mt * 16 + fr) * 132 + 32 * kk + 8 * fq; const f32x4 s0 = *(const LAS f32x4*)sp, s1 = *(const LAS f32x4*)(sp + 4);
                const s16x8 sf = __builtin_bit_cast(s16x8, pg8::pack8(s0, s1));
                accl = __builtin_amdgcn_mfma_f32_16x16x32_bf16(vfl[kk], sf, accl, 0, 0, 0); acch = __builtin_amdgcn_mfma_f32_16x16x32_bf16(vfh[kk], sf, acch, 0, 0, 0); }
            const size_t tok = (size_t)b * SEQ + (size_t)chunk * 16;
            { typedef unsigned u32x2 __attribute__((ext_vector_type(2)));
              u32x2 o; o.x = pg8::cvt_pk_bf16(gelu_tanh(accl[0]), gelu_tanh(accl[1])); o.y = pg8::cvt_pk_bf16(gelu_tanh(accl[2]), gelu_tanh(accl[3]));
              *(u32x2*)((char*)YG + PG8_AOFF(tok + tl, g * 16 + 4 * fq, 2048)) = o;
              o.x = pg8::cvt_pk_bf16(gelu_tanh(acch[0]), gelu_tanh(acch[1])); o.y = pg8::cvt_pk_bf16(gelu_tanh(acch[2]), gelu_tanh(acch[3]));
              *(u32x2*)((char*)YG + PG8_AOFF(tok + th, g * 16 + 4 * fq, 2048)) = o; }
        }
        SSM_SYNC();
    }
#undef SSM_SYNC
}

struct Args { const float* in[N_IN]; float* out; unsigned char* ws; int ph_lo, ph_hi; };
__global__ void __launch_bounds__(NWAVES * 64, 2) hymba_fwd(Args args) {
    extern __shared__ __attribute__((aligned(16))) unsigned char lds[];
    Frame F;
    F.lds = (LAS unsigned char*)lds;
    F.MISC = (volatile LAS unsigned*)(F.lds + MISC_OFF);
    F.tid = threadIdx.x; F.lane = F.tid & 63; F.wave = __builtin_amdgcn_readfirstlane(F.tid >> 6);
    F.G = gridDim.x; { const int bx = blockIdx.x; F.vcu = (F.G % 8 == 0) ? (bx % 8) * (F.G / 8) + bx / 8 : bx; }
    F.in = args.in; F.out = args.out; F.ws = args.ws;
    unsigned char* ws = args.ws;
    F.ctl = (gu32*)(ws + WS_CTL);
    for (int u = F.tid; u < (LDS_BYTES - LDSCTL_OFF) / 4; u += NWAVES * 64) ((LAS unsigned*)(F.lds + LDSCTL_OFF))[u] = 0u;
    __syncthreads();
    XcdBarrier bar; bar.bar = (unsigned*)(F.ctl + CW_BAR); bar.x = 0; bar.st = nullptr;
    if (!MK_PER_PHASE) bar = xcd_barrier_post((unsigned*)(F.ctl + CW_BAR), F.MISC + 8);
#ifndef REP_BAR
#define REP_BAR 1
#endif
#define GRID_BAR() do { if (MK_PER_PHASE) { if (F.tid == 0) __hip_atomic_store(F.ctl + 0, 0xBADBA0u, RLX_AGENT); } else { for (int rb_ = 0; rb_ < REP_BAR; ++rb_) xcd_barrier(bar); } } while (0)
    const int lo = args.ph_lo, hi = args.ph_hi;
#define IN(k) (lo <= (k) && (k) < hi)
#define BOTH(k) (IN(k) && IN((k) + 1))
    pg8::ssq_t* const ssq = (pg8::ssq_t*)(ws + WS_CTL + SSQ_OFF);
    pg8::bf16_t* const HB = (pg8::bf16_t*)(ws + WS_HB); pg8::bf16_t* const QKV = (pg8::bf16_t*)(ws + WS_QKV); pg8::bf16_t* const UT = (pg8::bf16_t*)(ws + WS_UT);
    pg8::bf16_t* const YG = (pg8::bf16_t*)(ws + WS_YG); pg8::bf16_t* const CAT = (pg8::bf16_t*)(ws + WS_CAT); pg8::bf16_t* const HID = (pg8::bf16_t*)(ws + WS_HID);

#ifndef REP_PRO
#define REP_PRO 1
#endif
#ifndef REP_SSM
#define REP_SSM 1
#endif
#ifndef REP_ATT
#define REP_ATT 1
#endif
#ifndef REP_GEMM
#define REP_GEMM 1
#endif
#ifndef REP_RES
#define REP_RES 1
#endif
    if (IN(0)) { for (int rep = 0; rep < REP_PRO; ++rep) { p0_prologue(F); __syncthreads(); } if (BOTH(0)) GRID_BAR(); }

    for (int l = 0; l < DEPTH; ++l) {
        const int pb = 1 + 6 * l;
        const unsigned char* wl = ws + WS_W + (size_t)l * W_LAYER;
        if (IN(pb)) {
            pg8::Gemm g{HB, (const pg8::bf16_t*)(wl + W_IN), M, 8192, DMODEL, A_IMG, 1}; pg8::StaticOrder S; S.init(M, 8192, F.G, (int)blockIdx.x);
            pg8::EpiProj E{QKV, UT, ssq + (2 * l) * M, attn_body::C2, ws + WS_KI, ws + WS_VI};
#ifndef STG_IN
#define STG_IN 0
#endif
            if (STG_IN && (F.vcu & 1)) { for (int s_ = 0; s_ < STG_IN; ++s_) __builtin_amdgcn_s_sleep(48); }
            for (int rep = 0; rep < REP_GEMM; ++rep) { pg8::gemm_phase<pg8::EpiProj, pg8::StaticOrder, PG8_ALIGN, PG8_SP2>(F.lds + RING_OFF, g, S, E); __syncthreads(); }
            if (BOTH(pb)) GRID_BAR();
        }
        if (IN(pb + 1)) {
            for (int rep = 0; rep < REP_SSM; ++rep) for (int u = F.vcu; u < BATCH * NGRP; u += F.G) ssm_unit(F, l, u / NGRP, u % NGRP);
            __syncthreads();
            const float lam_init = 0.8f - 0.6f * expf(-0.3f * (float)l);
            const float d1 = wave_sum(F.in[I_LQ1][l * 64 + F.lane] * F.in[I_LK1][l * 64 + F.lane]), d2 = wave_sum(F.in[I_LQ2][l * 64 + F.lane] * F.in[I_LK2][l * 64 + F.lane]);
            const float lam = expf(d1) - expf(d2) + lam_init;
            const bool split = CONV_SPLIT && l == 0 && F.G == 256;
            const int half_id = (F.vcu >> 5) * 16 + (F.vcu & 15);
            if (split && (F.vcu & 16)) convert_items(F, 2 * IT_LAYER, DEPTH * IT_LAYER, half_id * NWAVES + F.wave, 128 * NWAVES);
            else
            for (int rep = 0; rep < REP_ATT; ++rep) for (int pu = split ? half_id : F.vcu; pu < 256; pu += split ? 128 : F.G) {
                const int bh = pu >> 3, pp = pu & 7, b = bh >> 4, h = bh & 15;
#ifndef ATT_V64
                attn_body::build_lut((char*)lds + RING_OFF, F.in[I_RELB], h, F.tid);
#endif
#if defined(PROBE_ATT_QB)
                for (int xr = 0; xr < PROBE_ATT_N; ++xr) { attn_body::UnitArgs ua; ua.kind = 0; ua.qcol = h * 128 + 64; ua.kcol = 0; ua.vcol = 0; ua.ocol = h * 128;
                    ua.relb = F.in[I_RELB]; ua.scr = (float*)(ws + WS_ATT) + (size_t)F.vcu * (2 * 256 * 64); ua.lam = lam; ua.oscale = 1.0f - lam_init; ua.gain = F.in[I_SUBG] + l * 128;
                    attn_body::attn_unit<8>(b, h, PROBE_ATT_QB, (const attn_body::bf16*)QKV, (const attn_body::bf16*)(ws + WS_KI + (size_t)((bh * 2 + 1) * 64) * 8192), (const attn_body::bf16*)(ws + WS_VI + (size_t)(bh * 64) * 16384), (attn_body::bf16*)CAT, (char*)lds + RING_OFF, ua); }
#endif
#ifdef ATT_V64
                for (int qi = 0; qi < 2; ++qi) { const int qb = qi ? 15 - pp : pp;
                    for (int kind = 0; kind < 4; ++kind) { const int s2 = (kind < 2) ? 64 : 0, vh = kind & 1;
                        attn_body::UnitArgs ua; ua.kind = kind; ua.qcol = h * 128 + s2; ua.kcol = 2048 + h * 128 + s2; ua.vcol = 4096 + h * 128 + vh * 64; ua.ocol = h * 128;
#elif defined(ATT_PP)
                for (int qi = 0; qi < 2; ++qi) { const int qb = qi ? 15 - pp : pp;
                    for (int kind = 0; kind < 2; ++kind) { const int s2 = (kind < 1) ? 64 : 0;
                        attn_body::UnitArgs ua; ua.kind = kind; ua.qcol = h * 128 + s2; ua.kcol = 2048 + h * 128 + s2; ua.vcol = 4096 + h * 128; ua.ocol = h * 128;
#else
                for (int qi = 0; qi < 4; ++qi) { const int qb = (qi == 0) ? pp : (qi == 1) ? 15 - pp : (qi == 2) ? 16 + pp : 31 - pp;
                    for (int kind = 0; kind < 2; ++kind) { const int s2 = (kind < 1) ? 64 : 0;
                        attn_body::UnitArgs ua; ua.kind = kind; ua.qcol = h * 128 + s2; ua.kcol = 2048 + h * 128 + s2; ua.vcol = 4096 + h * 128; ua.ocol = h * 128;
#endif
                        ua.relb = F.in[I_RELB]; ua.scr = (float*)(ws + WS_ATT) + (size_t)F.vcu * (2 * 256 * 64); ua.lam = lam; ua.oscale = 1.0f - lam_init; ua.gain = F.in[I_SUBG] + l * 128;
                        attn_body::attn_unit<8>(b, h, qb, (const attn_body::bf16*)QKV, (const attn_body::bf16*)(ws + WS_KI + (size_t)((bh * 2 + (s2 >> 6)) * 64) * 8192), (const attn_body::bf16*)(ws + WS_VI + (size_t)(bh * 64) * 16384), (attn_body::bf16*)CAT, (char*)lds + RING_OFF, ua); } }
            }
            if (BOTH(pb + 1)) GRID_BAR();
        }
        if (IN(pb + 2)) {
            pg8::Gemm g{YG, (const pg8::bf16_t*)(wl + W_GLU), M, 2048, 2048, A_IMG, 1}; pg8::StaticOrder S; S.init(M, 2048, F.G, (int)blockIdx.x);
            pg8::EpiGlu E{YG, CAT, F.in[I_BGLU] + l * 2048};
            for (int rep = 0; rep < REP_GEMM; ++rep) { pg8::gemm_phase<pg8::EpiGlu, pg8::StaticOrder, PG8_ALIGN, PG8_SP2>(F.lds + RING_OFF, g, S, E); __syncthreads(); }
            if (BOTH(pb + 2)) GRID_BAR();
        }
        if (IN(pb + 3)) {
            pg8::Gemm g{CAT, (const pg8::bf16_t*)(wl + W_OUT), M, DMODEL, DMODEL, A_IMG, 1}; pg8::StaticOrder S; S.init(M, DMODEL, F.G, (int)blockIdx.x);
            pg8::EpiRes E{HB, ssq + (2 * l + 1) * M};
            pg8::gemm_phase<pg8::EpiRes, pg8::StaticOrder, PG8_ALIGN, PG8_SP2>(F.lds + RING_OFF, g, S, E);
            if (BOTH(pb + 3)) GRID_BAR();
        }
        if (IN(pb + 4)) {
            pg8::Gemm g{HB, (const pg8::bf16_t*)(wl + W_UP), M, FF, DMODEL, A_IMG, 1}; pg8::StaticOrder S; S.init(M, FF, F.G, (int)blockIdx.x);
            pg8::EpiUp E{HID, FF, ssq + (2 * l + 1) * M};
#ifndef STG_UP
#define STG_UP 0
#endif
#ifndef STG_UP_WAYS
#define STG_UP_WAYS 2
#endif
            if (STG_UP) { const int k_ = F.vcu & (STG_UP_WAYS - 1); for (int s_ = 0; s_ < STG_UP * k_; ++s_) __builtin_amdgcn_s_sleep(48 * 2 / STG_UP_WAYS); }
            for (int rep = 0; rep < REP_GEMM; ++rep) { pg8::gemm_phase<pg8::EpiUp, pg8::StaticOrder, PG8_ALIGN, PG8_SP2>(F.lds + RING_OFF, g, S, E); __syncthreads(); }
            if (BOTH(pb + 4)) GRID_BAR();
        }
        if (IN(pb + 5)) {
            pg8::Gemm g{HID, (const pg8::bf16_t*)(wl + W_DN), M, DMODEL, FF, A_IMG, 1}; pg8::StaticOrder S; S.init(M, DMODEL, F.G, (int)blockIdx.x);
            pg8::EpiRes E{HB, ssq + (2 * l + 2) * M};
            pg8::gemm_phase<pg8::EpiRes, pg8::StaticOrder, PG8_ALIGN, PG8_SP2>(F.lds + RING_OFF, g, S, E);
            if (BOTH(pb + 5)) GRID_BAR();
        }
    }
    if (IN(N_PHASES - 1)) {
        const int gw = F.vcu * NWAVES + F.wave, NGW = F.G * NWAVES; const float* gf = F.in[I_NFIN]; const pg8::ssq_t* sq = ssq + 8 * M;
        f32x4 gq[8][2];
#pragma unroll
        for (int j = 0; j < 8; ++j) { const int c = 8 * (F.lane + 64 * j); gq[j][0] = *(const f32x4*)(gf + c); gq[j][1] = *(const f32x4*)(gf + c + 4); }
        v4u hw[8]; pg8::ssq_t qc = 0;
        if (gw < M) { qc = sq[gw];
#pragma unroll
            for (int j = 0; j < 8; ++j) hw[j] = *(const GAS v4u*)((const GAS unsigned char*)HB + PG8_AOFF(gw, 8 * (F.lane + 64 * j), DMODEL)); }
        for (int m = gw; m < M; m += NGW) { const int mn = m + NGW; v4u hn[8]; pg8::ssq_t qn = 0;
            if (mn < M) { qn = sq[mn];
#pragma unroll
                for (int j = 0; j < 8; ++j) hn[j] = *(const GAS v4u*)((const GAS unsigned char*)HB + PG8_AOFF(mn, 8 * (F.lane + 64 * j), DMODEL)); }
            const float rs = pg8::rstd_of(qc);
#pragma unroll
            for (int j = 0; j < 8; ++j) { const int c = 8 * (F.lane + 64 * j); const v4u w = hw[j];
                const f32x4 h0 = {pg8::bf_lo(w.x), pg8::bf_hi(w.x), pg8::bf_lo(w.y), pg8::bf_hi(w.y)}, h1 = {pg8::bf_lo(w.z), pg8::bf_hi(w.z), pg8::bf_lo(w.w), pg8::bf_hi(w.w)};
                GAS f32x4* o = (GAS f32x4*)(F.out + (size_t)m * DMODEL + c); o[0] = h0 * rs * gq[j][0]; o[1] = h1 * rs * gq[j][1]; }
#pragma unroll
            for (int j = 0; j < 8; ++j) hw[j] = hn[j];
            qc = qn; }
    }
#undef IN
#undef BOTH
}

extern "C" void kernel_launch(void* const* d_in, const int* in_sizes, int n_in, void* d_out, int out_size, void* d_ws, size_t ws_size, hipStream_t stream) {
    static int grid = 0;
    if (grid == 0) {
        if (n_in != N_IN || in_sizes[0] != M * DMODEL || out_size != M * DMODEL || ws_size < WS_END) { fprintf(stderr, "kernel_launch: built for %d inputs, x/out of %d floats, >= %zu bytes of workspace; got n_in %d, in0 %d, out %d, ws %zu; nothing launched\n", (int)N_IN, M * DMODEL, (size_t)WS_END, n_in, n_in > 0 ? in_sizes[0] : -1, out_size, ws_size); grid = -1; return; }
        int dev = 0, cus = 0, per_cu = 0;
        if (hipGetDevice(&dev) != hipSuccess || hipDeviceGetAttribute(&cus, hipDeviceAttributeMultiprocessorCount, dev) != hipSuccess) { fprintf(stderr, "kernel_launch: hipGetDevice / hipDeviceGetAttribute failed; nothing launched\n"); grid = -1; return; }
        if (hipFuncSetAttribute((const void*)hymba_fwd, hipFuncAttributeMaxDynamicSharedMemorySize, LDS_BYTES) != hipSuccess) { fprintf(stderr, "kernel_launch: hipFuncSetAttribute failed\n"); grid = -1; return; }
        if (hipOccupancyMaxActiveBlocksPerMultiprocessor(&per_cu, (const void*)hymba_fwd, NWAVES * 64, LDS_BYTES) != hipSuccess || per_cu < 1)
            fprintf(stderr, "kernel_launch: note: the occupancy query reports %d workgroups per CU\n", per_cu);
        (void)hipGetLastError();
        grid = cus;
    }
    if (grid < 0) return;
    if (hipMemsetAsync((char*)d_ws + WS_CTL, 0, CTL_ZERO_BYTES, stream) != hipSuccess) { fprintf(stderr, "kernel_launch: hipMemsetAsync failed\n"); return; }
    Args a{};
    for (int i = 0; i < N_IN; ++i) a.in[i] = (const float*)d_in[i];
    a.out = (float*)d_out; a.ws = (unsigned char*)d_ws;
#if MK_PER_PHASE
    for (int ph = 0; ph < N_PHASES; ++ph) { a.ph_lo = ph; a.ph_hi = ph + 1; hipLaunchKernelGGL(hymba_fwd, dim3(grid), dim3(NWAVES * 64), LDS_BYTES, stream, a); }
#else
    a.ph_lo = 0; a.ph_hi = N_PHASES; hipLaunchKernelGGL(hymba_fwd, dim3(grid), dim3(NWAVES * 64), LDS_BYTES, stream, a);
#endif
    const hipError_t le = hipPeekAtLastError();
    if (le != hipSuccess) fprintf(stderr, "kernel_launch: launch failed: %s\n", hipGetErrorName(le));
}
```

```cpp
#define MK_PER_PHASE 0
#define A_IMG 1
#define STG_UP 2
#define PROBE_ATT_2BAR 1
#define CONV_SPLIT 2
#include <hip/hip_runtime.h>
#include <cstdio>
#include <cstdint>
#ifndef A_IMG
#define A_IMG 0
#endif
namespace pg8 {
#define PG8_LAS __attribute__((address_space(3)))
typedef unsigned short bf16_t;
typedef short bf16x8 __attribute__((ext_vector_type(8)));
typedef float f32x4 __attribute__((ext_vector_type(4)));
typedef unsigned u32x4 __attribute__((ext_vector_type(4)));
constexpr int BM = 256, BK = 64, HALF = 128, HTB = HALF * BK * 2  , STAGE_BYTES = 8 * HTB, NXCD = 8, WGM = 8;

__host__ __device__ __forceinline__ int lds_byte(int r, int c) { const int st = (r >> 4) * 2 + (c >> 5), rr = r & 15, cc = c & 31, ob = rr * 64 + cc * 2; return st * 1024 + (ob ^ (((ob >> 9) & 1) << 5)); }
__host__ __device__ __forceinline__ void stage_rc(int b, int& R, int& C) { const int st = b / 1024, sb = b % 1024, swz = sb ^ (((sb >> 9) & 1) << 5); R = (st >> 1) * 16 + swz / 64; C = (st & 1) * 32 + (swz % 64) / 2; }
__host__ __device__ __forceinline__ int perm32(int rho) { const int n = rho >> 4, i = rho & 15; return 8 * (i >> 2) + 4 * n + (i & 3); }

struct Unit { int pm, pn; };
struct Gemm { const bf16_t* A; const bf16_t* Bt; int M, N, K; int a_img, b_img; };
#define PG8_AOFF(row, col, K) (A_IMG ? pg8::img_off((int)(row), (int)(col), (K), false) : ((size_t)(row) * (size_t)(K) + (size_t)(col)) * 2)
__host__ __device__ __forceinline__ int perm32_inv(int x) { return 16 * ((x >> 2) & 1) + 4 * (x >> 3) + (x & 3); }
__host__ __device__ __forceinline__ size_t img_off(int row, int col, int K, bool permB) {
    const int r = row & 127, R = permB ? ((r & ~31) + perm32_inv(r & 31)) : r;
    return ((size_t)((row >> 8) * (K >> 6) + (col >> 6)) * 2 + ((row >> 7) & 1)) * (size_t)HTB + (size_t)lds_byte(R, col & 63); }

struct StaticOrder {
    int nM, nN, nwg, G, c;
    __host__ __device__ void init(int M, int N, int G_, int c_) { nM = M / BM; nN = N / BM; nwg = nM * nN; G = G_; c = c_; }
    __host__ __device__ bool next(int i, Unit& u) const {
        const long L = (long)i * G + c; if (L >= nwg) return false;
        int wgid = (int)L; { const int q = nwg / NXCD, r = nwg % NXCD, xcd = wgid % NXCD, off = wgid / NXCD; wgid = (xcd < r ? xcd * (q + 1) : r * (q + 1) + (xcd - r) * q) + off; }
        const int nig = WGM * nN, gid = wgid / nig, fm = gid * WGM, gsz = (nM - fm) < WGM ? (nM - fm) : WGM;
        u.pm = fm + ((wgid % nig) % gsz); u.pn = (wgid % nig) / gsz; return true;
    }
    __device__ __forceinline__ void a_ready(const Unit&) const {}
    __device__ __forceinline__ void done(const Unit&) const {}
};

__device__ __forceinline__ unsigned cvt_pk_bf16(float lo, float hi) { unsigned r; asm volatile("v_cvt_pk_bf16_f32 %0, %1, %2" : "=v"(r) : "v"(lo), "v"(hi)); return r; }
typedef float f32x2 __attribute__((ext_vector_type(2)));
__device__ __forceinline__ f32x2 gelu_pk(f32x2 v) {
    const f32x2 av = __builtin_elementwise_abs(v), d = av * 0.2316418882f + 1.0f;
    f32x2 t; t.x = __builtin_amdgcn_rcpf(d.x); t.y = __builtin_amdgcn_rcpf(d.y);
    f32x2 q = t * 0.5307027145f + (-0.7265760135f); q = q * t + 0.7107068705f; q = q * t + (-0.142248368f); q = q * t + 0.127414796f; q = q * t;
    const f32x2 s = (v * v) * (-0.72134752044f);
    f32x2 e; e.x = __builtin_amdgcn_exp2f(s.x); e.y = __builtin_amdgcn_exp2f(s.y);
    const f32x2 m = v * (q * e), r = v - m;
    f32x2 o; o.x = v.x < 0.f ? m.x : r.x; o.y = v.y < 0.f ? m.y : r.y; return o;
}

template <int ACT  > struct EpiBf16 {
    static constexpr bool PERM = true, AFTER_DRAIN = false; static_assert(ACT == 0 || ACT == 1, "EpiBf16: ACT is 0 (none) or 1 (gelu_pk)");
    bf16_t* O; int ldc; const float* bias; int split_cols; size_t split_stride; float scale0;
    __device__ __forceinline__ void operator()(const f32x4 (&acc)[2][2][4][2], const Unit& u, int wr, int wc, int fr, int fq) const {
        const int row0 = u.pm * BM + wr * 64 + fr; int colt = u.pn * BM; bf16_t* base = O;
        float sc = 1.f; if (split_cols) { const int t = colt / split_cols; base += (size_t)t * split_stride; colt -= t * split_cols; if (t == 0) sc = scale0; }
        const int col0 = colt + wc * 32 + 8 * fq, bcol0 = u.pn * BM + wc * 32 + 8 * fq;
        f32x4 bv[2][2];
#pragma unroll
        for (int bj = 0; bj < 2; ++bj)
#pragma unroll
            for (int n = 0; n < 2; ++n) bv[bj][n] = bias ? *(const f32x4*)(bias + bcol0 + bj * HALF + 4 * n) : (f32x4){0.f, 0.f, 0.f, 0.f};
#pragma unroll
        for (int ai = 0; ai < 2; ++ai)
#pragma unroll
            for (int m = 0; m < 4; ++m) { bf16_t* rowp = base + (size_t)(row0 + ai * HALF + m * 16) * ldc + col0;
#pragma unroll
                for (int bj = 0; bj < 2; ++bj) { f32x4 v0 = acc[ai][bj][m][0] + bv[bj][0], v1 = acc[ai][bj][m][1] + bv[bj][1];
                    if (ACT == 1) { f32x2 a = gelu_pk((f32x2){v0[0], v0[1]}), b = gelu_pk((f32x2){v0[2], v0[3]}), c = gelu_pk((f32x2){v1[0], v1[1]}), d = gelu_pk((f32x2){v1[2], v1[3]});
                        v0 = (f32x4){a.x, a.y, b.x, b.y}; v1 = (f32x4){c.x, c.y, d.x, d.y}; }
                    v0 = v0 * sc; v1 = v1 * sc; u32x4 w; w.x = cvt_pk_bf16(v0[0], v0[1]); w.y = cvt_pk_bf16(v0[2], v0[3]); w.z = cvt_pk_bf16(v1[0], v1[1]); w.w = cvt_pk_bf16(v1[2], v1[3]);
                    *(u32x4*)(rowp + bj * HALF) = w; } }
    }
};

__device__ __forceinline__ u32x4 pack8(f32x4 v0, f32x4 v1) { u32x4 w; w.x = cvt_pk_bf16(v0[0], v0[1]); w.y = cvt_pk_bf16(v0[2], v0[3]); w.z = cvt_pk_bf16(v1[0], v1[1]); w.w = cvt_pk_bf16(v1[2], v1[3]); return w; }
__device__ __forceinline__ float bf_lo(unsigned w) { return __uint_as_float(w << 16); }
__device__ __forceinline__ float bf_hi(unsigned w) { return __uint_as_float(w & 0xffff0000u); }
constexpr float RMS_EPS = 1e-6f;
typedef unsigned long long ssq_t;
constexpr float SSQ_SCALE = 16777216.0f, SSQ_INV = 1.0f / (16777216.0f * 4096.0f);
__device__ __forceinline__ float rstd_of(ssq_t q) { const float x = fmaf((float)(unsigned)(q >> 32), 4294967296.0f, (float)(unsigned)q); return __builtin_amdgcn_rsqf(x * SSQ_INV + RMS_EPS); }
struct EpiProj {
    static constexpr bool PERM = true, AFTER_DRAIN = false, IDEMP = true;
    bf16_t* __restrict__ QKV; bf16_t* __restrict__ UT; const ssq_t* __restrict__ ssq; float c2; unsigned char* __restrict__ KI; unsigned char* __restrict__ VI;
    __device__ __forceinline__ void operator()(const f32x4 (&acc)[2][2][4][2], const Unit& u, int wr, int wc, int fr, int fq) const {
        const int row0 = u.pm * BM + wr * 64 + fr, colt = u.pn * BM;
        const float sc = (colt < 2048) ? c2 : 1.f;
        ssq_t q[2][4];
#pragma unroll
        for (int ai = 0; ai < 2; ++ai)
#pragma unroll
            for (int m = 0; m < 4; ++m) q[ai][m] = ssq[row0 + ai * HALF + m * 16];
#pragma unroll
        for (int ai = 0; ai < 2; ++ai)
#pragma unroll
            for (int m = 0; m < 4; ++m) { const int row = row0 + ai * HALF + m * 16;
                const float rs = sc * rstd_of(q[ai][m]);
#pragma unroll
                for (int bj = 0; bj < 2; ++bj) { const int col = colt + bj * HALF + wc * 32 + 8 * fq;
                    const u32x4 w = pack8(acc[ai][bj][m][0] * rs, acc[ai][bj][m][1] * rs);
                    if (colt < 2048) *(u32x4*)(QKV + (size_t)row * 6144 + col) = w;
                    else if (colt < 4096) { const int c = col - 2048, key = row & 4095;
                        *(u32x4*)(KI + ((size_t)(((row >> 12) * 16 + (c >> 7)) * 2 + ((c >> 6) & 1)) * 64 + (key >> 6)) * 8192 + ((c & 63) >> 3) * 1024 + (key & 63) * 16) = w; }
                    else if (colt < 6144) { const int c = col - 4096, key = row & 4095, cc = c & 127;
                        *(u32x4*)(VI + ((size_t)((row >> 12) * 16 + (c >> 7)) * 64 + (key >> 6)) * 16384 + ((cc >> 5) * 4 + ((key & 63) >> 4)) * 1024 + (key & 15) * 64 + ((cc & 31) >> 3) * 16) = w; }
                    else { const int cu = col - 6144; *(u32x4*)(UT + ((size_t)(cu >> 4) * 8192 + row) * 16 + (cu & 15)) = w; } } }
    }
};
struct EpiUp {
    static constexpr bool PERM = true, AFTER_DRAIN = false, IDEMP = true;
    bf16_t* __restrict__ O; int ldc; const ssq_t* __restrict__ ssq;
    __device__ __forceinline__ void operator()(const f32x4 (&acc)[2][2][4][2], const Unit& u, int wr, int wc, int fr, int fq) const {
        const int row0 = u.pm * BM + wr * 64 + fr, colt = u.pn * BM;
        ssq_t q[2][4];
#pragma unroll
        for (int ai = 0; ai < 2; ++ai)
#pragma unroll
            for (int m = 0; m < 4; ++m) q[ai][m] = ssq[row0 + ai * HALF + m * 16];
#pragma unroll
        for (int ai = 0; ai < 2; ++ai)
#pragma unroll
            for (int m = 0; m < 4; ++m) { const int row = row0 + ai * HALF + m * 16;
                const float rs = rstd_of(q[ai][m]);
#pragma unroll
                for (int bj = 0; bj < 2; ++bj) { const int col = colt + bj * HALF + wc * 32 + 8 * fq;
                    f32x4 v0 = acc[ai][bj][m][0] * rs, v1 = acc[ai][bj][m][1] * rs;
#pragma unroll
                    for (int e = 0; e < 4; ++e) { const float a = fmaxf(v0[e], 0.f), b = fmaxf(v1[e], 0.f); v0[e] = a * a; v1[e] = b * b; }
                    *(u32x4*)((char*)O + PG8_AOFF(row, col, ldc)) = pack8(v0, v1); } }
    }
};
struct EpiGlu {
    static constexpr bool PERM = true, AFTER_DRAIN = false, IDEMP = true;
    const bf16_t* __restrict__ YG; bf16_t* __restrict__ CAT; const float* __restrict__ bias;
    __device__ __forceinline__ void operator()(const f32x4 (&acc)[2][2][4][2], const Unit& u, int wr, int wc, int fr, int fq) const {
        const int row0 = u.pm * BM + wr * 64 + fr, colt = u.pn * BM;
        f32x4 bv[2][2];
#pragma unroll
        for (int bj = 0; bj < 2; ++bj)
#pragma unroll
            for (int n = 0; n < 2; ++n) bv[bj][n] = *(const f32x4*)(bias + colt + bj * HALF + wc * 32 + 8 * fq + 4 * n);
#pragma unroll
        for (int ai = 0; ai < 2; ++ai) {
            u32x4 yw[4][2];
#pragma unroll
            for (int m = 0; m < 4; ++m)
#pragma unroll
                for (int bj = 0; bj < 2; ++bj) yw[m][bj] = *(const u32x4*)((const char*)YG + PG8_AOFF(row0 + ai * HALF + m * 16, colt + bj * HALF + wc * 32 + 8 * fq, 2048));
#pragma unroll
            for (int m = 0; m < 4; ++m) { const int row = row0 + ai * HALF + m * 16;
#pragma unroll
                for (int bj = 0; bj < 2; ++bj) { const int col = colt + bj * HALF + wc * 32 + 8 * fq; const u32x4 y = yw[m][bj];
                    f32x4 v0 = acc[ai][bj][m][0] + bv[bj][0], v1 = acc[ai][bj][m][1] + bv[bj][1];
#pragma unroll
                    for (int e = 0; e < 4; ++e) { v0[e] = __builtin_amdgcn_rcpf(1.0f + __builtin_amdgcn_exp2f(-1.4426950408889634f * v0[e])); v1[e] = __builtin_amdgcn_rcpf(1.0f + __builtin_amdgcn_exp2f(-1.4426950408889634f * v1[e])); }
                    v0[0] *= bf_lo(y.x); v0[1] *= bf_hi(y.x); v0[2] *= bf_lo(y.y); v0[3] *= bf_hi(y.y);
                    v1[0] *= bf_lo(y.z); v1[1] *= bf_hi(y.z); v1[2] *= bf_lo(y.w); v1[3] *= bf_hi(y.w);
                    *(u32x4*)((char*)CAT + PG8_AOFF(row, 2048 + col, 4096)) = pack8(v0, v1); } }
            asm volatile("" ::: "memory"); }
    }
};
struct EpiRes {
    static constexpr bool PERM = true, AFTER_DRAIN = false, IDEMP = false;
    bf16_t* HB; ssq_t* __restrict__ ssq_out;
    __device__ __forceinline__ void operator()(const f32x4 (&acc)[2][2][4][2], const Unit& u, int wr, int wc, int fr, int fq) const {
        const int row0 = u.pm * BM + wr * 64 + fr, colt = u.pn * BM;
        u32x4 b[2][4][2];
#pragma unroll
        for (int ai = 0; ai < 2; ++ai)
#pragma unroll
            for (int m = 0; m < 4; ++m)
#pragma unroll
                for (int bj = 0; bj < 2; ++bj) b[ai][m][bj] = *(const u32x4*)((const char*)HB + PG8_AOFF(row0 + ai * HALF + m * 16, colt + bj * HALF + wc * 32 + 8 * fq, 4096));
#pragma unroll
        for (int ai = 0; ai < 2; ++ai) { float sm[4];
#pragma unroll
            for (int m = 0; m < 4; ++m) { const int row = row0 + ai * HALF + m * 16; float ss = 0.f;
#pragma unroll
                for (int bj = 0; bj < 2; ++bj) { const u32x4 w = b[ai][m][bj];
                    const f32x4 h0 = (f32x4){bf_lo(w.x), bf_hi(w.x), bf_lo(w.y), bf_hi(w.y)} + acc[ai][bj][m][0], h1 = (f32x4){bf_lo(w.z), bf_hi(w.z), bf_lo(w.w), bf_hi(w.w)} + acc[ai][bj][m][1];
                    *(u32x4*)((char*)HB + PG8_AOFF(row, colt + bj * HALF + wc * 32 + 8 * fq, 4096)) = pack8(h0, h1);
                    ss += (h0[0] * h0[0] + h0[1] * h0[1]) + (h0[2] * h0[2] + h0[3] * h0[3]) + (h1[0] * h1[0] + h1[1] * h1[1]) + (h1[2] * h1[2] + h1[3] * h1[3]); }
                ss += __shfl_xor(ss, 16); ss += __shfl_xor(ss, 32); sm[m] = ss; }
            const float mine = fq == 0 ? sm[0] : fq == 1 ? sm[1] : fq == 2 ? sm[2] : sm[3];
            __hip_atomic_fetch_add(ssq_out + row0 + ai * HALF + fq * 16, (ssq_t)(mine * SSQ_SCALE), __ATOMIC_RELAXED, __HIP_MEMORY_SCOPE_AGENT);
            asm volatile("" ::: "memory"); }
    }
};

template <class Epi, class Sched, bool ALIGN_EPI = false, bool SP2 = false>
__device__ __forceinline__ void gemm_phase(PG8_LAS unsigned char* lds, const Gemm g, const Sched& S, const Epi& E) {
    int tid_ = threadIdx.x; asm volatile("" : "+v"(tid_));
    const int tid = tid_, wid = __builtin_amdgcn_readfirstlane(tid >> 6), lane = tid & 63, wr = wid >> 2, wc = wid & 3, fr = lane & 15, fq = lane >> 4;
    const int K = g.K, nt = K / BK;
    unsigned voffA[2], voffB[2];
#pragma unroll
    for (int i = 0; i < 2; ++i) { int R, C; stage_rc(tid * 16 + i * 8192, R, C); const int Rb = Epi::PERM ? ((R & ~31) + perm32(R & 31)) : R;
        voffA[i] = g.a_img ? (unsigned)(tid * 16 + i * 8192) : (unsigned)(R * K + C) * 2u; voffB[i] = g.b_img ? (unsigned)(tid * 16 + i * 8192) : (unsigned)(Rb * K + C) * 2u; }
    const size_t kstA = g.a_img ? (size_t)2 * HTB : (size_t)(BK * 2), hstA = g.a_img ? (size_t)HTB : (size_t)HALF * K * 2, tstA = g.a_img ? (size_t)nt * 2 * HTB : (size_t)2 * HALF * K * 2;
    const size_t kstB = g.b_img ? (size_t)2 * HTB : (size_t)(BK * 2), hstB = g.b_img ? (size_t)HTB : (size_t)HALF * K * 2, tstB = g.b_img ? (size_t)nt * 2 * HTB : (size_t)2 * HALF * K * 2;
    const unsigned ldsw = (unsigned)wid * 1024u;
    const int aoff = lds_byte(wr * 64 + fr, fq * 8), boff = lds_byte(wc * 32 + fr, fq * 8);
#define PG8_SA(b, h) (((b) * 2 + (h)) * HTB)
#define PG8_SB(b, h) ((4 + (b) * 2 + (h)) * HTB)
#define PG8_STAGE(bufoff, rs, goff, voff) do { _Pragma("unroll") for (int _i = 0; _i < 2; ++_i) \
        __builtin_amdgcn_raw_ptr_buffer_load_lds(rs, (PG8_LAS unsigned*)(lds + (bufoff) + ldsw + _i * 8192), 16, (voff)[_i], (goff), 0, 0); } while (0)
#define PG8_LDA(dst, b, h) do { _Pragma("unroll") for (int m = 0; m < 4; ++m) _Pragma("unroll") for (int k = 0; k < 2; ++k) dst[m][k] = *(const PG8_LAS bf16x8*)(lds + PG8_SA(b, h) + aoff + m * 2048 + k * 1024); } while (0)
#define PG8_LDB(dst, b, h) do { _Pragma("unroll") for (int n = 0; n < 2; ++n) _Pragma("unroll") for (int k = 0; k < 2; ++k) dst[n][k] = *(const PG8_LAS bf16x8*)(lds + PG8_SB(b, h) + boff + n * 2048 + k * 1024); } while (0)
#define PG8_MMA(ai, bj, At, Bt) do { __builtin_amdgcn_s_setprio(1); _Pragma("unroll") for (int m = 0; m < 4; ++m) _Pragma("unroll") for (int n = 0; n < 2; ++n) _Pragma("unroll") for (int k = 0; k < 2; ++k) \
        acc[ai][bj][m][n] = __builtin_amdgcn_mfma_f32_16x16x32_bf16(Bt[n][k], At[m][k], acc[ai][bj][m][n], 0, 0, 0); __builtin_amdgcn_s_setprio(0); } while (0)
#define PG8_WAIT_V(n) asm volatile("s_waitcnt vmcnt(" #n ")" ::: "memory")
#define PG8_WAIT_V_SEL(flag, nrelax, nstd) asm volatile("s_cmp_lg_u32 %0, 0\n\ts_cbranch_scc1 .Lpg8r%=\n\ts_waitcnt vmcnt(" #nstd ")\n\ts_branch .Lpg8d%=\n.Lpg8r%=:\n\ts_waitcnt vmcnt(" #nrelax ")\n.Lpg8d%=:" :: "s"(flag) : "memory", "scc")
#define PG8_WAIT_L(n) asm volatile("s_waitcnt lgkmcnt(" #n ")" ::: "memory")
#ifdef PG8_BAR2
#define PG8_BAR do { __builtin_amdgcn_s_barrier(); __builtin_amdgcn_s_barrier(); } while (0)
#else
#define PG8_BAR __builtin_amdgcn_s_barrier()
#endif
#define PG8_SCHED __builtin_amdgcn_sched_barrier(0)
    Unit cur, nxt; int ui = 0;
    if (!S.next(0, cur)) return;
    f32x4 acc[2][2][4][2];
#pragma unroll
    for (int a = 0; a < 2; ++a)
#pragma unroll
        for (int b = 0; b < 2; ++b)
#pragma unroll
            for (int m = 0; m < 4; ++m)
#pragma unroll
                for (int n = 0; n < 2; ++n) acc[a][b][m][n] = (f32x4){0.f, 0.f, 0.f, 0.f};
    bf16x8 At[4][2], B0[2][2], B1[2][2];
    const __amdgpu_buffer_rsrc_t rsA = __builtin_amdgcn_make_buffer_rsrc((void*)g.A, 0, (unsigned)((size_t)g.M * K * 2), 0x00020000), rsB = __builtin_amdgcn_make_buffer_rsrc((void*)g.Bt, 0, (unsigned)((size_t)g.N * K * 2), 0x00020000);
    unsigned cA = (unsigned)((size_t)cur.pm * tstA), cB = (unsigned)((size_t)cur.pn * tstB);
    S.a_ready(cur);
    if constexpr (SP2) {
        PG8_STAGE(PG8_SB(0, 0), rsB, cB, voffB); PG8_STAGE(PG8_SB(0, 1), rsB, cB + (unsigned)hstB, voffB); PG8_STAGE(PG8_SA(0, 0), rsA, cA, voffA); PG8_STAGE(PG8_SA(0, 1), rsA, cA + (unsigned)hstA, voffA);
        if (wr == 1) PG8_BAR;
        PG8_WAIT_V(2); PG8_BAR;
        PG8_STAGE(PG8_SB(1, 0), rsB, cB + (unsigned)kstB, voffB); PG8_STAGE(PG8_SA(1, 0), rsA, cA + (unsigned)kstA, voffA); PG8_STAGE(PG8_SB(1, 1), rsB, cB + (unsigned)(hstB + kstB), voffB);
        PG8_WAIT_V(6); PG8_BAR;
    } else {
        PG8_STAGE(PG8_SB(0, 0), rsB, cB, voffB); PG8_STAGE(PG8_SA(0, 0), rsA, cA, voffA); PG8_STAGE(PG8_SB(0, 1), rsB, cB + (unsigned)hstB, voffB); PG8_STAGE(PG8_SA(0, 1), rsA, cA + (unsigned)hstA, voffA);
        if (wr == 1) PG8_BAR;
        PG8_WAIT_V(4); PG8_BAR;
        PG8_STAGE(PG8_SB(1, 0), rsB, cB + (unsigned)kstB, voffB); PG8_STAGE(PG8_SA(1, 0), rsA, cA + (unsigned)kstA, voffA); PG8_STAGE(PG8_SB(1, 1), rsB, cB + (unsigned)(hstB + kstB), voffB);
        PG8_WAIT_V(6); PG8_BAR;
    }
    for (;;) {
        const bool has_next = S.next(ui + 1, nxt);
        const unsigned nA = has_next ? (unsigned)((size_t)nxt.pm * tstA) : cA, nB = has_next ? (unsigned)((size_t)nxt.pn * tstB) : cB;
        for (int t = 0; t < nt; t += 2) {
            const bool last = (t == nt - 2);
            const unsigned a1 = cA + (unsigned)((size_t)(t + 1) * kstA);
            const unsigned a2 = last ? nA : cA + (unsigned)((size_t)(t + 2) * kstA), b2 = last ? nB : cB + (unsigned)((size_t)(t + 2) * kstB);
            const unsigned a3 = a2 + (unsigned)kstA, b3 = b2 + (unsigned)kstB;
            if (last && has_next) S.a_ready(nxt);
            if constexpr (SP2) {
            PG8_LDB(B0, 0, 0); PG8_LDB(B1, 0, 1); PG8_SCHED; PG8_LDA(At, 0, 0); PG8_STAGE(PG8_SA(1, 1), rsA, a1 + (unsigned)hstA, voffA);
            PG8_WAIT_V(8); PG8_WAIT_L(0); PG8_BAR; PG8_MMA(0, 0, At, B0); PG8_MMA(0, 1, At, B1); PG8_BAR; PG8_SCHED;
            PG8_LDA(At, 0, 1); PG8_STAGE(PG8_SB(0, 0), rsB, b2, voffB); PG8_STAGE(PG8_SB(0, 1), rsB, b2 + (unsigned)hstB, voffB); PG8_STAGE(PG8_SA(0, 0), rsA, a2, voffA);
            PG8_WAIT_V(8); PG8_WAIT_L(0); PG8_BAR; PG8_MMA(1, 0, At, B0); PG8_MMA(1, 1, At, B1); PG8_BAR; PG8_SCHED;
            PG8_LDB(B0, 1, 0); PG8_LDB(B1, 1, 1); PG8_SCHED; PG8_LDA(At, 1, 0); PG8_STAGE(PG8_SA(0, 1), rsA, a2 + (unsigned)hstA, voffA);
            PG8_WAIT_V(8); PG8_WAIT_L(0); PG8_BAR; PG8_MMA(0, 0, At, B0); PG8_MMA(0, 1, At, B1); PG8_BAR; PG8_SCHED;
            PG8_LDA(At, 1, 1); PG8_STAGE(PG8_SB(1, 0), rsB, b3, voffB); PG8_STAGE(PG8_SB(1, 1), rsB, b3 + (unsigned)hstB, voffB); PG8_STAGE(PG8_SA(1, 0), rsA, a3, voffA);
            PG8_WAIT_V(8); PG8_WAIT_L(0); PG8_BAR; PG8_MMA(1, 0, At, B0); PG8_MMA(1, 1, At, B1); PG8_BAR; PG8_SCHED;
            } else {
            PG8_LDB(B0, 0, 0); PG8_SCHED; PG8_LDA(At, 0, 0); PG8_STAGE(PG8_SA(1, 1), rsA, a1 + (unsigned)hstA, voffA);
            PG8_WAIT_L(8); PG8_BAR; PG8_WAIT_L(0); PG8_MMA(0, 0, At, B0); PG8_BAR; PG8_SCHED;
            PG8_LDB(B1, 0, 1); PG8_STAGE(PG8_SB(0, 0), rsB, b2, voffB);
            PG8_BAR; PG8_WAIT_L(0); PG8_MMA(0, 1, At, B1); PG8_BAR;
            PG8_LDA(At, 0, 1); PG8_STAGE(PG8_SA(0, 0), rsA, a2, voffA);
            PG8_BAR; PG8_WAIT_L(0); PG8_MMA(1, 0, At, B0); PG8_BAR; PG8_SCHED;
            PG8_STAGE(PG8_SB(0, 1), rsB, b2 + (unsigned)hstB, voffB);
            PG8_WAIT_V(6); PG8_BAR; PG8_MMA(1, 1, At, B1); PG8_BAR;
            PG8_LDB(B0, 1, 0); PG8_SCHED; PG8_LDA(At, 1, 0); PG8_STAGE(PG8_SA(0, 1), rsA, a2 + (unsigned)hstA, voffA);
            PG8_WAIT_L(8); PG8_BAR; PG8_WAIT_L(0); PG8_MMA(0, 0, At, B0); PG8_BAR; PG8_SCHED;
            PG8_LDB(B1, 1, 1); PG8_STAGE(PG8_SB(1, 0), rsB, b3, voffB);
            PG8_BAR; PG8_WAIT_L(0); PG8_MMA(0, 1, At, B1); PG8_BAR;
            PG8_LDA(At, 1, 1); PG8_STAGE(PG8_SA(1, 0), rsA, a3, voffA);
            PG8_BAR; PG8_WAIT_L(0); PG8_MMA(1, 0, At, B0); PG8_BAR; PG8_SCHED;
            PG8_STAGE(PG8_SB(1, 1), rsB, b3 + (unsigned)hstB, voffB);
            PG8_WAIT_V(6); PG8_BAR; PG8_MMA(1, 1, At, B1); PG8_BAR;
            }
        }
        if constexpr (ALIGN_EPI) { if (wr == 0) PG8_BAR; }
        if constexpr (!Epi::AFTER_DRAIN) { E(acc, cur, wr, wc, fr, fq);
#ifdef PROBE_EPI2
            if constexpr (Epi::IDEMP) { asm volatile("" ::: "memory"); E(acc, cur, wr, wc, fr, fq); }
#endif
            S.done(cur); }
        if (!has_next) break;
#pragma unroll
        for (int a = 0; a < 2; ++a)
#pragma unroll
            for (int b = 0; b < 2; ++b)
#pragma unroll
                for (int m = 0; m < 4; ++m)
#pragma unroll
                    for (int n = 0; n < 2; ++n) acc[a][b][m][n] = (f32x4){0.f, 0.f, 0.f, 0.f};
        cur = nxt; cA = nA; cB = nB; ++ui;
        if constexpr (ALIGN_EPI) { if (wr == 1) PG8_BAR; }
    }
    PG8_WAIT_V(0);
    if constexpr (!ALIGN_EPI) { if (wr == 0) PG8_BAR; }
    PG8_BAR;
    if constexpr (Epi::AFTER_DRAIN) { E.fused(acc, cur, wr, wc, fr, fq, lds, wid, lane); S.done(cur); }
#undef PG8_SA
#undef PG8_SB
#undef PG8_STAGE
#undef PG8_LDA
#undef PG8_LDB
#undef PG8_MMA
#undef PG8_WAIT_V
#undef PG8_WAIT_V_SEL
#undef PG8_WAIT_L
#undef PG8_BAR
#undef PG8_SCHED
}
}

#ifndef PG8_SP2
#define PG8_SP2 true
#endif
#ifndef PG8_ALIGN
#define PG8_ALIGN true
#endif
#include <hip/hip_bf16.h>
#include <cmath>
namespace attn_body {
using bf16=__hip_bfloat16;
using bf16x8=__attribute__((ext_vector_type(8)))short;
using s16x4=__attribute__((ext_vector_type(4)))short;
using f32x16=__attribute__((ext_vector_type(16)))float;
using u32x4=__attribute__((ext_vector_type(4)))unsigned;
constexpr int BATCH=2,NHEAD=16,SEQ=4096,D=64,DM=6144;
constexpr int OPITCH=4096;
constexpr int NW=8,QBLK=32,QB=QBLK*4,KVBLK=64,NQB=SEQ/QB;
constexpr int ATTN_PITCH=DM, ATTN_UNIT_ROWS=QB;
__device__ __forceinline__ int crow(int r,int hi){return (r&3)+8*(r>>2)+4*hi;}
#define SBAR() __builtin_amdgcn_sched_barrier(0)
__device__ __forceinline__ void cmask(f32x16&p0,f32x16&p1,int jb,int qrel,int hi){
  const float NEG=-INFINITY; int kb=64*jb+4*hi;
  #pragma unroll
  for(int r=0;r<16;++r){int kv=kb+(r&3)+8*(r>>2); if(kv>qrel)p0[r]=NEG; if(kv+32>qrel)p1[r]=NEG;}
}

__device__ __forceinline__ int t5_bucket(int n){ if(n<16)return n; const int st[15]={19,21,24,27,31,35,40,46,52,59,67,77,87,99,113}; int b=16;
  #pragma unroll
  for(int i=0;i<15;++i)b+=(n>=st[i])?1:0; return b; }
typedef const __attribute__((address_space(3))) float* lds_cfptr;
__device__ __forceinline__ void bmask(f32x16&p0,f32x16&p1,int jb,int qrel,int hi,lds_cfptr lut){
  const float NEG=-INFINITY; const int base=qrel-64*jb-4*hi;
  #pragma unroll
  for(int r=0;r<16;++r){const int n0=base-((r&3)+8*(r>>2)),n1=n0-32;
    const float b0=lut[n0<0?0:(n0>128?128:n0)],b1=lut[n1<0?0:(n1>128?128:n1)];
    p0[r]=(n0<0)?NEG:p0[r]+b0; p1[r]=(n1<0)?NEG:p1[r]+b1;}
}
constexpr int NSLOT=3, SLOTB=8192;
constexpr int VSLOTB=16384, NVSLOT=4;
constexpr int LDS_K=0, LDS_V=NSLOT*SLOTB, LDS_WS=NSLOT*SLOTB+NVSLOT*VSLOTB, LDS_OST=LDS_WS+NW*64*4, LDS_LUT=LDS_OST+NW*4096, LDS_BYTES=LDS_LUT+1024;
constexpr float C2=0.125f*1.4426950408889634f;
__device__ __forceinline__ void glds16(const void*gsrc,unsigned lds_dst){unsigned keep;
  asm volatile("s_mov_b32 %0, m0\n\ts_mov_b32 m0, %2\n\ts_nop 0\n\tglobal_load_lds_dwordx4 %1, off\n\ts_mov_b32 m0, %0":"=&s"(keep):"v"(gsrc),"s"(lds_dst):"memory");}
__device__ __forceinline__ float max3f(float a,float b,float c){float r;asm("v_max3_f32 %0, %1, %2, %3":"=v"(r):"v"(a),"v"(b),"v"(c));return r;}
__device__ __forceinline__ float max2f(float a,float b){float r;asm("v_max_f32_e32 %0, %1, %2":"=v"(r):"v"(a),"v"(b));return r;}
__device__ __forceinline__ float fadd_s(float a,float b){float r;asm("v_add_f32_e32 %0, %1, %2":"=v"(r):"v"(a),"v"(b));return r;}
__device__ __forceinline__ float fsub_s(float a,float b){float r;asm("v_sub_f32_e32 %0, %1, %2":"=v"(r):"v"(a),"v"(b));return r;}
typedef float f32x2_t __attribute__((ext_vector_type(2))); typedef __bf16 bf16x2_t __attribute__((ext_vector_type(2)));
__device__ __forceinline__ unsigned cvtpk_s(float lo,float hi){f32x2_t v={lo,hi};bf16x2_t b=__builtin_convertvector(v,bf16x2_t);return __builtin_bit_cast(unsigned,b);}
#ifdef PROBE_ATT_2BAR
#if PROBE_ATT_2BAR == 3
#define WAIT_BAR(N) asm volatile("s_waitcnt vmcnt(" #N ") lgkmcnt(0)\n\ts_barrier\n\ts_barrier\n\ts_barrier":::"memory")
#elif PROBE_ATT_2BAR == 2
#define WAIT_BAR(N) asm volatile("s_waitcnt vmcnt(" #N ") lgkmcnt(0)\n\ts_barrier\n\ts_nop 7\n\ts_nop 7":::"memory")
#else
#define WAIT_BAR(N) asm volatile("s_waitcnt vmcnt(" #N ") lgkmcnt(0)\n\ts_barrier\n\ts_barrier":::"memory")
#endif
#else
#define WAIT_BAR(N) asm volatile("s_waitcnt vmcnt(" #N ") lgkmcnt(0)\n\ts_barrier":::"memory")
#endif

__device__ __forceinline__ void qkt(f32x16&p0,f32x16&p1,const char*Kslot,const bf16x8*qr,const f32x16&negm,int r32,int hi){
  const char*kb=Kslot+hi*1024+r32*16;
  #pragma unroll
  for(int d0=0;d0<4;++d0){
    const bf16x8 b0=*reinterpret_cast<const bf16x8*>(kb+d0*2048);
    const bf16x8 b1=*reinterpret_cast<const bf16x8*>(kb+d0*2048+512);
    if(d0==0){p0=__builtin_amdgcn_mfma_f32_32x32x16_bf16(b0,qr[0],negm,0,0,0);p1=__builtin_amdgcn_mfma_f32_32x32x16_bf16(b1,qr[0],negm,0,0,0);}
    else{p0=__builtin_amdgcn_mfma_f32_32x32x16_bf16(b0,qr[d0],p0,0,0,0);p1=__builtin_amdgcn_mfma_f32_32x32x16_bf16(b1,qr[d0],p1,0,0,0);}}
}
typedef __attribute__((address_space(3))) const char* lds_cptr;
typedef short v4i16_t __attribute__((ext_vector_type(4)));
__device__ __forceinline__ void kload8(bf16x8*kf,lds_cptr kp){
  kf[0]=*(const __attribute__((address_space(3))) bf16x8*)(kp);      kf[1]=*(const __attribute__((address_space(3))) bf16x8*)(kp+512);
  kf[2]=*(const __attribute__((address_space(3))) bf16x8*)(kp+2048); kf[3]=*(const __attribute__((address_space(3))) bf16x8*)(kp+2560);
  kf[4]=*(const __attribute__((address_space(3))) bf16x8*)(kp+4096); kf[5]=*(const __attribute__((address_space(3))) bf16x8*)(kp+4608);
  kf[6]=*(const __attribute__((address_space(3))) bf16x8*)(kp+6144); kf[7]=*(const __attribute__((address_space(3))) bf16x8*)(kp+6656);
}
__device__ __forceinline__ void kload2(bf16x8*kf,lds_cptr kp,int j){ kf[2*j]=*(const __attribute__((address_space(3))) bf16x8*)(kp+j*2048); kf[2*j+1]=*(const __attribute__((address_space(3))) bf16x8*)(kp+j*2048+512); }
__device__ __forceinline__ s16x4 vtr(lds_cptr p){ return __builtin_bit_cast(s16x4,__builtin_amdgcn_ds_read_tr16_b64_v4i16((__attribute__((address_space(3))) v4i16_t*)p)); }
__device__ __forceinline__ void qkt1(f32x16&p0,const char*kb,const bf16x8*qr,const f32x16&negm){
  #pragma unroll
  for(int d0=0;d0<4;++d0){ const bf16x8 b0=*reinterpret_cast<const bf16x8*>(kb+d0*2048);
    if(d0==0)p0=__builtin_amdgcn_mfma_f32_32x32x16_bf16(b0,qr[0],negm,0,0,0); else p0=__builtin_amdgcn_mfma_f32_32x32x16_bf16(b0,qr[d0],p0,0,0,0);}
}
__device__ __forceinline__ void kload4(bf16x8*kf,lds_cptr kp){
  kf[0]=*(const __attribute__((address_space(3))) bf16x8*)(kp);      kf[1]=*(const __attribute__((address_space(3))) bf16x8*)(kp+2048);
  kf[2]=*(const __attribute__((address_space(3))) bf16x8*)(kp+4096); kf[3]=*(const __attribute__((address_space(3))) bf16x8*)(kp+6144);
}
__device__ __forceinline__ void kload1(bf16x8*kf,lds_cptr kp,int j){ kf[j]=*(const __attribute__((address_space(3))) bf16x8*)(kp+j*2048); }
__device__ __forceinline__ float rowmax1(const f32x16&p0){
  float a=max3f(p0[0],p0[1],p0[2]),b=max3f(p0[3],p0[4],p0[5]);
  a=max3f(a,p0[6],p0[7]);b=max3f(b,p0[8],p0[9]);a=max3f(a,p0[10],p0[11]);b=max3f(b,p0[12],p0[13]);a=max3f(a,p0[14],p0[15]);
  const float m=max2f(a,b);
  auto rr=__builtin_amdgcn_permlane32_swap(__float_as_uint(m),__float_as_uint(m),false,false);
  return max2f(__uint_as_float(rr[0]),__uint_as_float(rr[1]));
}
__device__ __forceinline__ void bmask1(f32x16&p0,int nb,lds_cfptr lut){
  #pragma unroll
  for(int r=0;r<16;++r){ int n0=nb-((r&3)+8*(r>>2)); n0=n0<-1?-1:(n0>128?128:n0); p0[r]+=lut[n0+1]; }
}
__device__ __forceinline__ void pv2(f32x16*o,int vb,bf16x8 pa0,bf16x8 pa1){
  #pragma unroll
  for(int d0=0;d0<4;++d0){s16x4 lo[2],hi[2];
    #pragma unroll
    for(int ks=0;ks<2;++ks){
      asm volatile("ds_read_b64_tr_b16 %0,%1 offset:%c2":"=&v"(lo[ks]):"v"(vb),"i"(d0*4096+ks*1024):"memory");
      asm volatile("ds_read_b64_tr_b16 %0,%1 offset:%c2":"=&v"(hi[ks]):"v"(vb),"i"(d0*4096+ks*1024+512):"memory");}
    asm volatile("s_waitcnt lgkmcnt(0)":::"memory");SBAR();
    #define PK(k) (bf16x8){lo[k][0],lo[k][1],lo[k][2],lo[k][3],hi[k][0],hi[k][1],hi[k][2],hi[k][3]}
    o[d0]=__builtin_amdgcn_mfma_f32_32x32x16_bf16(pa0,PK(0),o[d0],0,0,0);
    o[d0]=__builtin_amdgcn_mfma_f32_32x32x16_bf16(pa1,PK(1),o[d0],0,0,0);
    #undef PK
  }
}
__device__ __forceinline__ float rowmax(const f32x16&p0,const f32x16&p1){
  float a=max3f(p0[0],p0[1],p1[0]),b=max3f(p0[2],p0[3],p1[1]);a=max3f(a,p1[2],p1[3]);
  #pragma unroll
  for(int r=4;r<16;r+=4){a=max3f(a,p0[r],p0[r+1]);b=max3f(b,p0[r+2],p0[r+3]);a=max3f(a,p1[r],p1[r+1]);b=max3f(b,p1[r+2],p1[r+3]);}
  const float m=max2f(a,b);
  auto rr=__builtin_amdgcn_permlane32_swap(__float_as_uint(m),__float_as_uint(m),false,false);
  return max2f(__uint_as_float(rr[0]),__uint_as_float(rr[1]));
}
__device__ __forceinline__ void pv(f32x16*o,int vb,bf16x8 pa0,bf16x8 pa1,bf16x8 pa2,bf16x8 pa3){
  #pragma unroll
  for(int d0=0;d0<2;++d0){s16x4 lo[4],hi[4];
    #pragma unroll
    for(int ks=0;ks<4;++ks){
      asm volatile("ds_read_b64_tr_b16 %0,%1 offset:%c2":"=&v"(lo[ks]):"v"(vb),"i"(d0*4096+ks*1024):"memory");
      asm volatile("ds_read_b64_tr_b16 %0,%1 offset:%c2":"=&v"(hi[ks]):"v"(vb),"i"(d0*4096+ks*1024+512):"memory");}
    asm volatile("s_waitcnt lgkmcnt(0)":::"memory");SBAR();
    #define PK(k) (bf16x8){lo[k][0],lo[k][1],lo[k][2],lo[k][3],hi[k][0],hi[k][1],hi[k][2],hi[k][3]}
    o[d0]=__builtin_amdgcn_mfma_f32_32x32x16_bf16(pa0,PK(0),o[d0],0,0,0);
    o[d0]=__builtin_amdgcn_mfma_f32_32x32x16_bf16(pa1,PK(1),o[d0],0,0,0);
    o[d0]=__builtin_amdgcn_mfma_f32_32x32x16_bf16(pa2,PK(2),o[d0],0,0,0);
    o[d0]=__builtin_amdgcn_mfma_f32_32x32x16_bf16(pa3,PK(3),o[d0],0,0,0);
    #undef PK
  }
}

__device__ __forceinline__ void build_lut(char*shm,const float*relb,int h,int tid){
  __attribute__((address_space(3))) float* lw=(__attribute__((address_space(3))) float*)((__attribute__((address_space(3))) char*)shm+LDS_LUT);
  if(tid<129){ const int bk=t5_bucket(tid); lw[1+tid]=(relb[bk*NHEAD+h]-relb[31*NHEAD+h])*1.4426950408889634f; } else if(tid==129){ lw[0]=-INFINITY; }
}
#ifndef ATTN_STORE16
#define ATTN_STORE16(p,v) (*(u32x4*)(p)=(v))
#endif
struct UnitArgs { int kind; int qcol,kcol,vcol,ocol; const float* relb; float* scr; float lam,oscale; const float* gain; };
template<int THRL> __device__ __forceinline__ void attn_unit(int b,int h,int qb,const bf16*Q,const bf16*__restrict__ K,const bf16*__restrict__ V,bf16*O,char*shm,const UnitArgs&ua){
  int tid_=threadIdx.x; asm volatile("":"+v"(tid_)); const int tid=tid_,lane=tid&63,r32=lane&31,hi=lane>>5; const int wid=__builtin_amdgcn_readfirstlane(tid>>6);
  const int rg=wid&3,g=wid>>2;
#ifdef ATT_PRIO
  if(g)__builtin_amdgcn_s_setprio(ATT_PRIO);
#endif
  const long rowbase=(long)b*SEQ; const int q0=qb*QB;
  const bf16*Qw=Q+(rowbase+q0+rg*QBLK)*DM+ua.qcol;
  const unsigned lds0=(unsigned)(uintptr_t)shm;
  float*wsf=(float*)(shm+LDS_WS)+wid*64;
  const char*ksrc=(const char*)K+wid*1024+lane*16;
  const char*vsrc=(const char*)V+wid*1024+lane*16;
  const unsigned kdst=lds0+LDS_K+wid*1024, vdst=lds0+LDS_V+wid*1024;
  #define DMA_K(t,slot) glds16(ksrc+(long)(t)*8192,(unsigned)__builtin_amdgcn_readfirstlane(kdst+(slot)))
  #define VSL(t) (((t)&(NVSLOT-1))*VSLOTB)
  #define DMA_V(t) do{ glds16(vsrc+(long)(t)*16384,(unsigned)__builtin_amdgcn_readfirstlane(vdst+VSL(t))); glds16(vsrc+8192+(long)(t)*16384,(unsigned)__builtin_amdgcn_readfirstlane(vdst+VSL(t)+8192)); }while(0)
  const int vb0=(int)(lds0+LDS_V)+((lane>>4)&1)*32+(lane&3)*8+(4*hi+((lane&15)>>2))*64+g*2048;
  bf16x8 kf[4];
  const lds_cptr shm3=(lds_cptr)shm; const lds_cptr kp0=shm3+LDS_K+hi*1024+r32*16+g*512; const lds_cptr vp0=shm3+LDS_V+((lane>>4)&1)*32+(lane&3)*8+(4*hi+((lane&15)>>2))*64+g*2048;
  const int NTd=(q0+QB)/KVBLK, NT=NTd<4?4:NTd;
  const lds_cfptr lutp=(lds_cfptr)((lds_cptr)shm+LDS_LUT);
  DMA_K(0,0);DMA_V(0);DMA_K(1,SLOTB);
  bf16x8 qr[4];
  #pragma unroll
  for(int d0=0;d0<4;++d0)qr[d0]=*reinterpret_cast<const bf16x8*>(&Qw[(long)r32*DM+d0*16+hi*8]);
  float mhat=0.f,l_reg=0.f;f32x16 o[4];o[0]=f32x16{};o[1]=f32x16{};o[2]=f32x16{};o[3]=f32x16{};f32x16 negm=f32x16{};asm volatile("":"+v"(negm));
  const int qw=q0+rg*QBLK-32*g;
  const int qabs=q0+rg*QBLK+r32-32*g-4*hi;
  #define CMASK(P0,t) do{ if(qw-64*(t)<144)bmask1(P0,qabs-64*(t),lutp); }while(0)
  bool resc=false;
  #define START(P0) do{ const float rm=rowmax1(P0); resc=false; \
    { const float dl=(rm==-INFINITY)?0.f:rm; mhat=fadd_s(mhat,dl); \
      _Pragma("unroll") for(int r=0;r<16;++r){P0[r]=fsub_s(P0[r],dl);} \
      _Pragma("unroll") for(int r=0;r<16;++r)negm[r]=-mhat; asm volatile("":"+v"(negm)); } \
    _Pragma("unroll") for(int r=0;r<16;++r)P0[r]=__builtin_amdgcn_exp2f(P0[r]); }while(0)
  #define RESC() do{ if(resc){ asm volatile("s_waitcnt lgkmcnt(0)":::"memory"); \
      _Pragma("unroll") for(int d_=0;d_<4;++d_) _Pragma("unroll") for(int r=0;r<16;++r)o[d_][r]*=wsf[crow(r,hi)]; } }while(0)
  f32x16 pA0,pB0;
  int sl_prev=0,sl_cur=0,sl_next=SLOTB;
  #define ROT() do{sl_prev=sl_cur;sl_cur=sl_next;sl_next=(sl_next==(NSLOT-1)*SLOTB)?0:sl_next+SLOTB;}while(0)
  DMA_K(2,2*SLOTB);DMA_V(1);
  WAIT_BAR(6);
  qkt1(pA0,shm+LDS_K+hi*1024+r32*16+g*512,qr,negm);asm volatile("s_nop 15\n\ts_nop 7":"+v"(pA0));CMASK(pA0,0);
  START(pA0);
  WAIT_BAR(2);
  DMA_K(3,0);DMA_V(2);
  ROT();
  kload4(kf,kp0+sl_cur);
  WAIT_BAR(5);
  s16x4 vlo[8],vhi[8]; u32x4 pw0,pw1;
  #define PKW(P,B) cvtpk_s(P[B],P[B+1])
  #define PAF(k) __builtin_bit_cast(bf16x8,pw##k)
  #define VFR(i) (bf16x8){vlo[i][0],vlo[i][1],vlo[i][2],vlo[i][3],vhi[i][0],vhi[i][1],vhi[i][2],vhi[i][3]}
  #define PIN(x) asm volatile("":"+v"(x))
  #define MX3(a,b,c) __builtin_fmaxf(__builtin_fmaxf((a),(b)),(c))
  #define GAPA(MF,A0,A1,A2,A3,W0,W1,PW) do{ MF; sacc+=A0; sacc+=A1; sacc+=A2; sacc+=A3; PIN(sacc); W0; W1; PIN(PW); SBAR(); }while(0)
  #define EX(v) __builtin_amdgcn_exp2f(v)
  #define GAPB(MF,X,B) do{ MF; X[B]=EX(X[B]); X[B+1]=EX(X[B+1]); PIN(X); SBAR(); }while(0)
  #define VRD(w,d,k) do{ vlo[w]=vtr(vp_+((d)*4096+(k)*1024)); vhi[w]=vtr(vp_+((d)*4096+(k)*1024+512)); }while(0)
  #define KRD(G,j) do{ if(G){ kload1(kf,kp0+sl_next,j); SBAR(); } }while(0)
  #define STEP(C0,P0,t,GK,GV,GL) do{ SBAR(); \
    const lds_cptr vp_=vp0+VSL((t)-1); \
    VRD(0,0,0); VRD(1,1,0); SBAR(); float sacc=(P0[0]+P0[1]); \
    GAPA(C0=__builtin_amdgcn_mfma_f32_32x32x16_bf16(kf[0],qr[0],negm,0,0,0), P0[2],P0[3],P0[4],P0[5],     pw0[0]=PKW(P0,0), pw0[1]=PKW(P0,2), pw0); \
    VRD(2,2,0); VRD(3,3,0); SBAR(); GAPA(C0=__builtin_amdgcn_mfma_f32_32x32x16_bf16(kf[1],qr[1],C0,0,0,0), P0[6],P0[7],P0[8],P0[9],     pw0[2]=PKW(P0,4), pw0[3]=PKW(P0,6), pw0); \
    VRD(4,0,1); VRD(5,1,1); SBAR(); GAPA(C0=__builtin_amdgcn_mfma_f32_32x32x16_bf16(kf[2],qr[2],C0,0,0,0), P0[10],P0[11],P0[12],P0[13], pw1[0]=PKW(P0,8), pw1[1]=PKW(P0,10), pw1); \
    VRD(6,2,1); VRD(7,3,1); SBAR(); GAPA(C0=__builtin_amdgcn_mfma_f32_32x32x16_bf16(kf[3],qr[3],C0,0,0,0), P0[14],P0[15],0.f,0.f,       pw1[2]=PKW(P0,12),pw1[3]=PKW(P0,14), pw1); \
    l_reg+=sacc; \
    if(GK){DMA_K((t)+3,sl_cur);} if(GV){DMA_V((t)+2);} \
    CMASK(C0,t); \
    { float a=MX3(C0[0],C0[1],C0[2]),b=MX3(C0[3],C0[4],C0[5]); a=MX3(a,C0[6],C0[7]); b=MX3(b,C0[8],C0[9]); a=MX3(a,C0[10],C0[11]); b=MX3(b,C0[12],C0[13]); a=MX3(a,C0[14],C0[15]); \
      float rm=__builtin_fmaxf(a,b); { auto rr=__builtin_amdgcn_permlane32_swap(__float_as_uint(rm),__float_as_uint(rm),false,false); rm=__builtin_fmaxf(__uint_as_float(rr[0]),__uint_as_float(rr[1])); } \
      resc=false; \
      if(__builtin_expect(__any(rm>(float)THRL),0)){ const float dl=__builtin_fmaxf(rm,0.f); mhat+=dl; \
        _Pragma("unroll") for(int r=0;r<16;++r){C0[r]-=dl;} \
        _Pragma("unroll") for(int r=0;r<16;++r)negm[r]=-mhat; asm volatile("":"+v"(negm)); \
        const float f=__builtin_amdgcn_exp2f(-dl); l_reg*=f; if(hi==0)wsf[r32]=f; resc=true; } } \
    SBAR(); MIDBAR(); \
    GAPB(o[0]=__builtin_amdgcn_mfma_f32_32x32x16_bf16(PAF(0),VFR(0),o[0],0,0,0), C0,0); \
    GAPB(o[1]=__builtin_amdgcn_mfma_f32_32x32x16_bf16(PAF(0),VFR(1),o[1],0,0,0), C0,2); \
    KRD(GL,0); GAPB(o[2]=__builtin_amdgcn_mfma_f32_32x32x16_bf16(PAF(0),VFR(2),o[2],0,0,0), C0,4); \
    KRD(GL,1); GAPB(o[3]=__builtin_amdgcn_mfma_f32_32x32x16_bf16(PAF(0),VFR(3),o[3],0,0,0), C0,6); \
    KRD(GL,2); GAPB(o[0]=__builtin_amdgcn_mfma_f32_32x32x16_bf16(PAF(1),VFR(4),o[0],0,0,0), C0,8); \
    KRD(GL,3); GAPB(o[1]=__builtin_amdgcn_mfma_f32_32x32x16_bf16(PAF(1),VFR(5),o[1],0,0,0), C0,10); \
    GAPB(o[2]=__builtin_amdgcn_mfma_f32_32x32x16_bf16(PAF(1),VFR(6),o[2],0,0,0), C0,12); \
    GAPB(o[3]=__builtin_amdgcn_mfma_f32_32x32x16_bf16(PAF(1),VFR(7),o[3],0,0,0), C0,14); \
    }while(0)
#ifdef ATT_SKEW
  #define SKEW() do{ if(g)__builtin_amdgcn_s_sleep(ATT_SKEW); }while(0)
#else
  #define SKEW() do{}while(0)
#endif
#ifdef ATT_MIDBAR
  #define MIDBAR() do{ asm volatile("s_barrier":::"memory"); SBAR(); }while(0)
#else
  #define MIDBAR() do{}while(0)
#endif
  int t=1;
  #undef CMASK
  #define CMASK(P0,t) do{}while(0)
  for(;t+7<NT;t+=2){
#ifdef PROBE_ATT_STRICT
    STEP(pB0,pA0,t,true,true,true);     WAIT_BAR(2); SKEW(); RESC(); ROT();
    STEP(pA0,pB0,t+1,true,true,true);   WAIT_BAR(2); SKEW(); RESC(); ROT();
#else
    STEP(pB0,pA0,t,true,true,true);     WAIT_BAR(5); SKEW(); RESC(); ROT();
    STEP(pA0,pB0,t+1,true,true,true);   WAIT_BAR(5); SKEW(); RESC(); ROT();
#endif
  }
  #undef CMASK
  #define CMASK(P0,t) do{ if(qw-64*(t)<144)bmask1(P0,qabs-64*(t),lutp); }while(0)
  #define ENDW(tt) do{ if((tt)+3<NT){WAIT_BAR(5);} else if((tt)+2<NT){WAIT_BAR(4);} else {WAIT_BAR(0);} }while(0)
  for(;t+1<NT;t+=2){
    STEP(pB0,pA0,t,(t+3<NT),(t+2<NT),(t+1<NT));       ENDW(t);   RESC(); ROT();
    STEP(pA0,pB0,t+1,(t+4<NT),(t+3<NT),(t+2<NT));     ENDW(t+1); RESC(); ROT();
  }
  STEP(pB0,pA0,NT-1,false,false,false); RESC();
  { float sacc=pB0[0]+pB0[1]; _Pragma("unroll") for(int r=2;r<16;++r)sacc+=pB0[r]; l_reg+=sacc;
    pw0=(u32x4){PKW(pB0,0),PKW(pB0,2),PKW(pB0,4),PKW(pB0,6)};pw1=(u32x4){PKW(pB0,8),PKW(pB0,10),PKW(pB0,12),PKW(pB0,14)};
    SBAR(); pv2(o,vb0+VSL(NT-1),PAF(0),PAF(1)); }
  #undef PKW
  #undef PAF
  #undef VFR
  #undef PIN
  #undef MX3
  #undef GAPA
  #undef GAPB
  #undef EX
  #undef VRD
  #undef KRD
  #undef STEP
  #undef ENDW
  {auto rr=__builtin_amdgcn_permlane32_swap(__float_as_uint(l_reg),__float_as_uint(l_reg),false,false);l_reg=__uint_as_float(rr[0])+__uint_as_float(rr[1]);}
  asm volatile("s_waitcnt lgkmcnt(0)\n\ts_barrier":::"memory");
  typedef float f32x4v __attribute__((ext_vector_type(4)));
  float*xs=(float*)shm+rg*(64*64+64)+64*64;
  f32x4v*xo4=(f32x4v*)((float*)shm+rg*(64*64+64));
  if(g==1){
    #pragma unroll
    for(int d0=0;d0<4;++d0){
      #pragma unroll
      for(int r4=0;r4<4;++r4)xo4[(d0*4+r4)*64+lane]=(f32x4v){o[d0][4*r4],o[d0][4*r4+1],o[d0][4*r4+2],o[d0][4*r4+3]};}
    if(hi==0){xs[r32]=mhat;xs[32+r32]=l_reg;}
  }
  asm volatile("s_waitcnt lgkmcnt(0)\n\ts_barrier":::"memory");
  if(g==0){
    const float mb=xs[r32],lb=xs[32+r32];
    const float m=(lb>0.f)?__builtin_fmaxf(mhat,mb):mhat,wa=__builtin_amdgcn_exp2f(mhat-m),wb=(lb>0.f)?__builtin_amdgcn_exp2f(mb-m):0.f;
    const float linv=__builtin_amdgcn_rcpf(l_reg*wa+lb*wb);
    if(hi==0){wsf[r32]=wa*linv;wsf[32+r32]=wb*linv;}
    f32x4v*sc4=(f32x4v*)ua.scr+(rg*16)*64+lane;
    f32x4v t2[16];
    if(ua.kind!=0){
      #pragma unroll
      for(int i=0;i<16;++i)t2[i]=__builtin_nontemporal_load(sc4+i*64);
    }
    asm volatile("s_waitcnt lgkmcnt(0)":::"memory");
    #pragma unroll
    for(int r4=0;r4<4;++r4){ const f32x4v fa=*(const f32x4v*)(wsf+8*r4+4*hi),fb=*(const f32x4v*)(wsf+32+8*r4+4*hi);
      #pragma unroll
      for(int d0=0;d0<4;++d0){ const f32x4v ob=xo4[(d0*4+r4)*64+lane];
        #pragma unroll
        for(int j=0;j<4;++j)o[d0][4*r4+j]=o[d0][4*r4+j]*fa[j]+ob[j]*fb[j]; } }
    if(ua.kind==0){
      #pragma unroll
      for(int d0=0;d0<4;++d0){
        #pragma unroll
        for(int r4=0;r4<4;++r4)sc4[(d0*4+r4)*64]=(f32x4v){o[d0][4*r4],o[d0][4*r4+1],o[d0][4*r4+2],o[d0][4*r4+3]};} }
    else{
      float rs[16];
      #pragma unroll
      for(int r=0;r<16;++r){ float ss=0.f;
        #pragma unroll
        for(int d0=0;d0<4;++d0){const float a=o[d0][r]-ua.lam*t2[d0*4+(r>>2)][r&3]; o[d0][r]=a; ss+=a*a;}
        ss+=__shfl_xor(ss,1); ss+=__shfl_xor(ss,2); ss+=__shfl_xor(ss,4); ss+=__shfl_xor(ss,8); ss+=__shfl_xor(ss,16);
        rs[r]=ua.oscale*__builtin_amdgcn_rsqf(ss*(1.0f/128.0f)+1e-6f); }
      bf16*stg=(bf16*)(shm+LDS_OST)+wid*2048;
      #pragma unroll
      for(int vh=0;vh<2;++vh){
        const float g0=ua.gain[vh*64+r32],g1=ua.gain[vh*64+32+r32];
        #pragma unroll
        for(int r=0;r<16;++r){const int orow=crow(r,hi);
          stg[orow*64+r32]=__float2bfloat16(o[2*vh][r]*rs[r]*g0);
          stg[orow*64+32+r32]=__float2bfloat16(o[2*vh+1][r]*rs[r]*g1);}
        asm volatile("s_waitcnt lgkmcnt(0)":::"memory");
        #pragma unroll
        for(int i=0;i<4;++i){const int row=i*8+(lane>>3),ch=lane&7; const u32x4 v=*(const u32x4*)(stg+row*64+ch*8); ATTN_STORE16((char*)O+PG8_AOFF(rowbase+q0+rg*QBLK+row,ua.ocol+vh*64+ch*8,OPITCH),v);}
        asm volatile("s_waitcnt lgkmcnt(0)":::"memory");
      } }
  }
#ifdef ATT_PRIO
  __builtin_amdgcn_s_setprio(0);
#endif
  asm volatile("s_waitcnt lgkmcnt(0)\n\ts_barrier":::"memory");
  #undef DMA_K
  #undef DMA_V
  #undef VSL
  #undef CMASK
  #undef START
  #undef RESC
  #undef ROT
}
constexpr int ATTN_LDS_BYTES=LDS_BYTES;
#undef SBAR
#undef WAIT_BAR
}

constexpr int NWAVES = 8;
#ifndef MK_PER_PHASE
#define MK_PER_PHASE 0
#endif
constexpr int BATCH = 2, SEQ = 4096, DMODEL = 4096, M = BATCH * SEQ, DEPTH = 4, FF = 16384, NGRP = 128;
constexpr int N_PHASES = 2 + 6 * DEPTH;
constexpr size_t MiB = 1u << 20;
constexpr size_t WS_CTL = 0, CTL_ZERO_BYTES = 1 * MiB;
constexpr int CW_BAR = 4096;
constexpr size_t SSQ_OFF = 128 * 1024;
static_assert(SSQ_OFF + 9 * (size_t)M * 8 <= CTL_ZERO_BYTES, "ssq inside the memset region");
constexpr size_t WS_W = 16 * MiB, W_LAYER = 360 * MiB;
constexpr size_t W_IN = 0, W_OUT = 64 * MiB, W_UP = 96 * MiB, W_DN = 224 * MiB, W_GLU = 352 * MiB;
constexpr size_t WS_SSMP = WS_W + DEPTH * W_LAYER;
constexpr size_t SSMP_STRIDE = 144 * 1024;
constexpr size_t WS_KI = 1536 * MiB, WS_VI = 1568 * MiB;
constexpr size_t WS_H = 1536 * MiB, WS_HB = 1664 * MiB, WS_QKV = 1728 * MiB, WS_UT = 1824 * MiB, WS_YG = 1856 * MiB, WS_CAT = 1888 * MiB, WS_ATT = 1952 * MiB, WS_HID = 1984 * MiB, WS_END = 2240 * MiB;
static_assert(WS_SSMP + (size_t)DEPTH * NGRP * SSMP_STRIDE <= WS_H, "d_ws map");
constexpr int RING_OFF = 0, RING_BYTES = 131072;
constexpr int LDSCTL_OFF = RING_BYTES, MISC_OFF = LDSCTL_OFF + 320;
constexpr int LDS_BYTES = 147456;
static_assert(MISC_OFF + 128 <= LDS_BYTES, "LDS map");

#define GAS __attribute__((address_space(1)))
#define LAS __attribute__((address_space(3)))
typedef unsigned short bf16;
typedef unsigned v4u __attribute__((ext_vector_type(4)));
typedef float f32x4 __attribute__((ext_vector_type(4)));
typedef short bf16x8 __attribute__((ext_vector_type(8)));
typedef GAS unsigned gu32;
typedef GAS unsigned long long gu64;
#define RLX_AGENT __ATOMIC_RELAXED, __HIP_MEMORY_SCOPE_AGENT
#define LDS_WAIT() asm volatile("s_waitcnt lgkmcnt(0)" ::: "memory")
#define VM_WAIT() asm volatile("s_waitcnt vmcnt(0)" ::: "memory")
__device__ __forceinline__ unsigned long long rt() { return __builtin_amdgcn_s_memrealtime(); }
__device__ __forceinline__ unsigned f2bf(float f) { unsigned u = __builtin_bit_cast(unsigned, f); return (u + 0x7fffu + ((u >> 16) & 1u)) >> 16; }
__device__ __forceinline__ unsigned pk2(float lo, float hi) { return f2bf(lo) | (f2bf(hi) << 16); }

#define XB_TMO      128
#define XB_XCNT(j)  (256  + 64 * (j))
#define XB_XSUB(j)  (1280 + 64 * (j))
#define XB_XGEN(j)  (2304 + 64 * (j))
#define XB_TOP      3328
#define XB_TOPGEN   3392
#define XCD_BAR_WORDS 3456
#define XB_SPIN_CAP (1u << 18)

__device__ __forceinline__ unsigned xb_ld(unsigned* p)              { return __hip_atomic_load(p, __ATOMIC_RELAXED, __HIP_MEMORY_SCOPE_AGENT); }
__device__ __forceinline__ unsigned xb_add(unsigned* p, unsigned v) { return __hip_atomic_fetch_add(p, v, __ATOMIC_RELAXED, __HIP_MEMORY_SCOPE_AGENT); }
__device__ __forceinline__ unsigned xb_xcc_id() { return (unsigned)__builtin_amdgcn_s_getreg((3 << 11) | 20) & 0xFu; }
#define XB_SPIN(cond, bar) do { unsigned _sp = 0; while (cond) { __builtin_amdgcn_s_sleep(1); \
    if ((++_sp & 255u) == 0u) { if (xb_ld(&(bar)[XB_TMO])) break; if (_sp > XB_SPIN_CAP) { atomicAdd(&(bar)[XB_TMO], 1u); break; } } } } while (0)

struct XcdBarrier {
    unsigned* bar; unsigned x;
    volatile LAS unsigned* st;
};

__device__ __forceinline__ XcdBarrier xcd_barrier_post(unsigned* bar, volatile LAS unsigned* st) {
    XcdBarrier b; b.bar = bar; b.x = xb_xcc_id(); b.st = st;
    if (threadIdx.x == 0) (void)xb_add(&bar[XB_XCNT(b.x)], 1u);
    return b;
}
__device__ __forceinline__ void xcd_barrier_complete(unsigned* bar, unsigned x, unsigned& nloc, unsigned& nx) {
    const unsigned G = gridDim.x * gridDim.y * gridDim.z;
    unsigned sum, cnt, mine, sp = 0u;
    for (;;) {
        sum = 0u; cnt = 0u; mine = 0u;
#pragma unroll
        for (unsigned j = 0; j < 16; ++j) { const unsigned c = xb_ld(&bar[XB_XCNT(j)]); sum += c; cnt += (c > 0u) ? 1u : 0u; mine = (j == x) ? c : mine; }
        if (sum == G) break;
        __builtin_amdgcn_s_sleep(1);
        if ((++sp & 255u) == 0u) { if (xb_ld(&bar[XB_TMO])) break; if (sp > XB_SPIN_CAP) { atomicAdd(&bar[XB_TMO], 1u); break; } }
    }
    nloc = mine > 0u ? mine : 1u; nx = cnt > 0u ? cnt : 1u;
}

__device__ __forceinline__ void xcd_barrier(const XcdBarrier& b) {
    asm volatile("s_waitcnt vmcnt(0)" ::: "memory");
    __syncthreads();
    if (threadIdx.x == 0) {
        unsigned* bar = b.bar;
        __builtin_amdgcn_s_waitcnt(0);
        unsigned nloc = b.st[0], nx = b.st[1];
        if (nloc == 0u) { xcd_barrier_complete(bar, b.x, nloc, nx); b.st[0] = nloc; b.st[1] = nx; }
        const unsigned old = xb_add(&bar[XB_XSUB(b.x)], 1u);
        const unsigned gen = old / nloc;
        if (old + 1u == (gen + 1u) * nloc) {
            __builtin_amdgcn_fence(__ATOMIC_RELEASE, "agent");
            asm volatile("s_waitcnt vmcnt(0)" ::: "memory");
            const unsigned og = xb_add(&bar[XB_TOP], 1u);
            const unsigned tg = og / nx;
            if (og + 1u == (tg + 1u) * nx) xb_add(&bar[XB_TOPGEN], 1u);
            else XB_SPIN(xb_ld(&bar[XB_TOPGEN]) == tg, bar);
            __builtin_amdgcn_fence(__ATOMIC_ACQUIRE, "agent");
            xb_add(&bar[XB_XGEN(b.x)], 1u);
            asm volatile("s_waitcnt vmcnt(0)" ::: "memory");
        } else {
            XB_SPIN(xb_ld(&bar[XB_XGEN(b.x)]) == gen, bar);
            __builtin_amdgcn_fence(__ATOMIC_ACQUIRE, "agent");
            asm volatile("s_waitcnt vmcnt(0)" ::: "memory");
        }
    }
    __syncthreads();
}

struct Frame {
    LAS unsigned char* lds;
    volatile LAS unsigned* MISC;
    gu32* ctl;
    int tid, lane, wave;
    int vcu, G;
    const float* const* in;
    float* out; unsigned char* ws;
};
enum In { I_X = 0, I_WIN, I_WOUT, I_NMIX, I_NMLP, I_WUP, I_WDN, I_NFIN, I_RELB, I_LQ1, I_LK1, I_LQ2, I_LK2, I_SUBG, I_SLRE, I_SLIM, I_SLDT, I_SBRE, I_SBIM, I_SCRE, I_SCIM, I_SD, I_WGLU, I_BGLU, N_IN };

__device__ __forceinline__ float wave_sum(float v) {
#pragma unroll
    for (int o = 1; o < 64; o <<= 1) v += __shfl_xor(v, o);
    return v;
}
struct TItem { const float* src; const float* gain; bf16* dst; int N, K, n0, k0; };
struct TRegs { f32x4 v[8]; f32x4 g0, g1; };
__device__ __forceinline__ void tr_load(const TItem& t, TRegs& r, int lane) {
    const float* p = t.src + (size_t)(lane >> 4) * t.N + 4 * (lane & 15);
#pragma unroll
    for (int i = 0; i < 8; ++i) r.v[i] = *(const f32x4*)(p + (size_t)(4 * i) * t.N);
    if (t.gain) { r.g0 = *(const f32x4*)(t.gain + 8 * (lane >> 4)); r.g1 = *(const f32x4*)(t.gain + 8 * (lane >> 4) + 4); } else { r.g0 = (f32x4){1.f, 1.f, 1.f, 1.f}; r.g1 = r.g0; }
}
__device__ __forceinline__ void tr_store(const TItem& t, const TRegs& r, LAS float* scr, int lane) {
#pragma unroll
    for (int i = 0; i < 8; ++i) { LAS float* d = scr + (4 * i + (lane >> 4)) * 65 + 4 * (lane & 15); d[0] = r.v[i].x; d[1] = r.v[i].y; d[2] = r.v[i].z; d[3] = r.v[i].w; }
    LDS_WAIT(); asm volatile("" ::: "memory");
    const int c4 = lane >> 4;
#pragma unroll
    for (int j = 0; j < 4; ++j) { const int R = 16 * j + (lane & 15), nl = (R & ~31) + pg8::perm32(R & 31);
        const LAS float* s = scr + (8 * c4) * 65 + nl;
        v4u o; o.x = pg8::cvt_pk_bf16(s[0 * 65] * r.g0.x, s[1 * 65] * r.g0.y); o.y = pg8::cvt_pk_bf16(s[2 * 65] * r.g0.z, s[3 * 65] * r.g0.w); o.z = pg8::cvt_pk_bf16(s[4 * 65] * r.g1.x, s[5 * 65] * r.g1.y); o.w = pg8::cvt_pk_bf16(s[6 * 65] * r.g1.z, s[7 * 65] * r.g1.w);
        *(GAS v4u*)((GAS unsigned char*)t.dst + pg8::img_off(t.n0 + nl, t.k0 + 8 * c4, t.K, true)) = o; }
    LDS_WAIT(); asm volatile("" ::: "memory");
}
__device__ __forceinline__ void ssm_setup_unit(Frame& F, int l, int g) {
    LAS float* apr = (LAS float*)(F.lds + RING_OFF); LAS float* api = apr + 17 * 64; LAS float* bbr = api + 17 * 64; LAS float* bbi = bbr + 1024;
    LAS float* cr = bbi + 1024; LAS float* ci = cr + 1024; LAS float* gg = ci + 1024;
    const int lg = l * NGRP + g, tid = F.tid;
    bf16* P = (bf16*)(F.ws + WS_SSMP + (size_t)lg * SSMP_STRIDE); bf16* WmT = P; bf16* VmT = P + 32768; bf16* Kt = P + 65536; float* A16 = (float*)(P + 65536 + 17 * 256);
    if (tid < 64) { const int p = tid;
        const float dt = expf(F.in[I_SLDT][lg]), lr = F.in[I_SLRE][lg * 64 + p], li = F.in[I_SLIM][lg * 64 + p];
        const float mag = expf(lr * dt), th = li * dt, ar = mag * cosf(th), ai = mag * sinf(th);
        float pr = 1.f, pi = 0.f;
        for (int tau = 0; tau <= 16; ++tau) { apr[tau * 64 + p] = pr; api[tau * 64 + p] = pi; const float npr = pr * ar - pi * ai, npi = pr * ai + pi * ar; pr = npr; pi = npi; }
        const float den = lr * lr + li * li, nr = ar - 1.0f, ni = ai;
        gg[p] = (nr * lr + ni * li) / den; gg[64 + p] = (ni * lr - nr * li) / den; }
    __syncthreads();
    if (tid < 64) { A16[2 * tid] = apr[16 * 64 + tid]; A16[2 * tid + 1] = api[16 * 64 + tid]; }
    for (int idx = tid; idx < 1024; idx += NWAVES * 64) { const int p = idx >> 4;
        const float br = F.in[I_SBRE][(size_t)lg * 1024 + idx], bi = F.in[I_SBIM][(size_t)lg * 1024 + idx], gr = gg[p], gi = gg[64 + p];
        bbr[idx] = gr * br - gi * bi; bbi[idx] = gr * bi + gi * br;
        cr[idx] = F.in[I_SCRE][(size_t)lg * 1024 + idx]; ci[idx] = F.in[I_SCIM][(size_t)lg * 1024 + idx]; }
    __syncthreads();
    for (int e = tid; e < 32768; e += NWAVES * 64) { const int pp = e >> 8, k = e & 255, p = pp & 63, j = k >> 4, hh = k & 15, tau = 15 - j;
        const float ar = apr[tau * 64 + p], ai = api[tau * 64 + p], br = bbr[p * 16 + hh], bi = bbi[p * 16 + hh];
        WmT[e] = (bf16)f2bf(pp < 64 ? ar * br - ai * bi : ar * bi + ai * br); }
    for (int e = tid; e < 32768; e += NWAVES * 64) { const int n = e >> 7, pp = e & 127, p = pp & 63, t = n >> 4, hh = n & 15;
        const float ar = apr[(t + 1) * 64 + p], ai = api[(t + 1) * 64 + p], c_r = cr[hh * 64 + p], c_i = ci[hh * 64 + p];
        VmT[e] = (bf16)f2bf(pp < 64 ? c_r * ar - c_i * ai : -(c_r * ai + c_i * ar)); }
    for (int e = tid; e < 256; e += NWAVES * 64) Kt[e] = 0;
    for (int e = tid; e < 4096; e += NWAVES * 64) { const int tau = e >> 8, hh = (e >> 4) & 15, h2 = e & 15; float acc = 0.f;
        for (int p = 0; p < 64; ++p) { const float ar = apr[tau * 64 + p], ai = api[tau * 64 + p], c_r = cr[hh * 64 + p], c_i = ci[hh * 64 + p];
            const float xr = c_r * ar - c_i * ai, xi = c_r * ai + c_i * ar; acc += xr * bbr[p * 16 + h2] - xi * bbi[p * 16 + h2]; }
        if (tau == 0 && hh == h2) acc += F.in[I_SD][lg * 16 + hh];
        Kt[256 + e] = (bf16)f2bf(acc); }
    __syncthreads();
}
constexpr int IT_IN = (DMODEL / 64) * (8192 / 32), IT_OUT = (DMODEL / 64) * (DMODEL / 32), IT_UP = (DMODEL / 64) * (FF / 32), IT_DN = (FF / 64) * (DMODEL / 32), IT_GLU = (2048 / 64) * (2048 / 32);
constexpr int IT_LAYER = IT_IN + IT_OUT + IT_UP + IT_DN + IT_GLU;
#ifndef CONV_SPLIT_X8
#define CONV_SPLIT_X8 16
#endif
constexpr int CONV_SPLIT_LO = (int)((long)IT_LAYER * CONV_SPLIT_X8 / 8);
static_assert(CONV_SPLIT_LO >= IT_IN, "layer 0's in-projection weights are needed before the split phase");
#ifndef CONV_SPLIT_NB
#define CONV_SPLIT_NB 3
#endif
#ifndef CONV_SPLIT2
#define CONV_SPLIT2 0
#endif
constexpr int CONV_SPLIT2_LO = IT_IN;
#ifndef CONV_SPLIT
#define CONV_SPLIT 0
#endif
template <int NB> __device__ __forceinline__ void convert_items(Frame& F, int it_lo, int it_hi, int gw, int ngw) {
    int lane_ = F.lane; asm volatile("" : "+v"(lane_)); const int lane = lane_;
    LAS float* scr = (LAS float*)(F.lds + RING_OFF + F.wave * 16384);
    auto decode = [&](int it, TItem& t) {
        const int l = it / IT_LAYER; int r = it % IT_LAYER;
        unsigned char* wl = F.ws + WS_W + (size_t)l * W_LAYER;
        const float* W; const float* gain = nullptr; bf16* WT; int K, N;
        if (r < IT_IN) { W = F.in[I_WIN] + (size_t)l * DMODEL * 8192; K = DMODEL; N = 8192; gain = F.in[I_NMIX] + l * DMODEL; WT = (bf16*)(wl + W_IN); }
        else if ((r -= IT_IN) < IT_OUT) { W = F.in[I_WOUT] + (size_t)l * DMODEL * DMODEL; K = DMODEL; N = DMODEL; WT = (bf16*)(wl + W_OUT); }
        else if ((r -= IT_OUT) < IT_UP) { W = F.in[I_WUP] + (size_t)l * DMODEL * FF; K = DMODEL; N = FF; gain = F.in[I_NMLP] + l * DMODEL; WT = (bf16*)(wl + W_UP); }
        else if ((r -= IT_UP) < IT_DN) { W = F.in[I_WDN] + (size_t)l * FF * DMODEL; K = FF; N = DMODEL; WT = (bf16*)(wl + W_DN); }
        else { r -= IT_DN; W = F.in[I_WGLU] + (size_t)l * 2048 * 2048; K = 2048; N = 2048; WT = (bf16*)(wl + W_GLU); }
        const int nblk = N / 64, k0 = 32 * (r / nblk), n0 = 64 * (r % nblk);
        t.src = W + (size_t)k0 * N + n0; t.gain = gain ? gain + k0 : nullptr; t.dst = WT; t.N = N; t.K = K; t.n0 = n0; t.k0 = k0; };
    const int first = it_lo + gw;
    TItem t[NB]; TRegs r[NB];
#pragma unroll
    for (int k = 0; k < NB - 1; ++k) { const int i = first + k * ngw; if (i < it_hi) { decode(i, t[k]); tr_load(t[k], r[k], lane); } }
    for (int base = first; base < it_hi; base += NB * ngw) {
#pragma unroll
        for (int k = 0; k < NB; ++k) { const int cur = base + k * ngw;
            if (cur < it_hi) { const int nxt = cur + (NB - 1) * ngw;
                if (nxt < it_hi) { decode(nxt, t[(k + NB - 1) % NB]); tr_load(t[(k + NB - 1) % NB], r[(k + NB - 1) % NB], lane); }
                tr_store(t[k], r[k], scr, lane); } }
    }
}
__device__ __forceinline__ void p0_prologue(Frame& F) {
    const int gw = F.vcu * NWAVES + F.wave, NGW = F.G * NWAVES;
    convert_items<2>(F, 0, (CONV_SPLIT && F.G == 256) ? ((CONV_SPLIT2 || CONV_SPLIT == 2) ? CONV_SPLIT2_LO : CONV_SPLIT_LO) : DEPTH * IT_LAYER, gw, NGW);
    pg8::ssq_t* ssq0 = (pg8::ssq_t*)(F.ws + WS_CTL + SSQ_OFF);
    {
        f32x4 xv[16];
        if (gw < M) { const GAS f32x4* xr = (const GAS f32x4*)(F.in[I_X] + (size_t)gw * DMODEL) + F.lane;
#pragma unroll
            for (int j = 0; j < 16; ++j) xv[j] = xr[64 * j]; }
        for (int m = gw; m < M; m += NGW) {
            f32x4 xn[16]; const int mn = m + NGW;
            if (mn < M) { const GAS f32x4* xr = (const GAS f32x4*)(F.in[I_X] + (size_t)mn * DMODEL) + F.lane;
#pragma unroll
                for (int j = 0; j < 16; ++j) xn[j] = xr[64 * j]; }
            float s = 0.f;
#pragma unroll
            for (int j = 0; j < 16; ++j) { const f32x4 v = xv[j]; s += (v.x * v.x + v.y * v.y) + (v.z * v.z + v.w * v.w); *(GAS unsigned long long*)(F.ws + WS_HB + PG8_AOFF(m, 4 * (F.lane + 64 * j), DMODEL)) = (unsigned long long)pk2(v.x, v.y) | ((unsigned long long)pk2(v.z, v.w) << 32); }
            s = wave_sum(s); if (F.lane == 0) ssq0[m] = (pg8::ssq_t)(s * pg8::SSQ_SCALE);
#pragma unroll
            for (int j = 0; j < 16; ++j) xv[j] = xn[j];
        }
    }
    __syncthreads();
    for (int u = F.vcu; u < DEPTH * NGRP; u += F.G) ssm_setup_unit(F, u / NGRP, u % NGRP);
}
__device__ __forceinline__ float gelu_tanh(float y) { const float z = 0.7978845608028654f * (y + 0.044715f * y * y * y); return y * __builtin_amdgcn_rcpf(1.0f + __builtin_amdgcn_exp2f(-2.8853900817779268f * z)); }
__device__ __forceinline__ void ssm_unit(Frame& F, int l, int b, int g) {
    typedef short s16x8 __attribute__((ext_vector_type(8)));
#define SSM_SYNC() asm volatile("s_waitcnt lgkmcnt(0)\n\ts_barrier" ::: "memory")
    int lane_ = F.lane; asm volatile("" : "+v"(lane_));
    const int lane = lane_, w = F.wave, fr = lane & 15, fq = lane >> 4, tid = w * 64 + lane;
    const bf16* P = (const bf16*)(F.ws + WS_SSMP + (size_t)(l * NGRP + g) * SSMP_STRIDE); const bf16* WmT = P; const bf16* VmT = P + 32768; const bf16* Kt = P + 65536; const float* A16 = (const float*)(P + 65536 + 17 * 256);
    const bf16* U = (const bf16*)(F.ws + WS_UT) + ((size_t)g * M + (size_t)b * SEQ) * 16;
    bf16* YG = (bf16*)(F.ws + WS_YG);
    LAS float* S = (LAS float*)(F.lds + RING_OFF);
    LAS unsigned char* UQ = F.lds + RING_OFF + 64 * 132 * 4;
    s16x8 wf[8], kfl[4], kfh[8], vfl[4], vfh[4];
    const int tl = w, th = 15 - w;
    v4u pre[4];
#pragma unroll
    for (int i = 0; i < 4; ++i) pre[i] = *(const v4u*)(U + (size_t)(tid + 512 * i) * 8);
#pragma unroll
    for (int kk = 0; kk < 8; ++kk) wf[kk] = *(const s16x8*)(WmT + (16 * w + fr) * 256 + 32 * kk + 8 * fq);
#pragma unroll
    for (int kk = 0; kk < 4; ++kk) { const int tau = tl - 2 * kk - (fq >> 1); kfl[kk] = *(const s16x8*)(Kt + (tau < 0 ? 0 : tau + 1) * 256 + fr * 16 + 8 * (fq & 1)); }
#pragma unroll
    for (int kk = 0; kk < 8; ++kk) { const int tau = th - 2 * kk - (fq >> 1); kfh[kk] = *(const s16x8*)(Kt + (tau < 0 ? 0 : tau + 1) * 256 + fr * 16 + 8 * (fq & 1)); }
#pragma unroll
    for (int kk = 0; kk < 4; ++kk) { vfl[kk] = *(const s16x8*)(VmT + (tl * 16 + fr) * 128 + 32 * kk + 8 * fq); vfh[kk] = *(const s16x8*)(VmT + (th * 16 + fr) * 128 + 32 * kk + 8 * fq); }
    float sr = 0.f, si = 0.f, a16r = 0.f, a16i = 0.f;
    if (w == 0) { a16r = A16[2 * lane]; a16i = A16[2 * lane + 1]; }
    for (int q = 0; q < 4; ++q) {
#pragma unroll
        for (int i = 0; i < 4; ++i) { const int e = tid + 512 * i; *(LAS v4u*)(UQ + (e >> 5) * 528 + (e & 31) * 16) = pre[i]; }
        SSM_SYNC();
        if (q < 3) {
#pragma unroll
            for (int i = 0; i < 4; ++i) pre[i] = *(const v4u*)(U + (size_t)(q + 1) * 16384 + (size_t)(tid + 512 * i) * 8);
        }
#pragma unroll
        for (int mt = 0; mt < 4; ++mt) {
            const LAS unsigned char* ub = UQ + (mt * 16 + fr) * 528 + fq * 16;
            f32x4 acc = {0.f, 0.f, 0.f, 0.f};
#pragma unroll
            for (int kk = 0; kk < 8; ++kk) { const s16x8 uf = *(const LAS s16x8*)(ub + 64 * kk); acc = __builtin_amdgcn_mfma_f32_16x16x32_bf16(wf[kk], uf, acc, 0, 0, 0); }
            *(LAS f32x4*)(S + (mt * 16 + fr) * 132 + 16 * w + 4 * fq) = acc;
        }
        SSM_SYNC();
        if (w == 0) {
            for (int c0 = 0; c0 < 64; c0 += 8) { float tr[8], ti[8];
#pragma unroll
                for (int i = 0; i < 8; ++i) { tr[i] = S[(c0 + i) * 132 + lane]; ti[i] = S[(c0 + i) * 132 + 64 + lane]; }
#pragma unroll
                for (int i = 0; i < 8; ++i) { S[(c0 + i) * 132 + lane] = sr; S[(c0 + i) * 132 + 64 + lane] = si;
                    const float nsr = a16r * sr - a16i * si + tr[i], nsi = a16r * si + a16i * sr + ti[i]; sr = nsr; si = nsi; } }
        }
        SSM_SYNC();
#pragma unroll
        for (int mt = 0; mt < 4; ++mt) {
            const int chunk = q * 64 + mt * 16 + fr;
            const LAS unsigned char* ub = UQ + (mt * 16 + fr) * 528 + fq * 16;
            f32x4 accl = {0.f, 0.f, 0.f, 0.f}, acch = {0.f, 0.f, 0.f, 0.f};
#pragma unroll
            for (int kk = 0; kk < 8; ++kk) { const s16x8 uf = *(const LAS s16x8*)(ub + 64 * kk);
                if (kk < 4) accl = __builtin_amdgcn_mfma_f32_16x16x32_bf16(kfl[kk], uf, accl, 0, 0, 0);
                acch = __builtin_amdgcn_mfma_f32_16x16x32_bf16(kfh[kk], uf, acch, 0, 0, 0); }
#pragma unroll
            for (int kk = 0; kk < 4; ++kk) { const LAS float* sp = S + (mt * 16 + fr) * 132 + 32 * kk + 8 * fq; const f32x4 s0 = *(const LAS f32x4*)sp, s1 = *(const LAS f32x4*)(sp + 4);
                const s16x8 sf = __builtin_bit_cast(s16x8, pg8::pack8(s0, s1));
                accl = __builtin_amdgcn_mfma_f32_16x16x32_bf16(vfl[kk], sf, accl, 0, 0, 0); acch = __builtin_amdgcn_mfma_f32_16x16x32_bf16(vfh[kk], sf, acch, 0, 0, 0); }
            const size_t tok = (size_t)b * SEQ + (size_t)chunk * 16;
            { typedef unsigned u32x2 __attribute__((ext_vector_type(2)));
              u32x2 o; o.x = pg8::cvt_pk_bf16(gelu_tanh(accl[0]), gelu_tanh(accl[1])); o.y = pg8::cvt_pk_bf16(gelu_tanh(accl[2]), gelu_tanh(accl[3]));
              *(u32x2*)((char*)YG + PG8_AOFF(tok + tl, g * 16 + 4 * fq, 2048)) = o;
              o.x = pg8::cvt_pk_bf16(gelu_tanh(acch[0]), gelu_tanh(acch[1])); o.y = pg8::cvt_pk_bf16(gelu_tanh(acch[2]), gelu_tanh(acch[3]));
              *(u32x2*)((char*)YG + PG8_AOFF(tok + th, g * 16 + 4 * fq, 2048)) = o; }
        }
        SSM_SYNC();
    }
#undef SSM_SYNC
}

struct Args { const float* in[N_IN]; float* out; unsigned char* ws; int ph_lo, ph_hi; };
__global__ void __launch_bounds__(NWAVES * 64, 2) hymba_fwd(Args args) {
    extern __shared__ __attribute__((aligned(16))) unsigned char lds[];
    Frame F;
    F.lds = (LAS unsigned char*)lds;
    F.MISC = (volatile LAS unsigned*)(F.lds + MISC_OFF);
    F.tid = threadIdx.x; F.lane = F.tid & 63; F.wave = __builtin_amdgcn_readfirstlane(F.tid >> 6);
    F.G = gridDim.x; { const int bx = blockIdx.x; F.vcu = (F.G % 8 == 0) ? (bx % 8) * (F.G / 8) + bx / 8 : bx; }
    F.in = args.in; F.out = args.out; F.ws = args.ws;
    unsigned char* ws = args.ws;
    F.ctl = (gu32*)(ws + WS_CTL);
    for (int u = F.tid; u < (LDS_BYTES - LDSCTL_OFF) / 4; u += NWAVES * 64) ((LAS unsigned*)(F.lds + LDSCTL_OFF))[u] = 0u;
    __syncthreads();
    XcdBarrier bar; bar.bar = (unsigned*)(F.ctl + CW_BAR); bar.x = 0; bar.st = nullptr;
    if (!MK_PER_PHASE) bar = xcd_barrier_post((unsigned*)(F.ctl + CW_BAR), F.MISC + 8);
#ifndef REP_BAR
#define REP_BAR 1
#endif
#define GRID_BAR() do { if (MK_PER_PHASE) { if (F.tid == 0) __hip_atomic_store(F.ctl + 0, 0xBADBA0u, RLX_AGENT); } else { for (int rb_ = 0; rb_ < REP_BAR; ++rb_) xcd_barrier(bar); } } while (0)
    const int lo = args.ph_lo, hi = args.ph_hi;
#define IN(k) (lo <= (k) && (k) < hi)
#define BOTH(k) (IN(k) && IN((k) + 1))
    pg8::ssq_t* const ssq = (pg8::ssq_t*)(ws + WS_CTL + SSQ_OFF);
    pg8::bf16_t* const HB = (pg8::bf16_t*)(ws + WS_HB); pg8::bf16_t* const QKV = (pg8::bf16_t*)(ws + WS_QKV); pg8::bf16_t* const UT = (pg8::bf16_t*)(ws + WS_UT);
    pg8::bf16_t* const YG = (pg8::bf16_t*)(ws + WS_YG); pg8::bf16_t* const CAT = (pg8::bf16_t*)(ws + WS_CAT); pg8::bf16_t* const HID = (pg8::bf16_t*)(ws + WS_HID);

#ifndef REP_PRO
#define REP_PRO 1
#endif
#ifndef REP_SSM
#define REP_SSM 1
#endif
#ifndef REP_ATT
#define REP_ATT 1
#endif
#ifndef REP_GEMM
#define REP_GEMM 1
#endif
#ifndef REP_RES
#define REP_RES 1
#endif
    if (IN(0)) { for (int rep = 0; rep < REP_PRO; ++rep) { p0_prologue(F); __syncthreads(); } if (BOTH(0)) GRID_BAR(); }

    for (int l = 0; l < DEPTH; ++l) {
        const int pb = 1 + 6 * l;
        const unsigned char* wl = ws + WS_W + (size_t)l * W_LAYER;
        if (IN(pb)) {
#ifndef CONV_SPLIT2
#define CONV_SPLIT2 0
#endif
            const bool split2 = CONV_SPLIT && CONV_SPLIT2 && l == 0 && F.G == 256;
            pg8::Gemm g{HB, (const pg8::bf16_t*)(wl + W_IN), M, 8192, DMODEL, A_IMG, 1}; pg8::StaticOrder S;
            if (split2) S.init(M, 8192, 128, (F.vcu & 15) * 8 + (F.vcu >> 5)); else S.init(M, 8192, F.G, (int)blockIdx.x);
            pg8::EpiProj E{QKV, UT, ssq + (2 * l) * M, attn_body::C2, ws + WS_KI, ws + WS_VI};
#ifndef STG_IN
#define STG_IN 0
#endif
            if (STG_IN && (F.vcu & 1)) { for (int s_ = 0; s_ < STG_IN; ++s_) __builtin_amdgcn_s_sleep(48); }
            if (split2 && (F.vcu & 16)) convert_items<CONV_SPLIT_NB>(F, CONV_SPLIT2_LO, CONV_SPLIT_LO, ((F.vcu >> 5) * 16 + (F.vcu & 15)) * NWAVES + F.wave, 128 * NWAVES);
            else
            for (int rep = 0; rep < REP_GEMM; ++rep) { pg8::gemm_phase<pg8::EpiProj, pg8::StaticOrder, PG8_ALIGN, PG8_SP2>(F.lds + RING_OFF, g, S, E); __syncthreads(); }
            if (BOTH(pb)) GRID_BAR();
        }
        if (IN(pb + 1)) {
            for (int rep = 0; rep < REP_SSM; ++rep) for (int u = F.vcu; u < BATCH * NGRP; u += F.G) ssm_unit(F, l, u / NGRP, u % NGRP);
            __syncthreads();
            const float lam_init = 0.8f - 0.6f * expf(-0.3f * (float)l);
            const float d1 = wave_sum(F.in[I_LQ1][l * 64 + F.lane] * F.in[I_LK1][l * 64 + F.lane]), d2 = wave_sum(F.in[I_LQ2][l * 64 + F.lane] * F.in[I_LK2][l * 64 + F.lane]);
            const float lam = expf(d1) - expf(d2) + lam_init;
            const bool split = CONV_SPLIT && F.G == 256 && (l == 0 || (CONV_SPLIT == 2 && l == 1));
            const int half_id = (F.vcu >> 5) * 16 + (F.vcu & 15);
                        if (split && (F.vcu & 16)) convert_items<CONV_SPLIT_NB>(F, (CONV_SPLIT == 2) ? (l == 0 ? IT_IN : 2 * IT_LAYER) : CONV_SPLIT_LO, (CONV_SPLIT == 2 && l == 0) ? 2 * IT_LAYER : DEPTH * IT_LAYER, half_id * NWAVES + F.wave, 128 * NWAVES);
            else
            for (int rep = 0; rep < REP_ATT; ++rep) for (int pu = split ? half_id : F.vcu; pu < 256; pu += split ? 128 : F.G) {
                const int bh = pu >> 3, pp = pu & 7, b = bh >> 4, h = bh & 15;
#ifndef ATT_V64
                attn_body::build_lut((char*)lds + RING_OFF, F.in[I_RELB], h, F.tid);
#endif
#if defined(PROBE_ATT_QB)
                for (int xr = 0; xr < PROBE_ATT_N; ++xr) { attn_body::UnitArgs ua; ua.kind = 0; ua.qcol = h * 128 + 64; ua.kcol = 0; ua.vcol = 0; ua.ocol = h * 128;
                    ua.relb = F.in[I_RELB]; ua.scr = (float*)(ws + WS_ATT) + (size_t)F.vcu * (2 * 256 * 64); ua.lam = lam; ua.oscale = 1.0f - lam_init; ua.gain = F.in[I_SUBG] + l * 128;
                    attn_body::attn_unit<8>(b, h, PROBE_ATT_QB, (const attn_body::bf16*)QKV, (const attn_body::bf16*)(ws + WS_KI + (size_t)((bh * 2 + 1) * 64) * 8192), (const attn_body::bf16*)(ws + WS_VI + (size_t)(bh * 64) * 16384), (attn_body::bf16*)CAT, (char*)lds + RING_OFF, ua); }
#endif
#ifdef ATT_V64
                for (int qi = 0; qi < 2; ++qi) { const int qb = qi ? 15 - pp : pp;
                    for (int kind = 0; kind < 4; ++kind) { const int s2 = (kind < 2) ? 64 : 0, vh = kind & 1;
                        attn_body::UnitArgs ua; ua.kind = kind; ua.qcol = h * 128 + s2; ua.kcol = 2048 + h * 128 + s2; ua.vcol = 4096 + h * 128 + vh * 64; ua.ocol = h * 128;
#elif defined(ATT_PP)
                for (int qi = 0; qi < 2; ++qi) { const int qb = qi ? 15 - pp : pp;
                    for (int kind = 0; kind < 2; ++kind) { const int s2 = (kind < 1) ? 64 : 0;
                        attn_body::UnitArgs ua; ua.kind = kind; ua.qcol = h * 128 + s2; ua.kcol = 2048 + h * 128 + s2; ua.vcol = 4096 + h * 128; ua.ocol = h * 128;
#else
                for (int qi = 0; qi < 4; ++qi) { const int qb = (qi == 0) ? pp : (qi == 1) ? 15 - pp : (qi == 2) ? 16 + pp : 31 - pp;
                    for (int kind = 0; kind < 2; ++kind) { const int s2 = (kind < 1) ? 64 : 0;
                        attn_body::UnitArgs ua; ua.kind = kind; ua.qcol = h * 128 + s2; ua.kcol = 2048 + h * 128 + s2; ua.vcol = 4096 + h * 128; ua.ocol = h * 128;
#endif
                        ua.relb = F.in[I_RELB]; ua.scr = (float*)(ws + WS_ATT) + (size_t)F.vcu * (2 * 256 * 64); ua.lam = lam; ua.oscale = 1.0f - lam_init; ua.gain = F.in[I_SUBG] + l * 128;
                        attn_body::attn_unit<8>(b, h, qb, (const attn_body::bf16*)QKV, (const attn_body::bf16*)(ws + WS_KI + (size_t)((bh * 2 + (s2 >> 6)) * 64) * 8192), (const attn_body::bf16*)(ws + WS_VI + (size_t)(bh * 64) * 16384), (attn_body::bf16*)CAT, (char*)lds + RING_OFF, ua); } }
            }
            if (BOTH(pb + 1)) GRID_BAR();
        }
        if (IN(pb + 2)) {
            pg8::Gemm g{YG, (const pg8::bf16_t*)(wl + W_GLU), M, 2048, 2048, A_IMG, 1}; pg8::StaticOrder S; S.init(M, 2048, F.G, (int)blockIdx.x);
            pg8::EpiGlu E{YG, CAT, F.in[I_BGLU] + l * 2048};
            for (int rep = 0; rep < REP_GEMM; ++rep) { pg8::gemm_phase<pg8::EpiGlu, pg8::StaticOrder, PG8_ALIGN, PG8_SP2>(F.lds + RING_OFF, g, S, E); __syncthreads(); }
            if (BOTH(pb + 2)) GRID_BAR();
        }
        if (IN(pb + 3)) {
            pg8::Gemm g{CAT, (const pg8::bf16_t*)(wl + W_OUT), M, DMODEL, DMODEL, A_IMG, 1}; pg8::StaticOrder S; S.init(M, DMODEL, F.G, (int)blockIdx.x);
            pg8::EpiRes E{HB, ssq + (2 * l + 1) * M};
            pg8::gemm_phase<pg8::EpiRes, pg8::StaticOrder, PG8_ALIGN, PG8_SP2>(F.lds + RING_OFF, g, S, E);
            if (BOTH(pb + 3)) GRID_BAR();
        }
        if (IN(pb + 4)) {
            pg8::Gemm g{HB, (const pg8::bf16_t*)(wl + W_UP), M, FF, DMODEL, A_IMG, 1}; pg8::StaticOrder S; S.init(M, FF, F.G, (int)blockIdx.x);
            pg8::EpiUp E{HID, FF, ssq + (2 * l + 1) * M};
#ifndef STG_UP
#define STG_UP 0
#endif
#ifndef STG_UP_WAYS
#define STG_UP_WAYS 2
#endif
            if (STG_UP) { const int k_ = F.vcu & (STG_UP_WAYS - 1); for (int s_ = 0; s_ < STG_UP * k_; ++s_) __builtin_amdgcn_s_sleep(48 * 2 / STG_UP_WAYS); }
            for (int rep = 0; rep < REP_GEMM; ++rep) { pg8::gemm_phase<pg8::EpiUp, pg8::StaticOrder, PG8_ALIGN, PG8_SP2>(F.lds + RING_OFF, g, S, E); __syncthreads(); }
            if (BOTH(pb + 4)) GRID_BAR();
        }
        if (IN(pb + 5)) {
            pg8::Gemm g{HID, (const pg8::bf16_t*)(wl + W_DN), M, DMODEL, FF, A_IMG, 1}; pg8::StaticOrder S; S.init(M, DMODEL, F.G, (int)blockIdx.x);
            pg8::EpiRes E{HB, ssq + (2 * l + 2) * M};
            pg8::gemm_phase<pg8::EpiRes, pg8::StaticOrder, PG8_ALIGN, PG8_SP2>(F.lds + RING_OFF, g, S, E);
            if (BOTH(pb + 5)) GRID_BAR();
        }
    }
    if (IN(N_PHASES - 1)) {
        const int gw = F.vcu * NWAVES + F.wave, NGW = F.G * NWAVES; const float* gf = F.in[I_NFIN]; const pg8::ssq_t* sq = ssq + 8 * M;
        f32x4 gq[8][2];
#pragma unroll
        for (int j = 0; j < 8; ++j) { const int c = 8 * (F.lane + 64 * j); gq[j][0] = *(const f32x4*)(gf + c); gq[j][1] = *(const f32x4*)(gf + c + 4); }
        v4u hw[8]; pg8::ssq_t qc = 0;
        if (gw < M) { qc = sq[gw];
#pragma unroll
            for (int j = 0; j < 8; ++j) hw[j] = *(const GAS v4u*)((const GAS unsigned char*)HB + PG8_AOFF(gw, 8 * (F.lane + 64 * j), DMODEL)); }
        for (int m = gw; m < M; m += NGW) { const int mn = m + NGW; v4u hn[8]; pg8::ssq_t qn = 0;
            if (mn < M) { qn = sq[mn];
#pragma unroll
                for (int j = 0; j < 8; ++j) hn[j] = *(const GAS v4u*)((const GAS unsigned char*)HB + PG8_AOFF(mn, 8 * (F.lane + 64 * j), DMODEL)); }
            const float rs = pg8::rstd_of(qc);
#pragma unroll
            for (int j = 0; j < 8; ++j) { const int c = 8 * (F.lane + 64 * j); const v4u w = hw[j];
                const f32x4 h0 = {pg8::bf_lo(w.x), pg8::bf_hi(w.x), pg8::bf_lo(w.y), pg8::bf_hi(w.y)}, h1 = {pg8::bf_lo(w.z), pg8::bf_hi(w.z), pg8::bf_lo(w.w), pg8::bf_hi(w.w)};
                GAS f32x4* o = (GAS f32x4*)(F.out + (size_t)m * DMODEL + c); o[0] = h0 * rs * gq[j][0]; o[1] = h1 * rs * gq[j][1]; }
#pragma unroll
            for (int j = 0; j < 8; ++j) hw[j] = hn[j];
            qc = qn; }
    }
#undef IN
#undef BOTH
}

extern "C" void kernel_launch(void* const* d_in, const int* in_sizes, int n_in, void* d_out, int out_size, void* d_ws, size_t ws_size, hipStream_t stream) {
    static int grid = 0;
    if (grid == 0) {
        if (n_in != N_IN || in_sizes[0] != M * DMODEL || out_size != M * DMODEL || ws_size < WS_END) { fprintf(stderr, "kernel_launch: built for %d inputs, x/out of %d floats, >= %zu bytes of workspace; got n_in %d, in0 %d, out %d, ws %zu; nothing launched\n", (int)N_IN, M * DMODEL, (size_t)WS_END, n_in, n_in > 0 ? in_sizes[0] : -1, out_size, ws_size); grid = -1; return; }
        int dev = 0, cus = 0, per_cu = 0;
        if (hipGetDevice(&dev) != hipSuccess || hipDeviceGetAttribute(&cus, hipDeviceAttributeMultiprocessorCount, dev) != hipSuccess) { fprintf(stderr, "kernel_launch: hipGetDevice / hipDeviceGetAttribute failed; nothing launched\n"); grid = -1; return; }
        if (hipFuncSetAttribute((const void*)hymba_fwd, hipFuncAttributeMaxDynamicSharedMemorySize, LDS_BYTES) != hipSuccess) { fprintf(stderr, "kernel_launch: hipFuncSetAttribute failed\n"); grid = -1; return; }
        if (hipOccupancyMaxActiveBlocksPerMultiprocessor(&per_cu, (const void*)hymba_fwd, NWAVES * 64, LDS_BYTES) != hipSuccess || per_cu < 1)
            fprintf(stderr, "kernel_launch: note: the occupancy query reports %d workgroups per CU\n", per_cu);
        (void)hipGetLastError();
        grid = cus;
    }
    if (grid < 0) return;
    if (hipMemsetAsync((char*)d_ws + WS_CTL, 0, CTL_ZERO_BYTES, stream) != hipSuccess) { fprintf(stderr, "kernel_launch: hipMemsetAsync failed\n"); return; }
    Args a{};
    for (int i = 0; i < N_IN; ++i) a.in[i] = (const float*)d_in[i];
    a.out = (float*)d_out; a.ws = (unsigned char*)d_ws;
#if MK_PER_PHASE
    for (int ph = 0; ph < N_PHASES; ++ph) { a.ph_lo = ph; a.ph_hi = ph + 1; hipLaunchKernelGGL(hymba_fwd, dim3(grid), dim3(NWAVES * 64), LDS_BYTES, stream, a); }
#else
    a.ph_lo = 0; a.ph_hi = N_PHASES; hipLaunchKernelGGL(hymba_fwd, dim3(grid), dim3(NWAVES * 64), LDS_BYTES, stream, a);
#endif
    const hipError_t le = hipPeekAtLastError();
    if (le != hipSuccess) fprintf(stderr, "kernel_launch: launch failed: %s\n", hipGetErrorName(le));
}
```

```cpp
#define MK_PER_PHASE 0
#define A_IMG 1
#define STG_UP 2
#define PROBE_ATT_2BAR 1
#define CONV_SPLIT 2
#define S5_SHIFT 1
#include <hip/hip_runtime.h>
#include <cstdio>
#include <cstdint>
#ifndef A_IMG
#define A_IMG 0
#endif
namespace pg8 {
#define PG8_LAS __attribute__((address_space(3)))
typedef unsigned short bf16_t;
typedef short bf16x8 __attribute__((ext_vector_type(8)));
typedef float f32x4 __attribute__((ext_vector_type(4)));
typedef unsigned u32x4 __attribute__((ext_vector_type(4)));
constexpr int BM = 256, BK = 64, HALF = 128, HTB = HALF * BK * 2  , STAGE_BYTES = 8 * HTB, NXCD = 8, WGM = 8;

__host__ __device__ __forceinline__ int lds_byte(int r, int c) { const int st = (r >> 4) * 2 + (c >> 5), rr = r & 15, cc = c & 31, ob = rr * 64 + cc * 2; return st * 1024 + (ob ^ (((ob >> 9) & 1) << 5)); }
__host__ __device__ __forceinline__ void stage_rc(int b, int& R, int& C) { const int st = b / 1024, sb = b % 1024, swz = sb ^ (((sb >> 9) & 1) << 5); R = (st >> 1) * 16 + swz / 64; C = (st & 1) * 32 + (swz % 64) / 2; }
__host__ __device__ __forceinline__ int perm32(int rho) { const int n = rho >> 4, i = rho & 15; return 8 * (i >> 2) + 4 * n + (i & 3); }

struct Unit { int pm, pn; };
struct Gemm { const bf16_t* A; const bf16_t* Bt; int M, N, K; int a_img, b_img; };
#define PG8_AOFF(row, col, K) (A_IMG ? pg8::img_off((int)(row), (int)(col), (K), false) : ((size_t)(row) * (size_t)(K) + (size_t)(col)) * 2)
__host__ __device__ __forceinline__ int perm32_inv(int x) { return 16 * ((x >> 2) & 1) + 4 * (x >> 3) + (x & 3); }
__host__ __device__ __forceinline__ size_t img_off(int row, int col, int K, bool permB) {
    const int r = row & 127, R = permB ? ((r & ~31) + perm32_inv(r & 31)) : r;
    return ((size_t)((row >> 8) * (K >> 6) + (col >> 6)) * 2 + ((row >> 7) & 1)) * (size_t)HTB + (size_t)lds_byte(R, col & 63); }

struct StaticOrder {
    int nM, nN, nwg, G, c;
    __host__ __device__ void init(int M, int N, int G_, int c_) { nM = M / BM; nN = N / BM; nwg = nM * nN; G = G_; c = c_; }
    __host__ __device__ bool next(int i, Unit& u) const {
        const long L = (long)i * G + c; if (L >= nwg) return false;
        int wgid = (int)L; { const int q = nwg / NXCD, r = nwg % NXCD, xcd = wgid % NXCD, off = wgid / NXCD; wgid = (xcd < r ? xcd * (q + 1) : r * (q + 1) + (xcd - r) * q) + off; }
        const int nig = WGM * nN, gid = wgid / nig, fm = gid * WGM, gsz = (nM - fm) < WGM ? (nM - fm) : WGM;
        u.pm = fm + ((wgid % nig) % gsz); u.pn = (wgid % nig) / gsz; return true;
    }
    __device__ __forceinline__ void a_ready(const Unit&) const {}
    __device__ __forceinline__ void done(const Unit&) const {}
};

__device__ __forceinline__ unsigned cvt_pk_bf16(float lo, float hi) { unsigned r; asm volatile("v_cvt_pk_bf16_f32 %0, %1, %2" : "=v"(r) : "v"(lo), "v"(hi)); return r; }
typedef float f32x2 __attribute__((ext_vector_type(2)));
__device__ __forceinline__ f32x2 gelu_pk(f32x2 v) {
    const f32x2 av = __builtin_elementwise_abs(v), d = av * 0.2316418882f + 1.0f;
    f32x2 t; t.x = __builtin_amdgcn_rcpf(d.x); t.y = __builtin_amdgcn_rcpf(d.y);
    f32x2 q = t * 0.5307027145f + (-0.7265760135f); q = q * t + 0.7107068705f; q = q * t + (-0.142248368f); q = q * t + 0.127414796f; q = q * t;
    const f32x2 s = (v * v) * (-0.72134752044f);
    f32x2 e; e.x = __builtin_amdgcn_exp2f(s.x); e.y = __builtin_amdgcn_exp2f(s.y);
    const f32x2 m = v * (q * e), r = v - m;
    f32x2 o; o.x = v.x < 0.f ? m.x : r.x; o.y = v.y < 0.f ? m.y : r.y; return o;
}

template <int ACT  > struct EpiBf16 {
    static constexpr bool PERM = true, AFTER_DRAIN = false; static_assert(ACT == 0 || ACT == 1, "EpiBf16: ACT is 0 (none) or 1 (gelu_pk)");
    bf16_t* O; int ldc; const float* bias; int split_cols; size_t split_stride; float scale0;
    __device__ __forceinline__ void operator()(const f32x4 (&acc)[2][2][4][2], const Unit& u, int wr, int wc, int fr, int fq) const {
        const int row0 = u.pm * BM + wr * 64 + fr; int colt = u.pn * BM; bf16_t* base = O;
        float sc = 1.f; if (split_cols) { const int t = colt / split_cols; base += (size_t)t * split_stride; colt -= t * split_cols; if (t == 0) sc = scale0; }
        const int col0 = colt + wc * 32 + 8 * fq, bcol0 = u.pn * BM + wc * 32 + 8 * fq;
        f32x4 bv[2][2];
#pragma unroll
        for (int bj = 0; bj < 2; ++bj)
#pragma unroll
            for (int n = 0; n < 2; ++n) bv[bj][n] = bias ? *(const f32x4*)(bias + bcol0 + bj * HALF + 4 * n) : (f32x4){0.f, 0.f, 0.f, 0.f};
#pragma unroll
        for (int ai = 0; ai < 2; ++ai)
#pragma unroll
            for (int m = 0; m < 4; ++m) { bf16_t* rowp = base + (size_t)(row0 + ai * HALF + m * 16) * ldc + col0;
#pragma unroll
                for (int bj = 0; bj < 2; ++bj) { f32x4 v0 = acc[ai][bj][m][0] + bv[bj][0], v1 = acc[ai][bj][m][1] + bv[bj][1];
                    if (ACT == 1) { f32x2 a = gelu_pk((f32x2){v0[0], v0[1]}), b = gelu_pk((f32x2){v0[2], v0[3]}), c = gelu_pk((f32x2){v1[0], v1[1]}), d = gelu_pk((f32x2){v1[2], v1[3]});
                        v0 = (f32x4){a.x, a.y, b.x, b.y}; v1 = (f32x4){c.x, c.y, d.x, d.y}; }
                    v0 = v0 * sc; v1 = v1 * sc; u32x4 w; w.x = cvt_pk_bf16(v0[0], v0[1]); w.y = cvt_pk_bf16(v0[2], v0[3]); w.z = cvt_pk_bf16(v1[0], v1[1]); w.w = cvt_pk_bf16(v1[2], v1[3]);
                    *(u32x4*)(rowp + bj * HALF) = w; } }
    }
};

__device__ __forceinline__ u32x4 pack8(f32x4 v0, f32x4 v1) { u32x4 w; w.x = cvt_pk_bf16(v0[0], v0[1]); w.y = cvt_pk_bf16(v0[2], v0[3]); w.z = cvt_pk_bf16(v1[0], v1[1]); w.w = cvt_pk_bf16(v1[2], v1[3]); return w; }
__device__ __forceinline__ float bf_lo(unsigned w) { return __uint_as_float(w << 16); }
__device__ __forceinline__ float bf_hi(unsigned w) { return __uint_as_float(w & 0xffff0000u); }
constexpr float RMS_EPS = 1e-6f;
typedef unsigned long long ssq_t;
constexpr float SSQ_SCALE = 16777216.0f, SSQ_INV = 1.0f / (16777216.0f * 4096.0f);
__device__ __forceinline__ float rstd_of(ssq_t q) { const float x = fmaf((float)(unsigned)(q >> 32), 4294967296.0f, (float)(unsigned)q); return __builtin_amdgcn_rsqf(x * SSQ_INV + RMS_EPS); }
struct EpiProj {
    static constexpr bool PERM = true, AFTER_DRAIN = false, IDEMP = true;
    bf16_t* __restrict__ QKV; bf16_t* __restrict__ UT; const ssq_t* __restrict__ ssq; float c2; unsigned char* __restrict__ KI; unsigned char* __restrict__ VI;
    __device__ __forceinline__ void operator()(const f32x4 (&acc)[2][2][4][2], const Unit& u, int wr, int wc, int fr, int fq) const {
        const int row0 = u.pm * BM + wr * 64 + fr, colt = u.pn * BM;
        const float sc = (colt < 2048) ? c2 : 1.f;
        ssq_t q[2][4];
#pragma unroll
        for (int ai = 0; ai < 2; ++ai)
#pragma unroll
            for (int m = 0; m < 4; ++m) q[ai][m] = ssq[row0 + ai * HALF + m * 16];
#pragma unroll
        for (int ai = 0; ai < 2; ++ai)
#pragma unroll
            for (int m = 0; m < 4; ++m) { const int row = row0 + ai * HALF + m * 16;
                const float rs = sc * rstd_of(q[ai][m]);
#pragma unroll
                for (int bj = 0; bj < 2; ++bj) { const int col = colt + bj * HALF + wc * 32 + 8 * fq;
                    const u32x4 w = pack8(acc[ai][bj][m][0] * rs, acc[ai][bj][m][1] * rs);
                    if (colt < 2048) *(u32x4*)(QKV + (size_t)row * 6144 + col) = w;
                    else if (colt < 4096) { const int c = col - 2048, key = row & 4095;
                        *(u32x4*)(KI + ((size_t)(((row >> 12) * 16 + (c >> 7)) * 2 + ((c >> 6) & 1)) * 64 + (key >> 6)) * 8192 + ((c & 63) >> 3) * 1024 + (key & 63) * 16) = w; }
                    else if (colt < 6144) { const int c = col - 4096, key = row & 4095, cc = c & 127;
                        *(u32x4*)(VI + ((size_t)((row >> 12) * 16 + (c >> 7)) * 64 + (key >> 6)) * 16384 + ((cc >> 5) * 4 + ((key & 63) >> 4)) * 1024 + (key & 15) * 64 + ((cc & 31) >> 3) * 16) = w; }
                    else { const int cu = col - 6144; *(u32x4*)(UT + ((size_t)(cu >> 4) * 8192 + row) * 16 + (cu & 15)) = w; } } }
    }
};
struct EpiUp {
    static constexpr bool PERM = true, AFTER_DRAIN = false, IDEMP = true;
    bf16_t* __restrict__ O; int ldc; const ssq_t* __restrict__ ssq;
    __device__ __forceinline__ void operator()(const f32x4 (&acc)[2][2][4][2], const Unit& u, int wr, int wc, int fr, int fq) const {
        const int row0 = u.pm * BM + wr * 64 + fr, colt = u.pn * BM;
        ssq_t q[2][4];
#pragma unroll
        for (int ai = 0; ai < 2; ++ai)
#pragma unroll
            for (int m = 0; m < 4; ++m) q[ai][m] = ssq[row0 + ai * HALF + m * 16];
#pragma unroll
        for (int ai = 0; ai < 2; ++ai)
#pragma unroll
            for (int m = 0; m < 4; ++m) { const int row = row0 + ai * HALF + m * 16;
                const float rs = rstd_of(q[ai][m]);
#pragma unroll
                for (int bj = 0; bj < 2; ++bj) { const int col = colt + bj * HALF + wc * 32 + 8 * fq;
                    f32x4 v0 = acc[ai][bj][m][0] * rs, v1 = acc[ai][bj][m][1] * rs;
#pragma unroll
                    for (int e = 0; e < 4; ++e) { const float a = fmaxf(v0[e], 0.f), b = fmaxf(v1[e], 0.f); v0[e] = a * a; v1[e] = b * b; }
                    *(u32x4*)((char*)O + PG8_AOFF(row, col, ldc)) = pack8(v0, v1); } }
    }
};
struct EpiGlu {
    static constexpr bool PERM = true, AFTER_DRAIN = false, IDEMP = true;
    const bf16_t* __restrict__ YG; bf16_t* __restrict__ CAT; const float* __restrict__ bias;
    __device__ __forceinline__ void operator()(const f32x4 (&acc)[2][2][4][2], const Unit& u, int wr, int wc, int fr, int fq) const {
        const int row0 = u.pm * BM + wr * 64 + fr, colt = u.pn * BM;
        f32x4 bv[2][2];
#pragma unroll
        for (int bj = 0; bj < 2; ++bj)
#pragma unroll
            for (int n = 0; n < 2; ++n) bv[bj][n] = *(const f32x4*)(bias + colt + bj * HALF + wc * 32 + 8 * fq + 4 * n);
#pragma unroll
        for (int ai = 0; ai < 2; ++ai) {
            u32x4 yw[4][2];
#pragma unroll
            for (int m = 0; m < 4; ++m)
#pragma unroll
                for (int bj = 0; bj < 2; ++bj) yw[m][bj] = *(const u32x4*)((const char*)YG + PG8_AOFF(row0 + ai * HALF + m * 16, colt + bj * HALF + wc * 32 + 8 * fq, 2048));
#pragma unroll
            for (int m = 0; m < 4; ++m) { const int row = row0 + ai * HALF + m * 16;
#pragma unroll
                for (int bj = 0; bj < 2; ++bj) { const int col = colt + bj * HALF + wc * 32 + 8 * fq; const u32x4 y = yw[m][bj];
                    f32x4 v0 = acc[ai][bj][m][0] + bv[bj][0], v1 = acc[ai][bj][m][1] + bv[bj][1];
#pragma unroll
                    for (int e = 0; e < 4; ++e) { v0[e] = __builtin_amdgcn_rcpf(1.0f + __builtin_amdgcn_exp2f(-1.4426950408889634f * v0[e])); v1[e] = __builtin_amdgcn_rcpf(1.0f + __builtin_amdgcn_exp2f(-1.4426950408889634f * v1[e])); }
                    v0[0] *= bf_lo(y.x); v0[1] *= bf_hi(y.x); v0[2] *= bf_lo(y.y); v0[3] *= bf_hi(y.y);
                    v1[0] *= bf_lo(y.z); v1[1] *= bf_hi(y.z); v1[2] *= bf_lo(y.w); v1[3] *= bf_hi(y.w);
                    *(u32x4*)((char*)CAT + PG8_AOFF(row, 2048 + col, 4096)) = pack8(v0, v1); } }
            asm volatile("" ::: "memory"); }
    }
};
struct EpiRes {
    static constexpr bool PERM = true, AFTER_DRAIN = false, IDEMP = false;
    bf16_t* HB; ssq_t* __restrict__ ssq_out;
    __device__ __forceinline__ void operator()(const f32x4 (&acc)[2][2][4][2], const Unit& u, int wr, int wc, int fr, int fq) const {
        const int row0 = u.pm * BM + wr * 64 + fr, colt = u.pn * BM;
        u32x4 b[2][4][2];
#pragma unroll
        for (int ai = 0; ai < 2; ++ai)
#pragma unroll
            for (int m = 0; m < 4; ++m)
#pragma unroll
                for (int bj = 0; bj < 2; ++bj) b[ai][m][bj] = *(const u32x4*)((const char*)HB + PG8_AOFF(row0 + ai * HALF + m * 16, colt + bj * HALF + wc * 32 + 8 * fq, 4096));
#pragma unroll
        for (int ai = 0; ai < 2; ++ai) { float sm[4];
#pragma unroll
            for (int m = 0; m < 4; ++m) { const int row = row0 + ai * HALF + m * 16; float ss = 0.f;
#pragma unroll
                for (int bj = 0; bj < 2; ++bj) { const u32x4 w = b[ai][m][bj];
                    const f32x4 h0 = (f32x4){bf_lo(w.x), bf_hi(w.x), bf_lo(w.y), bf_hi(w.y)} + acc[ai][bj][m][0], h1 = (f32x4){bf_lo(w.z), bf_hi(w.z), bf_lo(w.w), bf_hi(w.w)} + acc[ai][bj][m][1];
                    *(u32x4*)((char*)HB + PG8_AOFF(row, colt + bj * HALF + wc * 32 + 8 * fq, 4096)) = pack8(h0, h1);
                    ss += (h0[0] * h0[0] + h0[1] * h0[1]) + (h0[2] * h0[2] + h0[3] * h0[3]) + (h1[0] * h1[0] + h1[1] * h1[1]) + (h1[2] * h1[2] + h1[3] * h1[3]); }
                ss += __shfl_xor(ss, 16); ss += __shfl_xor(ss, 32); sm[m] = ss; }
            const float mine = fq == 0 ? sm[0] : fq == 1 ? sm[1] : fq == 2 ? sm[2] : sm[3];
            __hip_atomic_fetch_add(ssq_out + row0 + ai * HALF + fq * 16, (ssq_t)(mine * SSQ_SCALE), __ATOMIC_RELAXED, __HIP_MEMORY_SCOPE_AGENT);
            asm volatile("" ::: "memory"); }
    }
};

template <class Epi, class Sched, bool ALIGN_EPI = false, bool SP2 = false>
__device__ __forceinline__ void gemm_phase(PG8_LAS unsigned char* lds, const Gemm g, const Sched& S, const Epi& E) {
    int tid_ = threadIdx.x; asm volatile("" : "+v"(tid_));
    const int tid = tid_, wid = __builtin_amdgcn_readfirstlane(tid >> 6), lane = tid & 63, wr = wid >> 2, wc = wid & 3, fr = lane & 15, fq = lane >> 4;
    const int K = g.K, nt = K / BK;
    unsigned voffA[2], voffB[2];
#pragma unroll
    for (int i = 0; i < 2; ++i) { int R, C; stage_rc(tid * 16 + i * 8192, R, C); const int Rb = Epi::PERM ? ((R & ~31) + perm32(R & 31)) : R;
        voffA[i] = g.a_img ? (unsigned)(tid * 16 + i * 8192) : (unsigned)(R * K + C) * 2u; voffB[i] = g.b_img ? (unsigned)(tid * 16 + i * 8192) : (unsigned)(Rb * K + C) * 2u; }
    const size_t kstA = g.a_img ? (size_t)2 * HTB : (size_t)(BK * 2), hstA = g.a_img ? (size_t)HTB : (size_t)HALF * K * 2, tstA = g.a_img ? (size_t)nt * 2 * HTB : (size_t)2 * HALF * K * 2;
    const size_t kstB = g.b_img ? (size_t)2 * HTB : (size_t)(BK * 2), hstB = g.b_img ? (size_t)HTB : (size_t)HALF * K * 2, tstB = g.b_img ? (size_t)nt * 2 * HTB : (size_t)2 * HALF * K * 2;
    const unsigned ldsw = (unsigned)wid * 1024u;
    const int aoff = lds_byte(wr * 64 + fr, fq * 8), boff = lds_byte(wc * 32 + fr, fq * 8);
#define PG8_SA(b, h) (((b) * 2 + (h)) * HTB)
#define PG8_SB(b, h) ((4 + (b) * 2 + (h)) * HTB)
#define PG8_STAGE(bufoff, rs, goff, voff) do { _Pragma("unroll") for (int _i = 0; _i < 2; ++_i) \
        __builtin_amdgcn_raw_ptr_buffer_load_lds(rs, (PG8_LAS unsigned*)(lds + (bufoff) + ldsw + _i * 8192), 16, (voff)[_i], (goff), 0, 0); } while (0)
#define PG8_LDA(dst, b, h) do { _Pragma("unroll") for (int m = 0; m < 4; ++m) _Pragma("unroll") for (int k = 0; k < 2; ++k) dst[m][k] = *(const PG8_LAS bf16x8*)(lds + PG8_SA(b, h) + aoff + m * 2048 + k * 1024); } while (0)
#define PG8_LDB(dst, b, h) do { _Pragma("unroll") for (int n = 0; n < 2; ++n) _Pragma("unroll") for (int k = 0; k < 2; ++k) dst[n][k] = *(const PG8_LAS bf16x8*)(lds + PG8_SB(b, h) + boff + n * 2048 + k * 1024); } while (0)
#define PG8_MMA(ai, bj, At, Bt) do { __builtin_amdgcn_s_setprio(1); _Pragma("unroll") for (int m = 0; m < 4; ++m) _Pragma("unroll") for (int n = 0; n < 2; ++n) _Pragma("unroll") for (int k = 0; k < 2; ++k) \
        acc[ai][bj][m][n] = __builtin_amdgcn_mfma_f32_16x16x32_bf16(Bt[n][k], At[m][k], acc[ai][bj][m][n], 0, 0, 0); __builtin_amdgcn_s_setprio(0); } while (0)
#define PG8_WAIT_V(n) asm volatile("s_waitcnt vmcnt(" #n ")" ::: "memory")
#define PG8_WAIT_V_SEL(flag, nrelax, nstd) asm volatile("s_cmp_lg_u32 %0, 0\n\ts_cbranch_scc1 .Lpg8r%=\n\ts_waitcnt vmcnt(" #nstd ")\n\ts_branch .Lpg8d%=\n.Lpg8r%=:\n\ts_waitcnt vmcnt(" #nrelax ")\n.Lpg8d%=:" :: "s"(flag) : "memory", "scc")
#define PG8_WAIT_L(n) asm volatile("s_waitcnt lgkmcnt(" #n ")" ::: "memory")
#ifdef PG8_BAR2
#define PG8_BAR do { __builtin_amdgcn_s_barrier(); __builtin_amdgcn_s_barrier(); } while (0)
#else
#define PG8_BAR __builtin_amdgcn_s_barrier()
#endif
#define PG8_SCHED __builtin_amdgcn_sched_barrier(0)
    Unit cur, nxt; int ui = 0;
    if (!S.next(0, cur)) return;
    f32x4 acc[2][2][4][2];
#pragma unroll
    for (int a = 0; a < 2; ++a)
#pragma unroll
        for (int b = 0; b < 2; ++b)
#pragma unroll
            for (int m = 0; m < 4; ++m)
#pragma unroll
                for (int n = 0; n < 2; ++n) acc[a][b][m][n] = (f32x4){0.f, 0.f, 0.f, 0.f};
    bf16x8 At[4][2], B0[2][2], B1[2][2];
    const __amdgpu_buffer_rsrc_t rsA = __builtin_amdgcn_make_buffer_rsrc((void*)g.A, 0, (unsigned)((size_t)g.M * K * 2), 0x00020000), rsB = __builtin_amdgcn_make_buffer_rsrc((void*)g.Bt, 0, (unsigned)((size_t)g.N * K * 2), 0x00020000);
    unsigned cA = (unsigned)((size_t)cur.pm * tstA), cB = (unsigned)((size_t)cur.pn * tstB);
    S.a_ready(cur);
    if constexpr (SP2) {
        PG8_STAGE(PG8_SB(0, 0), rsB, cB, voffB); PG8_STAGE(PG8_SB(0, 1), rsB, cB + (unsigned)hstB, voffB); PG8_STAGE(PG8_SA(0, 0), rsA, cA, voffA); PG8_STAGE(PG8_SA(0, 1), rsA, cA + (unsigned)hstA, voffA);
        if (wr == 1) PG8_BAR;
        PG8_WAIT_V(2); PG8_BAR;
        PG8_STAGE(PG8_SB(1, 0), rsB, cB + (unsigned)kstB, voffB); PG8_STAGE(PG8_SA(1, 0), rsA, cA + (unsigned)kstA, voffA); PG8_STAGE(PG8_SB(1, 1), rsB, cB + (unsigned)(hstB + kstB), voffB);
        PG8_WAIT_V(6); PG8_BAR;
    } else {
        PG8_STAGE(PG8_SB(0, 0), rsB, cB, voffB); PG8_STAGE(PG8_SA(0, 0), rsA, cA, voffA); PG8_STAGE(PG8_SB(0, 1), rsB, cB + (unsigned)hstB, voffB); PG8_STAGE(PG8_SA(0, 1), rsA, cA + (unsigned)hstA, voffA);
        if (wr == 1) PG8_BAR;
        PG8_WAIT_V(4); PG8_BAR;
        PG8_STAGE(PG8_SB(1, 0), rsB, cB + (unsigned)kstB, voffB); PG8_STAGE(PG8_SA(1, 0), rsA, cA + (unsigned)kstA, voffA); PG8_STAGE(PG8_SB(1, 1), rsB, cB + (unsigned)(hstB + kstB), voffB);
        PG8_WAIT_V(6); PG8_BAR;
    }
    for (;;) {
        const bool has_next = S.next(ui + 1, nxt);
        const unsigned nA = has_next ? (unsigned)((size_t)nxt.pm * tstA) : cA, nB = has_next ? (unsigned)((size_t)nxt.pn * tstB) : cB;
        for (int t = 0; t < nt; t += 2) {
            const bool last = (t == nt - 2);
            const unsigned a1 = cA + (unsigned)((size_t)(t + 1) * kstA);
            const unsigned a2 = last ? nA : cA + (unsigned)((size_t)(t + 2) * kstA), b2 = last ? nB : cB + (unsigned)((size_t)(t + 2) * kstB);
            const unsigned a3 = a2 + (unsigned)kstA, b3 = b2 + (unsigned)kstB;
            if (last && has_next) S.a_ready(nxt);
            if constexpr (SP2) {
            PG8_LDB(B0, 0, 0); PG8_LDB(B1, 0, 1); PG8_SCHED; PG8_LDA(At, 0, 0); PG8_STAGE(PG8_SA(1, 1), rsA, a1 + (unsigned)hstA, voffA);
            PG8_WAIT_V(8); PG8_WAIT_L(0); PG8_BAR; PG8_MMA(0, 0, At, B0); PG8_MMA(0, 1, At, B1); PG8_BAR; PG8_SCHED;
            PG8_LDA(At, 0, 1); PG8_STAGE(PG8_SB(0, 0), rsB, b2, voffB); PG8_STAGE(PG8_SB(0, 1), rsB, b2 + (unsigned)hstB, voffB); PG8_STAGE(PG8_SA(0, 0), rsA, a2, voffA);
            PG8_WAIT_V(8); PG8_WAIT_L(0); PG8_BAR; PG8_MMA(1, 0, At, B0); PG8_MMA(1, 1, At, B1); PG8_BAR; PG8_SCHED;
            PG8_LDB(B0, 1, 0); PG8_LDB(B1, 1, 1); PG8_SCHED; PG8_LDA(At, 1, 0); PG8_STAGE(PG8_SA(0, 1), rsA, a2 + (unsigned)hstA, voffA);
            PG8_WAIT_V(8); PG8_WAIT_L(0); PG8_BAR; PG8_MMA(0, 0, At, B0); PG8_MMA(0, 1, At, B1); PG8_BAR; PG8_SCHED;
            PG8_LDA(At, 1, 1); PG8_STAGE(PG8_SB(1, 0), rsB, b3, voffB); PG8_STAGE(PG8_SB(1, 1), rsB, b3 + (unsigned)hstB, voffB); PG8_STAGE(PG8_SA(1, 0), rsA, a3, voffA);
            PG8_WAIT_V(8); PG8_WAIT_L(0); PG8_BAR; PG8_MMA(1, 0, At, B0); PG8_MMA(1, 1, At, B1); PG8_BAR; PG8_SCHED;
            } else {
            PG8_LDB(B0, 0, 0); PG8_SCHED; PG8_LDA(At, 0, 0); PG8_STAGE(PG8_SA(1, 1), rsA, a1 + (unsigned)hstA, voffA);
            PG8_WAIT_L(8); PG8_BAR; PG8_WAIT_L(0); PG8_MMA(0, 0, At, B0); PG8_BAR; PG8_SCHED;
            PG8_LDB(B1, 0, 1); PG8_STAGE(PG8_SB(0, 0), rsB, b2, voffB);
            PG8_BAR; PG8_WAIT_L(0); PG8_MMA(0, 1, At, B1); PG8_BAR;
            PG8_LDA(At, 0, 1); PG8_STAGE(PG8_SA(0, 0), rsA, a2, voffA);
            PG8_BAR; PG8_WAIT_L(0); PG8_MMA(1, 0, At, B0); PG8_BAR; PG8_SCHED;
            PG8_STAGE(PG8_SB(0, 1), rsB, b2 + (unsigned)hstB, voffB);
            PG8_WAIT_V(6); PG8_BAR; PG8_MMA(1, 1, At, B1); PG8_BAR;
            PG8_LDB(B0, 1, 0); PG8_SCHED; PG8_LDA(At, 1, 0); PG8_STAGE(PG8_SA(0, 1), rsA, a2 + (unsigned)hstA, voffA);
            PG8_WAIT_L(8); PG8_BAR; PG8_WAIT_L(0); PG8_MMA(0, 0, At, B0); PG8_BAR; PG8_SCHED;
            PG8_LDB(B1, 1, 1); PG8_STAGE(PG8_SB(1, 0), rsB, b3, voffB);
            PG8_BAR; PG8_WAIT_L(0); PG8_MMA(0, 1, At, B1); PG8_BAR;
            PG8_LDA(At, 1, 1); PG8_STAGE(PG8_SA(1, 0), rsA, a3, voffA);
            PG8_BAR; PG8_WAIT_L(0); PG8_MMA(1, 0, At, B0); PG8_BAR; PG8_SCHED;
            PG8_STAGE(PG8_SB(1, 1), rsB, b3 + (unsigned)hstB, voffB);
            PG8_WAIT_V(6); PG8_BAR; PG8_MMA(1, 1, At, B1); PG8_BAR;
            }
        }
        if constexpr (ALIGN_EPI) { if (wr == 0) PG8_BAR; }
        if constexpr (!Epi::AFTER_DRAIN) { E(acc, cur, wr, wc, fr, fq);
#ifdef PROBE_EPI2
            if constexpr (Epi::IDEMP) { asm volatile("" ::: "memory"); E(acc, cur, wr, wc, fr, fq); }
#endif
            S.done(cur); }
        if (!has_next) break;
#pragma unroll
        for (int a = 0; a < 2; ++a)
#pragma unroll
            for (int b = 0; b < 2; ++b)
#pragma unroll
                for (int m = 0; m < 4; ++m)
#pragma unroll
                    for (int n = 0; n < 2; ++n) acc[a][b][m][n] = (f32x4){0.f, 0.f, 0.f, 0.f};
        cur = nxt; cA = nA; cB = nB; ++ui;
        if constexpr (ALIGN_EPI) { if (wr == 1) PG8_BAR; }
    }
    PG8_WAIT_V(0);
    if constexpr (!ALIGN_EPI) { if (wr == 0) PG8_BAR; }
    PG8_BAR;
    if constexpr (Epi::AFTER_DRAIN) { E.fused(acc, cur, wr, wc, fr, fq, lds, wid, lane); S.done(cur); }
#undef PG8_SA
#undef PG8_SB
#undef PG8_STAGE
#undef PG8_LDA
#undef PG8_LDB
#undef PG8_MMA
#undef PG8_WAIT_V
#undef PG8_WAIT_V_SEL
#undef PG8_WAIT_L
#undef PG8_BAR
#undef PG8_SCHED
}
}

#ifndef PG8_SP2
#define PG8_SP2 true
#endif
#ifndef PG8_ALIGN
#define PG8_ALIGN true
#endif
#include <hip/hip_bf16.h>
#include <cmath>
namespace attn_body {
using bf16=__hip_bfloat16;
using bf16x8=__attribute__((ext_vector_type(8)))short;
using s16x4=__attribute__((ext_vector_type(4)))short;
using f32x16=__attribute__((ext_vector_type(16)))float;
using u32x4=__attribute__((ext_vector_type(4)))unsigned;
constexpr int BATCH=2,NHEAD=16,SEQ=4096,D=64,DM=6144;
constexpr int OPITCH=4096;
constexpr int NW=8,QBLK=32,QB=QBLK*4,KVBLK=64,NQB=SEQ/QB;
constexpr int ATTN_PITCH=DM, ATTN_UNIT_ROWS=QB;
__device__ __forceinline__ int crow(int r,int hi){return (r&3)+8*(r>>2)+4*hi;}
#define SBAR() __builtin_amdgcn_sched_barrier(0)
__device__ __forceinline__ void cmask(f32x16&p0,f32x16&p1,int jb,int qrel,int hi){
  const float NEG=-INFINITY; int kb=64*jb+4*hi;
  #pragma unroll
  for(int r=0;r<16;++r){int kv=kb+(r&3)+8*(r>>2); if(kv>qrel)p0[r]=NEG; if(kv+32>qrel)p1[r]=NEG;}
}

__device__ __forceinline__ int t5_bucket(int n){ if(n<16)return n; const int st[15]={19,21,24,27,31,35,40,46,52,59,67,77,87,99,113}; int b=16;
  #pragma unroll
  for(int i=0;i<15;++i)b+=(n>=st[i])?1:0; return b; }
typedef const __attribute__((address_space(3))) float* lds_cfptr;
__device__ __forceinline__ void bmask(f32x16&p0,f32x16&p1,int jb,int qrel,int hi,lds_cfptr lut){
  const float NEG=-INFINITY; const int base=qrel-64*jb-4*hi;
  #pragma unroll
  for(int r=0;r<16;++r){const int n0=base-((r&3)+8*(r>>2)),n1=n0-32;
    const float b0=lut[n0<0?0:(n0>128?128:n0)],b1=lut[n1<0?0:(n1>128?128:n1)];
    p0[r]=(n0<0)?NEG:p0[r]+b0; p1[r]=(n1<0)?NEG:p1[r]+b1;}
}
constexpr int NSLOT=3, SLOTB=8192;
constexpr int VSLOTB=16384, NVSLOT=4;
constexpr int LDS_K=0, LDS_V=NSLOT*SLOTB, LDS_WS=NSLOT*SLOTB+NVSLOT*VSLOTB, LDS_OST=LDS_WS+NW*64*4, LDS_LUT=LDS_OST+NW*4096, LDS_BYTES=LDS_LUT+1024;
constexpr float C2=0.125f*1.4426950408889634f;
__device__ __forceinline__ void glds16(const void*gsrc,unsigned lds_dst){unsigned keep;
  asm volatile("s_mov_b32 %0, m0\n\ts_mov_b32 m0, %2\n\ts_nop 0\n\tglobal_load_lds_dwordx4 %1, off\n\ts_mov_b32 m0, %0":"=&s"(keep):"v"(gsrc),"s"(lds_dst):"memory");}
__device__ __forceinline__ float max3f(float a,float b,float c){float r;asm("v_max3_f32 %0, %1, %2, %3":"=v"(r):"v"(a),"v"(b),"v"(c));return r;}
__device__ __forceinline__ float max2f(float a,float b){float r;asm("v_max_f32_e32 %0, %1, %2":"=v"(r):"v"(a),"v"(b));return r;}
__device__ __forceinline__ float fadd_s(float a,float b){float r;asm("v_add_f32_e32 %0, %1, %2":"=v"(r):"v"(a),"v"(b));return r;}
__device__ __forceinline__ float fsub_s(float a,float b){float r;asm("v_sub_f32_e32 %0, %1, %2":"=v"(r):"v"(a),"v"(b));return r;}
typedef float f32x2_t __attribute__((ext_vector_type(2))); typedef __bf16 bf16x2_t __attribute__((ext_vector_type(2)));
__device__ __forceinline__ unsigned cvtpk_s(float lo,float hi){f32x2_t v={lo,hi};bf16x2_t b=__builtin_convertvector(v,bf16x2_t);return __builtin_bit_cast(unsigned,b);}
#ifdef PROBE_ATT_2BAR
#if PROBE_ATT_2BAR == 3
#define WAIT_BAR(N) asm volatile("s_waitcnt vmcnt(" #N ") lgkmcnt(0)\n\ts_barrier\n\ts_barrier\n\ts_barrier":::"memory")
#elif PROBE_ATT_2BAR == 2
#define WAIT_BAR(N) asm volatile("s_waitcnt vmcnt(" #N ") lgkmcnt(0)\n\ts_barrier\n\ts_nop 7\n\ts_nop 7":::"memory")
#else
#define WAIT_BAR(N) asm volatile("s_waitcnt vmcnt(" #N ") lgkmcnt(0)\n\ts_barrier\n\ts_barrier":::"memory")
#endif
#else
#define WAIT_BAR(N) asm volatile("s_waitcnt vmcnt(" #N ") lgkmcnt(0)\n\ts_barrier":::"memory")
#endif

__device__ __forceinline__ void qkt(f32x16&p0,f32x16&p1,const char*Kslot,const bf16x8*qr,const f32x16&negm,int r32,int hi){
  const char*kb=Kslot+hi*1024+r32*16;
  #pragma unroll
  for(int d0=0;d0<4;++d0){
    const bf16x8 b0=*reinterpret_cast<const bf16x8*>(kb+d0*2048);
    const bf16x8 b1=*reinterpret_cast<const bf16x8*>(kb+d0*2048+512);
    if(d0==0){p0=__builtin_amdgcn_mfma_f32_32x32x16_bf16(b0,qr[0],negm,0,0,0);p1=__builtin_amdgcn_mfma_f32_32x32x16_bf16(b1,qr[0],negm,0,0,0);}
    else{p0=__builtin_amdgcn_mfma_f32_32x32x16_bf16(b0,qr[d0],p0,0,0,0);p1=__builtin_amdgcn_mfma_f32_32x32x16_bf16(b1,qr[d0],p1,0,0,0);}}
}
typedef __attribute__((address_space(3))) const char* lds_cptr;
typedef short v4i16_t __attribute__((ext_vector_type(4)));
__device__ __forceinline__ void kload8(bf16x8*kf,lds_cptr kp){
  kf[0]=*(const __attribute__((address_space(3))) bf16x8*)(kp);      kf[1]=*(const __attribute__((address_space(3))) bf16x8*)(kp+512);
  kf[2]=*(const __attribute__((address_space(3))) bf16x8*)(kp+2048); kf[3]=*(const __attribute__((address_space(3))) bf16x8*)(kp+2560);
  kf[4]=*(const __attribute__((address_space(3))) bf16x8*)(kp+4096); kf[5]=*(const __attribute__((address_space(3))) bf16x8*)(kp+4608);
  kf[6]=*(const __attribute__((address_space(3))) bf16x8*)(kp+6144); kf[7]=*(const __attribute__((address_space(3))) bf16x8*)(kp+6656);
}
__device__ __forceinline__ void kload2(bf16x8*kf,lds_cptr kp,int j){ kf[2*j]=*(const __attribute__((address_space(3))) bf16x8*)(kp+j*2048); kf[2*j+1]=*(const __attribute__((address_space(3))) bf16x8*)(kp+j*2048+512); }
__device__ __forceinline__ s16x4 vtr(lds_cptr p){ return __builtin_bit_cast(s16x4,__builtin_amdgcn_ds_read_tr16_b64_v4i16((__attribute__((address_space(3))) v4i16_t*)p)); }
__device__ __forceinline__ void qkt1(f32x16&p0,const char*kb,const bf16x8*qr,const f32x16&negm){
  #pragma unroll
  for(int d0=0;d0<4;++d0){ const bf16x8 b0=*reinterpret_cast<const bf16x8*>(kb+d0*2048);
    if(d0==0)p0=__builtin_amdgcn_mfma_f32_32x32x16_bf16(b0,qr[0],negm,0,0,0); else p0=__builtin_amdgcn_mfma_f32_32x32x16_bf16(b0,qr[d0],p0,0,0,0);}
}
__device__ __forceinline__ void kload4(bf16x8*kf,lds_cptr kp){
  kf[0]=*(const __attribute__((address_space(3))) bf16x8*)(kp);      kf[1]=*(const __attribute__((address_space(3))) bf16x8*)(kp+2048);
  kf[2]=*(const __attribute__((address_space(3))) bf16x8*)(kp+4096); kf[3]=*(const __attribute__((address_space(3))) bf16x8*)(kp+6144);
}
__device__ __forceinline__ void kload1(bf16x8*kf,lds_cptr kp,int j){ kf[j]=*(const __attribute__((address_space(3))) bf16x8*)(kp+j*2048); }
__device__ __forceinline__ float rowmax1(const f32x16&p0){
  float a=max3f(p0[0],p0[1],p0[2]),b=max3f(p0[3],p0[4],p0[5]);
  a=max3f(a,p0[6],p0[7]);b=max3f(b,p0[8],p0[9]);a=max3f(a,p0[10],p0[11]);b=max3f(b,p0[12],p0[13]);a=max3f(a,p0[14],p0[15]);
  const float m=max2f(a,b);
  auto rr=__builtin_amdgcn_permlane32_swap(__float_as_uint(m),__float_as_uint(m),false,false);
  return max2f(__uint_as_float(rr[0]),__uint_as_float(rr[1]));
}
__device__ __forceinline__ void bmask1(f32x16&p0,int nb,lds_cfptr lut){
  #pragma unroll
  for(int r=0;r<16;++r){ int n0=nb-((r&3)+8*(r>>2)); n0=n0<-1?-1:(n0>128?128:n0); p0[r]+=lut[n0+1]; }
}
__device__ __forceinline__ void pv2(f32x16*o,int vb,bf16x8 pa0,bf16x8 pa1){
  #pragma unroll
  for(int d0=0;d0<4;++d0){s16x4 lo[2],hi[2];
    #pragma unroll
    for(int ks=0;ks<2;++ks){
      asm volatile("ds_read_b64_tr_b16 %0,%1 offset:%c2":"=&v"(lo[ks]):"v"(vb),"i"(d0*4096+ks*1024):"memory");
      asm volatile("ds_read_b64_tr_b16 %0,%1 offset:%c2":"=&v"(hi[ks]):"v"(vb),"i"(d0*4096+ks*1024+512):"memory");}
    asm volatile("s_waitcnt lgkmcnt(0)":::"memory");SBAR();
    #define PK(k) (bf16x8){lo[k][0],lo[k][1],lo[k][2],lo[k][3],hi[k][0],hi[k][1],hi[k][2],hi[k][3]}
    o[d0]=__builtin_amdgcn_mfma_f32_32x32x16_bf16(pa0,PK(0),o[d0],0,0,0);
    o[d0]=__builtin_amdgcn_mfma_f32_32x32x16_bf16(pa1,PK(1),o[d0],0,0,0);
    #undef PK
  }
}
__device__ __forceinline__ float rowmax(const f32x16&p0,const f32x16&p1){
  float a=max3f(p0[0],p0[1],p1[0]),b=max3f(p0[2],p0[3],p1[1]);a=max3f(a,p1[2],p1[3]);
  #pragma unroll
  for(int r=4;r<16;r+=4){a=max3f(a,p0[r],p0[r+1]);b=max3f(b,p0[r+2],p0[r+3]);a=max3f(a,p1[r],p1[r+1]);b=max3f(b,p1[r+2],p1[r+3]);}
  const float m=max2f(a,b);
  auto rr=__builtin_amdgcn_permlane32_swap(__float_as_uint(m),__float_as_uint(m),false,false);
  return max2f(__uint_as_float(rr[0]),__uint_as_float(rr[1]));
}
__device__ __forceinline__ void pv(f32x16*o,int vb,bf16x8 pa0,bf16x8 pa1,bf16x8 pa2,bf16x8 pa3){
  #pragma unroll
  for(int d0=0;d0<2;++d0){s16x4 lo[4],hi[4];
    #pragma unroll
    for(int ks=0;ks<4;++ks){
      asm volatile("ds_read_b64_tr_b16 %0,%1 offset:%c2":"=&v"(lo[ks]):"v"(vb),"i"(d0*4096+ks*1024):"memory");
      asm volatile("ds_read_b64_tr_b16 %0,%1 offset:%c2":"=&v"(hi[ks]):"v"(vb),"i"(d0*4096+ks*1024+512):"memory");}
    asm volatile("s_waitcnt lgkmcnt(0)":::"memory");SBAR();
    #define PK(k) (bf16x8){lo[k][0],lo[k][1],lo[k][2],lo[k][3],hi[k][0],hi[k][1],hi[k][2],hi[k][3]}
    o[d0]=__builtin_amdgcn_mfma_f32_32x32x16_bf16(pa0,PK(0),o[d0],0,0,0);
    o[d0]=__builtin_amdgcn_mfma_f32_32x32x16_bf16(pa1,PK(1),o[d0],0,0,0);
    o[d0]=__builtin_amdgcn_mfma_f32_32x32x16_bf16(pa2,PK(2),o[d0],0,0,0);
    o[d0]=__builtin_amdgcn_mfma_f32_32x32x16_bf16(pa3,PK(3),o[d0],0,0,0);
    #undef PK
  }
}

__device__ __forceinline__ void build_lut(char*shm,const float*relb,int h,int tid){
  __attribute__((address_space(3))) float* lw=(__attribute__((address_space(3))) float*)((__attribute__((address_space(3))) char*)shm+LDS_LUT);
  if(tid<129){ const int bk=t5_bucket(tid); lw[1+tid]=(relb[bk*NHEAD+h]-relb[31*NHEAD+h])*1.4426950408889634f; } else if(tid==129){ lw[0]=-INFINITY; }
}
#ifndef ATTN_STORE16
#define ATTN_STORE16(p,v) (*(u32x4*)(p)=(v))
#endif
struct UnitArgs { int kind; int qcol,kcol,vcol,ocol; const float* relb; float* scr; float lam,oscale; const float* gain; };
template<int THRL> __device__ __forceinline__ void attn_unit(int b,int h,int qb,const bf16*Q,const bf16*__restrict__ K,const bf16*__restrict__ V,bf16*O,char*shm,const UnitArgs&ua){
  int tid_=threadIdx.x; asm volatile("":"+v"(tid_)); const int tid=tid_,lane=tid&63,r32=lane&31,hi=lane>>5; const int wid=__builtin_amdgcn_readfirstlane(tid>>6);
  const int rg=wid&3,g=wid>>2;
#ifdef ATT_PRIO
  if(g)__builtin_amdgcn_s_setprio(ATT_PRIO);
#endif
  const long rowbase=(long)b*SEQ; const int q0=qb*QB;
  const bf16*Qw=Q+(rowbase+q0+rg*QBLK)*DM+ua.qcol;
  const unsigned lds0=(unsigned)(uintptr_t)shm;
  float*wsf=(float*)(shm+LDS_WS)+wid*64;
  const char*ksrc=(const char*)K+wid*1024+lane*16;
  const char*vsrc=(const char*)V+wid*1024+lane*16;
  const unsigned kdst=lds0+LDS_K+wid*1024, vdst=lds0+LDS_V+wid*1024;
  #define DMA_K(t,slot) glds16(ksrc+(long)(t)*8192,(unsigned)__builtin_amdgcn_readfirstlane(kdst+(slot)))
  #define VSL(t) (((t)&(NVSLOT-1))*VSLOTB)
  #define DMA_V(t) do{ glds16(vsrc+(long)(t)*16384,(unsigned)__builtin_amdgcn_readfirstlane(vdst+VSL(t))); glds16(vsrc+8192+(long)(t)*16384,(unsigned)__builtin_amdgcn_readfirstlane(vdst+VSL(t)+8192)); }while(0)
  const int vb0=(int)(lds0+LDS_V)+((lane>>4)&1)*32+(lane&3)*8+(4*hi+((lane&15)>>2))*64+g*2048;
  bf16x8 kf[4];
  const lds_cptr shm3=(lds_cptr)shm; const lds_cptr kp0=shm3+LDS_K+hi*1024+r32*16+g*512; const lds_cptr vp0=shm3+LDS_V+((lane>>4)&1)*32+(lane&3)*8+(4*hi+((lane&15)>>2))*64+g*2048;
  const int NTd=(q0+QB)/KVBLK, NT=NTd<4?4:NTd;
  const lds_cfptr lutp=(lds_cfptr)((lds_cptr)shm+LDS_LUT);
  DMA_K(0,0);DMA_V(0);DMA_K(1,SLOTB);
  bf16x8 qr[4];
  #pragma unroll
  for(int d0=0;d0<4;++d0)qr[d0]=*reinterpret_cast<const bf16x8*>(&Qw[(long)r32*DM+d0*16+hi*8]);
  float mhat=0.f,l_reg=0.f;f32x16 o[4];o[0]=f32x16{};o[1]=f32x16{};o[2]=f32x16{};o[3]=f32x16{};f32x16 negm=f32x16{};asm volatile("":"+v"(negm));
  const int qw=q0+rg*QBLK-32*g;
  const int qabs=q0+rg*QBLK+r32-32*g-4*hi;
  #define CMASK(P0,t) do{ if(qw-64*(t)<144)bmask1(P0,qabs-64*(t),lutp); }while(0)
  bool resc=false;
  #define START(P0) do{ const float rm=rowmax1(P0); resc=false; \
    { const float dl=(rm==-INFINITY)?0.f:rm; mhat=fadd_s(mhat,dl); \
      _Pragma("unroll") for(int r=0;r<16;++r){P0[r]=fsub_s(P0[r],dl);} \
      _Pragma("unroll") for(int r=0;r<16;++r)negm[r]=-mhat; asm volatile("":"+v"(negm)); } \
    _Pragma("unroll") for(int r=0;r<16;++r)P0[r]=__builtin_amdgcn_exp2f(P0[r]); }while(0)
  #define RESC() do{ if(resc){ asm volatile("s_waitcnt lgkmcnt(0)":::"memory"); \
      _Pragma("unroll") for(int d_=0;d_<4;++d_) _Pragma("unroll") for(int r=0;r<16;++r)o[d_][r]*=wsf[crow(r,hi)]; } }while(0)
  f32x16 pA0,pB0;
  int sl_prev=0,sl_cur=0,sl_next=SLOTB;
  #define ROT() do{sl_prev=sl_cur;sl_cur=sl_next;sl_next=(sl_next==(NSLOT-1)*SLOTB)?0:sl_next+SLOTB;}while(0)
  DMA_K(2,2*SLOTB);DMA_V(1);
  WAIT_BAR(6);
  qkt1(pA0,shm+LDS_K+hi*1024+r32*16+g*512,qr,negm);asm volatile("s_nop 15\n\ts_nop 7":"+v"(pA0));CMASK(pA0,0);
  START(pA0);
  WAIT_BAR(2);
  DMA_K(3,0);DMA_V(2);
  ROT();
  kload4(kf,kp0+sl_cur);
  WAIT_BAR(5);
  s16x4 vlo[8],vhi[8]; u32x4 pw0,pw1;
  #define PKW(P,B) cvtpk_s(P[B],P[B+1])
  #define PAF(k) __builtin_bit_cast(bf16x8,pw##k)
  #define VFR(i) (bf16x8){vlo[i][0],vlo[i][1],vlo[i][2],vlo[i][3],vhi[i][0],vhi[i][1],vhi[i][2],vhi[i][3]}
  #define PIN(x) asm volatile("":"+v"(x))
  #define MX3(a,b,c) __builtin_fmaxf(__builtin_fmaxf((a),(b)),(c))
  #define GAPA(MF,A0,A1,A2,A3,W0,W1,PW) do{ MF; sacc+=A0; sacc+=A1; sacc+=A2; sacc+=A3; PIN(sacc); W0; W1; PIN(PW); SBAR(); }while(0)
  #define EX(v) __builtin_amdgcn_exp2f(v)
  #define GAPB(MF,X,B) do{ MF; X[B]=EX(X[B]); X[B+1]=EX(X[B+1]); PIN(X); SBAR(); }while(0)
  #define VRD(w,d,k) do{ vlo[w]=vtr(vp_+((d)*4096+(k)*1024)); vhi[w]=vtr(vp_+((d)*4096+(k)*1024+512)); }while(0)
  #define KRD(G,j) do{ if(G){ kload1(kf,kp0+sl_next,j); SBAR(); } }while(0)
  #define STEP(C0,P0,t,GK,GV,GL) do{ SBAR(); \
    const lds_cptr vp_=vp0+VSL((t)-1); \
    VRD(0,0,0); VRD(1,1,0); SBAR(); float sacc=(P0[0]+P0[1]); \
    GAPA(C0=__builtin_amdgcn_mfma_f32_32x32x16_bf16(kf[0],qr[0],negm,0,0,0), P0[2],P0[3],P0[4],P0[5],     pw0[0]=PKW(P0,0), pw0[1]=PKW(P0,2), pw0); \
    VRD(2,2,0); VRD(3,3,0); SBAR(); GAPA(C0=__builtin_amdgcn_mfma_f32_32x32x16_bf16(kf[1],qr[1],C0,0,0,0), P0[6],P0[7],P0[8],P0[9],     pw0[2]=PKW(P0,4), pw0[3]=PKW(P0,6), pw0); \
    VRD(4,0,1); VRD(5,1,1); SBAR(); GAPA(C0=__builtin_amdgcn_mfma_f32_32x32x16_bf16(kf[2],qr[2],C0,0,0,0), P0[10],P0[11],P0[12],P0[13], pw1[0]=PKW(P0,8), pw1[1]=PKW(P0,10), pw1); \
    VRD(6,2,1); VRD(7,3,1); SBAR(); GAPA(C0=__builtin_amdgcn_mfma_f32_32x32x16_bf16(kf[3],qr[3],C0,0,0,0), P0[14],P0[15],0.f,0.f,       pw1[2]=PKW(P0,12),pw1[3]=PKW(P0,14), pw1); \
    l_reg+=sacc; \
    if(GK){DMA_K((t)+3,sl_cur);} if(GV){DMA_V((t)+2);} \
    CMASK(C0,t); \
    { float a=MX3(C0[0],C0[1],C0[2]),b=MX3(C0[3],C0[4],C0[5]); a=MX3(a,C0[6],C0[7]); b=MX3(b,C0[8],C0[9]); a=MX3(a,C0[10],C0[11]); b=MX3(b,C0[12],C0[13]); a=MX3(a,C0[14],C0[15]); \
      float rm=__builtin_fmaxf(a,b); { auto rr=__builtin_amdgcn_permlane32_swap(__float_as_uint(rm),__float_as_uint(rm),false,false); rm=__builtin_fmaxf(__uint_as_float(rr[0]),__uint_as_float(rr[1])); } \
      resc=false; \
      if(__builtin_expect(__any(rm>(float)THRL),0)){ const float dl=__builtin_fmaxf(rm,0.f); mhat+=dl; \
        _Pragma("unroll") for(int r=0;r<16;++r){C0[r]-=dl;} \
        _Pragma("unroll") for(int r=0;r<16;++r)negm[r]=-mhat; asm volatile("":"+v"(negm)); \
        const float f=__builtin_amdgcn_exp2f(-dl); l_reg*=f; if(hi==0)wsf[r32]=f; resc=true; } } \
    SBAR(); MIDBAR(); \
    GAPB(o[0]=__builtin_amdgcn_mfma_f32_32x32x16_bf16(PAF(0),VFR(0),o[0],0,0,0), C0,0); \
    GAPB(o[1]=__builtin_amdgcn_mfma_f32_32x32x16_bf16(PAF(0),VFR(1),o[1],0,0,0), C0,2); \
    KRD(GL,0); GAPB(o[2]=__builtin_amdgcn_mfma_f32_32x32x16_bf16(PAF(0),VFR(2),o[2],0,0,0), C0,4); \
    KRD(GL,1); GAPB(o[3]=__builtin_amdgcn_mfma_f32_32x32x16_bf16(PAF(0),VFR(3),o[3],0,0,0), C0,6); \
    KRD(GL,2); GAPB(o[0]=__builtin_amdgcn_mfma_f32_32x32x16_bf16(PAF(1),VFR(4),o[0],0,0,0), C0,8); \
    KRD(GL,3); GAPB(o[1]=__builtin_amdgcn_mfma_f32_32x32x16_bf16(PAF(1),VFR(5),o[1],0,0,0), C0,10); \
    GAPB(o[2]=__builtin_amdgcn_mfma_f32_32x32x16_bf16(PAF(1),VFR(6),o[2],0,0,0), C0,12); \
    GAPB(o[3]=__builtin_amdgcn_mfma_f32_32x32x16_bf16(PAF(1),VFR(7),o[3],0,0,0), C0,14); \
    }while(0)
#ifdef ATT_SKEW
  #define SKEW() do{ if(g)__builtin_amdgcn_s_sleep(ATT_SKEW); }while(0)
#else
  #define SKEW() do{}while(0)
#endif
#ifdef ATT_MIDBAR
  #define MIDBAR() do{ asm volatile("s_barrier":::"memory"); SBAR(); }while(0)
#else
  #define MIDBAR() do{}while(0)
#endif
  int t=1;
  #undef CMASK
  #define CMASK(P0,t) do{}while(0)
  for(;t+7<NT;t+=2){
#ifdef PROBE_ATT_STRICT
    STEP(pB0,pA0,t,true,true,true);     WAIT_BAR(2); SKEW(); RESC(); ROT();
    STEP(pA0,pB0,t+1,true,true,true);   WAIT_BAR(2); SKEW(); RESC(); ROT();
#else
    STEP(pB0,pA0,t,true,true,true);     WAIT_BAR(5); SKEW(); RESC(); ROT();
    STEP(pA0,pB0,t+1,true,true,true);   WAIT_BAR(5); SKEW(); RESC(); ROT();
#endif
  }
  #undef CMASK
  #define CMASK(P0,t) do{ if(qw-64*(t)<144)bmask1(P0,qabs-64*(t),lutp); }while(0)
  #define ENDW(tt) do{ if((tt)+3<NT){WAIT_BAR(5);} else if((tt)+2<NT){WAIT_BAR(4);} else {WAIT_BAR(0);} }while(0)
  for(;t+1<NT;t+=2){
    STEP(pB0,pA0,t,(t+3<NT),(t+2<NT),(t+1<NT));       ENDW(t);   RESC(); ROT();
    STEP(pA0,pB0,t+1,(t+4<NT),(t+3<NT),(t+2<NT));     ENDW(t+1); RESC(); ROT();
  }
  STEP(pB0,pA0,NT-1,false,false,false); RESC();
  { float sacc=pB0[0]+pB0[1]; _Pragma("unroll") for(int r=2;r<16;++r)sacc+=pB0[r]; l_reg+=sacc;
    pw0=(u32x4){PKW(pB0,0),PKW(pB0,2),PKW(pB0,4),PKW(pB0,6)};pw1=(u32x4){PKW(pB0,8),PKW(pB0,10),PKW(pB0,12),PKW(pB0,14)};
    SBAR(); pv2(o,vb0+VSL(NT-1),PAF(0),PAF(1)); }
  #undef PKW
  #undef PAF
  #undef VFR
  #undef PIN
  #undef MX3
  #undef GAPA
  #undef GAPB
  #undef EX
  #undef VRD
  #undef KRD
  #undef STEP
  #undef ENDW
  {auto rr=__builtin_amdgcn_permlane32_swap(__float_as_uint(l_reg),__float_as_uint(l_reg),false,false);l_reg=__uint_as_float(rr[0])+__uint_as_float(rr[1]);}
  asm volatile("s_waitcnt lgkmcnt(0)\n\ts_barrier":::"memory");
  typedef float f32x4v __attribute__((ext_vector_type(4)));
  float*xs=(float*)shm+rg*(64*64+64)+64*64;
  f32x4v*xo4=(f32x4v*)((float*)shm+rg*(64*64+64));
  if(g==1){
    #pragma unroll
    for(int d0=0;d0<4;++d0){
      #pragma unroll
      for(int r4=0;r4<4;++r4)xo4[(d0*4+r4)*64+lane]=(f32x4v){o[d0][4*r4],o[d0][4*r4+1],o[d0][4*r4+2],o[d0][4*r4+3]};}
    if(hi==0){xs[r32]=mhat;xs[32+r32]=l_reg;}
  }
  asm volatile("s_waitcnt lgkmcnt(0)\n\ts_barrier":::"memory");
  if(g==0){
    const float mb=xs[r32],lb=xs[32+r32];
    const float m=(lb>0.f)?__builtin_fmaxf(mhat,mb):mhat,wa=__builtin_amdgcn_exp2f(mhat-m),wb=(lb>0.f)?__builtin_amdgcn_exp2f(mb-m):0.f;
    const float linv=__builtin_amdgcn_rcpf(l_reg*wa+lb*wb);
    if(hi==0){wsf[r32]=wa*linv;wsf[32+r32]=wb*linv;}
    f32x4v*sc4=(f32x4v*)ua.scr+(rg*16)*64+lane;
    f32x4v t2[16];
    if(ua.kind!=0){
      #pragma unroll
      for(int i=0;i<16;++i)t2[i]=__builtin_nontemporal_load(sc4+i*64);
    }
    asm volatile("s_waitcnt lgkmcnt(0)":::"memory");
    #pragma unroll
    for(int r4=0;r4<4;++r4){ const f32x4v fa=*(const f32x4v*)(wsf+8*r4+4*hi),fb=*(const f32x4v*)(wsf+32+8*r4+4*hi);
      #pragma unroll
      for(int d0=0;d0<4;++d0){ const f32x4v ob=xo4[(d0*4+r4)*64+lane];
        #pragma unroll
        for(int j=0;j<4;++j)o[d0][4*r4+j]=o[d0][4*r4+j]*fa[j]+ob[j]*fb[j]; } }
    if(ua.kind==0){
      #pragma unroll
      for(int d0=0;d0<4;++d0){
        #pragma unroll
        for(int r4=0;r4<4;++r4)sc4[(d0*4+r4)*64]=(f32x4v){o[d0][4*r4],o[d0][4*r4+1],o[d0][4*r4+2],o[d0][4*r4+3]};} }
    else{
      float rs[16];
      #pragma unroll
      for(int r=0;r<16;++r){ float ss=0.f;
        #pragma unroll
        for(int d0=0;d0<4;++d0){const float a=o[d0][r]-ua.lam*t2[d0*4+(r>>2)][r&3]; o[d0][r]=a; ss+=a*a;}
        ss+=__shfl_xor(ss,1); ss+=__shfl_xor(ss,2); ss+=__shfl_xor(ss,4); ss+=__shfl_xor(ss,8); ss+=__shfl_xor(ss,16);
        rs[r]=ua.oscale*__builtin_amdgcn_rsqf(ss*(1.0f/128.0f)+1e-6f); }
      bf16*stg=(bf16*)(shm+LDS_OST)+wid*2048;
      #pragma unroll
      for(int vh=0;vh<2;++vh){
        const float g0=ua.gain[vh*64+r32],g1=ua.gain[vh*64+32+r32];
        #pragma unroll
        for(int r=0;r<16;++r){const int orow=crow(r,hi);
          stg[orow*64+r32]=__float2bfloat16(o[2*vh][r]*rs[r]*g0);
          stg[orow*64+32+r32]=__float2bfloat16(o[2*vh+1][r]*rs[r]*g1);}
        asm volatile("s_waitcnt lgkmcnt(0)":::"memory");
        #pragma unroll
        for(int i=0;i<4;++i){const int row=i*8+(lane>>3),ch=lane&7; const u32x4 v=*(const u32x4*)(stg+row*64+ch*8); ATTN_STORE16((char*)O+PG8_AOFF(rowbase+q0+rg*QBLK+row,ua.ocol+vh*64+ch*8,OPITCH),v);}
        asm volatile("s_waitcnt lgkmcnt(0)":::"memory");
      } }
  }
#ifdef ATT_PRIO
  __builtin_amdgcn_s_setprio(0);
#endif
  asm volatile("s_waitcnt lgkmcnt(0)\n\ts_barrier":::"memory");
  #undef DMA_K
  #undef DMA_V
  #undef VSL
  #undef CMASK
  #undef START
  #undef RESC
  #undef ROT
}
constexpr int ATTN_LDS_BYTES=LDS_BYTES;
#undef SBAR
#undef WAIT_BAR
}

constexpr int NWAVES = 8;
#ifndef MK_PER_PHASE
#define MK_PER_PHASE 0
#endif
constexpr int BATCH = 2, SEQ = 4096, DMODEL = 4096, M = BATCH * SEQ, DEPTH = 4, FF = 16384, NGRP = 128;
constexpr int N_PHASES = 2 + 6 * DEPTH;
constexpr size_t MiB = 1u << 20;
constexpr size_t WS_CTL = 0, CTL_ZERO_BYTES = 1 * MiB;
constexpr int CW_BAR = 4096;
constexpr size_t SSQ_OFF = 128 * 1024;
static_assert(SSQ_OFF + 9 * (size_t)M * 8 <= CTL_ZERO_BYTES, "ssq inside the memset region");
constexpr size_t WS_W = 16 * MiB, W_LAYER = 360 * MiB;
constexpr size_t W_IN = 0, W_OUT = 64 * MiB, W_UP = 96 * MiB, W_DN = 224 * MiB, W_GLU = 352 * MiB;
constexpr size_t WS_SSMP = WS_W + DEPTH * W_LAYER;
constexpr size_t SSMP_STRIDE = 144 * 1024;
constexpr size_t WS_KI = 1536 * MiB, WS_VI = 1568 * MiB;
constexpr size_t WS_H = 1536 * MiB, WS_HB = 1664 * MiB, WS_QKV = 1728 * MiB, WS_UT = 1824 * MiB, WS_YG = 1856 * MiB, WS_CAT = 1888 * MiB, WS_ATT = 1952 * MiB, WS_HID = 1984 * MiB, WS_END = 2240 * MiB;
static_assert(WS_SSMP + (size_t)DEPTH * NGRP * SSMP_STRIDE <= WS_H, "d_ws map");
constexpr int RING_OFF = 0, RING_BYTES = 131072;
constexpr int LDSCTL_OFF = RING_BYTES, MISC_OFF = LDSCTL_OFF + 320;
constexpr int LDS_BYTES = 147456;
static_assert(MISC_OFF + 128 <= LDS_BYTES, "LDS map");

#define GAS __attribute__((address_space(1)))
#define LAS __attribute__((address_space(3)))
typedef unsigned short bf16;
typedef unsigned v4u __attribute__((ext_vector_type(4)));
typedef float f32x4 __attribute__((ext_vector_type(4)));
typedef short bf16x8 __attribute__((ext_vector_type(8)));
typedef GAS unsigned gu32;
typedef GAS unsigned long long gu64;
#define RLX_AGENT __ATOMIC_RELAXED, __HIP_MEMORY_SCOPE_AGENT
#define LDS_WAIT() asm volatile("s_waitcnt lgkmcnt(0)" ::: "memory")
#define VM_WAIT() asm volatile("s_waitcnt vmcnt(0)" ::: "memory")
__device__ __forceinline__ unsigned long long rt() { return __builtin_amdgcn_s_memrealtime(); }
__device__ __forceinline__ unsigned f2bf(float f) { unsigned u = __builtin_bit_cast(unsigned, f); return (u + 0x7fffu + ((u >> 16) & 1u)) >> 16; }
__device__ __forceinline__ unsigned pk2(float lo, float hi) { return f2bf(lo) | (f2bf(hi) << 16); }

#define XB_TMO      128
#define XB_XCNT(j)  (256  + 64 * (j))
#define XB_XSUB(j)  (1280 + 64 * (j))
#define XB_XGEN(j)  (2304 + 64 * (j))
#define XB_TOP      3328
#define XB_TOPGEN   3392
#define XCD_BAR_WORDS 3456
#define XB_SPIN_CAP (1u << 18)

__device__ __forceinline__ unsigned xb_ld(unsigned* p)              { return __hip_atomic_load(p, __ATOMIC_RELAXED, __HIP_MEMORY_SCOPE_AGENT); }
__device__ __forceinline__ unsigned xb_add(unsigned* p, unsigned v) { return __hip_atomic_fetch_add(p, v, __ATOMIC_RELAXED, __HIP_MEMORY_SCOPE_AGENT); }
__device__ __forceinline__ unsigned xb_xcc_id() { return (unsigned)__builtin_amdgcn_s_getreg((3 << 11) | 20) & 0xFu; }
#define XB_SPIN(cond, bar) do { unsigned _sp = 0; while (cond) { __builtin_amdgcn_s_sleep(1); \
    if ((++_sp & 255u) == 0u) { if (xb_ld(&(bar)[XB_TMO])) break; if (_sp > XB_SPIN_CAP) { atomicAdd(&(bar)[XB_TMO], 1u); break; } } } } while (0)

struct XcdBarrier {
    unsigned* bar; unsigned x;
    volatile LAS unsigned* st;
};

__device__ __forceinline__ XcdBarrier xcd_barrier_post(unsigned* bar, volatile LAS unsigned* st) {
    XcdBarrier b; b.bar = bar; b.x = xb_xcc_id(); b.st = st;
    if (threadIdx.x == 0) (void)xb_add(&bar[XB_XCNT(b.x)], 1u);
    return b;
}
__device__ __forceinline__ void xcd_barrier_complete(unsigned* bar, unsigned x, unsigned& nloc, unsigned& nx) {
    const unsigned G = gridDim.x * gridDim.y * gridDim.z;
    unsigned sum, cnt, mine, sp = 0u;
    for (;;) {
        sum = 0u; cnt = 0u; mine = 0u;
#pragma unroll
        for (unsigned j = 0; j < 16; ++j) { const unsigned c = xb_ld(&bar[XB_XCNT(j)]); sum += c; cnt += (c > 0u) ? 1u : 0u; mine = (j == x) ? c : mine; }
        if (sum == G) break;
        __builtin_amdgcn_s_sleep(1);
        if ((++sp & 255u) == 0u) { if (xb_ld(&bar[XB_TMO])) break; if (sp > XB_SPIN_CAP) { atomicAdd(&bar[XB_TMO], 1u); break; } }
    }
    nloc = mine > 0u ? mine : 1u; nx = cnt > 0u ? cnt : 1u;
}

__device__ __forceinline__ void xcd_barrier(const XcdBarrier& b) {
    asm volatile("s_waitcnt vmcnt(0)" ::: "memory");
    __syncthreads();
    if (threadIdx.x == 0) {
        unsigned* bar = b.bar;
        __builtin_amdgcn_s_waitcnt(0);
        unsigned nloc = b.st[0], nx = b.st[1];
        if (nloc == 0u) { xcd_barrier_complete(bar, b.x, nloc, nx); b.st[0] = nloc; b.st[1] = nx; }
        const unsigned old = xb_add(&bar[XB_XSUB(b.x)], 1u);
        const unsigned gen = old / nloc;
        if (old + 1u == (gen + 1u) * nloc) {
            __builtin_amdgcn_fence(__ATOMIC_RELEASE, "agent");
            asm volatile("s_waitcnt vmcnt(0)" ::: "memory");
            const unsigned og = xb_add(&bar[XB_TOP], 1u);
            const unsigned tg = og / nx;
            if (og + 1u == (tg + 1u) * nx) xb_add(&bar[XB_TOPGEN], 1u);
            else XB_SPIN(xb_ld(&bar[XB_TOPGEN]) == tg, bar);
            __builtin_amdgcn_fence(__ATOMIC_ACQUIRE, "agent");
            xb_add(&bar[XB_XGEN(b.x)], 1u);
            asm volatile("s_waitcnt vmcnt(0)" ::: "memory");
        } else {
            XB_SPIN(xb_ld(&bar[XB_XGEN(b.x)]) == gen, bar);
            __builtin_amdgcn_fence(__ATOMIC_ACQUIRE, "agent");
            asm volatile("s_waitcnt vmcnt(0)" ::: "memory");
        }
    }
    __syncthreads();
}

struct Frame {
    LAS unsigned char* lds;
    volatile LAS unsigned* MISC;
    gu32* ctl;
    int tid, lane, wave;
    int vcu, G;
    const float* const* in;
    float* out; unsigned char* ws;
};
enum In { I_X = 0, I_WIN, I_WOUT, I_NMIX, I_NMLP, I_WUP, I_WDN, I_NFIN, I_RELB, I_LQ1, I_LK1, I_LQ2, I_LK2, I_SUBG, I_SLRE, I_SLIM, I_SLDT, I_SBRE, I_SBIM, I_SCRE, I_SCIM, I_SD, I_WGLU, I_BGLU, N_IN };

__device__ __forceinline__ float wave_sum(float v) {
#pragma unroll
    for (int o = 1; o < 64; o <<= 1) v += __shfl_xor(v, o);
    return v;
}
struct TItem { const float* src; const float* gain; bf16* dst; int N, K, n0, k0; };
struct TRegs { f32x4 v[8]; f32x4 g0, g1; };
__device__ __forceinline__ void tr_load(const TItem& t, TRegs& r, int lane) {
    const float* p = t.src + (size_t)(lane >> 4) * t.N + 4 * (lane & 15);
#pragma unroll
    for (int i = 0; i < 8; ++i) r.v[i] = *(const f32x4*)(p + (size_t)(4 * i) * t.N);
    if (t.gain) { r.g0 = *(const f32x4*)(t.gain + 8 * (lane >> 4)); r.g1 = *(const f32x4*)(t.gain + 8 * (lane >> 4) + 4); } else { r.g0 = (f32x4){1.f, 1.f, 1.f, 1.f}; r.g1 = r.g0; }
}
__device__ __forceinline__ void tr_store(const TItem& t, const TRegs& r, LAS float* scr, int lane) {
#pragma unroll
    for (int i = 0; i < 8; ++i) { LAS float* d = scr + (4 * i + (lane >> 4)) * 65 + 4 * (lane & 15); d[0] = r.v[i].x; d[1] = r.v[i].y; d[2] = r.v[i].z; d[3] = r.v[i].w; }
    LDS_WAIT(); asm volatile("" ::: "memory");
    const int c4 = lane >> 4;
#pragma unroll
    for (int j = 0; j < 4; ++j) { const int R = 16 * j + (lane & 15), nl = (R & ~31) + pg8::perm32(R & 31);
        const LAS float* s = scr + (8 * c4) * 65 + nl;
        v4u o; o.x = pg8::cvt_pk_bf16(s[0 * 65] * r.g0.x, s[1 * 65] * r.g0.y); o.y = pg8::cvt_pk_bf16(s[2 * 65] * r.g0.z, s[3 * 65] * r.g0.w); o.z = pg8::cvt_pk_bf16(s[4 * 65] * r.g1.x, s[5 * 65] * r.g1.y); o.w = pg8::cvt_pk_bf16(s[6 * 65] * r.g1.z, s[7 * 65] * r.g1.w);
        *(GAS v4u*)((GAS unsigned char*)t.dst + pg8::img_off(t.n0 + nl, t.k0 + 8 * c4, t.K, true)) = o; }
    LDS_WAIT(); asm volatile("" ::: "memory");
}
__device__ __forceinline__ void ssm_setup_unit(Frame& F, int l, int g) {
    LAS float* apr = (LAS float*)(F.lds + RING_OFF); LAS float* api = apr + 17 * 64; LAS float* bbr = api + 17 * 64; LAS float* bbi = bbr + 1024;
    LAS float* cr = bbi + 1024; LAS float* ci = cr + 1024; LAS float* gg = ci + 1024;
    const int lg = l * NGRP + g, tid = F.tid;
    bf16* P = (bf16*)(F.ws + WS_SSMP + (size_t)lg * SSMP_STRIDE); bf16* WmT = P; bf16* VmT = P + 32768; bf16* Kt = P + 65536; float* A16 = (float*)(P + 65536 + 17 * 256);
    if (tid < 64) { const int p = tid;
        const float dt = expf(F.in[I_SLDT][lg]), lr = F.in[I_SLRE][lg * 64 + p], li = F.in[I_SLIM][lg * 64 + p];
        const float mag = expf(lr * dt), th = li * dt, ar = mag * cosf(th), ai = mag * sinf(th);
        float pr = 1.f, pi = 0.f;
        for (int tau = 0; tau <= 16; ++tau) { apr[tau * 64 + p] = pr; api[tau * 64 + p] = pi; const float npr = pr * ar - pi * ai, npi = pr * ai + pi * ar; pr = npr; pi = npi; }
        const float den = lr * lr + li * li, nr = ar - 1.0f, ni = ai;
        gg[p] = (nr * lr + ni * li) / den; gg[64 + p] = (ni * lr - nr * li) / den; }
    __syncthreads();
    if (tid < 64) { A16[2 * tid] = apr[16 * 64 + tid]; A16[2 * tid + 1] = api[16 * 64 + tid]; }
    for (int idx = tid; idx < 1024; idx += NWAVES * 64) { const int p = idx >> 4;
        const float br = F.in[I_SBRE][(size_t)lg * 1024 + idx], bi = F.in[I_SBIM][(size_t)lg * 1024 + idx], gr = gg[p], gi = gg[64 + p];
        bbr[idx] = gr * br - gi * bi; bbi[idx] = gr * bi + gi * br;
        cr[idx] = F.in[I_SCRE][(size_t)lg * 1024 + idx]; ci[idx] = F.in[I_SCIM][(size_t)lg * 1024 + idx]; }
    __syncthreads();
    for (int e = tid; e < 32768; e += NWAVES * 64) { const int pp = e >> 8, k = e & 255, p = pp & 63, j = k >> 4, hh = k & 15, tau = 15 - j;
        const float ar = apr[tau * 64 + p], ai = api[tau * 64 + p], br = bbr[p * 16 + hh], bi = bbi[p * 16 + hh];
        WmT[e] = (bf16)f2bf(pp < 64 ? ar * br - ai * bi : ar * bi + ai * br); }
    for (int e = tid; e < 32768; e += NWAVES * 64) { const int n = e >> 7, pp = e & 127, p = pp & 63, t = n >> 4, hh = n & 15;
        const float ar = apr[(t + 1) * 64 + p], ai = api[(t + 1) * 64 + p], c_r = cr[hh * 64 + p], c_i = ci[hh * 64 + p];
        VmT[e] = (bf16)f2bf(pp < 64 ? c_r * ar - c_i * ai : -(c_r * ai + c_i * ar)); }
    for (int e = tid; e < 256; e += NWAVES * 64) Kt[e] = 0;
    for (int e = tid; e < 4096; e += NWAVES * 64) { const int tau = e >> 8, hh = (e >> 4) & 15, h2 = e & 15; float acc = 0.f;
        for (int p = 0; p < 64; ++p) { const float ar = apr[tau * 64 + p], ai = api[tau * 64 + p], c_r = cr[hh * 64 + p], c_i = ci[hh * 64 + p];
            const float xr = c_r * ar - c_i * ai, xi = c_r * ai + c_i * ar; acc += xr * bbr[p * 16 + h2] - xi * bbi[p * 16 + h2]; }
        if (tau == 0 && hh == h2) acc += F.in[I_SD][lg * 16 + hh];
        Kt[256 + e] = (bf16)f2bf(acc); }
    __syncthreads();
}
constexpr int IT_IN = (DMODEL / 64) * (8192 / 32), IT_OUT = (DMODEL / 64) * (DMODEL / 32), IT_UP = (DMODEL / 64) * (FF / 32), IT_DN = (FF / 64) * (DMODEL / 32), IT_GLU = (2048 / 64) * (2048 / 32);
constexpr int IT_LAYER = IT_IN + IT_OUT + IT_UP + IT_DN + IT_GLU;
#ifndef CONV_SPLIT_X8
#define CONV_SPLIT_X8 16
#endif
constexpr int CONV_SPLIT_LO = (int)((long)IT_LAYER * CONV_SPLIT_X8 / 8);
static_assert(CONV_SPLIT_LO >= IT_IN, "layer 0's in-projection weights are needed before the split phase");
#ifndef CONV_SPLIT_NB
#define CONV_SPLIT_NB 3
#endif
#ifndef CONV_SPLIT2
#define CONV_SPLIT2 0
#endif
constexpr int CONV_SPLIT2_LO = IT_IN;
#ifndef SETUP_DEFER
#define SETUP_DEFER 0
#endif
#ifndef CONV_SPLIT
#define CONV_SPLIT 0
#endif
template <int NB> __device__ __forceinline__ void convert_items(Frame& F, int it_lo, int it_hi, int gw, int ngw) {
    int lane_ = F.lane; asm volatile("" : "+v"(lane_)); const int lane = lane_;
    LAS float* scr = (LAS float*)(F.lds + RING_OFF + F.wave * 16384);
    auto decode = [&](int it, TItem& t) {
        const int l = it / IT_LAYER; int r = it % IT_LAYER;
        unsigned char* wl = F.ws + WS_W + (size_t)l * W_LAYER;
        const float* W; const float* gain = nullptr; bf16* WT; int K, N;
        if (r < IT_IN) { W = F.in[I_WIN] + (size_t)l * DMODEL * 8192; K = DMODEL; N = 8192; gain = F.in[I_NMIX] + l * DMODEL; WT = (bf16*)(wl + W_IN); }
        else if ((r -= IT_IN) < IT_OUT) { W = F.in[I_WOUT] + (size_t)l * DMODEL * DMODEL; K = DMODEL; N = DMODEL; WT = (bf16*)(wl + W_OUT); }
        else if ((r -= IT_OUT) < IT_UP) { W = F.in[I_WUP] + (size_t)l * DMODEL * FF; K = DMODEL; N = FF; gain = F.in[I_NMLP] + l * DMODEL; WT = (bf16*)(wl + W_UP); }
        else if ((r -= IT_UP) < IT_DN) { W = F.in[I_WDN] + (size_t)l * FF * DMODEL; K = FF; N = DMODEL; WT = (bf16*)(wl + W_DN); }
        else { r -= IT_DN; W = F.in[I_WGLU] + (size_t)l * 2048 * 2048; K = 2048; N = 2048; WT = (bf16*)(wl + W_GLU); }
        const int nblk = N / 64, k0 = 32 * (r / nblk), n0 = 64 * (r % nblk);
        t.src = W + (size_t)k0 * N + n0; t.gain = gain ? gain + k0 : nullptr; t.dst = WT; t.N = N; t.K = K; t.n0 = n0; t.k0 = k0; };
    const int first = it_lo + gw;
    TItem t[NB]; TRegs r[NB];
#pragma unroll
    for (int k = 0; k < NB - 1; ++k) { const int i = first + k * ngw; if (i < it_hi) { decode(i, t[k]); tr_load(t[k], r[k], lane); } }
    for (int base = first; base < it_hi; base += NB * ngw) {
#pragma unroll
        for (int k = 0; k < NB; ++k) { const int cur = base + k * ngw;
            if (cur < it_hi) { const int nxt = cur + (NB - 1) * ngw;
                if (nxt < it_hi) { decode(nxt, t[(k + NB - 1) % NB]); tr_load(t[(k + NB - 1) % NB], r[(k + NB - 1) % NB], lane); }
                tr_store(t[k], r[k], scr, lane); } }
    }
}
__device__ __forceinline__ void p0_prologue(Frame& F) {
    const int gw = F.vcu * NWAVES + F.wave, NGW = F.G * NWAVES;
    convert_items<2>(F, 0, (CONV_SPLIT && F.G == 256) ? ((CONV_SPLIT2 || CONV_SPLIT == 2) ? CONV_SPLIT2_LO : CONV_SPLIT_LO) : DEPTH * IT_LAYER, gw, NGW);
    pg8::ssq_t* ssq0 = (pg8::ssq_t*)(F.ws + WS_CTL + SSQ_OFF);
    {
        f32x4 xv[16];
        if (gw < M) { const GAS f32x4* xr = (const GAS f32x4*)(F.in[I_X] + (size_t)gw * DMODEL) + F.lane;
#pragma unroll
            for (int j = 0; j < 16; ++j) xv[j] = xr[64 * j]; }
        for (int m = gw; m < M; m += NGW) {
            f32x4 xn[16]; const int mn = m + NGW;
            if (mn < M) { const GAS f32x4* xr = (const GAS f32x4*)(F.in[I_X] + (size_t)mn * DMODEL) + F.lane;
#pragma unroll
                for (int j = 0; j < 16; ++j) xn[j] = xr[64 * j]; }
            float s = 0.f;
#pragma unroll
            for (int j = 0; j < 16; ++j) { const f32x4 v = xv[j]; s += (v.x * v.x + v.y * v.y) + (v.z * v.z + v.w * v.w); *(GAS unsigned long long*)(F.ws + WS_HB + PG8_AOFF(m, 4 * (F.lane + 64 * j), DMODEL)) = (unsigned long long)pk2(v.x, v.y) | ((unsigned long long)pk2(v.z, v.w) << 32); }
            s = wave_sum(s); if (F.lane == 0) ssq0[m] = (pg8::ssq_t)(s * pg8::SSQ_SCALE);
#pragma unroll
            for (int j = 0; j < 16; ++j) xv[j] = xn[j];
        }
    }
    __syncthreads();
    for (int u = F.vcu; u < ((CONV_SPLIT == 2 && SETUP_DEFER && F.G == 256) ? 1 : DEPTH) * NGRP; u += F.G) ssm_setup_unit(F, u / NGRP, u % NGRP);
}
__device__ __forceinline__ float gelu_tanh(float y) { const float z = 0.7978845608028654f * (y + 0.044715f * y * y * y); return y * __builtin_amdgcn_rcpf(1.0f + __builtin_amdgcn_exp2f(-2.8853900817779268f * z)); }
__device__ __forceinline__ void ssm_unit(Frame& F, int l, int b, int g) {
    typedef short s16x8 __attribute__((ext_vector_type(8)));
#define SSM_SYNC() asm volatile("s_waitcnt lgkmcnt(0)\n\ts_barrier" ::: "memory")
    int lane_ = F.lane; asm volatile("" : "+v"(lane_));
    const int lane = lane_, w = F.wave, fr = lane & 15, fq = lane >> 4, tid = w * 64 + lane;
    const bf16* P = (const bf16*)(F.ws + WS_SSMP + (size_t)(l * NGRP + g) * SSMP_STRIDE); const bf16* WmT = P; const bf16* VmT = P + 32768; const bf16* Kt = P + 65536; const float* A16 = (const float*)(P + 65536 + 17 * 256);
    const bf16* U = (const bf16*)(F.ws + WS_UT) + ((size_t)g * M + (size_t)b * SEQ) * 16;
    bf16* YG = (bf16*)(F.ws + WS_YG);
    LAS float* S = (LAS float*)(F.lds + RING_OFF);
    LAS unsigned char* UQ = F.lds + RING_OFF + 64 * 132 * 4;
    s16x8 wf[8], kfl[4], kfh[8], vfl[4], vfh[4];
    const int tl = w, th = 15 - w;
    v4u pre[4];
#pragma unroll
    for (int i = 0; i < 4; ++i) pre[i] = *(const v4u*)(U + (size_t)(tid + 512 * i) * 8);
#pragma unroll
    for (int kk = 0; kk < 8; ++kk) wf[kk] = *(const s16x8*)(WmT + (16 * w + fr) * 256 + 32 * kk + 8 * fq);
#pragma unroll
    for (int kk = 0; kk < 4; ++kk) { const int tau = tl - 2 * kk - (fq >> 1); kfl[kk] = *(const s16x8*)(Kt + (tau < 0 ? 0 : tau + 1) * 256 + fr * 16 + 8 * (fq & 1)); }
#pragma unroll
    for (int kk = 0; kk < 8; ++kk) { const int tau = th - 2 * kk - (fq >> 1); kfh[kk] = *(const s16x8*)(Kt + (tau < 0 ? 0 : tau + 1) * 256 + fr * 16 + 8 * (fq & 1)); }
#pragma unroll
    for (int kk = 0; kk < 4; ++kk) { vfl[kk] = *(const s16x8*)(VmT + (tl * 16 + fr) * 128 + 32 * kk + 8 * fq); vfh[kk] = *(const s16x8*)(VmT + (th * 16 + fr) * 128 + 32 * kk + 8 * fq); }
    float sr = 0.f, si = 0.f, a16r = 0.f, a16i = 0.f;
    if (w == 0) { a16r = A16[2 * lane]; a16i = A16[2 * lane + 1]; }
    for (int q = 0; q < 4; ++q) {
#pragma unroll
        for (int i = 0; i < 4; ++i) { const int e = tid + 512 * i; *(LAS v4u*)(UQ + (e >> 5) * 528 + (e & 31) * 16) = pre[i]; }
        SSM_SYNC();
        if (q < 3) {
#pragma unroll
            for (int i = 0; i < 4; ++i) pre[i] = *(const v4u*)(U + (size_t)(q + 1) * 16384 + (size_t)(tid + 512 * i) * 8);
        }
#pragma unroll
        for (int mt = 0; mt < 4; ++mt) {
            const LAS unsigned char* ub = UQ + (mt * 16 + fr) * 528 + fq * 16;
            f32x4 acc = {0.f, 0.f, 0.f, 0.f};
#pragma unroll
            for (int kk = 0; kk < 8; ++kk) { const s16x8 uf = *(const LAS s16x8*)(ub + 64 * kk); acc = __builtin_amdgcn_mfma_f32_16x16x32_bf16(wf[kk], uf, acc, 0, 0, 0); }
            *(LAS f32x4*)(S + (mt * 16 + fr) * 132 + 16 * w + 4 * fq) = acc;
        }
        SSM_SYNC();
        if (w == 0) {
            for (int c0 = 0; c0 < 64; c0 += 8) { float tr[8], ti[8];
#pragma unroll
                for (int i = 0; i < 8; ++i) { tr[i] = S[(c0 + i) * 132 + lane]; ti[i] = S[(c0 + i) * 132 + 64 + lane]; }
#pragma unroll
                for (int i = 0; i < 8; ++i) { S[(c0 + i) * 132 + lane] = sr; S[(c0 + i) * 132 + 64 + lane] = si;
                    const float nsr = a16r * sr - a16i * si + tr[i], nsi = a16r * si + a16i * sr + ti[i]; sr = nsr; si = nsi; } }
        }
        SSM_SYNC();
#pragma unroll
        for (int mt = 0; mt < 4; ++mt) {
            const int chunk = q * 64 + mt * 16 + fr;
            const LAS unsigned char* ub = UQ + (mt * 16 + fr) * 528 + fq * 16;
            f32x4 accl = {0.f, 0.f, 0.f, 0.f}, acch = {0.f, 0.f, 0.f, 0.f};
#pragma unroll
            for (int kk = 0; kk < 8; ++kk) { const s16x8 uf = *(const LAS s16x8*)(ub + 64 * kk);
                if (kk < 4) accl = __builtin_amdgcn_mfma_f32_16x16x32_bf16(kfl[kk], uf, accl, 0, 0, 0);
                acch = __builtin_amdgcn_mfma_f32_16x16x32_bf16(kfh[kk], uf, acch, 0, 0, 0); }
#pragma unroll
            for (int kk = 0; kk < 4; ++kk) { const LAS float* sp = S + (mt * 16 + fr) * 132 + 32 * kk + 8 * fq; const f32x4 s0 = *(const LAS f32x4*)sp, s1 = *(const LAS f32x4*)(sp + 4);
                const s16x8 sf = __builtin_bit_cast(s16x8, pg8::pack8(s0, s1));
                accl = __builtin_amdgcn_mfma_f32_16x16x32_bf16(vfl[kk], sf, accl, 0, 0, 0); acch = __builtin_amdgcn_mfma_f32_16x16x32_bf16(vfh[kk], sf, acch, 0, 0, 0); }
            const size_t tok = (size_t)b * SEQ + (size_t)chunk * 16;
            { typedef unsigned u32x2 __attribute__((ext_vector_type(2)));
              u32x2 o; o.x = pg8::cvt_pk_bf16(gelu_tanh(accl[0]), gelu_tanh(accl[1])); o.y = pg8::cvt_pk_bf16(gelu_tanh(accl[2]), gelu_tanh(accl[3]));
              *(u32x2*)((char*)YG + PG8_AOFF(tok + tl, g * 16 + 4 * fq, 2048)) = o;
              o.x = pg8::cvt_pk_bf16(gelu_tanh(acch[0]), gelu_tanh(acch[1])); o.y = pg8::cvt_pk_bf16(gelu_tanh(acch[2]), gelu_tanh(acch[3]));
              *(u32x2*)((char*)YG + PG8_AOFF(tok + th, g * 16 + 4 * fq, 2048)) = o; }
        }
        SSM_SYNC();
    }
#undef SSM_SYNC
}

struct Args { const float* in[N_IN]; float* out; unsigned char* ws; int ph_lo, ph_hi; };
__global__ void __launch_bounds__(NWAVES * 64, 2) hymba_fwd(Args args) {
    extern __shared__ __attribute__((aligned(16))) unsigned char lds[];
    Frame F;
    F.lds = (LAS unsigned char*)lds;
    F.MISC = (volatile LAS unsigned*)(F.lds + MISC_OFF);
    F.tid = threadIdx.x; F.lane = F.tid & 63; F.wave = __builtin_amdgcn_readfirstlane(F.tid >> 6);
    F.G = gridDim.x; { const int bx = blockIdx.x; F.vcu = (F.G % 8 == 0) ? (bx % 8) * (F.G / 8) + bx / 8 : bx; }
    F.in = args.in; F.out = args.out; F.ws = args.ws;
    unsigned char* ws = args.ws;
    F.ctl = (gu32*)(ws + WS_CTL);
    for (int u = F.tid; u < (LDS_BYTES - LDSCTL_OFF) / 4; u += NWAVES * 64) ((LAS unsigned*)(F.lds + LDSCTL_OFF))[u] = 0u;
    __syncthreads();
    XcdBarrier bar; bar.bar = (unsigned*)(F.ctl + CW_BAR); bar.x = 0; bar.st = nullptr;
    if (!MK_PER_PHASE) bar = xcd_barrier_post((unsigned*)(F.ctl + CW_BAR), F.MISC + 8);
#ifndef REP_BAR
#define REP_BAR 1
#endif
#define GRID_BAR() do { if (MK_PER_PHASE) { if (F.tid == 0) __hip_atomic_store(F.ctl + 0, 0xBADBA0u, RLX_AGENT); } else { for (int rb_ = 0; rb_ < REP_BAR; ++rb_) xcd_barrier(bar); } } while (0)
    const int lo = args.ph_lo, hi = args.ph_hi;
#define IN(k) (lo <= (k) && (k) < hi)
#define BOTH(k) (IN(k) && IN((k) + 1))
    pg8::ssq_t* const ssq = (pg8::ssq_t*)(ws + WS_CTL + SSQ_OFF);
    pg8::bf16_t* const HB = (pg8::bf16_t*)(ws + WS_HB); pg8::bf16_t* const QKV = (pg8::bf16_t*)(ws + WS_QKV); pg8::bf16_t* const UT = (pg8::bf16_t*)(ws + WS_UT);
    pg8::bf16_t* const YG = (pg8::bf16_t*)(ws + WS_YG); pg8::bf16_t* const CAT = (pg8::bf16_t*)(ws + WS_CAT); pg8::bf16_t* const HID = (pg8::bf16_t*)(ws + WS_HID);

#ifndef REP_PRO
#define REP_PRO 1
#endif
#ifndef REP_SSM
#define REP_SSM 1
#endif
#ifndef REP_ATT
#define REP_ATT 1
#endif
#ifndef REP_GEMM
#define REP_GEMM 1
#endif
#ifndef REP_RES
#define REP_RES 1
#endif
    if (IN(0)) { for (int rep = 0; rep < REP_PRO; ++rep) { p0_prologue(F); __syncthreads(); } if (BOTH(0)) GRID_BAR(); }

    for (int l = 0; l < DEPTH; ++l) {
        const int pb = 1 + 6 * l;
        const unsigned char* wl = ws + WS_W + (size_t)l * W_LAYER;
        if (IN(pb)) {
#ifndef CONV_SPLIT2
#define CONV_SPLIT2 0
#endif
            const bool split2 = CONV_SPLIT && CONV_SPLIT2 && l == 0 && F.G == 256;
            pg8::Gemm g{HB, (const pg8::bf16_t*)(wl + W_IN), M, 8192, DMODEL, A_IMG, 1}; pg8::StaticOrder S;
            if (split2) S.init(M, 8192, 128, (F.vcu & 15) * 8 + (F.vcu >> 5)); else S.init(M, 8192, F.G, (int)blockIdx.x);
            pg8::EpiProj E{QKV, UT, ssq + (2 * l) * M, attn_body::C2, ws + WS_KI, ws + WS_VI};
#ifndef STG_IN
#define STG_IN 0
#endif
            if (STG_IN && (F.vcu & 1)) { for (int s_ = 0; s_ < STG_IN; ++s_) __builtin_amdgcn_s_sleep(48); }
            if (split2 && (F.vcu & 16)) convert_items<CONV_SPLIT_NB>(F, CONV_SPLIT2_LO, CONV_SPLIT_LO, ((F.vcu >> 5) * 16 + (F.vcu & 15)) * NWAVES + F.wave, 128 * NWAVES);
            else
            for (int rep = 0; rep < REP_GEMM; ++rep) { pg8::gemm_phase<pg8::EpiProj, pg8::StaticOrder, PG8_ALIGN, PG8_SP2>(F.lds + RING_OFF, g, S, E); __syncthreads(); }
            if (BOTH(pb)) GRID_BAR();
        }
        if (IN(pb + 1)) {
#ifndef S5_SHIFT
#define S5_SHIFT 0
#endif
            const bool s5shift = S5_SHIFT && CONV_SPLIT == 2 && l == 0 && F.G == 256;
            const int su0 = s5shift ? ((F.vcu & 16) ? (F.vcu >> 5) * 16 + (F.vcu & 15) : BATCH * NGRP) : F.vcu, sustep = s5shift ? 128 : F.G;
            for (int rep = 0; rep < REP_SSM; ++rep) for (int u = su0; u < BATCH * NGRP; u += sustep) ssm_unit(F, l, u / NGRP, u % NGRP);
            __syncthreads();
            const float lam_init = 0.8f - 0.6f * expf(-0.3f * (float)l);
            const float d1 = wave_sum(F.in[I_LQ1][l * 64 + F.lane] * F.in[I_LK1][l * 64 + F.lane]), d2 = wave_sum(F.in[I_LQ2][l * 64 + F.lane] * F.in[I_LK2][l * 64 + F.lane]);
            const float lam = expf(d1) - expf(d2) + lam_init;
            const bool split = CONV_SPLIT && F.G == 256 && (l == 0 || (CONV_SPLIT == 2 && l == 1));
            const int half_id = (F.vcu >> 5) * 16 + (F.vcu & 15);
                        if (split && (F.vcu & 16)) { convert_items<CONV_SPLIT_NB>(F, (CONV_SPLIT == 2) ? (l == 0 ? IT_IN : 2 * IT_LAYER) : CONV_SPLIT_LO, (CONV_SPLIT == 2 && l == 0) ? 2 * IT_LAYER : DEPTH * IT_LAYER, half_id * NWAVES + F.wave, 128 * NWAVES);
                if (CONV_SPLIT == 2 && SETUP_DEFER && l == 0) { __syncthreads(); for (int u = NGRP + half_id; u < DEPTH * NGRP; u += 128) ssm_setup_unit(F, u / NGRP, u % NGRP); } }
            else
            for (int rep = 0; rep < REP_ATT; ++rep) for (int pu = split ? half_id : F.vcu; pu < 256; pu += split ? 128 : F.G) {
                const int bh = pu >> 3, pp = pu & 7, b = bh >> 4, h = bh & 15;
#ifndef ATT_V64
                attn_body::build_lut((char*)lds + RING_OFF, F.in[I_RELB], h, F.tid);
#endif
#if defined(PROBE_ATT_QB)
                for (int xr = 0; xr < PROBE_ATT_N; ++xr) { attn_body::UnitArgs ua; ua.kind = 0; ua.qcol = h * 128 + 64; ua.kcol = 0; ua.vcol = 0; ua.ocol = h * 128;
                    ua.relb = F.in[I_RELB]; ua.scr = (float*)(ws + WS_ATT) + (size_t)F.vcu * (2 * 256 * 64); ua.lam = lam; ua.oscale = 1.0f - lam_init; ua.gain = F.in[I_SUBG] + l * 128;
                    attn_body::attn_unit<8>(b, h, PROBE_ATT_QB, (const attn_body::bf16*)QKV, (const attn_body::bf16*)(ws + WS_KI + (size_t)((bh * 2 + 1) * 64) * 8192), (const attn_body::bf16*)(ws + WS_VI + (size_t)(bh * 64) * 16384), (attn_body::bf16*)CAT, (char*)lds + RING_OFF, ua); }
#endif
#ifdef ATT_V64
                for (int qi = 0; qi < 2; ++qi) { const int qb = qi ? 15 - pp : pp;
                    for (int kind = 0; kind < 4; ++kind) { const int s2 = (kind < 2) ? 64 : 0, vh = kind & 1;
                        attn_body::UnitArgs ua; ua.kind = kind; ua.qcol = h * 128 + s2; ua.kcol = 2048 + h * 128 + s2; ua.vcol = 4096 + h * 128 + vh * 64; ua.ocol = h * 128;
#elif defined(ATT_PP)
                for (int qi = 0; qi < 2; ++qi) { const int qb = qi ? 15 - pp : pp;
                    for (int kind = 0; kind < 2; ++kind) { const int s2 = (kind < 1) ? 64 : 0;
                        attn_body::UnitArgs ua; ua.kind = kind; ua.qcol = h * 128 + s2; ua.kcol = 2048 + h * 128 + s2; ua.vcol = 4096 + h * 128; ua.ocol = h * 128;
#else
                for (int qi = 0; qi < 4; ++qi) { const int qb = (qi == 0) ? pp : (qi == 1) ? 15 - pp : (qi == 2) ? 16 + pp : 31 - pp;
                    for (int kind = 0; kind < 2; ++kind) { const int s2 = (kind < 1) ? 64 : 0;
                        attn_body::UnitArgs ua; ua.kind = kind; ua.qcol = h * 128 + s2; ua.kcol = 2048 + h * 128 + s2; ua.vcol = 4096 + h * 128; ua.ocol = h * 128;
#endif
                        ua.relb = F.in[I_RELB]; ua.scr = (float*)(ws + WS_ATT) + (size_t)F.vcu * (2 * 256 * 64); ua.lam = lam; ua.oscale = 1.0f - lam_init; ua.gain = F.in[I_SUBG] + l * 128;
                        attn_body::attn_unit<8>(b, h, qb, (const attn_body::bf16*)QKV, (const attn_body::bf16*)(ws + WS_KI + (size_t)((bh * 2 + (s2 >> 6)) * 64) * 8192), (const attn_body::bf16*)(ws + WS_VI + (size_t)(bh * 64) * 16384), (attn_body::bf16*)CAT, (char*)lds + RING_OFF, ua); } }
            }
            if (BOTH(pb + 1)) GRID_BAR();
        }
        if (IN(pb + 2)) {
            pg8::Gemm g{YG, (const pg8::bf16_t*)(wl + W_GLU), M, 2048, 2048, A_IMG, 1}; pg8::StaticOrder S; S.init(M, 2048, F.G, (int)blockIdx.x);
            pg8::EpiGlu E{YG, CAT, F.in[I_BGLU] + l * 2048};
            for (int rep = 0; rep < REP_GEMM; ++rep) { pg8::gemm_phase<pg8::EpiGlu, pg8::StaticOrder, PG8_ALIGN, PG8_SP2>(F.lds + RING_OFF, g, S, E); __syncthreads(); }
            if (BOTH(pb + 2)) GRID_BAR();
        }
        if (IN(pb + 3)) {
            pg8::Gemm g{CAT, (const pg8::bf16_t*)(wl + W_OUT), M, DMODEL, DMODEL, A_IMG, 1}; pg8::StaticOrder S; S.init(M, DMODEL, F.G, (int)blockIdx.x);
            pg8::EpiRes E{HB, ssq + (2 * l + 1) * M};
            pg8::gemm_phase<pg8::EpiRes, pg8::StaticOrder, PG8_ALIGN, PG8_SP2>(F.lds + RING_OFF, g, S, E);
            if (BOTH(pb + 3)) GRID_BAR();
        }
        if (IN(pb + 4)) {
            pg8::Gemm g{HB, (const pg8::bf16_t*)(wl + W_UP), M, FF, DMODEL, A_IMG, 1}; pg8::StaticOrder S; S.init(M, FF, F.G, (int)blockIdx.x);
            pg8::EpiUp E{HID, FF, ssq + (2 * l + 1) * M};
#ifndef STG_UP
#define STG_UP 0
#endif
#ifndef STG_UP_WAYS
#define STG_UP_WAYS 2
#endif
            if (STG_UP) { const int k_ = F.vcu & (STG_UP_WAYS - 1); for (int s_ = 0; s_ < STG_UP * k_; ++s_) __builtin_amdgcn_s_sleep(48 * 2 / STG_UP_WAYS); }
            for (int rep = 0; rep < REP_GEMM; ++rep) { pg8::gemm_phase<pg8::EpiUp, pg8::StaticOrder, PG8_ALIGN, PG8_SP2>(F.lds + RING_OFF, g, S, E); __syncthreads(); }
            if (BOTH(pb + 4)) GRID_BAR();
        }
        if (IN(pb + 5)) {
            pg8::Gemm g{HID, (const pg8::bf16_t*)(wl + W_DN), M, DMODEL, FF, A_IMG, 1}; pg8::StaticOrder S; S.init(M, DMODEL, F.G, (int)blockIdx.x);
            pg8::EpiRes E{HB, ssq + (2 * l + 2) * M};
            pg8::gemm_phase<pg8::EpiRes, pg8::StaticOrder, PG8_ALIGN, PG8_SP2>(F.lds + RING_OFF, g, S, E);
            if (BOTH(pb + 5)) GRID_BAR();
        }
    }
    if (IN(N_PHASES - 1)) {
        const int gw = F.vcu * NWAVES + F.wave, NGW = F.G * NWAVES; const float* gf = F.in[I_NFIN]; const pg8::ssq_t* sq = ssq + 8 * M;
        f32x4 gq[8][2];
#pragma unroll
        for (int j = 0; j < 8; ++j) { const int c = 8 * (F.lane + 64 * j); gq[j][0] = *(const f32x4*)(gf + c); gq[j][1] = *(const f32x4*)(gf + c + 4); }
        v4u hw[8]; pg8::ssq_t qc = 0;
        if (gw < M) { qc = sq[gw];
#pragma unroll
            for (int j = 0; j < 8; ++j) hw[j] = *(const GAS v4u*)((const GAS unsigned char*)HB + PG8_AOFF(gw, 8 * (F.lane + 64 * j), DMODEL)); }
        for (int m = gw; m < M; m += NGW) { const int mn = m + NGW; v4u hn[8]; pg8::ssq_t qn = 0;
            if (mn < M) { qn = sq[mn];
#pragma unroll
                for (int j = 0; j < 8; ++j) hn[j] = *(const GAS v4u*)((const GAS unsigned char*)HB + PG8_AOFF(mn, 8 * (F.lane + 64 * j), DMODEL)); }
            const float rs = pg8::rstd_of(qc);
#pragma unroll
            for (int j = 0; j < 8; ++j) { const int c = 8 * (F.lane + 64 * j); const v4u w = hw[j];
                const f32x4 h0 = {pg8::bf_lo(w.x), pg8::bf_hi(w.x), pg8::bf_lo(w.y), pg8::bf_hi(w.y)}, h1 = {pg8::bf_lo(w.z), pg8::bf_hi(w.z), pg8::bf_lo(w.w), pg8::bf_hi(w.w)};
                GAS f32x4* o = (GAS f32x4*)(F.out + (size_t)m * DMODEL + c); o[0] = h0 * rs * gq[j][0]; o[1] = h1 * rs * gq[j][1]; }
#pragma unroll
            for (int j = 0; j < 8; ++j) hw[j] = hn[j];
            qc = qn; }
    }
#undef IN
#undef BOTH
}

extern "C" void kernel_launch(void* const* d_in, const int* in_sizes, int n_in, void* d_out, int out_size, void* d_ws, size_t ws_size, hipStream_t stream) {
    static int grid = 0;
    if (grid == 0) {
        if (n_in != N_IN || in_sizes[0] != M * DMODEL || out_size != M * DMODEL || ws_size < WS_END) { fprintf(stderr, "kernel_launch: built for %d inputs, x/out of %d floats, >= %zu bytes of workspace; got n_in %d, in0 %d, out %d, ws %zu; nothing launched\n", (int)N_IN, M * DMODEL, (size_t)WS_END, n_in, n_in > 0 ? in_sizes[0] : -1, out_size, ws_size); grid = -1; return; }
        int dev = 0, cus = 0, per_cu = 0;
        if (hipGetDevice(&dev) != hipSuccess || hipDeviceGetAttribute(&cus, hipDeviceAttributeMultiprocessorCount, dev) != hipSuccess) { fprintf(stderr, "kernel_launch: hipGetDevice / hipDeviceGetAttribute failed; nothing launched\n"); grid = -1; return; }
        if (hipFuncSetAttribute((const void*)hymba_fwd, hipFuncAttributeMaxDynamicSharedMemorySize, LDS_BYTES) != hipSuccess) { fprintf(stderr, "kernel_launch: hipFuncSetAttribute failed\n"); grid = -1; return; }
        if (hipOccupancyMaxActiveBlocksPerMultiprocessor(&per_cu, (const void*)hymba_fwd, NWAVES * 64, LDS_BYTES) != hipSuccess || per_cu < 1)
            fprintf(stderr, "kernel_launch: note: the occupancy query reports %d workgroups per CU\n", per_cu);
        (void)hipGetLastError();
        grid = cus;
    }
    if (grid < 0) return;
    if (hipMemsetAsync((char*)d_ws + WS_CTL, 0, CTL_ZERO_BYTES, stream) != hipSuccess) { fprintf(stderr, "kernel_launch: hipMemsetAsync failed\n"); return; }
    Args a{};
    for (int i = 0; i < N_IN; ++i) a.in[i] = (const float*)d_in[i];
    a.out = (float*)d_out; a.ws = (unsigned char*)d_ws;
#if MK_PER_PHASE
    for (int ph = 0; ph < N_PHASES; ++ph) { a.ph_lo = ph; a.ph_hi = ph + 1; hipLaunchKernelGGL(hymba_fwd, dim3(grid), dim3(NWAVES * 64), LDS_BYTES, stream, a); }
#else
    a.ph_lo = 0; a.ph_hi = N_PHASES; hipLaunchKernelGGL(hymba_fwd, dim3(grid), dim3(NWAVES * 64), LDS_BYTES, stream, a);
#endif
    const hipError_t le = hipPeekAtLastError();
    if (le != hipSuccess) fprintf(stderr, "kernel_launch: launch failed: %s\n", hipGetErrorName(le));
}
```
